# Optimizing an MI355X kernel written in HIP

```python
import math
import jax, jax.numpy as jnp
from jax import lax
import numpy as np

D_MODEL = 1024
BATCH = 4
SEQ = 8192
DEPTH = 2

N_META = 16
PREFIX = 128
BLOCK_Q = 128
N_EVEN = (DEPTH + 1) // 2
N_ODD = DEPTH // 2

POOL_WINDOWS = (2, 4, 8, 16)
N_POOL = len(POOL_WINDOWS)
POOL_GROUP = D_MODEL // 8
POOL_WIDTH = N_POOL * POOL_GROUP

DIFF_HEADS = 4
DIFF_QK_DIM = D_MODEL // 16
DIFF_V_DIM = 2 * DIFF_QK_DIM
DIFF_QK_WIDTH = DIFF_HEADS * 2 * DIFF_QK_DIM
DIFF_WIDTH = DIFF_HEADS * DIFF_V_DIM

EVEN_IN = POOL_WIDTH + 2 * DIFF_QK_WIDTH + DIFF_WIDTH
EVEN_MIX = POOL_WIDTH + DIFF_WIDTH

GLA_HEADS = 4
GLA_DK = D_MODEL // 2 // GLA_HEADS
GLA_DV = D_MODEL // GLA_HEADS
GLA_RANK = 16
GLA_TAU = 16.0
GLA_CHUNK = 64
ODD_IN = 2 * GLA_HEADS * GLA_DK + 2 * GLA_HEADS * GLA_DV + GLA_RANK

N_EXPERTS = 16
N_GROUPS = 4
EXPERTS_PER_GROUP = N_EXPERTS // N_GROUPS
TOP_K = 2
D_EXPERT = 512

ALPHA = (2.0 * DEPTH) ** 0.25
BETA = (8.0 * DEPTH) ** -0.25

kernel_name = 'hybrid_pool_diffattn_gla_groupmoe_deepnorm'


def layer_norm(x, g, b, eps=1e-5):
    xf = x.astype(jnp.float32)
    mu = jnp.mean(xf, -1, keepdims=True)
    var = jnp.mean(jnp.square(xf - mu), -1, keepdims=True)
    return ((xf - mu) * lax.rsqrt(var + eps) * g.astype(jnp.float32) + b.astype(jnp.float32)).astype(x.dtype)


def rms_norm(x, w, eps=1e-6):
    xf = x.astype(jnp.float32)
    return (xf * lax.rsqrt(jnp.mean(xf * xf, -1, keepdims=True) + eps) * w.astype(jnp.float32)).astype(x.dtype)


def pooling_mixer(u, valid, w_group, scale):
    B, L, _ = u.shape
    uf = u.astype(jnp.float32) * valid[None, :, None]
    csum = jnp.cumsum(uf, axis=1)
    ccnt = jnp.cumsum(valid)
    outs = []
    for gi, w in enumerate(POOL_WINDOWS):
        c = csum[..., gi * POOL_GROUP:(gi + 1) * POOL_GROUP]
        win_sum = c - jnp.pad(c, ((0, 0), (w, 0), (0, 0)))[:, :L]
        win_cnt = ccnt - jnp.pad(ccnt, (w, 0))[:L]
        mean = win_sum / jnp.maximum(win_cnt, 1.0)[None, :, None]
        outs.append(mean - uf[..., gi * POOL_GROUP:(gi + 1) * POOL_GROUP])
    d = jnp.stack(outs, axis=2)
    y = jnp.einsum('blgc,gcd->blgd', d, w_group.astype(jnp.float32)).reshape(B, L, POOL_WIDTH)
    return (y * scale.astype(jnp.float32)).astype(u.dtype)


def diff_attention(q, k, v, valid, lam, subln_w, lambda_init):
    B, L = q.shape[:2]
    nb = L // BLOCK_Q
    slopes = 2.0 ** (-8.0 * jnp.arange(1, DIFF_HEADS + 1, dtype=jnp.float32) / DIFF_HEADS)
    kpos = jnp.arange(L)
    key_ok = valid > 0
    scale = DIFF_QK_DIM ** -0.5
    qb = q.reshape(B, nb, BLOCK_Q, DIFF_HEADS, 2, DIFF_QK_DIM).swapaxes(0, 1)

    def block(args):
        qblk, bi = args
        qpos = bi * BLOCK_Q + jnp.arange(BLOCK_Q)
        s = jnp.einsum('bqhmd,bkhmd->bhmqk', qblk, k, preferred_element_type=jnp.float32) * scale
        dist = qpos[:, None] - kpos[None, :]
        allowed = (dist >= 0) & (key_ok[None, :] | (dist == 0))
        bias = -slopes[:, None, None] * dist.astype(jnp.float32)[None]
        s = jnp.where(allowed[None, None, None], s + bias[None, :, None], -jnp.inf)
        p = jax.nn.softmax(s, axis=-1)
        pdiff = p[:, :, 0] - lam * p[:, :, 1]
        return jnp.einsum('bhqk,bkhd->bqhd', pdiff.astype(v.dtype), v)

    o = lax.map(block, (qb, jnp.arange(nb)))
    o = o.swapaxes(0, 1).reshape(B, L, DIFF_HEADS, DIFF_V_DIM)
    o = rms_norm(o, subln_w) * (1.0 - lambda_init)
    return o.reshape(B, L, DIFF_WIDTH)


def gla_chunked(q, k, v, log_a):
    B, L, H, Dk = q.shape
    Dv = v.shape[-1]
    nc = L // GLA_CHUNK

    def to_chunks(t):
        return t.reshape(B, nc, GLA_CHUNK, H, t.shape[-1]).transpose(1, 0, 3, 2, 4)

    qc, kc, vc, ac = to_chunks(q), to_chunks(k), to_chunks(v), to_chunks(log_a)
    causal = jnp.tril(jnp.ones((GLA_CHUNK, GLA_CHUNK), dtype=bool))

    def step(S, inp):
        qi, ki, vi, ai = inp
        qf, kf, vf = qi.astype(jnp.float32), ki.astype(jnp.float32), vi.astype(jnp.float32)
        b = jnp.cumsum(ai.astype(jnp.float32), axis=2)
        inter = jnp.einsum('bhtk,bhkv->bhtv', qf * jnp.exp(b), S)
        rel = b[:, :, :, None, :] - b[:, :, None, :, :]
        decay = jnp.exp(jnp.where(causal[None, None, :, :, None], rel, -jnp.inf))
        att = jnp.einsum('bhtk,bhsk,bhtsk->bhts', qf, kf, decay)
        o = inter + jnp.einsum('bhts,bhsv->bhtv', att, vf)
        b_last = b[:, :, -1:, :]
        S = jnp.exp(b_last[:, :, 0, :, None]) * S + jnp.einsum('bhsk,bhsv->bhkv', kf * jnp.exp(b_last - b), vf)
        return S, o.astype(vi.dtype)

    S0 = jnp.zeros((B, H, Dk, Dv), jnp.float32)
    _, o = lax.scan(step, S0, (qc, kc, vc, ac))
    return o.transpose(1, 0, 3, 2, 4).reshape(B, L, H, Dv)


def even_mixer(h, valid, w_in, pool_w, pool_scale, lq1, lk1, lq2, lk2, subln, w_out, lambda_init):
    B, L, _ = h.shape
    z = h @ w_in
    u_pool, q, k, v = jnp.split(z, [POOL_WIDTH, POOL_WIDTH + DIFF_QK_WIDTH, POOL_WIDTH + 2 * DIFF_QK_WIDTH], axis=-1)
    y_pool = pooling_mixer(u_pool, valid, pool_w, pool_scale)
    lam = (jnp.exp(jnp.sum(lq1.astype(jnp.float32) * lk1.astype(jnp.float32)))
           - jnp.exp(jnp.sum(lq2.astype(jnp.float32) * lk2.astype(jnp.float32))) + lambda_init)
    y_attn = diff_attention(q.reshape(B, L, DIFF_HEADS, 2, DIFF_QK_DIM),
                            k.reshape(B, L, DIFF_HEADS, 2, DIFF_QK_DIM),
                            v.reshape(B, L, DIFF_HEADS, DIFF_V_DIM),
                            valid, lam, subln, lambda_init)
    return jnp.concatenate([y_pool, y_attn], axis=-1) @ w_out


def odd_mixer(h, valid, w_in, gate_w2, gate_b, head_norm, w_out):
    B, L, _ = h.shape
    nqk = GLA_HEADS * GLA_DK
    nv = GLA_HEADS * GLA_DV
    z = h @ w_in
    q, k, v, r, g_lr = jnp.split(z, [nqk, 2 * nqk, 2 * nqk + nv, 2 * nqk + 2 * nv], axis=-1)
    g = (g_lr @ gate_w2 + gate_b).astype(jnp.float32)
    log_a = (jax.nn.log_sigmoid(g) / GLA_TAU).reshape(B, L, GLA_HEADS, GLA_DK)
    q = q.reshape(B, L, GLA_HEADS, GLA_DK) * (GLA_DK ** -0.5)
    k = k.reshape(B, L, GLA_HEADS, GLA_DK) * valid.astype(k.dtype)[None, :, None, None]
    o = gla_chunked(q, k, v.reshape(B, L, GLA_HEADS, GLA_DV), log_a)
    o = rms_norm(o, head_norm) * jax.nn.silu(r).reshape(B, L, GLA_HEADS, GLA_DV)
    return o.reshape(B, L, nv) @ w_out


def grouped_moe(h, router_w, router_bias, w_gate, w_up, w_down):
    B, L, D = h.shape
    xt = h.reshape(-1, D)
    probs = jax.nn.softmax(jnp.dot(xt, router_w, preferred_element_type=jnp.float32), axis=-1)
    sel = (probs + router_bias.astype(jnp.float32)).reshape(-1, N_GROUPS, EXPERTS_PER_GROUP)
    group_score = lax.top_k(sel, TOP_K)[0].sum(-1)
    g = jnp.argmax(group_score, axis=-1)
    sel_g = jnp.take_along_axis(sel, g[:, None, None], axis=1)[:, 0]
    _, local = lax.top_k(sel_g, TOP_K)
    idx = g[:, None] * EXPERTS_PER_GROUP + local
    w = jnp.take_along_axis(probs, idx, axis=1)
    w = w / jnp.sum(w, -1, keepdims=True)
    combine = jnp.sum(jax.nn.one_hot(idx, N_EXPERTS, dtype=jnp.float32) * w[..., None], axis=1)
    y = jnp.zeros(xt.shape, jnp.float32)
    for e in range(N_EXPERTS):
        act = jax.nn.silu(xt @ w_gate[e]) * (xt @ w_up[e])
        y = y + combine[:, e:e + 1] * (act @ w_down[e]).astype(jnp.float32)
    return y.astype(h.dtype).reshape(B, L, D)


def setup_inputs(seed: int = 0) -> dict:
    key = jax.random.key(seed)
    ks = jax.random.split(key, 32)

    def nrm(i, shape, scale):
        return jax.random.normal(ks[i], shape, jnp.float32) * scale

    ne, no = N_EVEN, N_ODD
    return {
        'x': nrm(0, (BATCH, SEQ, D_MODEL), 1.0),
        'meta': nrm(1, (N_META, D_MODEL), 1.0),
        'even_w_in': nrm(2, (ne, D_MODEL, EVEN_IN), D_MODEL ** -0.5),
        'pool_w': nrm(3, (ne, N_POOL, POOL_GROUP, POOL_GROUP), POOL_GROUP ** -0.5),
        'pool_scale': 1.0 + nrm(4, (ne, POOL_WIDTH), 0.02),
        'diff_lq1': nrm(5, (ne, DIFF_QK_DIM), 0.1),
        'diff_lk1': nrm(6, (ne, DIFF_QK_DIM), 0.1),
        'diff_lq2': nrm(7, (ne, DIFF_QK_DIM), 0.1),
        'diff_lk2': nrm(8, (ne, DIFF_QK_DIM), 0.1),
        'diff_subln': 1.0 + nrm(9, (ne, DIFF_V_DIM), 0.02),
        'even_w_out': nrm(10, (ne, EVEN_MIX, D_MODEL), EVEN_MIX ** -0.5 * BETA),
        'odd_w_in': nrm(11, (no, D_MODEL, ODD_IN), D_MODEL ** -0.5),
        'gla_gate_w2': nrm(12, (no, GLA_RANK, GLA_HEADS * GLA_DK), GLA_RANK ** -0.5),
        'gla_gate_b': nrm(13, (no, GLA_HEADS * GLA_DK), 0.1),
        'gla_head_norm': 1.0 + nrm(14, (no, GLA_DV), 0.02),
        'odd_w_out': nrm(15, (no, GLA_HEADS * GLA_DV, D_MODEL), (GLA_HEADS * GLA_DV) ** -0.5 * BETA),
        'ln_mix_g': 1.0 + nrm(16, (DEPTH, D_MODEL), 0.02),
        'ln_mix_b': nrm(17, (DEPTH, D_MODEL), 0.02),
        'ln_ffn_g': 1.0 + nrm(18, (DEPTH, D_MODEL), 0.02),
        'ln_ffn_b': nrm(19, (DEPTH, D_MODEL), 0.02),
        'router_w': nrm(20, (D_MODEL, N_EXPERTS), D_MODEL ** -0.5),
        'router_bias': nrm(21, (N_EXPERTS,), 0.01),
        'moe_w_gate': nrm(22, (DEPTH, N_EXPERTS, D_MODEL, D_EXPERT), D_MODEL ** -0.5),
        'moe_w_up': nrm(23, (DEPTH, N_EXPERTS, D_MODEL, D_EXPERT), D_MODEL ** -0.5),
        'moe_w_down': nrm(24, (DEPTH, N_EXPERTS, D_EXPERT, D_MODEL), D_EXPERT ** -0.5 * BETA),
    }


def reference(x, meta, even_w_in, pool_w, pool_scale, diff_lq1, diff_lk1, diff_lq2, diff_lk2,
              diff_subln, even_w_out, odd_w_in, gla_gate_w2, gla_gate_b, gla_head_norm, odd_w_out,
              ln_mix_g, ln_mix_b, ln_ffn_g, ln_ffn_b, router_w, router_bias,
              moe_w_gate, moe_w_up, moe_w_down):
    B = x.shape[0]
    L = PREFIX + x.shape[1]
    pad = jnp.zeros((B, PREFIX - N_META, D_MODEL), x.dtype)
    metas = jnp.broadcast_to(meta.astype(x.dtype)[None], (B, N_META, D_MODEL))
    h = jnp.concatenate([pad, metas, x], axis=1)
    valid = (jnp.arange(L) >= PREFIX - N_META).astype(jnp.float32)
    for i in range(DEPTH):
        j = i // 2
        if i % 2 == 0:
            lambda_init = 0.8 - 0.6 * math.exp(-0.3 * i)
            mix = even_mixer(h, valid, even_w_in[j], pool_w[j], pool_scale[j], diff_lq1[j], diff_lk1[j],
                             diff_lq2[j], diff_lk2[j], diff_subln[j], even_w_out[j], lambda_init)
        else:
            mix = odd_mixer(h, valid, odd_w_in[j], gla_gate_w2[j], gla_gate_b[j], gla_head_norm[j], odd_w_out[j])
        h = layer_norm(ALPHA * h + mix, ln_mix_g[i], ln_mix_b[i])
        ffn = grouped_moe(h, router_w, router_bias, moe_w_gate[i], moe_w_up[i], moe_w_down[i])
        h = layer_norm(ALPHA * h + ffn, ln_ffn_g[i], ln_ffn_b[i])
    return h[:, PREFIX:]
```

```cpp
#include <hip/hip_runtime.h>
#include <cstdio>
#include <cstdint>

#define GAS __attribute__((address_space(1)))
#define LAS __attribute__((address_space(3)))
typedef unsigned short bf16_t;
typedef short bf16x8 __attribute__((ext_vector_type(8)));
typedef float f32x4 __attribute__((ext_vector_type(4)));
typedef float f32x2 __attribute__((ext_vector_type(2)));
typedef unsigned u32x4 __attribute__((ext_vector_type(4)));
typedef unsigned u32x2 __attribute__((ext_vector_type(2)));

constexpr int D = 1024, NB = 4, SEQ = 8192, NMETA = 16;
constexpr int LB = SEQ + NMETA;
constexpr int M1 = NB * LB;
constexpr int NPANEL = NB * SEQ / 256;
constexpr int EVEN_IN = 2048, ODD_IN = 3088, ODD_IN_PAD = 3328;
constexpr int NEXP = 16, DEXP = 512;
constexpr float ALPHA = 1.41421356237f;
constexpr float LN_EPS = 1e-5f, RMS_EPS = 1e-6f;
constexpr float LOG2E = 1.4426950408889634f;
constexpr float QSCALE0 = 0.125f * LOG2E;
constexpr float QSCALE1 = 0.08838834764831845f;
constexpr float LAMBDA_INIT = 0.2f;

constexpr size_t MiB = 1u << 20;
constexpr size_t WS_CTL = 0;
constexpr size_t CTL_BYTES = 1 * MiB;
constexpr size_t WS_MISC = 1 * MiB;
constexpr size_t WS_METARES = WS_MISC + 65536;
constexpr size_t WS_RW = 2 * MiB;
constexpr size_t WS_LIST = 3 * MiB;
constexpr size_t WS_W = 6 * MiB;
constexpr size_t W_IN0 = WS_W;
constexpr size_t W_OUT0 = W_IN0 + (size_t)2048 * 1024 * 2;
constexpr size_t W_IN1 = W_OUT0 + (size_t)1024 * 1024 * 2;
constexpr size_t W_OUT1 = W_IN1 + (size_t)ODD_IN_PAD * 1024 * 2;
constexpr size_t W_GU = W_OUT1 + (size_t)1024 * 1024 * 2;
constexpr size_t W_DN = W_GU + (size_t)2 * 16 * 1024 * 1024 * 2;
constexpr size_t W_END = W_DN + (size_t)2 * 16 * 1024 * 512 * 2;
constexpr size_t WS_HB = 118 * MiB;
constexpr size_t WS_Z = WS_HB + (size_t)M1 * 1024 * 2;
constexpr size_t WS_T = WS_Z;
constexpr size_t WS_YK = WS_Z;
constexpr size_t WS_OA = WS_Z + (size_t)M1 * ODD_IN * 2;
constexpr size_t WS_A2 = WS_OA + (size_t)M1 * 1024 * 2;
constexpr size_t WS_ACT = WS_OA;
constexpr size_t WS_END = WS_A2 + (size_t)M1 * 1024 * 2;
static_assert(W_END <= WS_HB, "weights fit");
static_assert(WS_END <= (size_t)512 * MiB, "workspace fits 512 MiB");
static_assert((size_t)69888 * 512 * 2 <= (size_t)2 * M1 * 1024 * 2, "ACT fits OA");
constexpr int CW_CNT = 64;
constexpr int LISTCAP = M1;

__device__ __forceinline__ unsigned f2bf(float f) { unsigned u = __builtin_bit_cast(unsigned, f); return (u + 0x7fffu + ((u >> 16) & 1u)) >> 16; }
__device__ __forceinline__ unsigned pk2(float lo, float hi) { return f2bf(lo) | (f2bf(hi) << 16); }
__device__ __forceinline__ float bf2f(unsigned short b) { return __builtin_bit_cast(float, (unsigned)b << 16); }
__device__ __forceinline__ float bflo(unsigned w) { return __builtin_bit_cast(float, w << 16); }
__device__ __forceinline__ float bfhi(unsigned w) { return __builtin_bit_cast(float, w & 0xffff0000u); }
__device__ __forceinline__ unsigned cvt_pk_bf16(float lo, float hi) { unsigned r; asm volatile("v_cvt_pk_bf16_f32 %0, %1, %2" : "=v"(r) : "v"(lo), "v"(hi)); return r; }
__device__ __forceinline__ float wave_sum(float v) {
#pragma unroll
    for (int o = 1; o < 64; o <<= 1) v += __shfl_xor(v, o);
    return v;
}
__device__ __forceinline__ float wave_max(float v) {
#pragma unroll
    for (int o = 1; o < 64; o <<= 1) v = fmaxf(v, __shfl_xor(v, o));
    return v;
}
struct Ptrs {
    const float *x, *meta, *even_w_in, *pool_w, *pool_scale, *lq1, *lk1, *lq2, *lk2, *subln, *even_w_out, *odd_w_in, *gate_w2, *gate_b, *head_norm, *odd_w_out,
        *ln_mix_g, *ln_mix_b, *ln_ffn_g, *ln_ffn_b, *router_w, *router_bias, *moe_w_gate, *moe_w_up, *moe_w_down;
    float* out; unsigned char* ws;
};
__device__ __forceinline__ int panel_row0(int pm) { return (pm >> 5) * LB + NMETA + (pm & 31) * 256; }
__device__ __forceinline__ const float* h0_ptr(const Ptrs& P, int row) { const int b = row / LB, p = row - b * LB; return p < NMETA ? P.meta + (size_t)p * D : P.x + ((size_t)b * SEQ + (p - NMETA)) * D; }
__device__ __forceinline__ float* hres_ptr(const Ptrs& P, int row) { const int b = row / LB, p = row - b * LB; return p < NMETA ? (float*)(P.ws + WS_METARES) + (size_t)(b * NMETA + p) * D : P.out + ((size_t)b * SEQ + (p - NMETA)) * D; }

namespace pg8 {
constexpr int BM = 256, BK = 64, HALF = 128, HTB = HALF * BK * 2, STAGE_BYTES = 8 * HTB, NXCD = 8, WGM = 8;
__host__ __device__ __forceinline__ int lds_byte(int r, int c) { const int st = (r >> 4) * 2 + (c >> 5), rr = r & 15, cc = c & 31, ob = rr * 64 + cc * 2; return st * 1024 + (ob ^ (((ob >> 9) & 1) << 5)); }
__host__ __device__ __forceinline__ void stage_rc(int b, int& R, int& C) { const int st = b / 1024, sb = b % 1024, swz = sb ^ (((sb >> 9) & 1) << 5); R = (st >> 1) * 16 + swz / 64; C = (st & 1) * 32 + (swz % 64) / 2; }
__host__ __device__ __forceinline__ int perm32(int rho) { const int n = rho >> 4, i = rho & 15; return 8 * (i >> 2) + 4 * n + (i & 3); }
struct Unit { int pm, pn, e, lt; };

__device__ __forceinline__ void static_tile(int L, int nM, int nN, int& pm, int& pn) {
    const int nwg = nM * nN; int wgid = L;
    { const int q = nwg / NXCD, r = nwg % NXCD, xcd = wgid % NXCD, off = wgid / NXCD; wgid = (xcd < r ? xcd * (q + 1) : r * (q + 1) + (xcd - r) * q) + off; }
    const int nig = WGM * nN, gid = wgid / nig, fm = gid * WGM, gsz = (nM - fm) < WGM ? (nM - fm) : WGM;
    pm = fm + ((wgid % nig) % gsz); pn = (wgid % nig) / gsz;
}

template <class Epi, class Sched>
__device__ __forceinline__ void gemm_phase(LAS unsigned char* lds, const bf16_t* Abase, const bf16_t* Bbase, const int K, const Sched& S, const Epi& E) {
    const int tid = threadIdx.x, wid = __builtin_amdgcn_readfirstlane(tid >> 6), lane = tid & 63, wr = wid >> 2, wc = wid & 3, fr = lane & 15, fq = lane >> 4;
    const int nt = K / BK;
    int RA[2], CA[2]; unsigned voffB[2];
#pragma unroll
    for (int i = 0; i < 2; ++i) { int R, C; stage_rc(tid * 16 + i * 8192, R, C); const int Rb = Epi::PERM ? ((R & ~31) + perm32(R & 31)) : R;
        RA[i] = R; CA[i] = C; voffB[i] = (unsigned)(Rb * K + C) * 2u; }
    const size_t kstep = (size_t)(BK * 2);
    const size_t hstep = (size_t)HALF * K * 2;
    const unsigned ldsw = (unsigned)wid * 1024u;
    const int aoff = lds_byte(wr * 64 + fr, fq * 8), boff = lds_byte(wc * 32 + fr, fq * 8);
#define PG8_SA(b, h) (((b) * 2 + (h)) * HTB)
#define PG8_SB(b, h) ((4 + (b) * 2 + (h)) * HTB)
#define PG8_STAGEB(bufoff, gbase) do { _Pragma("unroll") for (int _i = 0; _i < 2; ++_i) \
        __builtin_amdgcn_global_load_lds((const unsigned*)((const char*)(gbase) + voffB[_i]), (LAS unsigned*)(lds + (bufoff) + ldsw + _i * 8192), 16, 0, 0); } while (0)
#define PG8_STAGEA(bufoff, kbyte, off2) do { _Pragma("unroll") for (int _i = 0; _i < 2; ++_i) \
        __builtin_amdgcn_global_load_lds((const unsigned*)((const char*)Abase + (kbyte) + (off2)[_i]), (LAS unsigned*)(lds + (bufoff) + ldsw + _i * 8192), 16, 0, 0); } while (0)
#define PG8_LDA(dst, b, h) do { _Pragma("unroll") for (int m = 0; m < 4; ++m) _Pragma("unroll") for (int k = 0; k < 2; ++k) dst[m][k] = *(const LAS bf16x8*)(lds + PG8_SA(b, h) + aoff + m * 2048 + k * 1024); } while (0)
#define PG8_LDB(dst, b, h) do { _Pragma("unroll") for (int n = 0; n < 2; ++n) _Pragma("unroll") for (int k = 0; k < 2; ++k) dst[n][k] = *(const LAS bf16x8*)(lds + PG8_SB(b, h) + boff + n * 2048 + k * 1024); } while (0)
#define PG8_MMA(ai, bj, At, Bt) do { __builtin_amdgcn_s_setprio(1); _Pragma("unroll") for (int m = 0; m < 4; ++m) _Pragma("unroll") for (int n = 0; n < 2; ++n) _Pragma("unroll") for (int k = 0; k < 2; ++k) \
        acc[ai][bj][m][n] = __builtin_amdgcn_mfma_f32_16x16x32_bf16(Bt[n][k], At[m][k], acc[ai][bj][m][n], 0, 0, 0); __builtin_amdgcn_s_setprio(0); } while (0)
#define PG8_WAIT_V(n) asm volatile("s_waitcnt vmcnt(" #n ")" ::: "memory")
#define PG8_WAIT_L(n) asm volatile("s_waitcnt lgkmcnt(" #n ")" ::: "memory")
#define PG8_BAR __builtin_amdgcn_s_barrier()
#define PG8_SCHED __builtin_amdgcn_sched_barrier(0)
#define PG8_AOFFS(dst, u) do { _Pragma("unroll") for (int _h = 0; _h < 2; ++_h) _Pragma("unroll") for (int _i = 0; _i < 2; ++_i) \
        dst[_h][_i] = ((unsigned)S.arow(u, 128 * _h + RA[_i]) * (unsigned)K + (unsigned)CA[_i]) * 2u; } while (0)
    Unit cur, nxt; int ui = 0;
    if (!S.next(0, cur)) return;
    f32x4 acc[2][2][4][2];
#pragma unroll
    for (int a = 0; a < 2; ++a)
#pragma unroll
        for (int b = 0; b < 2; ++b)
#pragma unroll
            for (int m = 0; m < 4; ++m)
#pragma unroll
                for (int n = 0; n < 2; ++n) acc[a][b][m][n] = (f32x4){0.f, 0.f, 0.f, 0.f};
    bf16x8 At[4][2], B0[2][2], B1[2][2];
    unsigned curA[2][2], nxtA[2][2];
    PG8_AOFFS(curA, cur);
    const char* cB = (const char*)Bbase + S.boff(cur) * 2;
    PG8_STAGEB(PG8_SB(0, 0), cB); PG8_STAGEB(PG8_SB(0, 1), cB + hstep); PG8_STAGEA(PG8_SA(0, 0), 0, curA[0]); PG8_STAGEA(PG8_SA(0, 1), 0, curA[1]);
    if (wr == 1) PG8_BAR;
    PG8_WAIT_V(2); PG8_BAR;
    PG8_STAGEB(PG8_SB(1, 0), cB + kstep); PG8_STAGEA(PG8_SA(1, 0), kstep, curA[0]); PG8_STAGEB(PG8_SB(1, 1), cB + hstep + kstep);
    PG8_WAIT_V(6); PG8_BAR;
    for (;;) {
        const bool has_next = S.next(ui + 1, nxt);
        const char* nB = cB;
        if (has_next) { nB = (const char*)Bbase + S.boff(nxt) * 2; PG8_AOFFS(nxtA, nxt); }
        else {
#pragma unroll
            for (int h = 0; h < 2; ++h)
#pragma unroll
                for (int i = 0; i < 2; ++i) nxtA[h][i] = curA[h][i];
        }
        for (int t = 0; t < nt; t += 2) {
            const bool last = (t == nt - 2);
            const size_t k1 = (size_t)(t + 1) * kstep, k2 = last ? 0 : (size_t)(t + 2) * kstep, k3 = k2 + kstep;
            const char* b2 = last ? nB : cB + (size_t)(t + 2) * kstep; const char* b3 = b2 + kstep;
            unsigned o2[2][2];
#pragma unroll
            for (int h = 0; h < 2; ++h)
#pragma unroll
                for (int i = 0; i < 2; ++i) o2[h][i] = last ? nxtA[h][i] : curA[h][i];
            PG8_LDB(B0, 0, 0); PG8_LDB(B1, 0, 1); PG8_SCHED; PG8_LDA(At, 0, 0); PG8_STAGEA(PG8_SA(1, 1), k1, curA[1]);
            PG8_WAIT_V(8); PG8_WAIT_L(0); PG8_BAR; PG8_MMA(0, 0, At, B0); PG8_MMA(0, 1, At, B1); PG8_BAR; PG8_SCHED;
            PG8_LDA(At, 0, 1); PG8_STAGEB(PG8_SB(0, 0), b2); PG8_STAGEB(PG8_SB(0, 1), b2 + hstep); PG8_STAGEA(PG8_SA(0, 0), k2, o2[0]);
            PG8_WAIT_V(8); PG8_WAIT_L(0); PG8_BAR; PG8_MMA(1, 0, At, B0); PG8_MMA(1, 1, At, B1); PG8_BAR; PG8_SCHED;
            PG8_LDB(B0, 1, 0); PG8_LDB(B1, 1, 1); PG8_SCHED; PG8_LDA(At, 1, 0); PG8_STAGEA(PG8_SA(0, 1), k2, o2[1]);
            PG8_WAIT_V(8); PG8_WAIT_L(0); PG8_BAR; PG8_MMA(0, 0, At, B0); PG8_MMA(0, 1, At, B1); PG8_BAR; PG8_SCHED;
            PG8_LDA(At, 1, 1); PG8_STAGEB(PG8_SB(1, 0), b3); PG8_STAGEB(PG8_SB(1, 1), b3 + hstep); PG8_STAGEA(PG8_SA(1, 0), k3, o2[0]);
            PG8_WAIT_V(8); PG8_WAIT_L(0); PG8_BAR; PG8_MMA(1, 0, At, B0); PG8_MMA(1, 1, At, B1); PG8_BAR; PG8_SCHED;
        }
        if (wr == 0) PG8_BAR;
        E(acc, cur, wr, wc, fr, fq, S);
        if (!has_next) break;
#pragma unroll
        for (int a = 0; a < 2; ++a)
#pragma unroll
            for (int b = 0; b < 2; ++b)
#pragma unroll
                for (int m = 0; m < 4; ++m)
#pragma unroll
                    for (int n = 0; n < 2; ++n) acc[a][b][m][n] = (f32x4){0.f, 0.f, 0.f, 0.f};
        cur = nxt; cB = nB; ++ui;
#pragma unroll
        for (int h = 0; h < 2; ++h)
#pragma unroll
            for (int i = 0; i < 2; ++i) curA[h][i] = nxtA[h][i];
        if (wr == 1) PG8_BAR;
    }
    PG8_WAIT_V(0);
    PG8_BAR;
#undef PG8_SA
#undef PG8_SB
#undef PG8_STAGEA
#undef PG8_STAGEB
#undef PG8_LDA
#undef PG8_LDB
#undef PG8_MMA
#undef PG8_WAIT_V
#undef PG8_WAIT_L
#undef PG8_BAR
#undef PG8_SCHED
#undef PG8_AOFFS
}
}
using pg8::Unit;

struct DenseSched {
    int nN, nMain, nTot, G, c; bool meta;
    __device__ void init(int nN_, bool meta_, int G_, int c_) { nN = nN_; nMain = NPANEL * nN_; meta = meta_; nTot = nMain + (meta_ ? nN_ : 0); G = G_; c = c_; }
    __device__ __forceinline__ bool next(int i, Unit& u) const {
        const int L = i * G + c; if (L >= nTot) return false;
        if (L < nMain) pg8::static_tile(L, NPANEL, nN, u.pm, u.pn); else { u.pm = NPANEL; u.pn = L - nMain; }
        u.e = 0; u.lt = 0; return true;
    }
    __device__ __forceinline__ int arow(const Unit& u, int r) const { return u.pm < NPANEL ? panel_row0(u.pm) + r : (r < 64 ? (r >> 4) * LB + (r & 15) : 0); }
    __device__ __forceinline__ int orow(const Unit& u, int r) const { return u.pm < NPANEL ? panel_row0(u.pm) + r : (r < 64 ? (r >> 4) * LB + (r & 15) : -1); }
    __device__ __forceinline__ size_t boff(const Unit& u) const { return (size_t)u.pn * 256 * 1024; }
};
struct MoeSched {
    const LAS int* tstart;
    const LAS int* cnt;
    const int* list;
    int nN, G, c, K; size_t wbase;
    bool gather;
    __device__ __forceinline__ bool next(int i, Unit& u) const {
        const int L = i * G + c, ntile = tstart[16]; if (L >= ntile * nN) return false;
        const int tl = L / nN; u.pn = L - tl * nN; u.pm = tl; int e = 0;
#pragma unroll
        for (int j = 1; j < 16; ++j) e += (tl >= tstart[j]) ? 1 : 0;
        u.e = e; u.lt = tl - tstart[e]; return true;
    }
    __device__ __forceinline__ int slot(const Unit& u, int r) const { const int idx = u.lt * 256 + r; return idx < cnt[u.e] ? list[(size_t)u.e * LISTCAP + idx] : -1; }
    __device__ __forceinline__ int arow(const Unit& u, int r) const {
        if (!gather) return u.pm * 256 + r;
        const int idx = u.lt * 256 + r; const int s = list[(size_t)u.e * LISTCAP + (idx < cnt[u.e] ? idx : 0)]; return s >> 1; }
    __device__ __forceinline__ size_t boff(const Unit& u) const { return wbase + ((size_t)u.e * 1024 + (size_t)u.pn * 256) * K; }
};

struct EpiBf16 {
    static constexpr bool PERM = true;
    bf16_t* O; int ldc, ncols; int sc_lo, sc_hi; float sc;
    template <class Sched> __device__ __forceinline__ void operator()(const f32x4 (&acc)[2][2][4][2], const Unit& u, int wr, int wc, int fr, int fq, const Sched& S) const {
        const float s = (u.pn >= sc_lo && u.pn < sc_hi) ? sc : 1.f;
#pragma unroll
        for (int ai = 0; ai < 2; ++ai)
#pragma unroll
            for (int m = 0; m < 4; ++m) { const int orow = S.orow(u, ai * 128 + wr * 64 + m * 16 + fr);
#pragma unroll
                for (int bj = 0; bj < 2; ++bj) { const int col = u.pn * 256 + bj * 128 + wc * 32 + 8 * fq;
                    const f32x4 v0 = acc[ai][bj][m][0] * s, v1 = acc[ai][bj][m][1] * s;
                    u32x4 w; w.x = cvt_pk_bf16(v0[0], v0[1]); w.y = cvt_pk_bf16(v0[2], v0[3]); w.z = cvt_pk_bf16(v1[0], v1[1]); w.w = cvt_pk_bf16(v1[2], v1[3]);
                    if (orow >= 0 && col < ncols) *(u32x4*)(O + (size_t)orow * ldc + col) = w; } }
    }
};
template <int LAYER> struct EpiResF32 {
    static constexpr bool PERM = false;
    Ptrs P; float* T;
    template <class Sched> __device__ __forceinline__ void operator()(const f32x4 (&acc)[2][2][4][2], const Unit& u, int wr, int wc, int fr, int fq, const Sched& S) const {
#pragma unroll
        for (int ai = 0; ai < 2; ++ai)
#pragma unroll
            for (int m = 0; m < 4; ++m) { const int orow = S.orow(u, ai * 128 + wr * 64 + m * 16 + fr);
                if (orow >= 0) { const float* res = LAYER == 0 ? h0_ptr(P, orow) : (const float*)hres_ptr(P, orow); float* trow = T + (size_t)orow * D;
#pragma unroll
                    for (int bj = 0; bj < 2; ++bj)
#pragma unroll
                        for (int n = 0; n < 2; ++n) { const int col = u.pn * 256 + bj * 128 + wc * 32 + 16 * n + 4 * fq;
                            const f32x4 r = *(const f32x4*)(res + col); *(f32x4*)(trow + col) = r * ALPHA + acc[ai][bj][m][n]; } } }
    }
};
struct EpiSiluMul {
    static constexpr bool PERM = true;
    bf16_t* ACT;
    template <class Sched> __device__ __forceinline__ void operator()(const f32x4 (&acc)[2][2][4][2], const Unit& u, int wr, int wc, int fr, int fq, const Sched& S) const {
#pragma unroll
        for (int ai = 0; ai < 2; ++ai)
#pragma unroll
            for (int m = 0; m < 4; ++m) { const size_t arow = (size_t)u.pm * 256 + ai * 128 + wr * 64 + m * 16 + fr;
#pragma unroll
                for (int bj = 0; bj < 2; ++bj) { const int col = u.pn * 128 + bj * 64 + wc * 16 + 4 * fq;
                    const f32x4 g = acc[ai][bj][m][0], up = acc[ai][bj][m][1]; float a[4];
#pragma unroll
                    for (int i = 0; i < 4; ++i) a[i] = g[i] / (1.f + __expf(-g[i])) * up[i];
                    u32x2 w; w.x = cvt_pk_bf16(a[0], a[1]); w.y = cvt_pk_bf16(a[2], a[3]);
                    *(u32x2*)(ACT + arow * DEXP + col) = w; } }
    }
};
struct EpiScatter {
    static constexpr bool PERM = true;
    bf16_t* YK; const float* RW;
    template <class Sched> __device__ __forceinline__ void operator()(const f32x4 (&acc)[2][2][4][2], const Unit& u, int wr, int wc, int fr, int fq, const Sched& S) const {
#pragma unroll
        for (int ai = 0; ai < 2; ++ai)
#pragma unroll
            for (int m = 0; m < 4; ++m) { const int sl = S.slot(u, ai * 128 + wr * 64 + m * 16 + fr);
                if (sl >= 0) { const float w8 = RW[sl]; bf16_t* yrow = YK + ((size_t)(sl & 1) * M1 + (size_t)(sl >> 1)) * D;
#pragma unroll
                    for (int bj = 0; bj < 2; ++bj) { const int col = u.pn * 256 + bj * 128 + wc * 32 + 8 * fq;
                        const f32x4 v0 = acc[ai][bj][m][0] * w8, v1 = acc[ai][bj][m][1] * w8;
                        u32x4 w; w.x = cvt_pk_bf16(v0[0], v0[1]); w.y = cvt_pk_bf16(v0[2], v0[3]); w.z = cvt_pk_bf16(v1[0], v1[1]); w.w = cvt_pk_bf16(v1[2], v1[3]);
                        *(u32x4*)(yrow + col) = w; } } }
    }
};

template <int MODE> __device__ __forceinline__ int wrow_map(int n) { return MODE == 0 ? n : (8 * (n >> 2) + (n & 3) + (MODE == 2 ? 4 : 0)); }
template <int MODE> __device__ __forceinline__ void transpose_item(const float* W, int srcpitch, int K, int N, bf16_t* WT, int dpitch, int dcol0, LAS float* scr, int item, int lane) {
    const int nblk = (N + 31) / 32, kb = item / nblk, nb = item % nblk, k0 = 64 * kb, n0 = 32 * nb;
#pragma unroll 8
    for (int i = 0; i < 32; ++i) { const int kk = 2 * i + (lane >> 5), n = n0 + (lane & 31); scr[kk * 33 + (lane & 31)] = n < N ? W[(size_t)(k0 + kk) * srcpitch + n] : 0.f; }
    asm volatile("s_waitcnt lgkmcnt(0)" ::: "memory");
    const int c = lane & 7;
#pragma unroll
    for (int j = 0; j < 4; ++j) { const int nl = (lane >> 3) + 8 * j; const LAS float* s = scr + (8 * c) * 33 + nl;
        u32x4 o; o.x = pk2(s[0 * 33], s[1 * 33]); o.y = pk2(s[2 * 33], s[3 * 33]); o.z = pk2(s[4 * 33], s[5 * 33]); o.w = pk2(s[6 * 33], s[7 * 33]);
        if (n0 + nl < N) *(u32x4*)(WT + (size_t)wrow_map<MODE>(n0 + nl) * dpitch + dcol0 + k0 + 8 * c) = o; }
    asm volatile("s_waitcnt lgkmcnt(0)" ::: "memory");
}
__device__ __forceinline__ void stage_prep(const Ptrs& P, LAS unsigned char* lds, int wg, int nwg) {
    const int tid = threadIdx.x, lane = tid & 63, wave = tid >> 6;
    LAS float* scr = (LAS float*)(lds + wave * 16384);
    const int gw = wg * 8 + wave, NGW = nwg * 8;
    bf16_t* Win0 = (bf16_t*)(P.ws + W_IN0); bf16_t* Wout0 = (bf16_t*)(P.ws + W_OUT0); bf16_t* Win1 = (bf16_t*)(P.ws + W_IN1); bf16_t* Wout1 = (bf16_t*)(P.ws + W_OUT1);
    bf16_t* Wgu = (bf16_t*)(P.ws + W_GU); bf16_t* Wdn = (bf16_t*)(P.ws + W_DN);
    constexpr int I_IN0 = 16 * 64, I_OUT0 = 8 * 32, I_IN1 = 16 * 97, I_OUT1 = 16 * 32, I_G = 32 * 256, I_U = 32 * 256, I_D = 32 * 256;
    constexpr int NITEMS = I_IN0 + I_OUT0 + I_IN1 + I_OUT1 + I_G + I_U + I_D;
    for (int it = gw; it < NITEMS; it += NGW) {
        int r = it;
        if (r < I_IN0) { transpose_item<0>(P.even_w_in, EVEN_IN, 1024, EVEN_IN, Win0, 1024, 0, scr, r, lane); continue; } r -= I_IN0;
        if (r < I_OUT0) { transpose_item<0>(P.even_w_out + (size_t)512 * 1024, 1024, 512, 1024, Wout0, 1024, 512, scr, r, lane); continue; } r -= I_OUT0;
        if (r < I_IN1) { transpose_item<0>(P.odd_w_in, ODD_IN, 1024, ODD_IN, Win1, 1024, 0, scr, r, lane); continue; } r -= I_IN1;
        if (r < I_OUT1) { transpose_item<0>(P.odd_w_out, 1024, 1024, 1024, Wout1, 1024, 0, scr, r, lane); continue; } r -= I_OUT1;
        if (r < I_G) { const int le = r >> 8; transpose_item<1>(P.moe_w_gate + (size_t)le * 1024 * 512, 512, 1024, 512, Wgu + (size_t)le * 1024 * 1024, 1024, 0, scr, r & 255, lane); continue; } r -= I_G;
        if (r < I_U) { const int le = r >> 8; transpose_item<2>(P.moe_w_up + (size_t)le * 1024 * 512, 512, 1024, 512, Wgu + (size_t)le * 1024 * 1024, 1024, 0, scr, r & 255, lane); continue; } r -= I_U;
        { const int le = r >> 8; transpose_item<0>(P.moe_w_down + (size_t)le * 512 * 1024, 1024, 512, 1024, Wdn + (size_t)le * 1024 * 512, 512, 0, scr, r & 255, lane); }
    }
    for (int it = gw; it < 512 * 16; it += NGW) {
        const int cp = it >> 4, n = (it & 15) * 64 + lane, g = cp >> 7, c = cp & 127;
        const float* pw = P.pool_w + ((size_t)g * 128 + c) * 128; const float* ps = P.pool_scale + g * 128; const float* wo = P.even_w_out + (size_t)(g * 128) * 1024 + n;
        float a = 0.f;
        for (int d = 0; d < 128; ++d) a += pw[d] * ps[d] * wo[(size_t)d * 1024];
        Wout0[(size_t)n * 1024 + cp] = (bf16_t)f2bf(a);
    }
    for (int i = (wg * 512 + tid); i < (ODD_IN_PAD - ODD_IN) * 1024 / 8; i += nwg * 512) *(u32x4*)(Win1 + (size_t)ODD_IN * 1024 + (size_t)i * 8) = (u32x4){0u, 0u, 0u, 0u};
    bf16_t* Hb = (bf16_t*)(P.ws + WS_HB);
    for (int row = gw; row < M1; row += NGW) { const f32x4* xr = (const f32x4*)h0_ptr(P, row) + lane; unsigned long long* o8 = (unsigned long long*)(Hb + (size_t)row * D) + lane;
#pragma unroll
        for (int j = 0; j < 4; ++j) { const f32x4 v = xr[64 * j]; o8[64 * j] = (unsigned long long)pk2(v.x, v.y) | ((unsigned long long)pk2(v.z, v.w) << 32); } }
    if (wg == 0 && tid == 0) { float s1 = 0.f, s2 = 0.f; for (int i = 0; i < 64; ++i) { s1 += P.lq1[i] * P.lk1[i]; s2 += P.lq2[i] * P.lk2[i]; }
        ((float*)(P.ws + WS_MISC))[0] = __expf(s1) - __expf(s2) + LAMBDA_INIT; }
}

__device__ __forceinline__ void stage_pool(const Ptrs& P, int wg, int nwg) {
    const bf16_t* Z = (const bf16_t*)(P.ws + WS_Z); bf16_t* A2 = (bf16_t*)(P.ws + WS_A2);
    for (int it = wg * 512 + threadIdx.x; it < M1 * 64; it += nwg * 512) {
        const int row = it >> 6, ch = it & 63, gi = ch >> 4, w = 2 << gi; const int p = row % LB; const int cnt = (p + 1) < w ? (p + 1) : w;
        float s[8];
#pragma unroll
        for (int i = 0; i < 8; ++i) s[i] = 0.f;
        u32x4 self = (u32x4){0u, 0u, 0u, 0u};
        for (int j = 0; j < cnt; ++j) { const u32x4 v = *(const u32x4*)(Z + (size_t)(row - j) * EVEN_IN + ch * 8); if (j == 0) self = v;
            s[0] += bflo(v.x); s[1] += bfhi(v.x); s[2] += bflo(v.y); s[3] += bfhi(v.y); s[4] += bflo(v.z); s[5] += bfhi(v.z); s[6] += bflo(v.w); s[7] += bfhi(v.w); }
        const float inv = 1.f / (float)cnt;
        u32x4 o; o.x = pk2(s[0] * inv - bflo(self.x), s[1] * inv - bfhi(self.x)); o.y = pk2(s[2] * inv - bflo(self.y), s[3] * inv - bfhi(self.y));
        o.z = pk2(s[4] * inv - bflo(self.z), s[5] * inv - bfhi(self.z)); o.w = pk2(s[6] * inv - bflo(self.w), s[7] * inv - bfhi(self.w));
        *(u32x4*)(A2 + (size_t)row * D + ch * 8) = o;
    }
}

__device__ __forceinline__ void route16(const float (&lg)[16], const float* bias, int& e0, int& e1, float& w0, float& w1) {
    float mx = lg[0];
#pragma unroll
    for (int e = 1; e < 16; ++e) mx = fmaxf(mx, lg[e]);
    float p[16], sum = 0.f;
#pragma unroll
    for (int e = 0; e < 16; ++e) { p[e] = __expf(lg[e] - mx); sum += p[e]; }
    const float inv = 1.f / sum; float sel[16];
#pragma unroll
    for (int e = 0; e < 16; ++e) { p[e] *= inv; sel[e] = p[e] + bias[e]; }
    int gbest = 0; float gsb = -3.0e38f; int bi0 = 0, bi1 = 1; float bp0 = 0.f, bp1 = 0.f;
#pragma unroll
    for (int g = 0; g < 4; ++g) {
        int i0 = 0; float m0 = sel[4 * g];
#pragma unroll
        for (int i = 1; i < 4; ++i) if (sel[4 * g + i] > m0) { m0 = sel[4 * g + i]; i0 = i; }
        int i1 = (i0 == 0) ? 1 : 0; float m1 = (i0 == 0) ? sel[4 * g + 1] : sel[4 * g];
#pragma unroll
        for (int i = 1; i < 4; ++i) if (i != i0 && i != ((i0 == 0) ? 1 : 0) && sel[4 * g + i] > m1) { m1 = sel[4 * g + i]; i1 = i; }
        const float gs = m0 + m1;
        float q0 = 0.f, q1 = 0.f;
#pragma unroll
        for (int i = 0; i < 4; ++i) { q0 = (i == i0) ? p[4 * g + i] : q0; q1 = (i == i1) ? p[4 * g + i] : q1; }
        if (gs > gsb) { gsb = gs; gbest = g; bi0 = i0; bi1 = i1; bp0 = q0; bp1 = q1; }
    }
    e0 = gbest * 4 + bi0; e1 = gbest * 4 + bi1; const float ws = 1.f / (bp0 + bp1); w0 = bp0 * ws; w1 = bp1 * ws;
}

template <int LAYER> __device__ __forceinline__ void stage_ln_router(const Ptrs& P, LAS unsigned char* lds, int wg, int nwg) {
    const int tid = threadIdx.x, lane = tid & 63, wave = tid >> 6;
    LAS float* rw = (LAS float*)lds; LAS int* lcnt = (LAS int*)(lds + 65536); LAS int* lbase = lcnt + 16; LAS int* ent = lbase + 16;
    const int R = (M1 + nwg - 1) / nwg, r0 = wg * R, r1 = (r0 + R) < M1 ? (r0 + R) : M1;
    for (int i = tid; i < 1024 * 16 / 4; i += 512) ((LAS f32x4*)rw)[i] = ((const f32x4*)P.router_w)[i];
    if (tid < 16) lcnt[tid] = 0;
    __syncthreads();
    const float* T = (const float*)(P.ws + WS_T); bf16_t* Hb = (bf16_t*)(P.ws + WS_HB); float* RW = (float*)(P.ws + WS_RW);
    const float* lg_ = P.ln_mix_g + LAYER * D; const float* lb_ = P.ln_mix_b + LAYER * D;
    for (int row = r0 + wave; row < r1; row += 8) {
        if (LAYER == 1 && (row % LB) < NMETA) { if (lane == 0) { ent[2 * (row - r0)] = -1; ent[2 * (row - r0) + 1] = -1; } continue; }
        const f32x4* tr = (const f32x4*)(T + (size_t)row * D) + lane; f32x4 v[4]; float s = 0.f;
#pragma unroll
        for (int j = 0; j < 4; ++j) { v[j] = tr[64 * j]; s += (v[j].x + v[j].y) + (v[j].z + v[j].w); }
        const float mean = wave_sum(s) * (1.f / D); float s2 = 0.f;
#pragma unroll
        for (int j = 0; j < 4; ++j) { v[j] = v[j] - mean; s2 += (v[j].x * v[j].x + v[j].y * v[j].y) + (v[j].z * v[j].z + v[j].w * v[j].w); }
        const float rstd = 1.f / sqrtf(wave_sum(s2) * (1.f / D) + LN_EPS);
        f32x4* hr = (f32x4*)hres_ptr(P, row) + lane; unsigned long long* o8 = (unsigned long long*)(Hb + (size_t)row * D) + lane;
        float lg[16];
#pragma unroll
        for (int e = 0; e < 16; ++e) lg[e] = 0.f;
#pragma unroll
        for (int j = 0; j < 4; ++j) { const f32x4 g = ((const f32x4*)lg_)[lane + 64 * j], bb = ((const f32x4*)lb_)[lane + 64 * j];
            const f32x4 h = v[j] * rstd * g + bb; hr[64 * j] = h; o8[64 * j] = (unsigned long long)pk2(h.x, h.y) | ((unsigned long long)pk2(h.z, h.w) << 32);
#pragma unroll
            for (int q = 0; q < 4; ++q) { const LAS f32x4* wr_ = (const LAS f32x4*)(rw + (size_t)(4 * lane + 256 * j + q) * 16); const float hv = h[q];
#pragma unroll
                for (int e4 = 0; e4 < 4; ++e4) { const f32x4 w4 = wr_[e4]; lg[4 * e4] += hv * w4.x; lg[4 * e4 + 1] += hv * w4.y; lg[4 * e4 + 2] += hv * w4.z; lg[4 * e4 + 3] += hv * w4.w; } } }
#pragma unroll
        for (int e = 0; e < 16; ++e) lg[e] = wave_sum(lg[e]);
        if (lane == 0) { int e0, e1; float w0, w1; route16(lg, P.router_bias, e0, e1, w0, w1);
            const int li0 = atomicAdd((int*)&lcnt[e0], 1), li1 = atomicAdd((int*)&lcnt[e1], 1);
            ent[2 * (row - r0)] = e0 | (li0 << 8); ent[2 * (row - r0) + 1] = e1 | (li1 << 8);
            RW[2 * (size_t)row] = w0; RW[2 * (size_t)row + 1] = w1; }
    }
    __syncthreads();
    unsigned* gcnt = (unsigned*)(P.ws + WS_CTL) + CW_CNT + 64 * LAYER;
    if (tid < 16) lbase[tid] = (int)atomicAdd(gcnt + tid, (unsigned)lcnt[tid]);
    __syncthreads();
    int* list = (int*)(P.ws + WS_LIST);
    for (int i = tid; i < 2 * (r1 - r0); i += 512) { const int en = ent[i]; if (en >= 0) { const int e = en & 0xff, li = en >> 8; list[(size_t)e * LISTCAP + lbase[e] + li] = (r0 + (i >> 1)) * 2 + (i & 1); } }
    __syncthreads();
}

template <int LAYER> __device__ __forceinline__ void stage_ln2(const Ptrs& P, int wg, int nwg) {
    const int tid = threadIdx.x, lane = tid & 63, wave = tid >> 6; const int gw = wg * 8 + wave, NGW = nwg * 8;
    const bf16_t* YK = (const bf16_t*)(P.ws + WS_YK); bf16_t* Hb = (bf16_t*)(P.ws + WS_HB);
    const float* lg_ = P.ln_ffn_g + LAYER * D; const float* lb_ = P.ln_ffn_b + LAYER * D;
    for (int row = gw; row < M1; row += NGW) {
        if (LAYER == 1 && (row % LB) < NMETA) continue;
        f32x4* hr = (f32x4*)hres_ptr(P, row) + lane; const u32x2* y0 = (const u32x2*)(YK + (size_t)row * D) + lane; const u32x2* y1 = (const u32x2*)(YK + ((size_t)M1 + row) * D) + lane;
        f32x4 v[4]; float s = 0.f;
#pragma unroll
        for (int j = 0; j < 4; ++j) { const f32x4 h = hr[64 * j]; const u32x2 a = y0[64 * j], b = y1[64 * j];
            v[j].x = h.x * ALPHA + bflo(a.x) + bflo(b.x); v[j].y = h.y * ALPHA + bfhi(a.x) + bfhi(b.x); v[j].z = h.z * ALPHA + bflo(a.y) + bflo(b.y); v[j].w = h.w * ALPHA + bfhi(a.y) + bfhi(b.y);
            s += (v[j].x + v[j].y) + (v[j].z + v[j].w); }
        const float mean = wave_sum(s) * (1.f / D); float s2 = 0.f;
#pragma unroll
        for (int j = 0; j < 4; ++j) { v[j] = v[j] - mean; s2 += (v[j].x * v[j].x + v[j].y * v[j].y) + (v[j].z * v[j].z + v[j].w * v[j].w); }
        const float rstd = 1.f / sqrtf(wave_sum(s2) * (1.f / D) + LN_EPS);
        unsigned long long* o8 = (unsigned long long*)(Hb + (size_t)row * D) + lane;
#pragma unroll
        for (int j = 0; j < 4; ++j) { const f32x4 g = ((const f32x4*)lg_)[lane + 64 * j], bb = ((const f32x4*)lb_)[lane + 64 * j];
            const f32x4 h = v[j] * rstd * g + bb; hr[64 * j] = h;
            if (LAYER == 0) o8[64 * j] = (unsigned long long)pk2(h.x, h.y) | ((unsigned long long)pk2(h.z, h.w) << 32); }
    }
}

__device__ __forceinline__ void attn_naive_item(const Ptrs& P, int row, int h, LAS float* qs, int lane) {
    const bf16_t* Z = (const bf16_t*)(P.ws + WS_Z); bf16_t* A2 = (bf16_t*)(P.ws + WS_A2);
    const int b = row / LB, p = row - b * LB, rowb = b * LB;
    const bf16_t* zq = Z + (size_t)row * EVEN_IN + 512 + h * 128;
    qs[lane] = bf2f(zq[lane]); qs[64 + lane] = bf2f(zq[64 + lane]);
    asm volatile("s_waitcnt lgkmcnt(0)" ::: "memory");
    const float slope2 = exp2f(-2.f * (float)(h + 1)) * LOG2E;
    float m0 = -INFINITY, m1 = -INFINITY, l0 = 0.f, l1 = 0.f, o00 = 0.f, o01 = 0.f, o10 = 0.f, o11 = 0.f;
    for (int j0 = 0; j0 <= p; j0 += 64) {
        const int j = j0 + lane; const bool valid = j <= p; float s0 = -INFINITY, s1 = -INFINITY;
        if (valid) { const u32x4* kr = (const u32x4*)(Z + (size_t)(rowb + j) * EVEN_IN + 1024 + h * 128); float d0 = 0.f, d1 = 0.f;
#pragma unroll
            for (int c = 0; c < 8; ++c) { const u32x4 kv = kr[c]; const LAS float* q = qs + 8 * c;
                d0 += q[0] * bflo(kv.x) + q[1] * bfhi(kv.x) + q[2] * bflo(kv.y) + q[3] * bfhi(kv.y) + q[4] * bflo(kv.z) + q[5] * bfhi(kv.z) + q[6] * bflo(kv.w) + q[7] * bfhi(kv.w); }
#pragma unroll
            for (int c = 8; c < 16; ++c) { const u32x4 kv = kr[c]; const LAS float* q = qs + 8 * c;
                d1 += q[0] * bflo(kv.x) + q[1] * bfhi(kv.x) + q[2] * bflo(kv.y) + q[3] * bfhi(kv.y) + q[4] * bflo(kv.z) + q[5] * bfhi(kv.z) + q[6] * bflo(kv.w) + q[7] * bfhi(kv.w); }
            const float bias = -slope2 * (float)(p - j); s0 = d0 + bias; s1 = d1 + bias; }
        const float mn0 = fmaxf(m0, wave_max(s0)), mn1 = fmaxf(m1, wave_max(s1));
        const float f0 = exp2f(m0 - mn0), f1 = exp2f(m1 - mn1);
        const float p0 = valid ? exp2f(s0 - mn0) : 0.f, p1 = valid ? exp2f(s1 - mn1) : 0.f;
        l0 = l0 * f0 + wave_sum(p0); l1 = l1 * f1 + wave_sum(p1); o00 *= f0; o01 *= f0; o10 *= f1; o11 *= f1; m0 = mn0; m1 = mn1;
        const int nk = (p - j0 + 1) < 64 ? (p - j0 + 1) : 64;
        const bf16_t* vr = Z + (size_t)(rowb + j0) * EVEN_IN + 1536 + h * 128 + lane;
        for (int jj = 0; jj < nk; ++jj) { const float a0 = __shfl(p0, jj), a1 = __shfl(p1, jj); const float v0 = bf2f(vr[(size_t)jj * EVEN_IN]), v1 = bf2f(vr[(size_t)jj * EVEN_IN + 64]);
            o00 += a0 * v0; o01 += a0 * v1; o10 += a1 * v0; o11 += a1 * v1; }
    }
    const float lam = ((const float*)(P.ws + WS_MISC))[0];
    const float a0 = o00 / l0 - lam * o10 / l1, a1 = o01 / l0 - lam * o11 / l1;
    const float r = 1.f / sqrtf(wave_sum(a0 * a0 + a1 * a1) * (1.f / 128.f) + RMS_EPS);
    bf16_t* o = A2 + (size_t)row * D + 512 + h * 128;
    o[lane] = (bf16_t)f2bf(a0 * r * P.subln[lane] * (1.f - LAMBDA_INIT)); o[64 + lane] = (bf16_t)f2bf(a1 * r * P.subln[64 + lane] * (1.f - LAMBDA_INIT));
}

__global__ void __launch_bounds__(512, 2) k_prep(Ptrs P) { extern __shared__ __attribute__((aligned(16))) unsigned char lds[]; stage_prep(P, (LAS unsigned char*)lds, blockIdx.x, gridDim.x); }
__global__ void __launch_bounds__(512, 2) k_pool(Ptrs P) { stage_pool(P, blockIdx.x, gridDim.x); }
template <int LAYER> __global__ void __launch_bounds__(512, 2) k_ln_router(Ptrs P) { extern __shared__ __attribute__((aligned(16))) unsigned char lds[]; stage_ln_router<LAYER>(P, (LAS unsigned char*)lds, blockIdx.x, gridDim.x); }
template <int LAYER> __global__ void __launch_bounds__(512, 2) k_ln2(Ptrs P) { stage_ln2<LAYER>(P, blockIdx.x, gridDim.x); }
__global__ void __launch_bounds__(512, 2) k_attn_naive(Ptrs P) {
    __shared__ float qs[8][128]; const int lane = threadIdx.x & 63, wave = threadIdx.x >> 6;
    for (int it = blockIdx.x * 8 + wave; it < M1 * 4; it += gridDim.x * 8) attn_naive_item(P, it >> 2, it & 3, (LAS float*)qs[wave], lane);
}
__global__ void __launch_bounds__(256) k_gla_naive(Ptrs P) {
    __shared__ float sq[16][128], sk[16][128], sa[16][128], so[16][256], red[16][4];
    const int bh = blockIdx.x, b = bh >> 2, h = bh & 3, tid = threadIdx.x, lane = tid & 63, wave = tid >> 6;
    const bf16_t* Z = (const bf16_t*)(P.ws + WS_Z); bf16_t* A2 = (bf16_t*)(P.ws + WS_A2);
    float S[128];
#pragma unroll
    for (int c = 0; c < 128; ++c) S[c] = 0.f;
    const float hn = P.head_norm[tid];
    for (int p0 = 0; p0 < LB; p0 += 16) {
        for (int it = tid; it < 2048; it += 256) { const int s = it >> 7, c = it & 127; const bf16_t* zr = Z + (size_t)(b * LB + p0 + s) * ODD_IN;
            float g = P.gate_b[h * 128 + c];
#pragma unroll
            for (int j = 0; j < 16; ++j) g += bf2f(zr[3072 + j]) * P.gate_w2[j * 512 + h * 128 + c];
            const float ls = fminf(g, 0.f) - log1pf(__expf(-fabsf(g)));
            sq[s][c] = bf2f(zr[h * 128 + c]); sk[s][c] = bf2f(zr[512 + h * 128 + c]); sa[s][c] = __expf(ls * (1.f / 16.f)); }
        __syncthreads();
#pragma unroll 1
        for (int s = 0; s < 16; ++s) { const float v = bf2f(Z[(size_t)(b * LB + p0 + s) * ODD_IN + 1024 + h * 256 + tid]); float acc = 0.f;
#pragma unroll
            for (int c = 0; c < 128; ++c) { S[c] = sa[s][c] * S[c] + sk[s][c] * v; acc += sq[s][c] * S[c]; }
            so[s][tid] = acc; const float ss = wave_sum(acc * acc); if (lane == 0) red[s][wave] = ss; }
        __syncthreads();
#pragma unroll 1
        for (int s = 0; s < 16; ++s) { const size_t row = (size_t)(b * LB + p0 + s); const float tot = red[s][0] + red[s][1] + red[s][2] + red[s][3]; const float r = 1.f / sqrtf(tot * (1.f / 256.f) + RMS_EPS);
            const float rr = bf2f(Z[row * ODD_IN + 2048 + h * 256 + tid]); const float y = so[s][tid] * r * hn * (rr / (1.f + __expf(-rr)));
            A2[row * D + h * 256 + tid] = (bf16_t)f2bf(y); }
        __syncthreads();
    }
}
enum GemmKind { G_IN0 = 0, G_OUT0, G_GU0, G_DN0, G_IN1, G_OUT1, G_GU1, G_DN1 };
__device__ __forceinline__ void moe_setup(const Ptrs& P, int layer, LAS int* tstart, LAS int* cnt) {
    if (threadIdx.x == 0) { const unsigned* g = (const unsigned*)(P.ws + WS_CTL) + CW_CNT + 64 * layer; int acc = 0;
        for (int e = 0; e < 16; ++e) { const int c = (int)__hip_atomic_load(g + e, __ATOMIC_RELAXED, __HIP_MEMORY_SCOPE_AGENT); cnt[e] = c; tstart[e] = acc; acc += (c + 255) >> 8; } tstart[16] = acc; }
    __syncthreads();
}
template <int KIND> __device__ __forceinline__ void stage_gemm(const Ptrs& P, LAS unsigned char* lds, int wg, int nwg) {
    LAS unsigned char* ring = lds; LAS int* tstart = (LAS int*)(lds + pg8::STAGE_BYTES); LAS int* cnt = tstart + 32;
    const bf16_t* Hb = (const bf16_t*)(P.ws + WS_HB); bf16_t* Z = (bf16_t*)(P.ws + WS_Z); const bf16_t* A2 = (const bf16_t*)(P.ws + WS_A2); float* T = (float*)(P.ws + WS_T);
    bf16_t* ACT = (bf16_t*)(P.ws + WS_ACT); bf16_t* YK = (bf16_t*)(P.ws + WS_YK);
    if constexpr (KIND == G_IN0) { DenseSched S; S.init(EVEN_IN / 256, true, nwg, wg); EpiBf16 E{Z, EVEN_IN, EVEN_IN, 2, 4, QSCALE0};
        pg8::gemm_phase(ring, Hb, (const bf16_t*)(P.ws + W_IN0), 1024, S, E); }
    else if constexpr (KIND == G_OUT0) { DenseSched S; S.init(4, true, nwg, wg); EpiResF32<0> E{P, T};
        pg8::gemm_phase(ring, A2, (const bf16_t*)(P.ws + W_OUT0), 1024, S, E); }
    else if constexpr (KIND == G_IN1) { DenseSched S; S.init(ODD_IN_PAD / 256, true, nwg, wg); EpiBf16 E{Z, ODD_IN, ODD_IN, 0, 2, QSCALE1};
        pg8::gemm_phase(ring, Hb, (const bf16_t*)(P.ws + W_IN1), 1024, S, E); }
    else if constexpr (KIND == G_OUT1) { DenseSched S; S.init(4, false, nwg, wg); EpiResF32<1> E{P, T};
        pg8::gemm_phase(ring, A2, (const bf16_t*)(P.ws + W_OUT1), 1024, S, E); }
    else if constexpr (KIND == G_GU0 || KIND == G_GU1) { constexpr int layer = KIND == G_GU0 ? 0 : 1; moe_setup(P, layer, tstart, cnt);
        MoeSched S{tstart, cnt, (const int*)(P.ws + WS_LIST), 4, nwg, wg, 1024, (size_t)layer * 16 * 1024 * 1024, true}; EpiSiluMul E{ACT};
        pg8::gemm_phase(ring, Hb, (const bf16_t*)(P.ws + W_GU), 1024, S, E); }
    else { constexpr int layer = KIND == G_DN0 ? 0 : 1; moe_setup(P, layer, tstart, cnt);
        MoeSched S{tstart, cnt, (const int*)(P.ws + WS_LIST), 4, nwg, wg, 512, (size_t)layer * 16 * 1024 * 512, false}; EpiScatter E{YK, (const float*)(P.ws + WS_RW)};
        pg8::gemm_phase(ring, ACT, (const bf16_t*)(P.ws + W_DN), 512, S, E); }
}
template <int KIND> __global__ void __launch_bounds__(512, 2) k_gemm(Ptrs P) { extern __shared__ __attribute__((aligned(16))) unsigned char lds[]; stage_gemm<KIND>(P, (LAS unsigned char*)lds, blockIdx.x, gridDim.x); }

constexpr int LDS_BYTES = 147456;
extern "C" void kernel_launch(void* const* d_in, const int* in_sizes, int n_in, void* d_out, int out_size, void* d_ws, size_t ws_size, hipStream_t stream) {
    if (n_in != 25 || ws_size < WS_END) { fprintf(stderr, "kernel_launch: bad args n_in %d ws %zu (need %zu)\n", n_in, ws_size, (size_t)WS_END); return; }
    Ptrs P{};
    const float** pp = (const float**)&P;
    for (int i = 0; i < 25; ++i) pp[i] = (const float*)d_in[i];
    P.out = (float*)d_out; P.ws = (unsigned char*)d_ws;
    static bool attr = false;
    if (!attr) { attr = true;
#define SETA(k) (void)hipFuncSetAttribute((const void*)(k), hipFuncAttributeMaxDynamicSharedMemorySize, LDS_BYTES)
        SETA(k_prep); SETA(k_ln_router<0>); SETA(k_ln_router<1>);
        SETA(k_gemm<G_IN0>); SETA(k_gemm<G_OUT0>); SETA(k_gemm<G_GU0>); SETA(k_gemm<G_DN0>); SETA(k_gemm<G_IN1>); SETA(k_gemm<G_OUT1>); SETA(k_gemm<G_GU1>); SETA(k_gemm<G_DN1>);
    }
    (void)hipMemsetAsync((char*)d_ws + WS_CTL, 0, CTL_BYTES, stream);
    const dim3 G(256), B(512);
    hipLaunchKernelGGL(k_prep, G, B, LDS_BYTES, stream, P);
    hipLaunchKernelGGL(k_gemm<G_IN0>, G, B, LDS_BYTES, stream, P);
    hipLaunchKernelGGL(k_attn_naive, dim3(2048), B, 0, stream, P);
    hipLaunchKernelGGL(k_pool, dim3(1024), B, 0, stream, P);
    hipLaunchKernelGGL(k_gemm<G_OUT0>, G, B, LDS_BYTES, stream, P);
    hipLaunchKernelGGL(k_ln_router<0>, G, B, LDS_BYTES, stream, P);
    hipLaunchKernelGGL(k_gemm<G_GU0>, G, B, LDS_BYTES, stream, P);
    hipLaunchKernelGGL(k_gemm<G_DN0>, G, B, LDS_BYTES, stream, P);
    hipLaunchKernelGGL(k_ln2<0>, dim3(1024), B, 0, stream, P);
    hipLaunchKernelGGL(k_gemm<G_IN1>, G, B, LDS_BYTES, stream, P);
    hipLaunchKernelGGL(k_gla_naive, dim3(16), dim3(256), 0, stream, P);
    hipLaunchKernelGGL(k_gemm<G_OUT1>, G, B, LDS_BYTES, stream, P);
    hipLaunchKernelGGL(k_ln_router<1>, G, B, LDS_BYTES, stream, P);
    hipLaunchKernelGGL(k_gemm<G_GU1>, G, B, LDS_BYTES, stream, P);
    hipLaunchKernelGGL(k_gemm<G_DN1>, G, B, LDS_BYTES, stream, P);
    hipLaunchKernelGGL(k_ln2<1>, dim3(1024), B, 0, stream, P);
}
```

```cpp
#include <hip/hip_runtime.h>
#include <cstdio>
#include <cstdint>

#ifndef PROBE_FLAGS
#define PROBE_FLAGS 0
#endif
#ifndef PROBE_DUP
#define PROBE_DUP 0u
#endif
#define GAS __attribute__((address_space(1)))
#define LAS __attribute__((address_space(3)))
typedef unsigned short bf16_t;
typedef short bf16x8 __attribute__((ext_vector_type(8)));
typedef float f32x4 __attribute__((ext_vector_type(4)));
typedef float f32x2 __attribute__((ext_vector_type(2)));
typedef float f32x16 __attribute__((ext_vector_type(16)));
typedef unsigned u32x4 __attribute__((ext_vector_type(4)));
typedef unsigned u32x2 __attribute__((ext_vector_type(2)));

constexpr int D = 1024, NB = 4, SEQ = 8192, NMETA = 16;
constexpr int LB = SEQ + NMETA;
constexpr int M1 = NB * LB;
constexpr int NPANEL = NB * SEQ / 256;
constexpr int EVEN_IN = 2048, ODD_IN = 3088, ODD_N = 3072;
constexpr int NEXP = 16, DEXP = 512;
constexpr float ALPHA = 1.41421356237f;
constexpr float LN_EPS = 1e-5f, RMS_EPS = 1e-6f;
constexpr float LOG2E = 1.4426950408889634f;
constexpr float QSCALE0 = 0.125f * LOG2E;
constexpr float QSCALE1 = 0.08838834764831845f;
constexpr float LAMBDA_INIT = 0.2f;

constexpr size_t MiB = 1u << 20;
constexpr size_t WS_CTL = 0;
constexpr size_t CTL_BYTES = 1 * MiB;
constexpr size_t WS_MISC = 1 * MiB;
constexpr size_t WS_RW = 2 * MiB;
constexpr size_t WS_LIST = 3 * MiB;
constexpr size_t WS_GLR = 5 * MiB + 262144;
constexpr size_t WS_W = 8 * MiB;
constexpr size_t W_IN0 = WS_W;
constexpr size_t W_OUT0 = W_IN0 + (size_t)2048 * 1024 * 2;
constexpr size_t W_IN1 = W_OUT0 + (size_t)1024 * 1024 * 2;
constexpr size_t W_IN18 = W_IN1 + (size_t)ODD_N * 1024 * 2;
constexpr size_t W_OUT1 = W_IN18 + (size_t)ODD_N * 1024;
constexpr size_t W_OUT08 = W_OUT1 + (size_t)1024 * 1024 * 2;
constexpr size_t W_OUT18 = W_OUT08 + (size_t)1024 * 1024;
constexpr size_t W_GU = W_OUT18 + (size_t)1024 * 1024;
constexpr size_t W_DN = W_GU + (size_t)2 * 16 * 1024 * 1024;
constexpr size_t W_END = W_DN + (size_t)2 * 16 * 1024 * 512;
constexpr size_t WS_HB = 76 * MiB;
constexpr size_t WS_HB8 = WS_HB + (size_t)M1 * 1024 * 2;
constexpr size_t WS_Z = WS_HB8 + (size_t)M1 * 1024 + 524288;
constexpr size_t WS_T = WS_Z;
constexpr size_t WS_YK = WS_Z;
constexpr size_t WS_OA = WS_Z + (size_t)M1 * ODD_N * 2;
constexpr size_t WS_A2 = WS_OA + (size_t)M1 * 1024 * 2;
constexpr size_t WS_A2M = WS_MISC + 65536;
constexpr size_t WS_ACT = WS_OA;
constexpr size_t WS_LISTW = WS_A2 + (size_t)M1 * 1024;
constexpr size_t WS_END = WS_LISTW + (size_t)16 * M1 * 4;
static_assert(W_END <= WS_HB, "weights fit");
static_assert(WS_END <= (size_t)512 * MiB, "workspace fits 512 MiB");
static_assert(WS_LIST + (size_t)16 * M1 * 4 <= WS_GLR && WS_GLR + (size_t)M1 * 64 <= WS_W, "small buffers");
constexpr float F8_YSCALE = 32.f;
constexpr float F8_WSCALE = 32.f, F8_HSCALE = 4.f, F8_ASCALE = 4.f;
constexpr int F8_WSC = 0x7a7a7a7a, F8_HSC = 0x7d7d7d7d, F8_ASC = 0x7d7d7d7d;
constexpr int CW_CNT = 64;
constexpr int LISTCAP = M1;
constexpr int CW_KN = 256;
constexpr int CW_AQ = 512;

__device__ __forceinline__ float bf2f(unsigned short b) { return __builtin_bit_cast(float, (unsigned)b << 16); }
__device__ __forceinline__ float bflo(unsigned w) { return __builtin_bit_cast(float, w << 16); }
__device__ __forceinline__ float bfhi(unsigned w) { return __builtin_bit_cast(float, w & 0xffff0000u); }
typedef __bf16 bf16x2_t __attribute__((ext_vector_type(2)));
__device__ __forceinline__ unsigned cvt_pk_bf16(float lo, float hi) { const f32x2 v = {lo, hi}; const bf16x2_t b = __builtin_convertvector(v, bf16x2_t); return __builtin_bit_cast(unsigned, b); }
__device__ __forceinline__ unsigned pk2(float lo, float hi) { return cvt_pk_bf16(lo, hi); }
__device__ __forceinline__ unsigned f2bf(float f) { return cvt_pk_bf16(f, 0.f) & 0xffffu; }
__device__ __forceinline__ unsigned pk4_fp8(float a, float b, float c, float d) {
    a = fminf(fmaxf(a, -448.f), 448.f); b = fminf(fmaxf(b, -448.f), 448.f); c = fminf(fmaxf(c, -448.f), 448.f); d = fminf(fmaxf(d, -448.f), 448.f);
    int w = 0; w = __builtin_amdgcn_cvt_pk_fp8_f32(a, b, w, false); w = __builtin_amdgcn_cvt_pk_fp8_f32(c, d, w, true); return (unsigned)w; }
__device__ __forceinline__ void fp8x4_to_f32(unsigned w, float (&o)[4]) { const f32x2 a = __builtin_amdgcn_cvt_pk_f32_fp8((int)w, false), b = __builtin_amdgcn_cvt_pk_f32_fp8((int)w, true); o[0] = a.x; o[1] = a.y; o[2] = b.x; o[3] = b.y; }
__device__ __forceinline__ void lds_dma16(const void* gsrc, unsigned lds_dst) { unsigned keep;
    asm volatile("s_mov_b32 %0, m0\n\ts_mov_b32 m0, %2\n\ts_nop 0\n\tglobal_load_lds_dwordx4 %1, off\n\ts_mov_b32 m0, %0" : "=&s"(keep) : "v"(gsrc), "s"(lds_dst) : "memory"); }
__device__ __forceinline__ float wave_sum(float v) {
#pragma unroll
    for (int o = 1; o < 64; o <<= 1) v += __shfl_xor(v, o);
    return v;
}
__device__ __forceinline__ float wave_max(float v) {
#pragma unroll
    for (int o = 1; o < 64; o <<= 1) v = fmaxf(v, __shfl_xor(v, o));
    return v;
}
struct Ptrs {
    const float *x, *meta, *even_w_in, *pool_w, *pool_scale, *lq1, *lk1, *lq2, *lk2, *subln, *even_w_out, *odd_w_in, *gate_w2, *gate_b, *head_norm, *odd_w_out,
        *ln_mix_g, *ln_mix_b, *ln_ffn_g, *ln_ffn_b, *router_w, *router_bias, *moe_w_gate, *moe_w_up, *moe_w_down;
    float* out; unsigned char* ws;
};
constexpr int LDS_WIDTAB = 131072 + 512;
extern __shared__ __attribute__((aligned(16))) unsigned char lds_dyn_alias_[];
__device__ __forceinline__ unsigned hw_wave_key() { return (unsigned)__builtin_amdgcn_s_getreg((5 << 11) | 4) & 0x3fu; }
__device__ __forceinline__ int tid_opaque(const Ptrs&) {
    unsigned z = 0u; asm volatile("" : "+v"(z));
    const int lane = (int)__builtin_amdgcn_mbcnt_hi(~0u, __builtin_amdgcn_mbcnt_lo(~0u, z));
    const int wid = __builtin_amdgcn_readfirstlane(((const volatile LAS int*)((LAS unsigned char*)lds_dyn_alias_ + LDS_WIDTAB))[hw_wave_key()]);
    return wid * 64 + lane;
}
__device__ __forceinline__ int panel_row0(int pm) { return (pm >> 5) * LB + NMETA + (pm & 31) * 256; }
__device__ __forceinline__ const float* h0_ptr(const Ptrs& P, int row) { const int b = row / LB, p = row - b * LB; return p < NMETA ? P.meta + (size_t)p * D : P.x + ((size_t)b * SEQ + (p - NMETA)) * D; }

namespace pg8 {
constexpr int BM = 256, BK = 64, HALF = 128, HTB = HALF * BK * 2, STAGE_BYTES = 8 * HTB, NXCD = 8, WGM = 8;
__host__ __device__ __forceinline__ int lds_byte(int r, int c) { const int st = (r >> 4) * 2 + (c >> 5), rr = r & 15, cc = c & 31, ob = rr * 64 + cc * 2; return st * 1024 + (ob ^ (((ob >> 9) & 1) << 5)); }
__host__ __device__ __forceinline__ void stage_rc(int b, int& R, int& C) { const int st = b / 1024, sb = b % 1024, swz = sb ^ (((sb >> 9) & 1) << 5); R = (st >> 1) * 16 + swz / 64; C = (st & 1) * 32 + (swz % 64) / 2; }
__host__ __device__ __forceinline__ int perm32(int rho) { const int n = rho >> 4, i = rho & 15; return 8 * (i >> 2) + 4 * n + (i & 3); }
struct Unit { int pm, pn, e, lt, hn, par; };

__device__ __forceinline__ void static_tile(int L, int nM, int nN, int& pm, int& pn) {
    const int nwg = nM * nN; int wgid = L;
    { const int q = nwg / NXCD, r = nwg % NXCD, xcd = wgid % NXCD, off = wgid / NXCD; wgid = (xcd < r ? xcd * (q + 1) : r * (q + 1) + (xcd - r) * q) + off; }
    const int nig = WGM * nN, gid = wgid / nig, fm = gid * WGM, gsz = (nM - fm) < WGM ? (nM - fm) : WGM;
    pm = fm + ((wgid % nig) % gsz); pn = (wgid % nig) / gsz;
}

typedef int v8i32 __attribute__((ext_vector_type(8)));
template <class Epi, class Sched, bool F8 = false, bool HN = false>
__device__ __forceinline__ void gemm_phase(LAS unsigned char* lds, const void* Abase, const void* Bbase, const int KA, const int KB_, const Sched& S, const Epi& E, const int tid, const int sclA = 0x7f7f7f7f, const int sclB = 0x7f7f7f7f) {
    const int wid = __builtin_amdgcn_readfirstlane(tid >> 6), lane = tid & 63, wr = wid >> 2, wc = wid & 3, fr = lane & 15, fq = lane >> 4;
    const int nt = KA / 128;
    unsigned voffB[2];
#pragma unroll
    for (int i = 0; i < 2; ++i) { int R, C; stage_rc(tid * 16 + i * 8192, R, C); const int Rb = Epi::PERM ? ((R & ~31) + perm32(R & 31)) : R;
        voffB[i] = (unsigned)(Rb * KB_ + C * 2); }
    const size_t kstep = (size_t)(BK * 2);
    const size_t hstep = (size_t)HALF * KB_;
    const unsigned ldsw = (unsigned)wid * 1024u;
    const int aoff = lds_byte(wr * 64 + fr, fq * 8), boff = lds_byte(wc * 32 + fr, fq * 8);
#define PG8_SA(b, h) (((b) * 2 + (h)) * HTB)
#define PG8_SB(b, h) ((4 + (b) * 2 + (h)) * HTB)
#define PG8_STAGEB(bufoff, gbase) do { _Pragma("unroll") for (int _i = 0; _i < 2; ++_i) \
        __builtin_amdgcn_global_load_lds((const unsigned*)((const char*)(gbase) + voffB[_i]), (LAS unsigned*)(lds + (bufoff) + ldsw + _i * 8192), 16, 0, 0); } while (0)
#define PG8_STAGEA(bufoff, kbyte, off2) do { _Pragma("unroll") for (int _i = 0; _i < 2; ++_i) \
        __builtin_amdgcn_global_load_lds((const unsigned*)((const char*)Abase + (kbyte) + (off2)[_i]), (LAS unsigned*)(lds + (bufoff) + ldsw + _i * 8192), 16, 0, 0); } while (0)
#define PG8_STAGEA2(bufoff, kbyte, h) do { _Pragma("unroll") for (int _i = 0; _i < 2; ++_i) \
        __builtin_amdgcn_global_load_lds((const unsigned*)((const char*)Abase + (kbyte) + (last ? nxtA[h][_i] : curA[h][_i])), (LAS unsigned*)(lds + (bufoff) + ldsw + _i * 8192), 16, 0, 0); } while (0)
#define PG8_CAT(x0, x1) __builtin_shufflevector(x0, x1, 0, 1, 2, 3, 4, 5, 6, 7)
#define PG8_LDA(dst, b, h) do { _Pragma("unroll") for (int m = 0; m < 4; ++m) { \
        if constexpr (F8) dst##8[m] = __builtin_bit_cast(v8i32, PG8_CAT(*(const LAS u32x4*)(lds + PG8_SA(b, h) + aoff + m * 2048), *(const LAS u32x4*)(lds + PG8_SA(b, h) + aoff + m * 2048 + 1024))); \
        else { _Pragma("unroll") for (int k = 0; k < 2; ++k) dst[m][k] = *(const LAS bf16x8*)(lds + PG8_SA(b, h) + aoff + m * 2048 + k * 1024); } } } while (0)
#define PG8_LDB(dst, b, h) do { _Pragma("unroll") for (int n = 0; n < 2; ++n) { \
        if constexpr (F8) dst##8[n] = __builtin_bit_cast(v8i32, PG8_CAT(*(const LAS u32x4*)(lds + PG8_SB(b, h) + boff + n * 2048), *(const LAS u32x4*)(lds + PG8_SB(b, h) + boff + n * 2048 + 1024))); \
        else { _Pragma("unroll") for (int k = 0; k < 2; ++k) dst[n][k] = *(const LAS bf16x8*)(lds + PG8_SB(b, h) + boff + n * 2048 + k * 1024); } } } while (0)
#define PG8_MMA(ai, bj, At, Bt) do { __builtin_amdgcn_s_setprio(1); _Pragma("unroll") for (int m = 0; m < 4; ++m) _Pragma("unroll") for (int n = 0; n < 2; ++n) { \
        if constexpr (F8) asm volatile("v_mfma_scale_f32_16x16x128_f8f6f4 %0, %1, %2, %0, %3, %4 op_sel_hi:[0,0,0]" : "+v"(acc[ai][bj][m][n]) : "v"(Bt##8[n]), "v"(At##8[m]), "v"(sclB), "v"(sclA));     \
        else { _Pragma("unroll") for (int k = 0; k < 2; ++k) acc[ai][bj][m][n] = __builtin_amdgcn_mfma_f32_16x16x32_bf16(Bt[n][k], At[m][k], acc[ai][bj][m][n], 0, 0, 0); } } __builtin_amdgcn_s_setprio(0); } while (0)
#define PG8_WAIT_V(n) asm volatile("s_waitcnt vmcnt(" #n ")" ::: "memory")
#define PG8_WAIT_L(n) asm volatile("s_waitcnt lgkmcnt(" #n ")" ::: "memory")
#define PG8_BAR __builtin_amdgcn_s_barrier()
#define PG8_SCHED __builtin_amdgcn_sched_barrier(0)
#define PG8_AOFFS(dst, u) do { int tl_ = tid; asm volatile("" : "+v"(tl_));     \
        _Pragma("unroll") for (int _i = 0; _i < 2; ++_i) { int R_, C_; stage_rc(tl_ * 16 + _i * 8192, R_, C_); \
            _Pragma("unroll") for (int _h = 0; _h < 2; ++_h) dst[_h][_i] = (unsigned)S.arow(u, 128 * _h + R_) * (unsigned)KA + (unsigned)C_ * 2u; } } while (0)
    Unit cur, nxt; int ui = 0;
    if (!S.next(0, cur)) return;
    cur.par = 0;
    f32x4 acc[2][2][4][2];
#pragma unroll
    for (int a = 0; a < 2; ++a)
#pragma unroll
        for (int b = 0; b < 2; ++b)
#pragma unroll
            for (int m = 0; m < 4; ++m)
#pragma unroll
                for (int n = 0; n < 2; ++n) acc[a][b][m][n] = (f32x4){0.f, 0.f, 0.f, 0.f};
    bf16x8 At[4][2], B0[2][2], B1[2][2];
    v8i32 At8[4], B08[2], B18[2];
    unsigned curA[2][2], nxtA[2][2];
    if constexpr (Sched::LDSLIST) { if (wid == 0) S.dma_list(cur, (unsigned)__builtin_amdgcn_readfirstlane((int)(unsigned)(size_t)S.ltile), lane);
        asm volatile("s_waitcnt vmcnt(0)" ::: "memory"); PG8_BAR; }
    PG8_AOFFS(curA, cur);
    const char* cB = (const char*)Bbase + S.boff(cur);
    PG8_STAGEB(PG8_SB(0, 0), cB); PG8_STAGEB(PG8_SB(0, 1), cB + hstep); PG8_STAGEA(PG8_SA(0, 0), 0, curA[0]); PG8_STAGEA(PG8_SA(0, 1), 0, curA[1]);
    if (wr == 1) PG8_BAR;
    PG8_WAIT_V(2); PG8_BAR;
    PG8_STAGEB(PG8_SB(1, 0), cB + kstep); PG8_STAGEA(PG8_SA(1, 0), kstep, curA[0]); PG8_STAGEB(PG8_SB(1, 1), cB + hstep + kstep);
    PG8_WAIT_V(6); PG8_BAR;
    for (;;) {
        if constexpr (Epi::META) E.prefetch(cur, S, tid);
        const bool has_next = S.next(ui + 1, nxt); nxt.par = (ui + 1) & 1;
        const char* nB = cB;
        if (has_next) { nB = (const char*)Bbase + S.boff(nxt);
            if constexpr (Sched::LDSLIST) { if (wid == 0) S.dma_list(nxt, (unsigned)__builtin_amdgcn_readfirstlane((int)(unsigned)(size_t)S.ltile), lane); }
            else PG8_AOFFS(nxtA, nxt); }
        else {
#pragma unroll
            for (int h = 0; h < 2; ++h)
#pragma unroll
                for (int i = 0; i < 2; ++i) nxtA[h][i] = curA[h][i];
        }
#pragma unroll 1
        for (int t = 0; t < nt; t += 2) {
            const bool last = (t == nt - 2);
            if constexpr (Sched::LDSLIST) { if (last && has_next) PG8_AOFFS(nxtA, nxt); }
            const size_t k1 = (size_t)(t + 1) * kstep, k2 = last ? 0 : (size_t)(t + 2) * kstep, k3 = k2 + kstep;
            const char* b2 = last ? nB : cB + (size_t)(t + 2) * kstep; const char* b3 = b2 + kstep;
            PG8_LDB(B0, 0, 0); if (!HN || !cur.hn) PG8_LDB(B1, 0, 1); PG8_SCHED; PG8_LDA(At, 0, 0); PG8_STAGEA(PG8_SA(1, 1), k1, curA[1]);
            PG8_WAIT_V(8); PG8_WAIT_L(0); PG8_BAR; PG8_MMA(0, 0, At, B0); if (!HN || !cur.hn) PG8_MMA(0, 1, At, B1); PG8_BAR; PG8_SCHED;
            PG8_LDA(At, 0, 1); PG8_STAGEB(PG8_SB(0, 0), b2); PG8_STAGEB(PG8_SB(0, 1), b2 + hstep); PG8_STAGEA2(PG8_SA(0, 0), k2, 0);
            PG8_WAIT_V(8); PG8_WAIT_L(0); PG8_BAR; PG8_MMA(1, 0, At, B0); if (!HN || !cur.hn) PG8_MMA(1, 1, At, B1); PG8_BAR; PG8_SCHED;
            PG8_LDB(B0, 1, 0); if (!HN || !cur.hn) PG8_LDB(B1, 1, 1); PG8_SCHED; PG8_LDA(At, 1, 0); PG8_STAGEA2(PG8_SA(0, 1), k2, 1);
            PG8_WAIT_V(8); PG8_WAIT_L(0); PG8_BAR; PG8_MMA(0, 0, At, B0); if (!HN || !cur.hn) PG8_MMA(0, 1, At, B1); PG8_BAR; PG8_SCHED;
            PG8_LDA(At, 1, 1); PG8_STAGEB(PG8_SB(1, 0), b3); PG8_STAGEB(PG8_SB(1, 1), b3 + hstep); PG8_STAGEA2(PG8_SA(1, 0), k3, 0);
            PG8_WAIT_V(8); PG8_WAIT_L(0); PG8_BAR; PG8_MMA(1, 0, At, B0); if (!HN || !cur.hn) PG8_MMA(1, 1, At, B1); PG8_BAR; PG8_SCHED;
        }
        if (wr == 0) PG8_BAR;
        if constexpr (F8) asm volatile("s_nop 15\n\ts_nop 15" ::: "memory");
        E(acc, cur, wr, wc, fr, fq, S);
        if (!has_next) break;
#pragma unroll
        for (int a = 0; a < 2; ++a)
#pragma unroll
            for (int b = 0; b < 2; ++b)
#pragma unroll
                for (int m = 0; m < 4; ++m)
#pragma unroll
                    for (int n = 0; n < 2; ++n) acc[a][b][m][n] = (f32x4){0.f, 0.f, 0.f, 0.f};
        cur = nxt; cB = nB; ++ui;
#pragma unroll
        for (int h = 0; h < 2; ++h)
#pragma unroll
            for (int i = 0; i < 2; ++i) curA[h][i] = nxtA[h][i];
        if (wr == 1) PG8_BAR;
    }
    PG8_WAIT_V(0);
    PG8_BAR;
#undef PG8_SA
#undef PG8_SB
#undef PG8_STAGEA
#undef PG8_STAGEA2
#undef PG8_STAGEB
#undef PG8_LDA
#undef PG8_LDB
#undef PG8_MMA
#undef PG8_CAT
#undef PG8_WAIT_V
#undef PG8_WAIT_L
#undef PG8_BAR
#undef PG8_SCHED
#undef PG8_AOFFS
}
}
using pg8::Unit;

struct DenseSched {
    static constexpr bool LDSLIST = false;
    int nN, nTot, G, c, kb;
    __device__ void init(int nN_, int G_, int c_, int kb_ = 2048) { nN = nN_; nTot = NPANEL * nN_; G = G_; c = c_; kb = kb_; }
    __device__ __forceinline__ bool next(int i, Unit& u) const {
        const int L = i * G + c; if (L >= nTot) return false;
        pg8::static_tile(L, NPANEL, nN, u.pm, u.pn); u.e = 0; u.lt = 0; u.hn = 0; return true;
    }
    __device__ __forceinline__ int arow(const Unit& u, int r) const { return panel_row0(u.pm) + r; }
    __device__ __forceinline__ int orow(const Unit& u, int r) const { return panel_row0(u.pm) + r; }
    __device__ __forceinline__ size_t boff(const Unit& u) const { return (size_t)u.pn * 256 * kb; }
};
template <bool GATHER> struct MoeSchedT {
    static constexpr bool LDSLIST = GATHER;
    const LAS int* tstart;
    const LAS int* cnt;
    const int* list;
    const float* listw;
    int nN, G, c, K; size_t wbase;
    const LAS int* ltile;
    __device__ __forceinline__ bool next(int i, Unit& u) const {
        const int cx = (G & 7) ? c : (c & 7) * (G >> 3) + (c >> 3);
        const int L = i * G + cx, ntot = tstart[16] * nN;
        const int R0 = (ntot / G) * G, left = ntot - R0; const bool split = left > 0 && 2 * left <= G;
        int Lu = L, hn = 0, hsel = 0;
        if (split && L >= R0) { const int j = L - R0; if (j >= 2 * left) return false; Lu = R0 + (j >> 1); hn = 1; hsel = j & 1; }
        else if (L >= ntot) return false;
        const int tl = Lu / nN; u.pn = 2 * (Lu - tl * nN) + hsel; u.hn = hn; u.pm = tl; int e = 0;
#pragma unroll
        for (int j = 1; j < 16; ++j) e += (tl >= tstart[j]) ? 1 : 0;
        u.e = e; u.lt = tl - tstart[e]; return true;
    }
    __device__ __forceinline__ void dma_list(const Unit& u, unsigned lds_dst, int lane) const { lds_dma16((const char*)(list + (size_t)u.e * LISTCAP + (size_t)u.lt * 256) + lane * 16, lds_dst); }
    __device__ __forceinline__ void dma_listw(const Unit& u, unsigned lds_dst, int lane) const { lds_dma16((const char*)(listw + (size_t)u.e * LISTCAP + (size_t)u.lt * 256) + lane * 16, lds_dst); }
    __device__ __forceinline__ bool valid(const Unit& u, int r) const { return u.lt * 256 + r < cnt[u.e]; }
    __device__ __forceinline__ int arow(const Unit& u, int r) const {
        if (!GATHER) return u.pm * 256 + r;
        return ltile[valid(u, r) ? r : 0] >> 1; }
    __device__ __forceinline__ size_t boff(const Unit& u) const { return wbase + ((size_t)u.e * 1024 + (size_t)u.pn * 128) * K; }
};

struct EpiBf16 {
    static constexpr bool PERM = true, META = false;
    bf16_t* O; int ldc, ncols; int sc_lo, sc_hi; float sc; unsigned* kn; int kn_lo;
    template <class Sched> __device__ __forceinline__ void operator()(const f32x4 (&acc)[2][2][4][2], const Unit& u, int wr, int wc, int fr, int fq, const Sched& S) const {
        const float s = (u.pn >= sc_lo && u.pn < sc_hi) ? sc : 1.f;
        if (kn && (u.pn == kn_lo || u.pn == kn_lo + 1)) {
#pragma unroll
            for (int bj = 0; bj < 2; ++bj) { float mxs = 0.f;
#pragma unroll
                for (int ai = 0; ai < 2; ++ai)
#pragma unroll
                    for (int m = 0; m < 4; ++m) { const f32x4 v0 = acc[ai][bj][m][0], v1 = acc[ai][bj][m][1];
                        float ss = v0[0] * v0[0] + v0[1] * v0[1] + v0[2] * v0[2] + v0[3] * v0[3] + v1[0] * v1[0] + v1[1] * v1[1] + v1[2] * v1[2] + v1[3] * v1[3];
                        ss += __shfl_xor(ss, 16); ss += __shfl_xor(ss, 32); mxs = fmaxf(mxs, ss); }
                mxs = fmaxf(mxs, __shfl_xor(mxs, 1)); mxs = fmaxf(mxs, __shfl_xor(mxs, 2)); mxs = fmaxf(mxs, __shfl_xor(mxs, 4)); mxs = fmaxf(mxs, __shfl_xor(mxs, 8));
                if (fr == 0 && fq == 0) atomicMax(kn + ((u.pm >> 5) * 8 + (u.pn - kn_lo) * 4 + bj * 2 + (wc >> 1)) * 2 + (wc & 1), __float_as_uint(mxs)); } }
#pragma unroll
        for (int ai = 0; ai < 2; ++ai)
#pragma unroll
            for (int m = 0; m < 4; ++m) { const int orow = S.orow(u, ai * 128 + wr * 64 + m * 16 + fr);
#pragma unroll
                for (int bj = 0; bj < 2; ++bj) { const int col = u.pn * 256 + bj * 128 + wc * 32 + 8 * fq;
                    const f32x4 v0 = acc[ai][bj][m][0] * s, v1 = acc[ai][bj][m][1] * s;
                    u32x4 w; w.x = cvt_pk_bf16(v0[0], v0[1]); w.y = cvt_pk_bf16(v0[2], v0[3]); w.z = cvt_pk_bf16(v1[0], v1[1]); w.w = cvt_pk_bf16(v1[2], v1[3]);
                    if (orow >= 0 && col < ncols) *(u32x4*)(O + (size_t)orow * ldc + col) = w; } }
    }
};
struct EpiResBf16 {
    static constexpr bool PERM = true, META = false;
    const bf16_t* Hb; bf16_t* T;
    template <class Sched> __device__ __forceinline__ void operator()(const f32x4 (&acc)[2][2][4][2], const Unit& u, int wr, int wc, int fr, int fq, const Sched& S) const {
        u32x4 h[2][4][2];
#pragma unroll
        for (int ai = 0; ai < 2; ++ai)
#pragma unroll
            for (int m = 0; m < 4; ++m) { const size_t orow = (size_t)S.orow(u, ai * 128 + wr * 64 + m * 16 + fr);
#pragma unroll
                for (int bj = 0; bj < 2; ++bj) h[ai][m][bj] = *(const u32x4*)(Hb + orow * D + u.pn * 256 + bj * 128 + wc * 32 + 8 * fq); }
        __builtin_amdgcn_sched_barrier(0);
#pragma unroll
        for (int ai = 0; ai < 2; ++ai)
#pragma unroll
            for (int m = 0; m < 4; ++m) { const size_t orow = (size_t)S.orow(u, ai * 128 + wr * 64 + m * 16 + fr);
#pragma unroll
                for (int bj = 0; bj < 2; ++bj) { const int col = u.pn * 256 + bj * 128 + wc * 32 + 8 * fq;
                    const u32x4 hh = h[ai][m][bj]; const f32x4 v0 = acc[ai][bj][m][0], v1 = acc[ai][bj][m][1];
                    u32x4 w; w.x = cvt_pk_bf16(bflo(hh.x) * ALPHA + v0[0], bfhi(hh.x) * ALPHA + v0[1]); w.y = cvt_pk_bf16(bflo(hh.y) * ALPHA + v0[2], bfhi(hh.y) * ALPHA + v0[3]);
                    w.z = cvt_pk_bf16(bflo(hh.z) * ALPHA + v1[0], bfhi(hh.z) * ALPHA + v1[1]); w.w = cvt_pk_bf16(bflo(hh.w) * ALPHA + v1[2], bfhi(hh.w) * ALPHA + v1[3]);
                    *(u32x4*)(T + orow * D + col) = w; } }
    }
};
template <int MODE> __device__ __forceinline__ void meta_gemm(const bf16_t* Hb, const bf16_t* Res, const bf16_t* Bt, int N, bf16_t* O, int ldo, int sc_lo, int sc_hi, float sc, int wg, int nwg, const int tid_, unsigned* knm = nullptr) {
    const int lane = tid_ & 63, wave = __builtin_amdgcn_readfirstlane(tid_ >> 6), tok = lane & 15, kq = lane >> 4;
    for (int tile = wg * 8 + wave; tile < N / 16; tile += nwg * 8) {
        const bf16_t* wp = Bt + (size_t)(tile * 16 + tok) * 1024 + kq * 8; const bf16_t* hp = Hb + (size_t)tok * D + kq * 8;
        f32x4 acc = (f32x4){0.f, 0.f, 0.f, 0.f};
#pragma unroll 16
        for (int k = 0; k < 32; ++k) { const bf16x8 a = *(const bf16x8*)(wp + k * 32), bb = *(const bf16x8*)(hp + k * 32); acc = __builtin_amdgcn_mfma_f32_16x16x32_bf16(a, bb, acc, 0, 0, 0); }
        const int n = tile * 16 + 4 * kq;
        if (MODE == 0 && knm && tile >= 64 && tile < 96) {
            float ss = acc[0] * acc[0] + acc[1] * acc[1] + acc[2] * acc[2] + acc[3] * acc[3]; ss += __shfl_xor(ss, 16); ss += __shfl_xor(ss, 32);
            ss = fmaxf(ss, __shfl_xor(ss, 1)); ss = fmaxf(ss, __shfl_xor(ss, 2)); ss = fmaxf(ss, __shfl_xor(ss, 4)); ss = fmaxf(ss, __shfl_xor(ss, 8));
            if (lane == 0) atomicMax(knm + (tile - 64), __float_as_uint(ss)); }
        if (MODE == 0) { const float f = (n >= sc_lo && n < sc_hi) ? sc : 1.f; u32x2 w; w.x = cvt_pk_bf16(acc[0] * f, acc[1] * f); w.y = cvt_pk_bf16(acc[2] * f, acc[3] * f);
#pragma unroll
            for (int b = 0; b < NB; ++b) *(u32x2*)(O + (size_t)(b * LB + tok) * ldo + n) = w; }
        else { const u32x2 h = *(const u32x2*)(Res + (size_t)tok * D + n); u32x2 w; w.x = cvt_pk_bf16(bflo(h.x) * ALPHA + acc[0], bfhi(h.x) * ALPHA + acc[1]); w.y = cvt_pk_bf16(bflo(h.y) * ALPHA + acc[2], bfhi(h.y) * ALPHA + acc[3]);
#pragma unroll
            for (int b = 0; b < NB; ++b) *(u32x2*)(O + (size_t)(b * LB + tok) * ldo + n) = w; }
    }
}
struct EpiSiluMul {
    static constexpr bool PERM = true, META = false;
    unsigned char* ACT;
    template <class Sched> __device__ __forceinline__ void operator()(const f32x4 (&acc)[2][2][4][2], const Unit& u, int wr, int wc, int fr, int fq, const Sched& S) const {
#pragma unroll
        for (int ai = 0; ai < 2; ++ai)
#pragma unroll
            for (int m = 0; m < 4; ++m) { const size_t arow = (size_t)u.pm * 256 + ai * 128 + wr * 64 + m * 16 + fr;
#pragma unroll
                for (int bj = 0; bj < 2; ++bj) { if (bj == 1 && u.hn) continue; const int col = u.pn * 64 + bj * 64 + wc * 16 + 4 * fq;
                    const f32x4 g = acc[ai][bj][m][0], up = acc[ai][bj][m][1]; float a[4];
#pragma unroll
                    for (int i = 0; i < 4; ++i) a[i] = g[i] * __builtin_amdgcn_rcpf(1.f + __builtin_amdgcn_exp2f(g[i] * -1.44269504f)) * (up[i] * F8_ASCALE);
                    *(unsigned*)(ACT + arow * DEXP + col) = pk4_fp8(a[0], a[1], a[2], a[3]); } }
    }
};
struct EpiScatter {
    static constexpr bool PERM = true, META = true;
    unsigned char* YK; LAS int* ms; LAS float* mw;
    template <class Sched> __device__ __forceinline__ void prefetch(const Unit& u, const Sched& S, int tid) const {
        if (__builtin_amdgcn_readfirstlane(tid >> 6) == 0) { S.dma_list(u, (unsigned)__builtin_amdgcn_readfirstlane((int)(unsigned)(size_t)(ms + u.par * 256)), tid & 63);
            S.dma_listw(u, (unsigned)__builtin_amdgcn_readfirstlane((int)(unsigned)(size_t)(mw + u.par * 256)), tid & 63); } }
    template <class Sched> __device__ __forceinline__ void operator()(const f32x4 (&acc)[2][2][4][2], const Unit& u, int wr, int wc, int fr, int fq, const Sched& S) const {
        int sl[2][4]; float w8[2][4];
#pragma unroll
        for (int ai = 0; ai < 2; ++ai)
#pragma unroll
            for (int m = 0; m < 4; ++m) { const int rt = u.par * 256 + ai * 128 + wr * 64 + m * 16 + fr; sl[ai][m] = ms[rt]; w8[ai][m] = mw[rt] * F8_YSCALE; }
        const int nvalid = S.cnt[u.e] - u.lt * 256;
#pragma unroll
        for (int ai = 0; ai < 2; ++ai)
#pragma unroll
            for (int m = 0; m < 4; ++m) { const int rl = ai * 128 + wr * 64 + m * 16 + fr; const bool ok = rl < nvalid; const int s_ = ok ? sl[ai][m] : 0;
                unsigned char* yrow = YK + ((size_t)(s_ & 1) * M1 + (size_t)(s_ >> 1)) * D + u.pn * 128 + wc * 32 + 8 * fq;
#pragma unroll
                for (int bj = 0; bj < 2; ++bj) {
                    const f32x4 v0 = acc[ai][bj][m][0] * w8[ai][m], v1 = acc[ai][bj][m][1] * w8[ai][m];
                    u32x2 w; w.x = pk4_fp8(v0[0], v0[1], v0[2], v0[3]); w.y = pk4_fp8(v1[0], v1[1], v1[2], v1[3]);
                    if (ok && !(bj == 1 && u.hn)) *(u32x2*)(yrow + bj * 128) = w; } }
    }
};

template <int MODE> __device__ __forceinline__ int wrow_map(int n) { return MODE == 0 ? n : (8 * (n >> 2) + (n & 3) + (MODE == 2 ? 4 : 0)); }
template <int MODE> __device__ __forceinline__ void transpose_item_f8(const float* W, int srcpitch, int K, int N, unsigned char* WT, int dpitch, LAS float* scr, int item, int lane) {
    const int nblk = (N + 31) / 32, kb = item / nblk, nb = item % nblk, k0 = 64 * kb, n0 = 32 * nb;
    { float tmp[32];
#pragma unroll
        for (int i = 0; i < 32; ++i) { const int kk = 2 * i + (lane >> 5), n = n0 + (lane & 31); tmp[i] = n < N ? W[(size_t)(k0 + kk) * srcpitch + n] : 0.f; }
#pragma unroll
        for (int i = 0; i < 32; ++i) scr[(2 * i + (lane >> 5)) * 33 + (lane & 31)] = tmp[i] * F8_WSCALE; }
    asm volatile("s_waitcnt lgkmcnt(0)" ::: "memory");
#pragma unroll
    for (int j = 0; j < 2; ++j) { const int slot = lane + 64 * j, nl = slot >> 2, c = slot & 3; const LAS float* sp = scr + (16 * c) * 33 + nl;
        u32x4 o; o.x = pk4_fp8(sp[0 * 33], sp[1 * 33], sp[2 * 33], sp[3 * 33]); o.y = pk4_fp8(sp[4 * 33], sp[5 * 33], sp[6 * 33], sp[7 * 33]);
        o.z = pk4_fp8(sp[8 * 33], sp[9 * 33], sp[10 * 33], sp[11 * 33]); o.w = pk4_fp8(sp[12 * 33], sp[13 * 33], sp[14 * 33], sp[15 * 33]);
        if (n0 + nl < N) *(u32x4*)(WT + (size_t)wrow_map<MODE>(n0 + nl) * dpitch + k0 + 16 * c) = o; }
    asm volatile("s_waitcnt lgkmcnt(0)" ::: "memory");
}
template <int MODE> __device__ __forceinline__ void transpose_item(const float* W, int srcpitch, int K, int N, bf16_t* WT, int dpitch, int dcol0, LAS float* scr, int item, int lane) {
    const int nblk = (N + 31) / 32, kb = item / nblk, nb = item % nblk, k0 = 64 * kb, n0 = 32 * nb;
    { float tmp[32];
#pragma unroll
        for (int i = 0; i < 32; ++i) { const int kk = 2 * i + (lane >> 5), n = n0 + (lane & 31); tmp[i] = n < N ? W[(size_t)(k0 + kk) * srcpitch + n] : 0.f; }
#pragma unroll
        for (int i = 0; i < 32; ++i) scr[(2 * i + (lane >> 5)) * 33 + (lane & 31)] = tmp[i]; }
    asm volatile("s_waitcnt lgkmcnt(0)" ::: "memory");
    const int c = lane & 7;
#pragma unroll
    for (int j = 0; j < 4; ++j) { const int nl = (lane >> 3) + 8 * j; const LAS float* s = scr + (8 * c) * 33 + nl;
        u32x4 o; o.x = pk2(s[0 * 33], s[1 * 33]); o.y = pk2(s[2 * 33], s[3 * 33]); o.z = pk2(s[4 * 33], s[5 * 33]); o.w = pk2(s[6 * 33], s[7 * 33]);
        if (n0 + nl < N) *(u32x4*)(WT + (size_t)wrow_map<MODE>(n0 + nl) * dpitch + dcol0 + k0 + 8 * c) = o; }
    asm volatile("s_waitcnt lgkmcnt(0)" ::: "memory");
}
constexpr int PI_IN0 = 16 * 64, PI_OUT0 = 8 * 32, PI_OUT08 = 8 * 32, PI_IN1 = 16 * 96, PI_IN18 = 16 * 96, PI_OUT18 = 16 * 32, PI_G = 32 * 256, PI_U = 32 * 256, PI_D = 32 * 256;
constexpr int PREP_EARLY = PI_IN0, PREP_NITEMS = PI_IN0 + PI_OUT0 + PI_OUT08 + PI_IN1 + PI_IN18 + PI_OUT18 + PI_G + PI_U + PI_D;
__device__ __forceinline__ void prep_items(const Ptrs& P, LAS unsigned char* lds, const int it_lo, const int it_hi, const int gw, const int NGW, const int lane, const int wave) {
    LAS float* scr = (LAS float*)(lds + wave * 16384);
    bf16_t* Win0 = (bf16_t*)(P.ws + W_IN0); bf16_t* Wout0 = (bf16_t*)(P.ws + W_OUT0); bf16_t* Win1 = (bf16_t*)(P.ws + W_IN1);
    unsigned char* Wgu = P.ws + W_GU; unsigned char* Wdn = P.ws + W_DN;
    struct ItemD { const float* W; unsigned char* dst; int srcpitch, N, nblk, dpitch, dcol, mode, f8; };
    auto decode = [&](int it, ItemD& d, int& r) {
        r = it;
        if (r < PI_IN0) { d = ItemD{P.even_w_in, (unsigned char*)Win0, EVEN_IN, EVEN_IN, 64, 2048, 0, 0, 0}; return; } r -= PI_IN0;
        if (r < PI_OUT0) { d = ItemD{P.even_w_out + (size_t)512 * 1024, (unsigned char*)Wout0, 1024, 1024, 32, 2048, 1024, 0, 0}; return; } r -= PI_OUT0;
        if (r < PI_OUT08) { d = ItemD{P.even_w_out + (size_t)512 * 1024, P.ws + W_OUT08, 1024, 1024, 32, 1024, 512, 0, 1}; return; } r -= PI_OUT08;
        if (r < PI_IN1) { d = ItemD{P.odd_w_in, (unsigned char*)Win1, ODD_IN, ODD_N, 96, 2048, 0, 0, 0}; return; } r -= PI_IN1;
        if (r < PI_IN18) { d = ItemD{P.odd_w_in, P.ws + W_IN18, ODD_IN, ODD_N, 96, 1024, 0, 0, 1}; return; } r -= PI_IN18;
        if (r < PI_OUT18) { d = ItemD{P.odd_w_out, P.ws + W_OUT18, 1024, 1024, 32, 1024, 0, 0, 1}; return; } r -= PI_OUT18;
        if (r < PI_G) { const int le = r >> 8; r &= 255; d = ItemD{P.moe_w_gate + (size_t)le * 1024 * 512, Wgu + (size_t)le * 1024 * 1024, 512, 512, 16, 1024, 0, 1, 1}; return; } r -= PI_G;
        if (r < PI_U) { const int le = r >> 8; r &= 255; d = ItemD{P.moe_w_up + (size_t)le * 1024 * 512, Wgu + (size_t)le * 1024 * 1024, 512, 512, 16, 1024, 0, 2, 1}; return; } r -= PI_U;
        { const int le = r >> 8; r &= 255; d = ItemD{P.moe_w_down + (size_t)le * 512 * 1024, Wdn + (size_t)le * 1024 * 512, 1024, 1024, 32, 512, 0, 0, 1}; } };
#define PREP_LOAD(d, r, tmp) do { const int kb_ = (r) / (d).nblk, nb_ = (r) % (d).nblk; \
        _Pragma("unroll") for (int i = 0; i < 8; ++i) { const int kk = 8 * i + (lane >> 3), n = 32 * nb_ + 4 * (lane & 7); tmp[i] = *(const f32x4*)((d).W + (size_t)(64 * kb_ + kk) * (d).srcpitch + n); } } while (0)
#define PREP_STORE(d, r, tmp) do { const int kb_ = (r) / (d).nblk, nb_ = (r) % (d).nblk, k0_ = 64 * kb_, n0_ = 32 * nb_; const float sc_ = (d).f8 ? F8_WSCALE : 1.f; \
        _Pragma("unroll") for (int i = 0; i < 8; ++i) { LAS float* wp_ = scr + (8 * i + (lane >> 3)) * 33 + 4 * (lane & 7); wp_[0] = tmp[i][0] * sc_; wp_[1] = tmp[i][1] * sc_; wp_[2] = tmp[i][2] * sc_; wp_[3] = tmp[i][3] * sc_; } \
        asm volatile("s_waitcnt lgkmcnt(0)" ::: "memory"); \
        if ((d).f8) { _Pragma("unroll") for (int j = 0; j < 2; ++j) { const int slot = lane + 64 * j, nl = slot >> 2, c = slot & 3; const LAS float* sp = scr + (16 * c) * 33 + nl; \
                u32x4 o; o.x = pk4_fp8(sp[0 * 33], sp[1 * 33], sp[2 * 33], sp[3 * 33]); o.y = pk4_fp8(sp[4 * 33], sp[5 * 33], sp[6 * 33], sp[7 * 33]); \
                o.z = pk4_fp8(sp[8 * 33], sp[9 * 33], sp[10 * 33], sp[11 * 33]); o.w = pk4_fp8(sp[12 * 33], sp[13 * 33], sp[14 * 33], sp[15 * 33]); \
                const int n = n0_ + nl, rown = (d).mode == 0 ? n : (8 * (n >> 2) + (n & 3) + ((d).mode == 2 ? 4 : 0)); \
                if (n < (d).N) *(u32x4*)((d).dst + (size_t)rown * (d).dpitch + (d).dcol + k0_ + 16 * c) = o; } } \
        else { const int c = lane & 7; \
            _Pragma("unroll") for (int j = 0; j < 4; ++j) { const int nl = (lane >> 3) + 8 * j; const LAS float* sp = scr + (8 * c) * 33 + nl; \
                u32x4 o; o.x = pk2(sp[0 * 33], sp[1 * 33]); o.y = pk2(sp[2 * 33], sp[3 * 33]); o.z = pk2(sp[4 * 33], sp[5 * 33]); o.w = pk2(sp[6 * 33], sp[7 * 33]); \
                if (n0_ + nl < (d).N) *(u32x4*)((d).dst + (size_t)(n0_ + nl) * (d).dpitch + (d).dcol + (size_t)(k0_ + 8 * c) * 2) = o; } } \
        asm volatile("s_waitcnt lgkmcnt(0)" ::: "memory"); } while (0)
#define PREP_TRY(idx, d, r, tmp, ok) do { ok = (idx) < it_hi; decode(ok ? (idx) : it_lo, d, r); PREP_LOAD(d, r, tmp); } while (0)
    { ItemD dA, dB, dC; int rA = 0, rB = 0, rC = 0; f32x4 tA[8], tB[8], tC[8]; bool okA, okB, okC;
        int it = it_lo + gw;
        PREP_TRY(it, dA, rA, tA, okA); PREP_TRY(it + NGW, dB, rB, tB, okB);
        while (okA) {
            PREP_TRY(it + 2 * NGW, dC, rC, tC, okC);
            PREP_STORE(dA, rA, tA);
            if (!okB) break;
            PREP_TRY(it + 3 * NGW, dA, rA, tA, okA);
            PREP_STORE(dB, rB, tB);
            if (!okC) break;
            PREP_TRY(it + 4 * NGW, dB, rB, tB, okB);
            PREP_STORE(dC, rC, tC);
            it += 3 * NGW; } }
#undef PREP_TRY
#undef PREP_LOAD
#undef PREP_STORE
}
__device__ __forceinline__ void prep_fold(const Ptrs& P, const int gw, const int NGW, const int lane) {
    bf16_t* Wout0 = (bf16_t*)(P.ws + W_OUT0);
    for (int it = gw; it < 128 * 16; it += NGW) {
        const int cp0 = (it >> 4) * 4, n = (it & 15) * 64 + lane, g = cp0 >> 7, c0 = cp0 & 127;
        const float* pw = P.pool_w + ((size_t)g * 128 + c0) * 128; const float* ps = P.pool_scale + g * 128; const float* wo = P.even_w_out + (size_t)(g * 128) * 1024 + n;
        float a[4] = {0.f, 0.f, 0.f, 0.f}; float wv[128];
#pragma unroll
        for (int d = 0; d < 128; ++d) wv[d] = wo[(size_t)d * 1024];
        __builtin_amdgcn_sched_barrier(0);
#pragma unroll
        for (int d = 0; d < 128; ++d) { const float w = ps[d] * wv[d];
#pragma unroll
            for (int j = 0; j < 4; ++j) a[j] += pw[j * 128 + d] * w; }
#pragma unroll
        for (int j = 0; j < 4; ++j) { Wout0[(size_t)n * 1024 + cp0 + j] = (bf16_t)f2bf(a[j]); }
        *(unsigned*)(P.ws + W_OUT08 + (size_t)n * 1024 + cp0) = pk4_fp8(a[0] * F8_WSCALE, a[1] * F8_WSCALE, a[2] * F8_WSCALE, a[3] * F8_WSCALE);
    }
}
__device__ __forceinline__ void stage_prep(const Ptrs& P, LAS unsigned char* lds, int wg, int nwg) {
    const int tid = tid_opaque(P), lane = tid & 63, wave = __builtin_amdgcn_readfirstlane(tid >> 6);
    const int gw = wg * 8 + wave, NGW = nwg * 8;
    prep_items(P, lds, 0, nwg == 256 ? PREP_EARLY : PREP_NITEMS, gw, NGW, lane, wave);
    if (nwg != 256) prep_fold(P, gw, NGW, lane);
    bf16_t* Hb = (bf16_t*)(P.ws + WS_HB);
    for (int row0 = gw * 4; row0 < M1; row0 += NGW * 4) { f32x4 v[4][4];
#pragma unroll
        for (int q = 0; q < 4; ++q) { const f32x4* xr = (const f32x4*)h0_ptr(P, row0 + q) + lane;
#pragma unroll
            for (int j = 0; j < 4; ++j) v[q][j] = xr[64 * j]; }
#pragma unroll
        for (int q = 0; q < 4; ++q) { unsigned long long* o8 = (unsigned long long*)(Hb + (size_t)(row0 + q) * D) + lane;
#pragma unroll
            for (int j = 0; j < 4; ++j) o8[64 * j] = (unsigned long long)pk2(v[q][j].x, v[q][j].y) | ((unsigned long long)pk2(v[q][j].z, v[q][j].w) << 32); } }
    if (wg == 0 && tid == 0) { float s1 = 0.f, s2 = 0.f; for (int i = 0; i < 64; ++i) { s1 += P.lq1[i] * P.lk1[i]; s2 += P.lq2[i] * P.lk2[i]; }
        ((float*)(P.ws + WS_MISC))[0] = __expf(s1) - __expf(s2) + LAMBDA_INIT; }
}

template <int W> __device__ __forceinline__ void pool_block(const bf16_t* Z, unsigned char* A28, bf16_t* A2m, int row0, int p0, int col) {
    u32x4 v[W + 15];
#pragma unroll
    for (int k = 0; k < W + 15; ++k) v[k] = (p0 - (W - 1) + k >= 0) ? *(const u32x4*)(Z + (size_t)(row0 - (W - 1) + k) * EVEN_IN + col) : (u32x4){0u, 0u, 0u, 0u};
    float s[8];
#pragma unroll
    for (int i = 0; i < 8; ++i) s[i] = 0.f;
#pragma unroll
    for (int k = 0; k < W - 1; ++k) { s[0] += bflo(v[k].x); s[1] += bfhi(v[k].x); s[2] += bflo(v[k].y); s[3] += bfhi(v[k].y); s[4] += bflo(v[k].z); s[5] += bfhi(v[k].z); s[6] += bflo(v[k].w); s[7] += bfhi(v[k].w); }
#pragma unroll
    for (int r = 0; r < 16; ++r) { const u32x4 in = v[W - 1 + r];
        s[0] += bflo(in.x); s[1] += bfhi(in.x); s[2] += bflo(in.y); s[3] += bfhi(in.y); s[4] += bflo(in.z); s[5] += bfhi(in.z); s[6] += bflo(in.w); s[7] += bfhi(in.w);
        const int p = p0 + r; const float inv = 1.f / (float)((p + 1) < W ? (p + 1) : W);
        const float dv[8] = {s[0] * inv - bflo(in.x), s[1] * inv - bfhi(in.x), s[2] * inv - bflo(in.y), s[3] * inv - bfhi(in.y), s[4] * inv - bflo(in.z), s[5] * inv - bfhi(in.z), s[6] * inv - bflo(in.w), s[7] * inv - bfhi(in.w)};
        const int row = row0 + r;
        if (p < NMETA) { u32x4 o; o.x = pk2(dv[0], dv[1]); o.y = pk2(dv[2], dv[3]); o.z = pk2(dv[4], dv[5]); o.w = pk2(dv[6], dv[7]); *(u32x4*)(A2m + (size_t)((row / LB) * NMETA + p) * D + col) = o; }
        else { u32x2 o; o.x = pk4_fp8(dv[0] * F8_ASCALE, dv[1] * F8_ASCALE, dv[2] * F8_ASCALE, dv[3] * F8_ASCALE); o.y = pk4_fp8(dv[4] * F8_ASCALE, dv[5] * F8_ASCALE, dv[6] * F8_ASCALE, dv[7] * F8_ASCALE); *(u32x2*)(A28 + (size_t)row * D + col) = o; }
        const u32x4 out = v[r];
        s[0] -= bflo(out.x); s[1] -= bfhi(out.x); s[2] -= bflo(out.y); s[3] -= bfhi(out.y); s[4] -= bflo(out.z); s[5] -= bfhi(out.z); s[6] -= bflo(out.w); s[7] -= bfhi(out.w); }
}
__device__ __forceinline__ void stage_pool(const Ptrs& P, int wg, int nwg) {
    const bf16_t* Z = (const bf16_t*)(P.ws + WS_Z); unsigned char* A28 = P.ws + WS_A2; bf16_t* A2m = (bf16_t*)(P.ws + WS_A2M);
    const int tid_ = tid_opaque(P), lane = tid_ & 63; const int gwv = __builtin_amdgcn_readfirstlane(wg * 8 + (tid_ >> 6)), NGW = nwg * 8;
    for (int it = gwv; it < (M1 / 64) * 4; it += NGW) { const int gi = it & 3, blk = (it >> 2) * 4 + (lane >> 4), row0 = blk * 16, p0 = row0 % LB, col = gi * 128 + (lane & 15) * 8;
        if (gi == 0) pool_block<2>(Z, A28, A2m, row0, p0, col); else if (gi == 1) pool_block<4>(Z, A28, A2m, row0, p0, col);
        else if (gi == 2) pool_block<8>(Z, A28, A2m, row0, p0, col); else pool_block<16>(Z, A28, A2m, row0, p0, col); }
}

__device__ __forceinline__ void route16(const float (&lg)[16], const float* bias, int& e0, int& e1, float& w0, float& w1) {
    float mx = lg[0];
#pragma unroll
    for (int e = 1; e < 16; ++e) mx = fmaxf(mx, lg[e]);
    float p[16], sum = 0.f;
#pragma unroll
    for (int e = 0; e < 16; ++e) { p[e] = __expf(lg[e] - mx); sum += p[e]; }
    const float inv = 1.f / sum; float sel[16];
#pragma unroll
    for (int e = 0; e < 16; ++e) { p[e] *= inv; sel[e] = p[e] + bias[e]; }
    int gbest = 0; float gsb = -3.0e38f; int bi0 = 0, bi1 = 1; float bp0 = 0.f, bp1 = 0.f;
#pragma unroll
    for (int g = 0; g < 4; ++g) {
        int i0 = 0; float m0 = sel[4 * g];
#pragma unroll
        for (int i = 1; i < 4; ++i) if (sel[4 * g + i] > m0) { m0 = sel[4 * g + i]; i0 = i; }
        int i1 = (i0 == 0) ? 1 : 0; float m1 = (i0 == 0) ? sel[4 * g + 1] : sel[4 * g];
#pragma unroll
        for (int i = 1; i < 4; ++i) if (i != i0 && i != ((i0 == 0) ? 1 : 0) && sel[4 * g + i] > m1) { m1 = sel[4 * g + i]; i1 = i; }
        const float gs = m0 + m1;
        float q0 = 0.f, q1 = 0.f;
#pragma unroll
        for (int i = 0; i < 4; ++i) { q0 = (i == i0) ? p[4 * g + i] : q0; q1 = (i == i1) ? p[4 * g + i] : q1; }
        if (gs > gsb) { gsb = gs; gbest = g; bi0 = i0; bi1 = i1; bp0 = q0; bp1 = q1; }
    }
    e0 = gbest * 4 + bi0; e1 = gbest * 4 + bi1; const float ws = 1.f / (bp0 + bp1); w0 = bp0 * ws; w1 = bp1 * ws;
}

constexpr int LN_WROW = 80, LN_LGS = 1024 * LN_WROW, LN_CNT = LN_LGS + 8 * 256, LN_ENT = LN_CNT + 128, LN_GB = 90112;
template <int MODE> __device__ __forceinline__ void stage_ln(const Ptrs& P, LAS unsigned char* lds, int wg, int nwg) {
    constexpr int LAYER = MODE & 1; constexpr bool MIX = MODE < 2, MATV = MODE != 3, ROUTE = MODE < 2, MF = MODE < 3;
    const int tid = tid_opaque(P), lane = tid & 63, wave = __builtin_amdgcn_readfirstlane(tid >> 6);
    constexpr int O_TL = 0, TLP = 2064, O_PD = 66560, O_ST = 99328, O_SE = 99584, O_CE = 99648;
    constexpr int O_GB = MF ? 100352 : LN_GB, O_LGS = MF ? 108544 : LN_LGS, O_CNT = MF ? 110592 : LN_CNT, O_ENT = MF ? 110720 : LN_ENT;
    LAS float* lgs = (LAS float*)(lds + O_LGS) + wave * 64; LAS int* lcnt = (LAS int*)(lds + O_CNT); LAS int* lbase = lcnt + 16; LAS int* ent = (LAS int*)(lds + O_ENT); LAS float* entw = (LAS float*)(lds + O_ENT + 2048);
    int R = (((M1 + nwg - 1) / nwg) + 3) & ~3, r0 = wg * R, r1 = (r0 + R) < M1 ? (r0 + R) : M1;
    if ((MODE == 1 || MODE == 3) && nwg == 256) { R = 128; r0 = (wg >> 6) * LB + NMETA + (wg & 63) * 128; r1 = r0 + 128; }
    if (ROUTE) { if (tid < 16) lcnt[tid] = 0; for (int i = tid; i < 2 * R; i += 512) ent[i] = -1; }
    { const float* gb_ = (tid < 256 ? (MIX ? P.ln_mix_g : P.ln_ffn_g) : (MIX ? P.ln_mix_b : P.ln_ffn_b)) + LAYER * D; const int i_ = tid & 255, hf_ = i_ >> 7, q_ = (i_ >> 6) & 1, ln_ = i_ & 63;
        ((LAS f32x4*)(lds + O_GB))[tid] = *(const f32x4*)(gb_ + hf_ * 512 + ln_ * 8 + q_ * 4); }
    bf16x8 bw[8];
    if (MF) { const float* gp_ = (MIX ? P.ln_mix_g : P.ln_ffn_g) + LAYER * D; const float* bp_ = (MIX ? P.ln_mix_b : P.ln_ffn_b) + LAYER * D;
        const float* wsrc_ = MODE == 2 ? P.odd_w_in + ODD_N : P.router_w; const int wst_ = MODE == 2 ? ODD_IN : 16;
        const int n_ = lane & 31, kh_ = lane >> 5, e_ = n_ & 15; const bool lo_ = n_ >= 16;
#pragma unroll
        for (int ks = 0; ks < 8; ++ks) { unsigned hw[8];
#pragma unroll
            for (int j = 0; j < 8; ++j) { const int k_ = 128 * wave + 16 * ks + 8 * kh_ + j; const float wv = gp_[k_] * wsrc_[(size_t)k_ * wst_ + e_]; const unsigned hb_ = cvt_pk_bf16(wv, 0.f) & 0xffffu;
                const float res_ = wv - __uint_as_float(hb_ << 16); hw[j] = lo_ ? (cvt_pk_bf16(res_, 0.f) & 0xffffu) : hb_; }
            const u32x4 pk_ = (u32x4){hw[0] | (hw[1] << 16), hw[2] | (hw[3] << 16), hw[4] | (hw[5] << 16), hw[6] | (hw[7] << 16)}; bw[ks] = __builtin_bit_cast(bf16x8, pk_); }
        { const int e2_ = tid & 15, part_ = tid >> 4; float s_ = 0.f, c_ = 0.f;
            for (int k_ = part_ * 32; k_ < part_ * 32 + 32; ++k_) { const float wr_ = wsrc_[(size_t)k_ * wst_ + e2_]; s_ += gp_[k_] * wr_; c_ += bp_[k_] * wr_; }
            ((LAS float*)(lds + O_PD))[part_ * 16 + e2_] = s_; ((LAS float*)(lds + O_PD))[512 + part_ * 16 + e2_] = c_; }
        __syncthreads();
        if (tid < 32) { const int e2_ = tid & 15; const int which_ = tid >> 4; float a_ = 0.f; for (int p_ = 0; p_ < 32; ++p_) a_ += ((LAS float*)(lds + O_PD))[which_ * 512 + p_ * 16 + e2_]; ((LAS float*)(lds + (which_ ? O_CE : O_SE)))[e2_] = a_; } }
    __syncthreads();
    bf16_t* Hb = (bf16_t*)(P.ws + WS_HB); const bf16_t* T = (const bf16_t*)(P.ws + WS_T); const unsigned char* YK = P.ws + WS_YK; float* RW = (float*)(P.ws + WS_RW); float* GLR = (float*)(P.ws + WS_GLR);
    u32x4 raw[4][2], ry[4][2];
#define LN_LDRAW(q0n) do { _Pragma("unroll") for (int j = 0; j < 4; ++j) { const int rr_ = (q0n) + j, rw_ = rr_ < r1 ? rr_ : r1 - 1; \
        _Pragma("unroll") for (int hf = 0; hf < 2; ++hf) { const size_t off_ = (size_t)rw_ * D + hf * 512 + lane * 8; \
            if (MIX) raw[j][hf] = *(const u32x4*)(T + off_); \
            else { raw[j][hf] = *(const u32x4*)(Hb + off_); const u32x2 y0_ = *(const u32x2*)(YK + off_), y1_ = *(const u32x2*)(YK + (size_t)M1 * D + off_); ry[j][hf] = (u32x4){y0_.x, y0_.y, y1_.x, y1_.y}; } } } } while (0)
    const int qend = MF ? r0 + 32 * ((r1 - r0 + 31) / 32) : r1;
    constexpr bool PF = MODE != 2;
    if (PF && (MF || r0 + 4 * wave < r1)) LN_LDRAW(r0 + 4 * wave);
    for (int q0 = r0 + 4 * wave; q0 < qend; q0 += 32) {
        if (!PF) LN_LDRAW(q0);
        float x[4][16]; bool act[4]; int rows[4];
#pragma unroll
        for (int j = 0; j < 4; ++j) { const int rr = q0 + j; rows[j] = rr < r1 ? rr : r1 - 1; const int p = rows[j] % LB; act[j] = rr < r1 && !((MODE == 1 || MODE == 3) && p < NMETA); }
#pragma unroll
        for (int j = 0; j < 4; ++j)
#pragma unroll
            for (int hf = 0; hf < 2; ++hf) {
                if (MIX) { const u32x4 t = raw[j][hf];
                    x[j][hf * 8 + 0] = bflo(t.x); x[j][hf * 8 + 1] = bfhi(t.x); x[j][hf * 8 + 2] = bflo(t.y); x[j][hf * 8 + 3] = bfhi(t.y); x[j][hf * 8 + 4] = bflo(t.z); x[j][hf * 8 + 5] = bfhi(t.z); x[j][hf * 8 + 6] = bflo(t.w); x[j][hf * 8 + 7] = bfhi(t.w); }
                else { const u32x4 h = raw[j][hf], yy = ry[j][hf];
                    float a0[4], a1[4], b0[4], b1[4]; fp8x4_to_f32(yy.x, a0); fp8x4_to_f32(yy.y, a1); fp8x4_to_f32(yy.z, b0); fp8x4_to_f32(yy.w, b1);
                    constexpr float ys = 1.f / F8_YSCALE;
                    x[j][hf * 8 + 0] = bflo(h.x) * ALPHA + (a0[0] + b0[0]) * ys; x[j][hf * 8 + 1] = bfhi(h.x) * ALPHA + (a0[1] + b0[1]) * ys;
                    x[j][hf * 8 + 2] = bflo(h.y) * ALPHA + (a0[2] + b0[2]) * ys; x[j][hf * 8 + 3] = bfhi(h.y) * ALPHA + (a0[3] + b0[3]) * ys;
                    x[j][hf * 8 + 4] = bflo(h.z) * ALPHA + (a1[0] + b1[0]) * ys; x[j][hf * 8 + 5] = bfhi(h.z) * ALPHA + (a1[1] + b1[1]) * ys;
                    x[j][hf * 8 + 6] = bflo(h.w) * ALPHA + (a1[2] + b1[2]) * ys; x[j][hf * 8 + 7] = bfhi(h.w) * ALPHA + (a1[3] + b1[3]) * ys; } }
        if (MF) {
#pragma unroll
            for (int j = 0; j < 4; ++j)
#pragma unroll
                for (int hf = 0; hf < 2; ++hf) { u32x4 tw_ = raw[j][hf];
                    if (!MIX) { tw_.x = cvt_pk_bf16(x[j][hf * 8], x[j][hf * 8 + 1]); tw_.y = cvt_pk_bf16(x[j][hf * 8 + 2], x[j][hf * 8 + 3]); tw_.z = cvt_pk_bf16(x[j][hf * 8 + 4], x[j][hf * 8 + 5]); tw_.w = cvt_pk_bf16(x[j][hf * 8 + 6], x[j][hf * 8 + 7]); }
                    *(LAS u32x4*)(lds + O_TL + (4 * wave + j) * TLP + hf * 1024 + lane * 16) = tw_; } }
        __builtin_amdgcn_sched_barrier(0);
        if (PF && (MF || q0 + 32 < r1)) LN_LDRAW(q0 + 32);
        float mean[4], rstd[4];
#pragma unroll
        for (int j = 0; j < 4; ++j) { float sm = 0.f;
#pragma unroll
            for (int i = 0; i < 16; ++i) sm += x[j][i];
            mean[j] = sm; }
#pragma unroll
        for (int o = 1; o < 64; o <<= 1) {
#pragma unroll
            for (int j = 0; j < 4; ++j) mean[j] += __shfl_xor(mean[j], o); }
#pragma unroll
        for (int j = 0; j < 4; ++j) { mean[j] *= (1.f / D); float s2 = 0.f;
#pragma unroll
            for (int i = 0; i < 16; ++i) { x[j][i] -= mean[j]; s2 += x[j][i] * x[j][i]; }
            rstd[j] = s2; }
#pragma unroll
        for (int o = 1; o < 64; o <<= 1) {
#pragma unroll
            for (int j = 0; j < 4; ++j) rstd[j] += __shfl_xor(rstd[j], o); }
#pragma unroll
        for (int j = 0; j < 4; ++j) rstd[j] = 1.f / sqrtf(rstd[j] * (1.f / D) + LN_EPS);
        {
#pragma unroll
            for (int hf = 0; hf < 2; ++hf)
#pragma unroll
                for (int q = 0; q < 2; ++q) { const f32x4 g4 = ((const LAS f32x4*)(lds + O_GB))[(hf * 2 + q) * 64 + lane], b4 = ((const LAS f32x4*)(lds + O_GB))[256 + (hf * 2 + q) * 64 + lane];
#pragma unroll
                    for (int e = 0; e < 4; ++e)
#pragma unroll
                        for (int j = 0; j < 4; ++j) x[j][hf * 8 + q * 4 + e] = x[j][hf * 8 + q * 4 + e] * rstd[j] * g4[e] + b4[e]; } }
#pragma unroll
        for (int j = 0; j < 4; ++j) {
            if (act[j]) {
                if (MODE != 3) {
#pragma unroll
                    for (int hf = 0; hf < 2; ++hf) { u32x4 w; w.x = pk2(x[j][hf * 8], x[j][hf * 8 + 1]); w.y = pk2(x[j][hf * 8 + 2], x[j][hf * 8 + 3]); w.z = pk2(x[j][hf * 8 + 4], x[j][hf * 8 + 5]); w.w = pk2(x[j][hf * 8 + 6], x[j][hf * 8 + 7]);
                        *(u32x4*)(Hb + (size_t)rows[j] * D + hf * 512 + lane * 8) = w;
                        if (ROUTE || MODE == 2) { u32x2 w8; w8.x = pk4_fp8(x[j][hf * 8] * F8_HSCALE, x[j][hf * 8 + 1] * F8_HSCALE, x[j][hf * 8 + 2] * F8_HSCALE, x[j][hf * 8 + 3] * F8_HSCALE);
                            w8.y = pk4_fp8(x[j][hf * 8 + 4] * F8_HSCALE, x[j][hf * 8 + 5] * F8_HSCALE, x[j][hf * 8 + 6] * F8_HSCALE, x[j][hf * 8 + 7] * F8_HSCALE);
                            *(u32x2*)(P.ws + WS_HB8 + (size_t)rows[j] * D + hf * 512 + lane * 8) = w8; } } }
                else { const int b = rows[j] / LB, p = rows[j] - b * LB; float* orow = P.out + ((size_t)b * SEQ + (p - NMETA)) * D;
#pragma unroll
                    for (int hf = 0; hf < 2; ++hf)
#pragma unroll
                        for (int q = 0; q < 2; ++q) *(f32x4*)(orow + hf * 512 + lane * 8 + q * 4) = (f32x4){x[j][hf * 8 + q * 4], x[j][hf * 8 + q * 4 + 1], x[j][hf * 8 + q * 4 + 2], x[j][hf * 8 + q * 4 + 3]}; } } }
        if (MF) {
            asm volatile("s_waitcnt lgkmcnt(0)\n\ts_barrier" ::: "memory");
            f32x16 dacc = f32x16{};
            { const LAS unsigned char* ap_ = lds + O_TL + (lane & 31) * TLP + (128 * wave + 8 * (lane >> 5)) * 2;
#pragma unroll
                for (int ks = 0; ks < 8; ++ks) { const bf16x8 a_ = *(const LAS bf16x8*)(ap_ + ks * 32); dacc = __builtin_amdgcn_mfma_f32_32x32x16_bf16(a_, bw[ks], dacc, 0, 0, 0); } }
            { LAS float* pd_ = (LAS float*)(lds + O_PD) + wave * 1024 + (lane & 31);
#pragma unroll
                for (int r = 0; r < 16; ++r) pd_[(((r & 3) + 8 * (r >> 2)) + 4 * (lane >> 5)) * 32] = dacc[r]; }
            if (lane == 0) {
#pragma unroll
                for (int j = 0; j < 4; ++j) { ((LAS float*)(lds + O_ST))[(4 * wave + j) * 2] = mean[j]; ((LAS float*)(lds + O_ST))[(4 * wave + j) * 2 + 1] = rstd[j]; } }
            asm volatile("s_waitcnt lgkmcnt(0)\n\ts_barrier" ::: "memory");
            { const int rw_ = 4 * wave + (lane >> 4), e_ = lane & 15; const LAS float* pd_ = (const LAS float*)(lds + O_PD) + rw_ * 32 + e_; float pre = 0.f;
#pragma unroll
                for (int w_ = 0; w_ < 8; ++w_) pre += pd_[w_ * 1024] + pd_[w_ * 1024 + 16];
                const float mr_ = ((const LAS float*)(lds + O_ST))[rw_ * 2], rs_ = ((const LAS float*)(lds + O_ST))[rw_ * 2 + 1];
                const float lgt_ = rs_ * (pre - mr_ * ((const LAS float*)(lds + O_SE))[e_]) + ((const LAS float*)(lds + O_CE))[e_];
                if (MODE == 2) { const int j = lane >> 4; bool a_ = false;
#pragma unroll
                    for (int jj = 0; jj < 4; ++jj) a_ = (jj == j) ? act[jj] : a_;
                    if (a_) GLR[(size_t)(q0 + j) * 16 + e_] = lgt_; }
                else lgs[lane] = lgt_; }
            if (ROUTE) { asm volatile("s_waitcnt lgkmcnt(0)" ::: "memory");
                const int j = lane >> 4; float lg[16];
#pragma unroll
                for (int e4 = 0; e4 < 4; ++e4) { const f32x4 t4 = *(const LAS f32x4*)(lgs + j * 16 + e4 * 4); lg[e4 * 4] = t4.x; lg[e4 * 4 + 1] = t4.y; lg[e4 * 4 + 2] = t4.z; lg[e4 * 4 + 3] = t4.w; }
                int e0, e1; float w0, w1; route16(lg, P.router_bias, e0, e1, w0, w1);
                bool a_ = false;
#pragma unroll
                for (int jj = 0; jj < 4; ++jj) a_ = (jj == j) ? act[jj] : a_;
                if (a_ && (lane & 15) == 0) { const int row = q0 + j; const int li0 = atomicAdd((int*)&lcnt[e0], 1), li1 = atomicAdd((int*)&lcnt[e1], 1);
                    ent[2 * (row - r0)] = e0 | (li0 << 8); ent[2 * (row - r0) + 1] = e1 | (li1 << 8); entw[2 * (row - r0)] = w0; entw[2 * (row - r0) + 1] = w1; }
                asm volatile("s_waitcnt lgkmcnt(0)" ::: "memory"); }
        }
    }
    if (ROUTE) {
        __syncthreads();
        unsigned* gcnt = (unsigned*)(P.ws + WS_CTL) + CW_CNT + 64 * LAYER;
        if (tid < 16) lbase[tid] = (int)atomicAdd(gcnt + tid, (unsigned)lcnt[tid]);
        __syncthreads();
        int* list = (int*)(P.ws + WS_LIST); float* listw = (float*)(P.ws + WS_LISTW);
        for (int i = tid; i < 2 * (r1 - r0); i += 512) { const int en = ent[i]; if (en >= 0) { const int e = en & 0xff, li = en >> 8; const size_t at = (size_t)e * LISTCAP + lbase[e] + li; list[at] = (r0 + (i >> 1)) * 2 + (i & 1); listw[at] = entw[i]; } }
    }
    __syncthreads();
}

__device__ __forceinline__ void attn_naive_item(const Ptrs& P, int row, int h, LAS float* qs, int lane) {
    const bf16_t* Z = (const bf16_t*)(P.ws + WS_Z); bf16_t* A2m = (bf16_t*)(P.ws + WS_A2M);
    const int b = row / LB, p = row - b * LB, rowb = b * LB;
    const bf16_t* zq = Z + (size_t)row * EVEN_IN + 512 + h * 128;
    qs[lane] = bf2f(zq[lane]); qs[64 + lane] = bf2f(zq[64 + lane]);
    asm volatile("s_waitcnt lgkmcnt(0)" ::: "memory");
    const float slope2 = exp2f(-2.f * (float)(h + 1)) * LOG2E;
    float m0 = -INFINITY, m1 = -INFINITY, l0 = 0.f, l1 = 0.f, o00 = 0.f, o01 = 0.f, o10 = 0.f, o11 = 0.f;
    for (int j0 = 0; j0 <= p; j0 += 64) {
        const int j = j0 + lane; const bool valid = j <= p; float s0 = -INFINITY, s1 = -INFINITY;
        if (valid) { const u32x4* kr = (const u32x4*)(Z + (size_t)(rowb + j) * EVEN_IN + 1024 + h * 128); float d0 = 0.f, d1 = 0.f;
#pragma unroll
            for (int c = 0; c < 8; ++c) { const u32x4 kv = kr[c]; const LAS float* q = qs + 8 * c;
                d0 += q[0] * bflo(kv.x) + q[1] * bfhi(kv.x) + q[2] * bflo(kv.y) + q[3] * bfhi(kv.y) + q[4] * bflo(kv.z) + q[5] * bfhi(kv.z) + q[6] * bflo(kv.w) + q[7] * bfhi(kv.w); }
#pragma unroll
            for (int c = 8; c < 16; ++c) { const u32x4 kv = kr[c]; const LAS float* q = qs + 8 * c;
                d1 += q[0] * bflo(kv.x) + q[1] * bfhi(kv.x) + q[2] * bflo(kv.y) + q[3] * bfhi(kv.y) + q[4] * bflo(kv.z) + q[5] * bfhi(kv.z) + q[6] * bflo(kv.w) + q[7] * bfhi(kv.w); }
            const float bias = -slope2 * (float)(p - j); s0 = d0 + bias; s1 = d1 + bias; }
        const float mn0 = fmaxf(m0, wave_max(s0)), mn1 = fmaxf(m1, wave_max(s1));
        const float f0 = exp2f(m0 - mn0), f1 = exp2f(m1 - mn1);
        const float p0 = valid ? exp2f(s0 - mn0) : 0.f, p1 = valid ? exp2f(s1 - mn1) : 0.f;
        l0 = l0 * f0 + wave_sum(p0); l1 = l1 * f1 + wave_sum(p1); o00 *= f0; o01 *= f0; o10 *= f1; o11 *= f1; m0 = mn0; m1 = mn1;
        const int nk = (p - j0 + 1) < 64 ? (p - j0 + 1) : 64;
        const bf16_t* vr = Z + (size_t)(rowb + j0) * EVEN_IN + 1536 + h * 128 + lane;
        for (int jj = 0; jj < nk; ++jj) { const float a0 = __shfl(p0, jj), a1 = __shfl(p1, jj); const float v0 = bf2f(vr[(size_t)jj * EVEN_IN]), v1 = bf2f(vr[(size_t)jj * EVEN_IN + 64]);
            o00 += a0 * v0; o01 += a0 * v1; o10 += a1 * v0; o11 += a1 * v1; }
    }
    const float lam = ((const float*)(P.ws + WS_MISC))[0];
    const float a0 = o00 / l0 - lam * o10 / l1, a1 = o01 / l0 - lam * o11 / l1;
    const float r = 1.f / sqrtf(wave_sum(a0 * a0 + a1 * a1) * (1.f / 128.f) + RMS_EPS);
    bf16_t* o = A2m + (size_t)(b * NMETA + p) * D + 512 + h * 128;
    o[lane] = (bf16_t)f2bf(a0 * r * P.subln[lane] * (1.f - LAMBDA_INIT)); o[64 + lane] = (bf16_t)f2bf(a1 * r * P.subln[64 + lane] * (1.f - LAMBDA_INIT));
}

namespace att {
typedef short s16x4 __attribute__((ext_vector_type(4)));
typedef short v4i16_t __attribute__((ext_vector_type(4)));
constexpr int KSLOT = 8192, VSLOT = 16384, NBUF = 2;
constexpr int LDS_K = 0, LDS_V = NBUF * KSLOT, LDS_WS = LDS_V + NBUF * VSLOT, LDS_OST = LDS_WS + 2048, LDS_TOTAL = LDS_OST + 8 * 8192;
static_assert(LDS_TOTAL <= 131072, "attention LDS");
constexpr float THR = 8.f;
__device__ __forceinline__ int crow(int r, int hi) { return (r & 3) + 8 * (r >> 2) + 4 * hi; }
__device__ __forceinline__ float swapmax(float v) { auto rr = __builtin_amdgcn_permlane32_swap(__float_as_uint(v), __float_as_uint(v), false, false); return fmaxf(__uint_as_float(rr[0]), __uint_as_float(rr[1])); }
__device__ __forceinline__ float swapsum(float v) { auto rr = __builtin_amdgcn_permlane32_swap(__float_as_uint(v), __float_as_uint(v), false, false); return __uint_as_float(rr[0]) + __uint_as_float(rr[1]); }
#define VTR_A(dst, base, off) asm volatile("ds_read_b64_tr_b16 %0, %1 offset:%2" : "=v"(dst) : "v"(base), "n"(off))
#define VTR_WAIT(n, a, b) asm volatile("s_waitcnt lgkmcnt(%2)" : "+v"(a), "+v"(b) : "n"(n))
__device__ __forceinline__ s16x4 vtr(const LAS unsigned char* p) { return __builtin_bit_cast(s16x4, __builtin_amdgcn_ds_read_tr16_b64_v4i16((LAS v4i16_t*)p)); }

__device__ __forceinline__ void glds16(const void* gsrc, unsigned lds_dst) { unsigned keep;
    asm volatile("s_mov_b32 %0, m0\n\ts_mov_b32 m0, %2\n\ts_nop 0\n\tglobal_load_lds_dwordx4 %1, off\n\ts_mov_b32 m0, %0" : "=&s"(keep) : "v"(gsrc), "s"(lds_dst) : "memory"); }
#define ATT_WAITBAR() asm volatile("s_waitcnt vmcnt(0) lgkmcnt(0)\n\ts_barrier" ::: "memory")
#define ATT_WAITBAR_N(n) asm volatile("s_waitcnt vmcnt(" #n ") lgkmcnt(0)\n\ts_barrier" ::: "memory")
constexpr int PD = 3, K4 = PD + 1, V3 = PD + 2;
constexpr int L2_K = 0, L2_V = K4 * KSLOT, L2_WS = L2_V + V3 * VSLOT, L2_TOTAL = L2_WS + 2048, L2_OST = 0;
static_assert(L2_TOTAL + 128 <= 131072 && 8 * 8192 <= L2_WS, "attention v2 LDS");
__device__ __forceinline__ unsigned short bfr(float f) { return (unsigned short)f2bf(f); }
__device__ __forceinline__ void attn_unit(const Ptrs& P, LAS unsigned char* lds, int b, int vh, int qb) {
    const int tid = tid_opaque(P), lane = tid & 63, r32 = lane & 31, hi = lane >> 5; const int wid = __builtin_amdgcn_readfirstlane(tid >> 6);
    const bf16_t* Z = (const bf16_t*)(P.ws + WS_Z); bf16_t* Ob = (bf16_t*)(P.ws + WS_OA);
    const int rowb = b * LB, hd = vh >> 1;
    const int qrow0 = rowb + NMETA + 256 * qb + 32 * wid;
    const bf16_t* Kc = Z + 1024 + vh * 64; const bf16_t* Vc = Z + 1536 + hd * 128;
    const float slope2 = __uint_as_float(__builtin_amdgcn_readfirstlane(__float_as_uint(exp2f(-2.f * (float)(hd + 1)) * LOG2E)));
    LAS float* wsf = (LAS float*)(lds + L2_WS) + wid * 64;
    bf16x8 qr[4];
    { const bf16_t* qp = Z + (size_t)(qrow0 + r32) * EVEN_IN + 512 + vh * 64 + hi * 8;
#pragma unroll
        for (int ks = 0; ks < 4; ++ks) qr[ks] = *(const bf16x8*)(qp + ks * 16); }
#define ATT_KROW0(i) (((i) >= NR) ? rowb : rowb + NMETA + 64 * (4 * qb + 3 - (i)))
#define ATT_PK0(i) (((i) >= NR) ? 0 : NMETA + 64 * (4 * qb + 3 - (i)))
#define ATT_DMA(i) do { const int kr0_ = ATT_KROW0(i); const int ks_ = (i) % K4, vs_ = (i) % V3; \
        glds16(Kc + (size_t)(kr0_ + krow_) * EVEN_IN + kchk_ * 8, (unsigned)__builtin_amdgcn_readfirstlane((int)(lds0 + L2_K + ks_ * KSLOT + wid * 1024))); \
        _Pragma("unroll") for (int i_ = 0; i_ < 2; ++i_) { const int pc_ = wid * 2 + i_, db_ = pc_ >> 2, rg_ = pc_ & 3; \
            glds16(Vc + (size_t)(kr0_ + 16 * rg_ + (lane >> 2)) * EVEN_IN + db_ * 32 + (lane & 3) * 8, (unsigned)__builtin_amdgcn_readfirstlane((int)(lds0 + L2_V + vs_ * VSLOT + pc_ * 1024))); } } while (0)
    const unsigned lds0 = (unsigned)(size_t)lds;
    const int krow_ = 8 * wid + (lane >> 3), kchk_ = (lane & 7) ^ ((krow_ >> 1) & 7);
    int koff[4];
#pragma unroll
    for (int ks = 0; ks < 4; ++ks) koff[ks] = r32 * 128 + (((2 * ks + hi) ^ ((r32 >> 1) & 7)) << 4);
    int NR = 1 << 30, NT;
    ATT_DMA(0); ATT_DMA(1); ATT_DMA(2);
    { float qs = 0.f;
#pragma unroll
        for (int ks = 0; ks < 4; ++ks) { const u32x4 w = __builtin_bit_cast(u32x4, qr[ks]);
#pragma unroll
            for (int j = 0; j < 4; ++j) { const float a_ = bflo(w[j]), b_ = bfhi(w[j]); qs += a_ * a_ + b_ * b_; } }
        qs = swapsum(qs);
#pragma unroll
        for (int o_ = 1; o_ < 32; o_ <<= 1) qs = fmaxf(qs, __shfl_xor(qs, o_));
        if (lane == 0) wsf[0] = qs;
        ATT_WAITBAR();
        float q2 = 0.f;
#pragma unroll
        for (int w_ = 0; w_ < 8; ++w_) q2 = fmaxf(q2, ((LAS float*)(lds + L2_WS))[w_ * 64]);
        const unsigned* kn = (const unsigned*)(P.ws + WS_CTL) + CW_KN;
        const int kl_ = lane < 6 ? lane : 0; const unsigned kw_ = __hip_atomic_load(kn + (kl_ < 2 ? (b * 8 + vh) * 2 + kl_ : 64 + vh * 4 + (kl_ - 2)), __ATOMIC_RELAXED, __HIP_MEMORY_SCOPE_AGENT);
        const float k2r = __uint_as_float(__builtin_amdgcn_readlane(kw_, 0)) + __uint_as_float(__builtin_amdgcn_readlane(kw_, 1));
        const float k2m = __uint_as_float(__builtin_amdgcn_readlane(kw_, 2)) + __uint_as_float(__builtin_amdgcn_readlane(kw_, 3)) + __uint_as_float(__builtin_amdgcn_readlane(kw_, 4)) + __uint_as_float(__builtin_amdgcn_readlane(kw_, 5));
        const float QK = sqrtf(q2 * fmaxf(k2r, k2m) * 1.02f) * 1.01f + 1.f;
        const float dist = (151.f + 2.f * QK) / slope2;
        int tskip = (int)floorf(((float)(256 * qb - 63) - dist) * (1.f / 64.f)); tskip = tskip < -1 ? -1 : tskip;
        NR = 4 * qb + 3 - tskip; const bool hasm = (float)(NMETA + 256 * qb - 15) <= dist;
        NR = __builtin_amdgcn_readfirstlane(NR); NT = NR + (__builtin_amdgcn_readfirstlane((int)hasm) ? 1 : 0); }
    const int qrel = 32 * wid + r32, pq = NMETA + 256 * qb + qrel;
    float l = 0.f, cin = 0.f;
#define ATT_SETC() do { } while (0)
    f32x16 o[4];
#pragma unroll
    for (int d = 0; d < 4; ++d) o[d] = f32x16{};
    u32x4 pw[4];
    f32x16 p0, p1;
    const LAS unsigned char* vpl = lds + L2_V + ((lane >> 4) & 1) * 32 + (lane & 3) * 8 + (4 * hi + ((lane & 15) >> 2)) * 64;
#define ATT_QK(i) do { bf16x8 kf_[8];     \
        { const LAS unsigned char* kb_ = lds + L2_K + ((i) % K4) * KSLOT; \
          _Pragma("unroll") for (int ks = 0; ks < 4; ++ks) { kf_[2 * ks] = *(const LAS bf16x8*)(kb_ + koff[ks]); kf_[2 * ks + 1] = *(const LAS bf16x8*)(kb_ + koff[ks] + 4096); } } \
        __builtin_amdgcn_sched_barrier(0); \
        { const float cl_ = slope2 * (float)(ATT_PK0(i) + 4 * hi - pq) + cin, s32_ = 32.f * slope2; \
          _Pragma("unroll") for (int r = 0; r < 16; ++r) { p0[r] = fmaf(slope2, (float)((r & 3) + 8 * (r >> 2)), cl_); p1[r] = p0[r] + s32_; } } \
        _Pragma("unroll") for (int ks = 0; ks < 4; ++ks) { \
            p0 = __builtin_amdgcn_mfma_f32_32x32x16_bf16(kf_[2 * ks], qr[ks], p0, 0, 0, 0); p1 = __builtin_amdgcn_mfma_f32_32x32x16_bf16(kf_[2 * ks + 1], qr[ks], p1, 0, 0, 0); } \
        if ((i) < 4 || (i) >= NR) { const int lim_ = (((i) >= NR) ? 15 : qrel - 64 * (3 - (i))) - 4 * hi;     \
            _Pragma("unroll") for (int r = 0; r < 16; ++r) { const int kv = (r & 3) + 8 * (r >> 2); if (kv > lim_) p0[r] = -INFINITY; if (kv + 32 > lim_) p1[r] = -INFINITY; } } } while (0)
#define ATT_PV(vslot) do { const LAS unsigned char* vp_ = vpl + (vslot) * VSLOT; \
        _Pragma("unroll") for (int s2_ = 0; s2_ < 4; ++s2_) { s16x4 vq_[8]; \
            _Pragma("unroll") for (int d = 0; d < 4; ++d) { vq_[2 * d] = vtr(vp_ + d * 4096 + s2_ * 1024); vq_[2 * d + 1] = vtr(vp_ + d * 4096 + s2_ * 1024 + 512); } \
            _Pragma("unroll") for (int d = 0; d < 4; ++d) { const bf16x8 vf = (bf16x8){vq_[2 * d][0], vq_[2 * d][1], vq_[2 * d][2], vq_[2 * d][3], vq_[2 * d + 1][0], vq_[2 * d + 1][1], vq_[2 * d + 1][2], vq_[2 * d + 1][3]}; \
                o[d] = __builtin_amdgcn_mfma_f32_32x32x16_bf16(__builtin_bit_cast(bf16x8, pw[s2_]), vf, o[d], 0, 0, 0); } } } while (0)
#define ATT_ROWMAX(mx) do { float a_ = fmaxf(p0[0], p1[0]); _Pragma("unroll") for (int r = 1; r < 16; ++r) a_ = fmaxf(a_, fmaxf(p0[r], p1[r])); mx = swapmax(a_); } while (0)
#define ATT_IMAX(im) do { int a_ = __float_as_int(p0[0]); _Pragma("unroll") for (int r = 1; r < 16; ++r) { const int b_ = __float_as_int(p0[r]); a_ = a_ > b_ ? a_ : b_; } \
        _Pragma("unroll") for (int r = 0; r < 16; ++r) { const int b_ = __float_as_int(p1[r]); a_ = a_ > b_ ? a_ : b_; } im = a_; } while (0)
#define ATT_EXP_PACK() do { float sacc = 0.f; \
        _Pragma("unroll") for (int r = 0; r < 16; ++r) { p0[r] = __builtin_amdgcn_exp2f(p0[r]); p1[r] = __builtin_amdgcn_exp2f(p1[r]); sacc += p0[r] + p1[r]; } \
        l += sacc; \
        _Pragma("unroll") for (int j = 0; j < 4; ++j) { pw[0][j] = cvt_pk_bf16(p0[2 * j], p0[2 * j + 1]); pw[1][j] = cvt_pk_bf16(p0[8 + 2 * j], p0[8 + 2 * j + 1]); \
            pw[2][j] = cvt_pk_bf16(p1[2 * j], p1[2 * j + 1]); pw[3][j] = cvt_pk_bf16(p1[8 + 2 * j], p1[8 + 2 * j + 1]); } } while (0)
    f32x16 q0, q1;
    ATT_WAITBAR_N(6);
    ATT_QK(0);
    { float mx; ATT_ROWMAX(mx); const float d0 = fmaxf(mx, -256.f); cin -= d0;
#pragma unroll
        for (int r = 0; r < 16; ++r) { p0[r] = __builtin_amdgcn_exp2f(p0[r] - d0); p1[r] = __builtin_amdgcn_exp2f(p1[r] - d0); } }
#define ATT_PACK4(O0, O1, g) do { const int b_ = (((g) >> 1) * 8 + ((g) & 1) * 4) & 15; \
        if ((g) < 4) { pw[(g) >> 1][2 * ((g) & 1)] = cvt_pk_bf16(O0[b_], O0[b_ + 1]); pw[(g) >> 1][2 * ((g) & 1) + 1] = cvt_pk_bf16(O0[b_ + 2], O0[b_ + 3]); sacc += (O0[b_] + O0[b_ + 1]) + (O0[b_ + 2] + O0[b_ + 3]); } \
        else { pw[(g) >> 1][2 * ((g) & 1)] = cvt_pk_bf16(O1[b_], O1[b_ + 1]); pw[(g) >> 1][2 * ((g) & 1) + 1] = cvt_pk_bf16(O1[b_ + 2], O1[b_ + 3]); sacc += (O1[b_] + O1[b_ + 1]) + (O1[b_ + 2] + O1[b_ + 3]); } \
        asm volatile("" : "+v"(pw[(g) >> 1][2 * ((g) & 1)]), "+v"(pw[(g) >> 1][2 * ((g) & 1) + 1]), "+v"(sacc)); } while (0)
#define ATT_STEP(i, N0, N1, O0, O1) do { \
        { bf16x8 kf_[8]; float sacc = 0.f; \
          { const LAS unsigned char* kb_ = lds + L2_K + ((i) % K4) * KSLOT; \
            _Pragma("unroll") for (int ks = 0; ks < 4; ++ks) { kf_[2 * ks] = *(const LAS bf16x8*)(kb_ + koff[ks]); kf_[2 * ks + 1] = *(const LAS bf16x8*)(kb_ + koff[ks] + 4096); } } \
          __builtin_amdgcn_sched_barrier(0); \
          { const float cl_ = slope2 * (float)(ATT_PK0(i) + 4 * hi - pq) + cin, s32_ = 32.f * slope2; \
            _Pragma("unroll") for (int r = 0; r < 16; ++r) { N0[r] = fmaf(slope2, (float)((r & 3) + 8 * (r >> 2)), cl_); N1[r] = N0[r] + s32_; } } \
          _Pragma("unroll") for (int ks = 0; ks < 4; ++ks) { \
              N0 = __builtin_amdgcn_mfma_f32_32x32x16_bf16(kf_[2 * ks], qr[ks], N0, 0, 0, 0); ATT_PACK4(O0, O1, 2 * ks); __builtin_amdgcn_sched_barrier(0); \
              N1 = __builtin_amdgcn_mfma_f32_32x32x16_bf16(kf_[2 * ks + 1], qr[ks], N1, 0, 0, 0); ATT_PACK4(O0, O1, 2 * ks + 1); __builtin_amdgcn_sched_barrier(0); } \
          l += sacc; \
          if ((i) < 4 || (i) >= NR) { const int lim_ = (((i) >= NR) ? 15 : qrel - 64 * (3 - (i))) - 4 * hi; \
              _Pragma("unroll") for (int r = 0; r < 16; ++r) { const int kv = (r & 3) + 8 * (r >> 2); if (kv > lim_) N0[r] = -INFINITY; if (kv + 32 > lim_) N1[r] = -INFINITY; } } } \
        unsigned vp_ = (unsigned)(size_t)vpl + (unsigned)((((i) - 1) % V3) * VSLOT); asm volatile("" : "+v"(vp_)); \
        s16x4 vq[2][8]; \
        _Pragma("unroll") for (int d = 0; d < 4; ++d) { VTR_A(vq[0][2 * d], vp_, d * 4096); VTR_A(vq[0][2 * d + 1], vp_, d * 4096 + 512); } \
        __builtin_amdgcn_sched_barrier(0); \
        int imx; { int a_ = __float_as_int(N0[0]); _Pragma("unroll") for (int r = 1; r < 16; ++r) { const int b_ = __float_as_int(N0[r]); a_ = a_ > b_ ? a_ : b_; } \
            _Pragma("unroll") for (int r = 0; r < 16; ++r) { const int b_ = __float_as_int(N1[r]); a_ = a_ > b_ ? a_ : b_; } imx = a_; } \
        if (__any(imx > __builtin_bit_cast(int, THR))) { \
            float mx; { float a_ = fmaxf(N0[0], N1[0]); _Pragma("unroll") for (int r = 1; r < 16; ++r) a_ = fmaxf(a_, fmaxf(N0[r], N1[r])); mx = swapmax(a_); } \
            const float dl = ceilf(fmaxf(mx, 0.f)), f = __builtin_amdgcn_exp2f(-dl); cin -= dl; l *= f; \
            if (hi == 0) wsf[r32] = f; \
            asm volatile("s_waitcnt lgkmcnt(0)" ::: "memory"); \
            _Pragma("unroll") for (int r = 0; r < 16; ++r) { const float fr_ = wsf[crow(r, hi)]; N0[r] -= dl; N1[r] -= dl; \
                _Pragma("unroll") for (int d = 0; d < 4; ++d) o[d][r] *= fr_; } \
            const unsigned du = (unsigned)dl; \
            _Pragma("unroll") for (int s2_ = 0; s2_ < 4; ++s2_) _Pragma("unroll") for (int j = 0; j < 4; ++j) { const unsigned w = pw[s2_][j]; unsigned lo = w & 0xffffu, hh = w >> 16; \
                    lo = (((lo >> 7) & 0xffu) > du) ? lo - (du << 7) : 0u; hh = (((hh >> 7) & 0xffu) > du) ? hh - (du << 7) : 0u; pw[s2_][j] = lo | (hh << 16); } \
        } \
        _Pragma("unroll") for (int s2_ = 0; s2_ < 4; ++s2_) { \
            if (s2_ < 3) { _Pragma("unroll") for (int d = 0; d < 4; ++d) { VTR_A(vq[(s2_ + 1) & 1][2 * d], vp_, d * 4096 + (s2_ + 1) * 1024); VTR_A(vq[(s2_ + 1) & 1][2 * d + 1], vp_, d * 4096 + (s2_ + 1) * 1024 + 512); } } \
            __builtin_amdgcn_sched_barrier(0); \
            _Pragma("unroll") for (int d = 0; d < 4; ++d) { VTR_WAIT((s2_ < 3 ? 8 : 0) + 6 - 2 * d, vq[s2_ & 1][2 * d], vq[s2_ & 1][2 * d + 1]); \
                const s16x4 lo = vq[s2_ & 1][2 * d], h4 = vq[s2_ & 1][2 * d + 1]; \
                const bf16x8 vf = (bf16x8){lo[0], lo[1], lo[2], lo[3], h4[0], h4[1], h4[2], h4[3]}; \
                o[d] = __builtin_amdgcn_mfma_f32_32x32x16_bf16(__builtin_bit_cast(bf16x8, pw[s2_]), vf, o[d], 0, 0, 0); \
                const int e_ = s2_ * 4 + d; \
                if (e_ < 8) { float x0_ = __builtin_amdgcn_exp2f(N0[2 * e_]), x1_ = __builtin_amdgcn_exp2f(N0[2 * e_ + 1]); asm volatile("" : "+v"(x0_), "+v"(x1_)); N0[2 * e_] = x0_; N0[2 * e_ + 1] = x1_; }     \
                else { float x0_ = __builtin_amdgcn_exp2f(N1[(2 * e_) & 15]), x1_ = __builtin_amdgcn_exp2f(N1[(2 * e_ + 1) & 15]); asm volatile("" : "+v"(x0_), "+v"(x1_)); N1[(2 * e_) & 15] = x0_; N1[(2 * e_ + 1) & 15] = x1_; } } \
            __builtin_amdgcn_sched_barrier(0); } } while (0)
    { int i = 1;
        for (; i + 1 < NT; i += 2) { ATT_WAITBAR_N(0); if (i + 2 < NT) ATT_DMA(i + 2); if (i + 3 < NT) ATT_DMA(i + 3);
            ATT_STEP(i, q0, q1, p0, p1); ATT_STEP(i + 1, p0, p1, q0, q1); }
        if (i < NT) { ATT_WAITBAR_N(0); ATT_STEP(i, q0, q1, p0, p1); float sacc = 0.f;
#pragma unroll
            for (int g = 0; g < 8; ++g) ATT_PACK4(q0, q1, g);
            l += sacc; }
        else { float sacc = 0.f;
#pragma unroll
            for (int g = 0; g < 8; ++g) ATT_PACK4(p0, p1, g);
            l += sacc; } }
#undef ATT_STEP
#undef ATT_PACK4
    ATT_PV((NT - 1) % V3);
    l = swapsum(l);
    if (hi == 0) wsf[32 + r32] = l;
    ATT_WAITBAR();
    LAS bf16_t* stg = (LAS bf16_t*)(lds + L2_OST + wid * 8192);
    int lane_e = lane; asm volatile("" : "+v"(lane_e));
    const int r32e = lane_e & 31, hie = lane_e >> 5;
#pragma unroll
    for (int r = 0; r < 16; ++r) { const int orow = crow(r, hie); const float rl = 1.f / wsf[32 + orow];
#pragma unroll
        for (int d = 0; d < 4; ++d) stg[orow * 128 + d * 32 + r32e] = (bf16_t)f2bf(o[d][r] * rl); }
    asm volatile("s_waitcnt lgkmcnt(0)" ::: "memory");
#pragma unroll
    for (int i = 0; i < 8; ++i) { const int row = i * 4 + (lane_e >> 4), ch = lane_e & 15; const u32x4 v = *(const LAS u32x4*)(stg + row * 128 + ch * 8);
        *(u32x4*)(Ob + (size_t)(qrow0 + row) * D + vh * 128 + ch * 8) = v; }
    ATT_WAITBAR();
#undef ATT_DMA
#undef ATT_KROW0
#undef ATT_PK0
#undef ATT_QK
#undef ATT_PV
#undef ATT_ROWMAX
#undef ATT_IMAX
#undef ATT_EXP_PACK
#undef ATT_SETC
}
}

__device__ __forceinline__ void stage_attn(const Ptrs& P, LAS unsigned char* lds, int wg, int nwg, int flags) {
    const int tid_ = tid_opaque(P); const int lane = tid_ & 63, wave = __builtin_amdgcn_readfirstlane(tid_ >> 6);
    if (!(flags & 2)) { LAS float* qs = (LAS float*)(lds) + wave * 128;
        for (int it = wg * 8 + wave; it < NB * NMETA * 4; it += nwg * 8) { const int rr = it >> 2; attn_naive_item(P, (rr >> 4) * LB + (rr & 15), it & 3, qs, lane); }
        }
    __syncthreads();
    if (nwg == 256 && wg >= 192 && !(flags & 2)) { prep_items(P, lds, PREP_EARLY, PREP_NITEMS, (wg - 192) * 8 + wave, 64 * 8, lane, wave); prep_fold(P, (wg - 192) * 8 + wave, 64 * 8, lane); __syncthreads(); }
    if (flags & 1) return;
    unsigned* qhead = (unsigned*)(P.ws + WS_CTL) + CW_AQ; LAS int* qslot = (LAS int*)(lds + att::L2_TOTAL + 64);
    for (;;) {
        if (tid_ == 0) qslot[0] = (int)atomicAdd(qhead, 1u);
        __syncthreads();
        const int L = __builtin_amdgcn_readfirstlane(qslot[0]);
        __syncthreads();
        if (L >= 1024) break;
        int b, vh, qb;
        if (L < 512) { qb = 31 - (L >> 4); b = (L >> 2) & 3; vh = 4 + (L & 3); }
        else { const int j = L & 255; qb = 31 - (j >> 3); b = (j >> 1) & 3; vh = (L < 768 ? 2 : 0) + (j & 1); }
        att::attn_unit(P, lds, b, vh, qb); }
}
__device__ __forceinline__ void stage_combine(const Ptrs& P, int wg, int nwg) {
    const int tid_ = tid_opaque(P); const int lane = tid_ & 63, wave = __builtin_amdgcn_readfirstlane(tid_ >> 6); const bf16_t* Ob = (const bf16_t*)(P.ws + WS_OA); unsigned char* A28 = P.ws + WS_A2;
    const float lam = ((const float*)(P.ws + WS_MISC))[0]; const int h = lane >> 4, c = (lane & 15) * 8;
    float sw[8];
#pragma unroll
    for (int j = 0; j < 8; ++j) sw[j] = P.subln[c + j] * (1.f - LAMBDA_INIT);
    for (int rr0 = (wg * 8 + wave) * 4; rr0 < NB * SEQ; rr0 += nwg * 8 * 4) {
        u32x4 av[4], bv[4];
#pragma unroll
        for (int q = 0; q < 4; ++q) { const int rr = rr0 + q, row = (rr >> 13) * LB + NMETA + (rr & 8191);
            av[q] = *(const u32x4*)(Ob + (size_t)row * D + (2 * h) * 128 + c); bv[q] = *(const u32x4*)(Ob + (size_t)row * D + (2 * h + 1) * 128 + c); }
#pragma unroll
        for (int q = 0; q < 4; ++q) { const int rr = rr0 + q, row = (rr >> 13) * LB + NMETA + (rr & 8191); const u32x4 a = av[q], bb = bv[q];
            float v[8]; v[0] = bflo(a.x) - lam * bflo(bb.x); v[1] = bfhi(a.x) - lam * bfhi(bb.x); v[2] = bflo(a.y) - lam * bflo(bb.y); v[3] = bfhi(a.y) - lam * bfhi(bb.y);
            v[4] = bflo(a.z) - lam * bflo(bb.z); v[5] = bfhi(a.z) - lam * bfhi(bb.z); v[6] = bflo(a.w) - lam * bflo(bb.w); v[7] = bfhi(a.w) - lam * bfhi(bb.w);
            float ss = 0.f;
#pragma unroll
            for (int j = 0; j < 8; ++j) ss += v[j] * v[j];
            ss += __shfl_xor(ss, 1); ss += __shfl_xor(ss, 2); ss += __shfl_xor(ss, 4); ss += __shfl_xor(ss, 8);
            const float r = 1.f / sqrtf(ss * (1.f / 128.f) + RMS_EPS);
            const float rr_ = r * F8_ASCALE; u32x2 o; o.x = pk4_fp8(v[0] * rr_ * sw[0], v[1] * rr_ * sw[1], v[2] * rr_ * sw[2], v[3] * rr_ * sw[3]); o.y = pk4_fp8(v[4] * rr_ * sw[4], v[5] * rr_ * sw[5], v[6] * rr_ * sw[6], v[7] * rr_ * sw[7]);
            *(u32x2*)(A28 + (size_t)row * D + 512 + h * 128 + c) = o; } }
}

namespace gla {
 using att::s16x4; using att::vtr; using att::crow;
constexpr int LQD = 0, LKD = 16384, LKW = 32768, LP = 49152, LV = 58368, LOS = 91136, LEB = 124928, LHN = LEB + 1024, LGL = LHN + 1024, LEND = LGL + 4096;
static_assert(LEND <= 131072, "gla LDS");
constexpr int PST = 144, OST = 528;
constexpr size_t U_BYTES = (size_t)128 * 256 * 4;
__device__ __forceinline__ float* u_slot(const Ptrs& P, int bh, int seg) { return (float*)(P.ws + WS_OA + ((size_t)bh * 16 + seg) * U_BYTES); }
__device__ __forceinline__ float* a_slot(const Ptrs& P, int bh, int seg) { return (float*)(P.ws + WS_OA + (size_t)256 * U_BYTES) + ((size_t)bh * 16 + seg) * 128; }
__device__ __forceinline__ float* eb_slot(const Ptrs& P, int b, int cidx) { return (float*)(P.ws + WS_OA + (size_t)256 * U_BYTES + 262144) + ((size_t)b * 129 + cidx) * 512; }

constexpr int PRE_W2 = 0, PRE_TOT = 32768;
__device__ __forceinline__ void pre_chunk(const Ptrs& P, LAS unsigned char* lds, int tid, int r0, int nrows, float* eb, const float (&gb)[8]) {
    const int lane = tid & 63; const int w = __builtin_amdgcn_readfirstlane(tid >> 6);
    bf16_t* Z = (bf16_t*)(P.ws + WS_Z); const float* GLR = (const float*)(P.ws + WS_GLR); LAS float* gl = (LAS float*)(lds + LGL);
    const LAS f32x4* w2l = (const LAS f32x4*)(lds + PRE_W2); LAS f32x4* totl = (LAS f32x4*)(lds + PRE_TOT);
    const int nact = nrows >> 3; const bool act = w < nact;
    bf16_t* zr = Z + (size_t)(r0 + 8 * w) * ODD_N + 8 * lane;
#define PRE_BAR() asm volatile("s_waitcnt lgkmcnt(0)\n\ts_barrier" ::: "memory")
    u32x4 qv[8], kv[8];
    const f32x4 glr = ((const f32x4*)(GLR + (size_t)r0 * 16))[tid & 255];
    __builtin_amdgcn_sched_barrier(0);
#pragma unroll
    for (int t = 0; t < 8; ++t) { qv[t] = *(const u32x4*)(zr + (size_t)t * ODD_N); kv[t] = *(const u32x4*)(zr + (size_t)t * ODD_N + 512); }
    __builtin_amdgcn_sched_barrier(0);
    ((LAS f32x4*)gl)[tid & 255] = glr;
    PRE_BAR();
    float cum[8][8];
    if (act) {
#pragma unroll
        for (int t = 0; t < 8; ++t)
#pragma unroll
            for (int ch = 0; ch < 8; ++ch) cum[t][ch] = gb[ch];
#pragma unroll
        for (int j4 = 0; j4 < 4; ++j4) { f32x4 glv[8];
#pragma unroll
            for (int t = 0; t < 8; ++t) glv[t] = ((const LAS f32x4*)gl)[(8 * w + t) * 4 + j4];
#pragma unroll
            for (int jj = 0; jj < 4; ++jj) { const f32x4 wa = w2l[((4 * j4 + jj) * 2 + 0) * 64 + lane], wb = w2l[((4 * j4 + jj) * 2 + 1) * 64 + lane];
#pragma unroll
                for (int t = 0; t < 8; ++t) { const float sg = glv[t][jj];
                    cum[t][0] += sg * wa[0]; cum[t][1] += sg * wa[1]; cum[t][2] += sg * wa[2]; cum[t][3] += sg * wa[3];
                    cum[t][4] += sg * wb[0]; cum[t][5] += sg * wb[1]; cum[t][6] += sg * wb[2]; cum[t][7] += sg * wb[3]; } } }
#pragma unroll
        for (int ch = 0; ch < 8; ++ch) { float run = 0.f;
#pragma unroll
            for (int t = 0; t < 8; ++t) { const float g = cum[t][ch]; run += (fminf(g, 0.f) - __logf(1.f + __expf(-fabsf(g)))) * (1.f / 16.f); cum[t][ch] = run; } }
        totl[(w * 2 + 0) * 64 + lane] = (f32x4){cum[7][0], cum[7][1], cum[7][2], cum[7][3]}; totl[(w * 2 + 1) * 64 + lane] = (f32x4){cum[7][4], cum[7][5], cum[7][6], cum[7][7]};
    }
    PRE_BAR();
    if (act) {
        float off[8];
#pragma unroll
        for (int ch = 0; ch < 8; ++ch) off[ch] = 0.f;
        for (int pw_ = 0; pw_ < w; ++pw_) { const f32x4 a = totl[(pw_ * 2 + 0) * 64 + lane], b = totl[(pw_ * 2 + 1) * 64 + lane];
            off[0] += a[0]; off[1] += a[1]; off[2] += a[2]; off[3] += a[3]; off[4] += b[0]; off[5] += b[1]; off[6] += b[2]; off[7] += b[3]; }
#pragma unroll
        for (int t = 0; t < 8; ++t) { float e[8], ie[8];
#pragma unroll
            for (int ch = 0; ch < 8; ++ch) { e[ch] = __expf(off[ch] + cum[t][ch]); ie[ch] = __builtin_amdgcn_rcpf(e[ch]); }
            const u32x4 q = qv[t], k = kv[t]; u32x4 qo, ko;
            qo.x = cvt_pk_bf16(bflo(q.x) * e[0], bfhi(q.x) * e[1]); qo.y = cvt_pk_bf16(bflo(q.y) * e[2], bfhi(q.y) * e[3]); qo.z = cvt_pk_bf16(bflo(q.z) * e[4], bfhi(q.z) * e[5]); qo.w = cvt_pk_bf16(bflo(q.w) * e[6], bfhi(q.w) * e[7]);
            ko.x = cvt_pk_bf16(bflo(k.x) * ie[0], bfhi(k.x) * ie[1]); ko.y = cvt_pk_bf16(bflo(k.y) * ie[2], bfhi(k.y) * ie[3]); ko.z = cvt_pk_bf16(bflo(k.z) * ie[4], bfhi(k.z) * ie[5]); ko.w = cvt_pk_bf16(bflo(k.w) * ie[6], bfhi(k.w) * ie[7]);
            *(u32x4*)(zr + (size_t)t * ODD_N) = qo; *(u32x4*)(zr + (size_t)t * ODD_N + 512) = ko; }
        if (w == nact - 1) {
            *(f32x4*)(eb + 8 * lane) = (f32x4){__expf(off[0] + cum[7][0]), __expf(off[1] + cum[7][1]), __expf(off[2] + cum[7][2]), __expf(off[3] + cum[7][3])};
            *(f32x4*)(eb + 8 * lane + 4) = (f32x4){__expf(off[4] + cum[7][4]), __expf(off[5] + cum[7][5]), __expf(off[6] + cum[7][6]), __expf(off[7] + cum[7][7])}; }
    }
    PRE_BAR();
#undef PRE_BAR
}
__device__ __forceinline__ void stage_pre(const Ptrs& P, LAS unsigned char* lds, int wg, int nwg) {
    const int tid = tid_opaque(P); const int lane = tid & 63;
    for (int idx = tid; idx < 2048; idx += 512) { const int j = idx >> 7, hf = (idx >> 6) & 1, ln = idx & 63; ((LAS f32x4*)(lds + PRE_W2))[idx] = *(const f32x4*)(P.gate_w2 + j * 512 + 8 * ln + 4 * hf); }
    float gb[8];
    { const f32x4 a = *(const f32x4*)(P.gate_b + 8 * lane), b = *(const f32x4*)(P.gate_b + 8 * lane + 4); gb[0] = a[0]; gb[1] = a[1]; gb[2] = a[2]; gb[3] = a[3]; gb[4] = b[0]; gb[5] = b[1]; gb[6] = b[2]; gb[7] = b[3]; }
    __syncthreads();
    for (int it = wg; it < NB * 128; it += nwg) { const int b = it >> 7, j = it & 127, rowb = b * LB;
        if (j == 0) pre_chunk(P, lds, tid, rowb, NMETA, eb_slot(P, b, 0), gb);
        pre_chunk(P, lds, tid, rowb + NMETA + 64 * j, 64, eb_slot(P, b, j + 1), gb); }
}

__device__ __forceinline__ void segment_state(const Ptrs& P, LAS unsigned char* lds, int bh, int seg) {
    const int tid = tid_opaque(P), lane = tid & 63, r32 = lane & 31, hi = lane >> 5; const int wid = __builtin_amdgcn_readfirstlane(tid >> 6);
    const int b = bh >> 2, h = bh & 3, rowb = b * LB;
    const bf16_t* Z = (const bf16_t*)(P.ws + WS_Z);
    constexpr int BUF = 49152, BV = 0, BKW = 32768, BEB = 98304;
    const unsigned lds0 = (unsigned)(size_t)lds;
    f32x16 S[4];
#pragma unroll
    for (int cb = 0; cb < 4; ++cb) S[cb] = f32x16{};
    const int nch = 8 + (seg == 0 ? 1 : 0);
    const LAS unsigned char* trb = lds + ((lane >> 4) & 1) * 32 + (lane & 3) * 8 + (8 * hi + ((lane & 15) >> 2)) * 64;
#define GS_R0(ch) ((seg == 0 && (ch) == 0) ? rowb : rowb + NMETA + 64 * (seg * 8 + (ch) - (seg == 0 ? 1 : 0)))
#define GS_ISSUE(ch) do { const int r0_ = GS_R0(ch), bo_ = ((ch) & 1) * BUF; \
        _Pragma("unroll") for (int i_ = 0; i_ < 4; ++i_) { const int pc = wid * 4 + i_, db = pc >> 2, rg = pc & 3; \
            att::glds16(Z + (size_t)(r0_ + 16 * rg + (lane >> 2)) * ODD_N + 1024 + h * 256 + db * 32 + (lane & 3) * 8, (unsigned)__builtin_amdgcn_readfirstlane((int)(lds0 + bo_ + BV + pc * 1024))); } \
        _Pragma("unroll") for (int i_ = 0; i_ < 2; ++i_) { const int pc = wid * 2 + i_, cb = pc >> 2, rg = pc & 3; \
            att::glds16(Z + (size_t)(r0_ + 16 * rg + (lane >> 2)) * ODD_N + 512 + h * 128 + cb * 32 + (lane & 3) * 8, (unsigned)__builtin_amdgcn_readfirstlane((int)(lds0 + bo_ + BKW + pc * 1024))); } \
        if (wid == 0) { const int cidx_ = (seg == 0 && (ch) == 0) ? 0 : seg * 8 + (ch) - (seg == 0 ? 1 : 0) + 1; \
            att::glds16(eb_slot(P, b, cidx_) + h * 128 + lane * 4, (unsigned)__builtin_amdgcn_readfirstlane((int)(lds0 + BEB + ((ch) & 1) * 1024))); } } while (0)
    GS_ISSUE(0); GS_ISSUE(1);
    float aprod = 1.f;
    for (int ch = 0; ch < nch; ++ch) {
        const int bo = (ch & 1) * BUF; const bool metac = (seg == 0 && ch == 0);
        if (ch + 1 < nch) { if (wid == 0) asm volatile("s_waitcnt vmcnt(7) lgkmcnt(0)\n\ts_barrier" ::: "memory"); else asm volatile("s_waitcnt vmcnt(6) lgkmcnt(0)\n\ts_barrier" ::: "memory"); }
        else asm volatile("s_waitcnt vmcnt(0) lgkmcnt(0)\n\ts_barrier" ::: "memory");
        const LAS float* eB = (const LAS float*)(lds + BEB + (ch & 1) * 1024);
        if (tid < 128) aprod *= eB[tid];
        const int nks = metac ? 1 : 4;
        bf16x8 vf[4];
#pragma unroll
        for (int ks = 0; ks < 4; ++ks) { const s16x4 lo = vtr(trb + bo + BV + (wid * 4 + ks) * 1024), h4 = vtr(trb + bo + BV + (wid * 4 + ks) * 1024 + 256); vf[ks] = (bf16x8){lo[0], lo[1], lo[2], lo[3], h4[0], h4[1], h4[2], h4[3]}; }
#pragma unroll
        for (int cb = 0; cb < 4; ++cb) {
#pragma unroll
            for (int ks = 0; ks < 4; ++ks) if (ks < nks) { const s16x4 lo = vtr(trb + bo + BKW + (cb * 4 + ks) * 1024), h4 = vtr(trb + bo + BKW + (cb * 4 + ks) * 1024 + 256);
                const bf16x8 kf = (bf16x8){lo[0], lo[1], lo[2], lo[3], h4[0], h4[1], h4[2], h4[3]};
                S[cb] = __builtin_amdgcn_mfma_f32_32x32x16_bf16(kf, vf[ks], S[cb], 0, 0, 0); }
#pragma unroll
            for (int g = 0; g < 4; ++g) { const f32x4 e4 = *(const LAS f32x4*)(eB + 32 * cb + 8 * g + 4 * hi); S[cb][4 * g] *= e4.x; S[cb][4 * g + 1] *= e4.y; S[cb][4 * g + 2] *= e4.z; S[cb][4 * g + 3] *= e4.w; } }
        asm volatile("s_waitcnt lgkmcnt(0)\n\ts_barrier" ::: "memory");
        if (ch + 2 < nch) GS_ISSUE(ch + 2);
    }
#undef GS_ISSUE
#undef GS_R0
    float* u = u_slot(P, bh, seg);
#pragma unroll
    for (int cb = 0; cb < 4; ++cb)
#pragma unroll
        for (int r = 0; r < 16; ++r) u[(size_t)(32 * cb + crow(r, hi)) * 256 + 32 * wid + r32] = S[cb][r];
    if (tid < 128) a_slot(P, bh, seg)[tid] = aprod;
    asm volatile("s_waitcnt vmcnt(0) lgkmcnt(0)\n\ts_barrier" ::: "memory");
}
__device__ __forceinline__ void segment_out(const Ptrs& P, LAS unsigned char* lds, int bh, int seg) {
    const int tid = tid_opaque(P), lane = tid & 63, r32 = lane & 31, hi = lane >> 5; const int wid = __builtin_amdgcn_readfirstlane(tid >> 6);
    const int b = bh >> 2, h = bh & 3, rowb = b * LB;
    const bf16_t* Z = (const bf16_t*)(P.ws + WS_Z); unsigned char* A28 = P.ws + WS_A2;
    LAS float* eB = (LAS float*)(lds + LEB); LAS float* hnl = (LAS float*)(lds + LHN);
    if (tid < 256) hnl[tid] = P.head_norm[tid];
    f32x16 S[4];
    if (seg > 0) { const float* u = u_slot(P, bh, seg - 1);
#pragma unroll
        for (int cb = 0; cb < 4; ++cb)
#pragma unroll
            for (int r = 0; r < 16; ++r) S[cb][r] = u[(size_t)(32 * cb + crow(r, hi)) * 256 + 32 * wid + r32]; }
    else {
#pragma unroll
        for (int cb = 0; cb < 4; ++cb) S[cb] = f32x16{}; }
    const int nch = 8 + (seg == 0 ? 1 : 0);
    const unsigned lds0 = (unsigned)(size_t)lds;
    const LAS unsigned char* trb = lds + ((lane >> 4) & 1) * 32 + (lane & 3) * 8 + (8 * hi + ((lane & 15) >> 2)) * 64;
#define GO_META(ch) (seg == 0 && (ch) == 0)
#define GO_R0(ch) (GO_META(ch) ? rowb : rowb + NMETA + 64 * (seg * 8 + (ch) - (seg == 0 ? 1 : 0)))
#define GO_CIDX(ch) (GO_META(ch) ? 0 : seg * 8 + (ch) - (seg == 0 ? 1 : 0) + 1)
#define GO_ISSUE_A(ch) do { const int r0_ = GO_R0(ch); \
        _Pragma("unroll") for (int i_ = 0; i_ < 4; ++i_) { const int pc = wid * 4 + i_, db = pc >> 2, rg = pc & 3; \
            att::glds16(Z + (size_t)(r0_ + 16 * rg + (lane >> 2)) * ODD_N + 1024 + h * 256 + db * 32 + (lane & 3) * 8, (unsigned)__builtin_amdgcn_readfirstlane((int)(lds0 + LV + pc * 1024))); } \
        if (!GO_META(ch)) { _Pragma("unroll") for (int i_ = 0; i_ < 2; ++i_) { const int chk = wid * 2 + i_; \
            att::glds16(Z + (size_t)(r0_ + lane) * ODD_N + h * 128 + chk * 8, (unsigned)__builtin_amdgcn_readfirstlane((int)(lds0 + LQD + chk * 1024))); \
            att::glds16(Z + (size_t)(r0_ + lane) * ODD_N + 512 + h * 128 + chk * 8, (unsigned)__builtin_amdgcn_readfirstlane((int)(lds0 + LKD + chk * 1024))); } } } while (0)
#define GO_ISSUE_B(ch) do { const int r0_ = GO_R0(ch); \
        _Pragma("unroll") for (int i_ = 0; i_ < 2; ++i_) { const int pc = wid * 2 + i_, cb = pc >> 2, rg = pc & 3; \
            att::glds16(Z + (size_t)(r0_ + 16 * rg + (lane >> 2)) * ODD_N + 512 + h * 128 + cb * 32 + (lane & 3) * 8, (unsigned)__builtin_amdgcn_readfirstlane((int)(lds0 + LKW + pc * 1024))); } \
        if (wid == 0) att::glds16(eb_slot(P, b, GO_CIDX(ch)) + h * 128 + lane * 4, (unsigned)__builtin_amdgcn_readfirstlane((int)(lds0 + LEB))); } while (0)
    GO_ISSUE_A(0); GO_ISSUE_B(0);
    for (int ch = 0; ch < nch; ++ch) {
        const bool outc = !GO_META(ch); const int r0 = GO_R0(ch);
        asm volatile("s_waitcnt vmcnt(0) lgkmcnt(0)\n\ts_barrier" ::: "memory");
        u32x4 rgv[4];
        if (outc) { const u32x4* rgp = (const u32x4*)(Z + (size_t)(r0 + (tid >> 3)) * ODD_N + 2048 + h * 256 + (tid & 7) * 32);
#pragma unroll
            for (int q = 0; q < 4; ++q) rgv[q] = rgp[q]; }
        f32x16 o[2];
        if (outc) {
            if (wid < 4) { const int sb = wid & 1, tb = wid >> 1; f32x16 x = f32x16{};
                if (!(sb == 1 && tb == 0)) {
#pragma unroll
                    for (int ks = 0; ks < 8; ++ks) { const bf16x8 a = *(const LAS bf16x8*)(lds + LKD + (2 * ks + hi) * 1024 + (32 * sb + r32) * 16), bq = *(const LAS bf16x8*)(lds + LQD + (2 * ks + hi) * 1024 + (32 * tb + r32) * 16);
                        x = __builtin_amdgcn_mfma_f32_32x32x16_bf16(a, bq, x, 0, 0, 0); }
                    if (sb == tb) {
#pragma unroll
                        for (int r = 0; r < 16; ++r) if (crow(r, hi) > r32) x[r] = 0.f; }
                }
#pragma unroll
                for (int g = 0; g < 4; ++g) { u32x2 w; w.x = cvt_pk_bf16(x[4 * g], x[4 * g + 1]); w.y = cvt_pk_bf16(x[4 * g + 2], x[4 * g + 3]);
                    *(LAS u32x2*)(lds + LP + (32 * tb + r32) * PST + (32 * sb + 8 * g + 4 * hi) * 2) = w; } }
            o[0] = f32x16{}; o[1] = f32x16{};
#pragma unroll
            for (int cb = 0; cb < 4; ++cb)
#pragma unroll
                for (int s2 = 0; s2 < 2; ++s2) { u32x4 sw;
#pragma unroll
                    for (int j = 0; j < 4; ++j) sw[j] = cvt_pk_bf16(S[cb][8 * s2 + 2 * j], S[cb][8 * s2 + 2 * j + 1]);
                    const int kst = 2 * cb + s2;
#pragma unroll
                    for (int tb = 0; tb < 2; ++tb) { const LAS unsigned char* ap = lds + LQD + (2 * kst) * 1024 + (32 * tb + r32) * 16 + 8 * hi;
                        const u32x2 a0 = *(const LAS u32x2*)ap, a1 = *(const LAS u32x2*)(ap + 1024); const u32x4 a = (u32x4){a0.x, a0.y, a1.x, a1.y};
                        o[tb] = __builtin_amdgcn_mfma_f32_32x32x16_bf16(__builtin_bit_cast(bf16x8, a), __builtin_bit_cast(bf16x8, sw), o[tb], 0, 0, 0); } }
        }
        const int nks = outc ? 4 : 1;
        bf16x8 vf[4];
#pragma unroll
        for (int ks = 0; ks < 4; ++ks) { const s16x4 lo = vtr(trb + LV + (wid * 4 + ks) * 1024), h4 = vtr(trb + LV + (wid * 4 + ks) * 1024 + 256); vf[ks] = (bf16x8){lo[0], lo[1], lo[2], lo[3], h4[0], h4[1], h4[2], h4[3]}; }
        asm volatile("s_waitcnt lgkmcnt(0)\n\ts_barrier" ::: "memory");
        if (outc) asm volatile("" :: "v"(rgv[0]), "v"(rgv[1]), "v"(rgv[2]), "v"(rgv[3]));
        if (ch + 1 < nch) GO_ISSUE_A(ch + 1);
        if (outc) {
#pragma unroll
            for (int ks = 0; ks < 4; ++ks)
#pragma unroll
                for (int tb = 0; tb < 2; ++tb) { const bf16x8 a = *(const LAS bf16x8*)(lds + LP + (32 * tb + r32) * PST + (16 * ks + 8 * hi) * 2);
                    o[tb] = __builtin_amdgcn_mfma_f32_32x32x16_bf16(a, vf[ks], o[tb], 0, 0, 0); }
#pragma unroll
            for (int tb = 0; tb < 2; ++tb)
#pragma unroll
                for (int r = 0; r < 16; ++r) *(LAS bf16_t*)(lds + LOS + (32 * tb + crow(r, hi)) * OST + (32 * wid + r32) * 2) = (bf16_t)f2bf(o[tb][r]);
        }
#pragma unroll
        for (int cb = 0; cb < 4; ++cb) {
#pragma unroll
            for (int ks = 0; ks < 4; ++ks) if (ks < nks) { const s16x4 lo = vtr(trb + LKW + (cb * 4 + ks) * 1024), h4 = vtr(trb + LKW + (cb * 4 + ks) * 1024 + 256);
                const bf16x8 kf = (bf16x8){lo[0], lo[1], lo[2], lo[3], h4[0], h4[1], h4[2], h4[3]};
                S[cb] = __builtin_amdgcn_mfma_f32_32x32x16_bf16(kf, vf[ks], S[cb], 0, 0, 0); }
#pragma unroll
            for (int g = 0; g < 4; ++g) { const f32x4 e4 = *(const LAS f32x4*)(eB + 32 * cb + 8 * g + 4 * hi); S[cb][4 * g] *= e4.x; S[cb][4 * g + 1] *= e4.y; S[cb][4 * g + 2] *= e4.z; S[cb][4 * g + 3] *= e4.w; } }
        asm volatile("s_waitcnt lgkmcnt(0)\n\ts_barrier" ::: "memory");
        if (ch + 1 < nch) GO_ISSUE_B(ch + 1);
        if (outc) {
            const int t = tid >> 3, j8 = tid & 7; const size_t row = (size_t)(r0 + t);
            float ss = 0.f;
#pragma unroll
            for (int q = 0; q < 4; ++q) { const u32x4 a = *(const LAS u32x4*)(lds + LOS + t * OST + j8 * 64 + q * 16);
                const float v0 = bflo(a.x), v1 = bfhi(a.x), v2 = bflo(a.y), v3 = bfhi(a.y), v4 = bflo(a.z), v5 = bfhi(a.z), v6 = bflo(a.w), v7 = bfhi(a.w);
                ss += v0 * v0 + v1 * v1 + v2 * v2 + v3 * v3 + v4 * v4 + v5 * v5 + v6 * v6 + v7 * v7; }
            ss += __shfl_xor(ss, 1); ss += __shfl_xor(ss, 2); ss += __shfl_xor(ss, 4);
            const float rn = 1.f / sqrtf(ss * (1.f / 256.f) + RMS_EPS);
            u32x2* dst = (u32x2*)(A28 + row * D + h * 256 + j8 * 32);
#pragma unroll
            for (int q = 0; q < 4; ++q) { const u32x4 a = *(const LAS u32x4*)(lds + LOS + t * OST + j8 * 64 + q * 16);
                const float v[8] = {bflo(a.x), bfhi(a.x), bflo(a.y), bfhi(a.y), bflo(a.z), bfhi(a.z), bflo(a.w), bfhi(a.w)};
                const u32x4 g4 = rgv[q]; const float gv[8] = {bflo(g4.x), bfhi(g4.x), bflo(g4.y), bfhi(g4.y), bflo(g4.z), bfhi(g4.z), bflo(g4.w), bfhi(g4.w)}; float y[8];
#pragma unroll
                for (int e = 0; e < 8; ++e) y[e] = v[e] * (rn * F8_ASCALE) * hnl[j8 * 32 + 8 * q + e] * (gv[e] * __builtin_amdgcn_rcpf(1.f + __expf(-gv[e])));
                u32x2 w; w.x = pk4_fp8(y[0], y[1], y[2], y[3]); w.y = pk4_fp8(y[4], y[5], y[6], y[7]); dst[q] = w;
                __builtin_amdgcn_sched_barrier(0); }
        }
    }
    asm volatile("s_waitcnt vmcnt(0) lgkmcnt(0)\n\ts_barrier" ::: "memory");
#undef GO_META
#undef GO_R0
#undef GO_CIDX
#undef GO_ISSUE_A
#undef GO_ISSUE_B
}
template <bool OUT> __device__ __forceinline__ void segment(const Ptrs& P, LAS unsigned char* lds, int bh, int seg) {
    const int tid = tid_opaque(P), lane = tid & 63, r32 = lane & 31, hi = lane >> 5; const int wid = __builtin_amdgcn_readfirstlane(tid >> 6);
    const int b = bh >> 2, h = bh & 3, rowb = b * LB;
    const bf16_t* Z = (const bf16_t*)(P.ws + WS_Z); unsigned char* A28 = P.ws + WS_A2;
    LAS float* eB = (LAS float*)(lds + LEB); LAS float* hnl = (LAS float*)(lds + LHN);
    if (OUT && tid < 256) hnl[tid] = P.head_norm[tid];
    f32x16 S[4];
    if (OUT && seg > 0) { const float* u = u_slot(P, bh, seg - 1);
#pragma unroll
        for (int cb = 0; cb < 4; ++cb)
#pragma unroll
            for (int r = 0; r < 16; ++r) S[cb][r] = u[(size_t)(32 * cb + crow(r, hi)) * 256 + 32 * wid + r32]; }
    else {
#pragma unroll
        for (int cb = 0; cb < 4; ++cb) S[cb] = f32x16{}; }
    float aprod = 1.f;
    const int nch = 8 + (seg == 0 ? 1 : 0);
    const LAS unsigned char* trb = lds + ((lane >> 4) & 1) * 32 + (lane & 3) * 8 + (8 * hi + ((lane & 15) >> 2)) * 64;
    for (int ch = 0; ch < nch; ++ch) {
        const bool metac = (seg == 0 && ch == 0);
        const int cj = seg * 8 + ch - (seg == 0 ? 1 : 0);
        const int r0 = metac ? rowb : rowb + NMETA + 64 * cj;
        const float* ebg = eb_slot(P, b, metac ? 0 : cj + 1) + h * 128;
#pragma unroll
        for (int i_ = 0; i_ < 4; ++i_) { const int pc = wid * 4 + i_, db = pc >> 2, rg = pc & 3;
            __builtin_amdgcn_global_load_lds((const unsigned*)(Z + (size_t)(r0 + 16 * rg + (lane >> 2)) * ODD_N + 1024 + h * 256 + db * 32 + (lane & 3) * 8), (LAS unsigned*)(lds + LV + pc * 1024), 16, 0, 0); }
#pragma unroll
        for (int i_ = 0; i_ < 2; ++i_) { const int pc = wid * 2 + i_, cb = pc >> 2, rg = pc & 3;
            __builtin_amdgcn_global_load_lds((const unsigned*)(Z + (size_t)(r0 + 16 * rg + (lane >> 2)) * ODD_N + 512 + h * 128 + cb * 32 + (lane & 3) * 8), (LAS unsigned*)(lds + LKW + pc * 1024), 16, 0, 0); }
        const bool outc = OUT && !metac;
        u32x4 rgv[4];
        if (outc) { const u32x4* rgp = (const u32x4*)(Z + (size_t)(r0 + (tid >> 3)) * ODD_N + 2048 + h * 256 + (tid & 7) * 32);
#pragma unroll
            for (int q = 0; q < 4; ++q) rgv[q] = rgp[q]; }
        if (outc) {
#pragma unroll
            for (int i_ = 0; i_ < 2; ++i_) { const int chk = wid * 2 + i_;
                __builtin_amdgcn_global_load_lds((const unsigned*)(Z + (size_t)(r0 + lane) * ODD_N + h * 128 + chk * 8), (LAS unsigned*)(lds + LQD + chk * 1024), 16, 0, 0);
                __builtin_amdgcn_global_load_lds((const unsigned*)(Z + (size_t)(r0 + lane) * ODD_N + 512 + h * 128 + chk * 8), (LAS unsigned*)(lds + LKD + chk * 1024), 16, 0, 0); } }
        if (tid < 128) { const float e = ebg[tid]; eB[tid] = e; aprod *= e; }
        __syncthreads();
        f32x16 o[2];
        if (outc) {
            if (wid < 4) { const int sb = wid & 1, tb = wid >> 1; f32x16 x = f32x16{};
                if (!(sb == 1 && tb == 0)) {
#pragma unroll
                    for (int ks = 0; ks < 8; ++ks) { const bf16x8 a = *(const LAS bf16x8*)(lds + LKD + (2 * ks + hi) * 1024 + (32 * sb + r32) * 16), bq = *(const LAS bf16x8*)(lds + LQD + (2 * ks + hi) * 1024 + (32 * tb + r32) * 16);
                        x = __builtin_amdgcn_mfma_f32_32x32x16_bf16(a, bq, x, 0, 0, 0); }
                    if (sb == tb) {
#pragma unroll
                        for (int r = 0; r < 16; ++r) if (crow(r, hi) > r32) x[r] = 0.f; }
                }
#pragma unroll
                for (int g = 0; g < 4; ++g) { u32x2 w; w.x = cvt_pk_bf16(x[4 * g], x[4 * g + 1]); w.y = cvt_pk_bf16(x[4 * g + 2], x[4 * g + 3]);
                    *(LAS u32x2*)(lds + LP + (32 * tb + r32) * PST + (32 * sb + 8 * g + 4 * hi) * 2) = w; } }
            o[0] = f32x16{}; o[1] = f32x16{};
#pragma unroll
            for (int cb = 0; cb < 4; ++cb)
#pragma unroll
                for (int s2 = 0; s2 < 2; ++s2) { u32x4 sw;
#pragma unroll
                    for (int j = 0; j < 4; ++j) sw[j] = cvt_pk_bf16(S[cb][8 * s2 + 2 * j], S[cb][8 * s2 + 2 * j + 1]);
                    const int kst = 2 * cb + s2;
#pragma unroll
                    for (int tb = 0; tb < 2; ++tb) { const LAS unsigned char* ap = lds + LQD + (2 * kst) * 1024 + (32 * tb + r32) * 16 + 8 * hi;
                        const u32x2 a0 = *(const LAS u32x2*)ap, a1 = *(const LAS u32x2*)(ap + 1024); const u32x4 a = (u32x4){a0.x, a0.y, a1.x, a1.y};
                        o[tb] = __builtin_amdgcn_mfma_f32_32x32x16_bf16(__builtin_bit_cast(bf16x8, a), __builtin_bit_cast(bf16x8, sw), o[tb], 0, 0, 0); } }
            __syncthreads();
        }
        const int nks = metac ? 1 : 4;
        bf16x8 vf[4];
#pragma unroll
        for (int ks = 0; ks < 4; ++ks) { const s16x4 lo = vtr(trb + LV + (wid * 4 + ks) * 1024), h4 = vtr(trb + LV + (wid * 4 + ks) * 1024 + 256); vf[ks] = (bf16x8){lo[0], lo[1], lo[2], lo[3], h4[0], h4[1], h4[2], h4[3]}; }
        if (outc) {
#pragma unroll
            for (int ks = 0; ks < 4; ++ks)
#pragma unroll
                for (int tb = 0; tb < 2; ++tb) { const bf16x8 a = *(const LAS bf16x8*)(lds + LP + (32 * tb + r32) * PST + (16 * ks + 8 * hi) * 2);
                    o[tb] = __builtin_amdgcn_mfma_f32_32x32x16_bf16(a, vf[ks], o[tb], 0, 0, 0); }
#pragma unroll
            for (int tb = 0; tb < 2; ++tb)
#pragma unroll
                for (int r = 0; r < 16; ++r) *(LAS bf16_t*)(lds + LOS + (32 * tb + crow(r, hi)) * OST + (32 * wid + r32) * 2) = (bf16_t)f2bf(o[tb][r]);
        }
#pragma unroll
        for (int cb = 0; cb < 4; ++cb) {
#pragma unroll
            for (int ks = 0; ks < 4; ++ks) if (ks < nks) { const s16x4 lo = vtr(trb + LKW + (cb * 4 + ks) * 1024), h4 = vtr(trb + LKW + (cb * 4 + ks) * 1024 + 256);
                const bf16x8 kf = (bf16x8){lo[0], lo[1], lo[2], lo[3], h4[0], h4[1], h4[2], h4[3]};
                S[cb] = __builtin_amdgcn_mfma_f32_32x32x16_bf16(kf, vf[ks], S[cb], 0, 0, 0); }
#pragma unroll
            for (int g = 0; g < 4; ++g) { const f32x4 e4 = *(const LAS f32x4*)(eB + 32 * cb + 8 * g + 4 * hi); S[cb][4 * g] *= e4.x; S[cb][4 * g + 1] *= e4.y; S[cb][4 * g + 2] *= e4.z; S[cb][4 * g + 3] *= e4.w; } }
        __syncthreads();
        if (outc) {
            const int t = tid >> 3, j8 = tid & 7; const size_t row = (size_t)(r0 + t);
            float ss = 0.f;
#pragma unroll
            for (int q = 0; q < 4; ++q) { const u32x4 a = *(const LAS u32x4*)(lds + LOS + t * OST + j8 * 64 + q * 16);
                const float v0 = bflo(a.x), v1 = bfhi(a.x), v2 = bflo(a.y), v3 = bfhi(a.y), v4 = bflo(a.z), v5 = bfhi(a.z), v6 = bflo(a.w), v7 = bfhi(a.w);
                ss += v0 * v0 + v1 * v1 + v2 * v2 + v3 * v3 + v4 * v4 + v5 * v5 + v6 * v6 + v7 * v7; }
            ss += __shfl_xor(ss, 1); ss += __shfl_xor(ss, 2); ss += __shfl_xor(ss, 4);
            const float rn = 1.f / sqrtf(ss * (1.f / 256.f) + RMS_EPS);
            u32x2* dst = (u32x2*)(A28 + row * D + h * 256 + j8 * 32);
#pragma unroll
            for (int q = 0; q < 4; ++q) { const u32x4 a = *(const LAS u32x4*)(lds + LOS + t * OST + j8 * 64 + q * 16);
                const float v[8] = {bflo(a.x), bfhi(a.x), bflo(a.y), bfhi(a.y), bflo(a.z), bfhi(a.z), bflo(a.w), bfhi(a.w)};
                const u32x4 g4 = rgv[q]; const float gv[8] = {bflo(g4.x), bfhi(g4.x), bflo(g4.y), bfhi(g4.y), bflo(g4.z), bfhi(g4.z), bflo(g4.w), bfhi(g4.w)}; float y[8];
#pragma unroll
                for (int e = 0; e < 8; ++e) y[e] = v[e] * (rn * F8_ASCALE) * hnl[j8 * 32 + 8 * q + e] * (gv[e] * __builtin_amdgcn_rcpf(1.f + __expf(-gv[e])));
                u32x2 w; w.x = pk4_fp8(y[0], y[1], y[2], y[3]); w.y = pk4_fp8(y[4], y[5], y[6], y[7]); dst[q] = w;
                __builtin_amdgcn_sched_barrier(0); }
        }
    }
    if (!OUT) { float* u = u_slot(P, bh, seg);
#pragma unroll
        for (int cb = 0; cb < 4; ++cb)
#pragma unroll
            for (int r = 0; r < 16; ++r) u[(size_t)(32 * cb + crow(r, hi)) * 256 + 32 * wid + r32] = S[cb][r];
        if (tid < 128) a_slot(P, bh, seg)[tid] = aprod; }
    __syncthreads();
}
}
template <bool OUT> __device__ __forceinline__ void stage_gla_seg(const Ptrs& P, LAS unsigned char* lds, int wg, int nwg) {
    for (int u = wg; u < 256; u += nwg) { if constexpr (OUT) gla::segment_out(P, lds, u >> 4, u & 15); else gla::segment_state(P, lds, u >> 4, u & 15); }
}
__device__ __forceinline__ void stage_gla_scan(const Ptrs& P, int wg, int nwg) {
    const int tid_ = tid_opaque(P);
    for (int idx = wg * 512 + tid_; idx < 16 * 32768; idx += nwg * 512) { const int bh = idx >> 15, e = idx & 32767, cch = e >> 8;
        float uv[15], av[15];
#pragma unroll
        for (int sg = 0; sg < 15; ++sg) { uv[sg] = gla::u_slot(P, bh, sg)[e]; av[sg] = gla::a_slot(P, bh, sg)[cch]; }
        float Sv = 0.f;
#pragma unroll
        for (int sg = 0; sg < 15; ++sg) { Sv = av[sg] * Sv + uv[sg]; gla::u_slot(P, bh, sg)[e] = Sv; } }
}

#define XB_TMO      128
#define XB_XCNT(j)  (256  + 64 * (j))
#define XB_XSUB(j)  (1280 + 64 * (j))
#define XB_XGEN(j)  (2304 + 64 * (j))
#define XB_TOP      3328
#define XB_TOPGEN   3392
#define XCD_BAR_WORDS 3456
#define XB_SPIN_CAP (1u << 18)
__device__ __forceinline__ unsigned xb_ld(unsigned* p)              { return __hip_atomic_load(p, __ATOMIC_RELAXED, __HIP_MEMORY_SCOPE_AGENT); }
__device__ __forceinline__ unsigned xb_add(unsigned* p, unsigned v) { return __hip_atomic_fetch_add(p, v, __ATOMIC_RELAXED, __HIP_MEMORY_SCOPE_AGENT); }
__device__ __forceinline__ unsigned xb_xcc_id() { return (unsigned)__builtin_amdgcn_s_getreg((3 << 11) | 20) & 0xFu; }
#define XB_SPIN(cond, bar) do { unsigned _sp = 0; while (cond) { __builtin_amdgcn_s_sleep(1); \
    if ((++_sp & 255u) == 0u) { if (xb_ld(&(bar)[XB_TMO])) break; if (_sp > XB_SPIN_CAP) { atomicAdd(&(bar)[XB_TMO], 1u); break; } } } } while (0)
struct XcdBarrier { unsigned* bar; unsigned x; volatile LAS unsigned* st; };
__device__ __forceinline__ XcdBarrier xcd_barrier_post(unsigned* bar, volatile LAS unsigned* st, const bool t0) {
    XcdBarrier b; b.bar = bar; b.x = xb_xcc_id(); b.st = st;
    if (t0) (void)xb_add(&bar[XB_XCNT(b.x)], 1u);
    return b;
}
__device__ __forceinline__ void xcd_barrier_complete(unsigned* bar, unsigned x, unsigned& nloc, unsigned& nx) {
    const unsigned G = gridDim.x * gridDim.y * gridDim.z;
    unsigned sum, cnt, mine, sp = 0u;
    for (;;) {
        sum = 0u; cnt = 0u; mine = 0u;
#pragma unroll
        for (unsigned j = 0; j < 16; ++j) { const unsigned c = xb_ld(&bar[XB_XCNT(j)]); sum += c; cnt += (c > 0u) ? 1u : 0u; mine = (j == x) ? c : mine; }
        if (sum == G) break;
        __builtin_amdgcn_s_sleep(1);
        if ((++sp & 255u) == 0u) { if (xb_ld(&bar[XB_TMO])) break; if (sp > XB_SPIN_CAP) { atomicAdd(&bar[XB_TMO], 1u); break; } }
    }
    nloc = mine > 0u ? mine : 1u; nx = cnt > 0u ? cnt : 1u;
}
__device__ __forceinline__ void xcd_barrier(const XcdBarrier& b, const bool t0) {
    asm volatile("s_waitcnt vmcnt(0)" ::: "memory");
    __syncthreads();
    if (t0) {
        unsigned* bar = b.bar;
        __builtin_amdgcn_s_waitcnt(0);
        unsigned nloc = b.st[0], nx = b.st[1];
        if (nloc == 0u) { xcd_barrier_complete(bar, b.x, nloc, nx); b.st[0] = nloc; b.st[1] = nx; }
        const unsigned old = xb_add(&bar[XB_XSUB(b.x)], 1u);
        const unsigned gen = old / nloc;
        if (old + 1u == (gen + 1u) * nloc) {
            __builtin_amdgcn_fence(__ATOMIC_RELEASE, "agent");
            asm volatile("s_waitcnt vmcnt(0)" ::: "memory");
            const unsigned og = xb_add(&bar[XB_TOP], 1u);
            const unsigned tg = og / nx;
            if (og + 1u == (tg + 1u) * nx) xb_add(&bar[XB_TOPGEN], 1u);
            else XB_SPIN(xb_ld(&bar[XB_TOPGEN]) == tg, bar);
            __builtin_amdgcn_fence(__ATOMIC_ACQUIRE, "agent");
            xb_add(&bar[XB_XGEN(b.x)], 1u);
            asm volatile("s_waitcnt vmcnt(0)" ::: "memory");
        } else {
            XB_SPIN(xb_ld(&bar[XB_XGEN(b.x)]) == gen, bar);
            __builtin_amdgcn_fence(__ATOMIC_ACQUIRE, "agent");
            asm volatile("s_waitcnt vmcnt(0)" ::: "memory");
        }
    }
    __syncthreads();
}

constexpr int LDS_BYTES = 147456;
constexpr int LDS_CTL = 131072;
constexpr int CW_BAR = 4096;
enum GemmKind { G_IN0 = 0, G_OUT0, G_GU0, G_DN0, G_IN1, G_OUT1, G_GU1, G_DN1 };
__device__ __forceinline__ void moe_setup(const Ptrs& P, int layer, LAS int* tstart, LAS int* cnt, const int tid) {
    if (tid < 64) { const unsigned* g = (const unsigned*)(P.ws + WS_CTL) + CW_CNT + 64 * layer;
        const int c = tid < 16 ? (int)__hip_atomic_load(g + tid, __ATOMIC_RELAXED, __HIP_MEMORY_SCOPE_AGENT) : 0; const int tiles = (c + 255) >> 8; int incl = tiles;
#pragma unroll
        for (int d = 1; d < 16; d <<= 1) { const int o = __shfl_up(incl, d); if (tid >= d) incl += o; }
        if (tid < 16) { cnt[tid] = c; tstart[tid] = incl - tiles; }
        if (tid == 15) tstart[16] = incl; }
    __syncthreads();
}
template <int KIND> __device__ __forceinline__ void stage_gemm(const Ptrs& P, LAS unsigned char* lds, int wg, int nwg) {
    const int tid = tid_opaque(P);
    LAS unsigned char* ring = lds; LAS int* tstart = (LAS int*)(lds + LDS_CTL + 256); LAS int* cnt = (LAS int*)(lds + LDS_CTL + 384);
    const bf16_t* Hb = (const bf16_t*)(P.ws + WS_HB); bf16_t* Z = (bf16_t*)(P.ws + WS_Z); const unsigned char* A28 = P.ws + WS_A2; const bf16_t* A2m = (const bf16_t*)(P.ws + WS_A2M); bf16_t* T = (bf16_t*)(P.ws + WS_T);
    unsigned char* ACT = P.ws + WS_ACT; unsigned char* YK = P.ws + WS_YK;
    if constexpr (KIND == G_IN0) { meta_gemm<0>(Hb, Hb, (const bf16_t*)(P.ws + W_IN0), EVEN_IN, Z, EVEN_IN, 512, 1024, QSCALE0, wg, nwg, tid, (unsigned*)(P.ws + WS_CTL) + CW_KN + 64);
        DenseSched S; S.init(EVEN_IN / 256, nwg, wg); EpiBf16 E{Z, EVEN_IN, EVEN_IN, 2, 4, QSCALE0, (unsigned*)(P.ws + WS_CTL) + CW_KN, 4};
        pg8::gemm_phase(ring, Hb, P.ws + W_IN0, 2048, 2048, S, E, tid); }
    else if constexpr (KIND == G_OUT0) { meta_gemm<1>(A2m, Hb, (const bf16_t*)(P.ws + W_OUT0), 1024, T, D, 0, 0, 1.f, wg, nwg, tid);
        DenseSched S; S.init(4, nwg, wg, 1024); EpiResBf16 E{Hb, T};
        pg8::gemm_phase<EpiResBf16, DenseSched, true>(ring, A28, P.ws + W_OUT08, 1024, 1024, S, E, tid, F8_ASC, F8_WSC); }
    else if constexpr (KIND == G_IN1) { meta_gemm<0>(Hb, Hb, (const bf16_t*)(P.ws + W_IN1), ODD_N, Z, ODD_N, 0, 512, QSCALE1, wg, nwg, tid);
        DenseSched S; S.init(ODD_N / 256, nwg, wg, 1024); EpiBf16 E{Z, ODD_N, ODD_N, 0, 2, QSCALE1, nullptr, 0};
        pg8::gemm_phase<EpiBf16, DenseSched, true>(ring, P.ws + WS_HB8, P.ws + W_IN18, 1024, 1024, S, E, tid, F8_HSC, F8_WSC); }
    else if constexpr (KIND == G_OUT1) { DenseSched S; S.init(4, nwg, wg, 1024); EpiResBf16 E{Hb, T};
        pg8::gemm_phase<EpiResBf16, DenseSched, true>(ring, A28, P.ws + W_OUT18, 1024, 1024, S, E, tid, F8_ASC, F8_WSC); }
    else if constexpr (KIND == G_GU0 || KIND == G_GU1) { constexpr int layer = KIND == G_GU0 ? 0 : 1; moe_setup(P, layer, tstart, cnt, tid);
        MoeSchedT<true> S{tstart, cnt, (const int*)(P.ws + WS_LIST), (const float*)(P.ws + WS_LISTW), 4, nwg, wg, 1024, (size_t)layer * 16 * 1024 * 1024, (const LAS int*)(lds + LDS_CTL + 1024)}; EpiSiluMul E{ACT};
        pg8::gemm_phase<EpiSiluMul, MoeSchedT<true>, true, true>(ring, P.ws + WS_HB8, P.ws + W_GU, 1024, 1024, S, E, tid, F8_HSC, F8_WSC); }
    else { constexpr int layer = KIND == G_DN0 ? 0 : 1; moe_setup(P, layer, tstart, cnt, tid);
        MoeSchedT<false> S{tstart, cnt, (const int*)(P.ws + WS_LIST), (const float*)(P.ws + WS_LISTW), 4, nwg, wg, 512, (size_t)layer * 16 * 1024 * 512, nullptr}; EpiScatter E{YK, (LAS int*)(lds + LDS_CTL + 1024), (LAS float*)(lds + LDS_CTL + 3072)};
        pg8::gemm_phase<EpiScatter, MoeSchedT<false>, true, true>(ring, ACT, P.ws + W_DN, 512, 512, S, E, tid, F8_ASC, F8_WSC); }
}

constexpr int NPHASE = 19;
struct Args { Ptrs P; int lo, hi, flags, pad; };
__global__ void __launch_bounds__(512, 2) mega(Args a) {
    extern __shared__ __attribute__((aligned(16))) unsigned char lds_[];
    LAS unsigned char* lds = (LAS unsigned char*)lds_;
    const Ptrs& P = a.P;
    const int wg = blockIdx.x, nwg = gridDim.x, lo = a.lo, hi = a.hi;
    for (int u = threadIdx.x; u < (LDS_BYTES - LDS_CTL) / 4; u += 512) ((LAS unsigned*)(lds + LDS_CTL))[u] = 0u;
    __syncthreads();
    if ((threadIdx.x & 63) == 0) ((volatile LAS int*)(lds + LDS_WIDTAB))[hw_wave_key()] = (int)(threadIdx.x >> 6);
    __syncthreads();
    XcdBarrier bar; bar.bar = (unsigned*)(P.ws + WS_CTL) + CW_BAR; bar.x = 0; bar.st = nullptr;
    const bool multi = (hi - lo) > 1;
    if (multi) bar = xcd_barrier_post((unsigned*)(P.ws + WS_CTL) + CW_BAR, (volatile LAS unsigned*)(lds + LDS_CTL) + 8, tid_opaque(P) == 0);
#define IN(k) (lo <= (k) && (k) < hi)
#define SEAM(k) do { if (IN(k) && IN((k) + 1)) xcd_barrier(bar, tid_opaque(P) == 0); } while (0)
#define RUN(k, ...) do { if (IN(k)) { __VA_ARGS__; } SEAM(k); } while (0)
    RUN(0, stage_prep(P, lds, wg, nwg));
    RUN(1, stage_gemm<G_IN0>(P, lds, wg, nwg));
    RUN(2, if (!(a.flags & 2)) stage_pool(P, wg, nwg); stage_attn(P, lds, wg, nwg, a.flags));
    RUN(3, stage_combine(P, wg, nwg));
    RUN(4, stage_gemm<G_OUT0>(P, lds, wg, nwg));
    RUN(5, stage_ln<0>(P, lds, wg, nwg));
    RUN(6, stage_gemm<G_GU0>(P, lds, wg, nwg));
    RUN(7, stage_gemm<G_DN0>(P, lds, wg, nwg));
    RUN(8, stage_ln<2>(P, lds, wg, nwg));
    RUN(9, stage_gemm<G_IN1>(P, lds, wg, nwg));
    RUN(10, gla::stage_pre(P, lds, wg, nwg));
    RUN(11, stage_gla_seg<false>(P, lds, wg, nwg));
    RUN(12, stage_gla_scan(P, wg, nwg));
    RUN(13, stage_gla_seg<true>(P, lds, wg, nwg));
    RUN(14, stage_gemm<G_OUT1>(P, lds, wg, nwg));
    RUN(15, stage_ln<1>(P, lds, wg, nwg));
    RUN(16, stage_gemm<G_GU1>(P, lds, wg, nwg));
    RUN(17, stage_gemm<G_DN1>(P, lds, wg, nwg));
    RUN(18, stage_ln<3>(P, lds, wg, nwg));
#undef RUN
#undef IN
#undef SEAM
}

#ifndef MK_MULTI
#define MK_MULTI 0
#endif
extern "C" void kernel_launch(void* const* d_in, const int* in_sizes, int n_in, void* d_out, int out_size, void* d_ws, size_t ws_size, hipStream_t stream) {
    static int grid = 0;
    if (grid == 0) {
        if (n_in != 25 || ws_size < WS_END || out_size != NB * SEQ * D) { fprintf(stderr, "kernel_launch: bad args n_in %d ws %zu (need %zu) out %d\n", n_in, ws_size, (size_t)WS_END, out_size); grid = -1; return; }
        int dev = 0, cus = 0, per_cu = 0;
        if (hipGetDevice(&dev) != hipSuccess || hipDeviceGetAttribute(&cus, hipDeviceAttributeMultiprocessorCount, dev) != hipSuccess) { grid = -1; return; }
        if (hipFuncSetAttribute((const void*)mega, hipFuncAttributeMaxDynamicSharedMemorySize, LDS_BYTES) != hipSuccess) { fprintf(stderr, "kernel_launch: hipFuncSetAttribute failed\n"); grid = -1; return; }
        if (hipOccupancyMaxActiveBlocksPerMultiprocessor(&per_cu, (const void*)mega, 512, LDS_BYTES) != hipSuccess || per_cu < 1) { fprintf(stderr, "kernel_launch: occupancy query says %d blocks/CU\n", per_cu); (void)hipGetLastError(); grid = -1; return; }
        grid = cus;
    }
    if (grid < 0) return;
    (void)hipMemsetAsync((char*)d_ws + WS_CTL, 0, CTL_BYTES, stream);
    Args a{};
    const float** pp = (const float**)&a.P;
    for (int i = 0; i < 25; ++i) pp[i] = (const float*)d_in[i];
    a.P.out = (float*)d_out; a.P.ws = (unsigned char*)d_ws;
#if MK_MULTI
    for (int k = 0; k < NPHASE; ++k) { a.lo = k; a.hi = k + 1; for (int r = 0; r < 1 + (int)((PROBE_DUP >> k) & 1u); ++r) { a.flags = r ? PROBE_FLAGS : 0; hipLaunchKernelGGL(mega, dim3(grid), dim3(512), LDS_BYTES, stream, a); } }
#else
    a.lo = 0; a.hi = NPHASE; hipLaunchKernelGGL(mega, dim3(grid), dim3(512), LDS_BYTES, stream, a);
#endif
}
```

```cpp
#include <hip/hip_runtime.h>
#include <cstdio>
#include <cstdint>

#ifndef PROBE_FLAGS
#define PROBE_FLAGS 0
#endif
#ifndef PROBE_DUP
#define PROBE_DUP 0u
#endif
#define GAS __attribute__((address_space(1)))
#define LAS __attribute__((address_space(3)))
typedef unsigned short bf16_t;
typedef short bf16x8 __attribute__((ext_vector_type(8)));
typedef float f32x4 __attribute__((ext_vector_type(4)));
typedef float f32x2 __attribute__((ext_vector_type(2)));
typedef float f32x16 __attribute__((ext_vector_type(16)));
typedef unsigned u32x4 __attribute__((ext_vector_type(4)));
typedef unsigned u32x2 __attribute__((ext_vector_type(2)));

constexpr int D = 1024, NB = 4, SEQ = 8192, NMETA = 16;
constexpr int LB = SEQ + NMETA;
constexpr int M1 = NB * LB;
constexpr int NPANEL = NB * SEQ / 256;
constexpr int EVEN_IN = 2048, ODD_IN = 3088, ODD_N = 3072;
constexpr int NEXP = 16, DEXP = 512;
constexpr float ALPHA = 1.41421356237f;
constexpr float LN_EPS = 1e-5f, RMS_EPS = 1e-6f;
constexpr float LOG2E = 1.4426950408889634f;
constexpr float QSCALE0 = 0.125f * LOG2E;
constexpr float QSCALE1 = 0.08838834764831845f;
constexpr float LAMBDA_INIT = 0.2f;

constexpr size_t MiB = 1u << 20;
constexpr size_t WS_CTL = 0;
constexpr size_t CTL_BYTES = 1 * MiB;
constexpr size_t WS_MISC = 1 * MiB;
constexpr size_t WS_RW = 2 * MiB;
constexpr size_t WS_LIST = 3 * MiB;
constexpr size_t WS_GLR = 5 * MiB + 262144;
constexpr size_t WS_W = 8 * MiB;
constexpr size_t W_IN0 = WS_W;
constexpr size_t W_OUT0 = W_IN0 + (size_t)2048 * 1024 * 2;
constexpr size_t W_IN1 = W_OUT0 + (size_t)1024 * 1024 * 2;
constexpr size_t W_IN18 = W_IN1 + (size_t)ODD_N * 1024 * 2;
constexpr size_t W_OUT1 = W_IN18 + (size_t)ODD_N * 1024;
constexpr size_t W_OUT08 = W_OUT1 + (size_t)1024 * 1024 * 2;
constexpr size_t W_OUT18 = W_OUT08 + (size_t)1024 * 1024;
constexpr size_t W_GU = W_OUT18 + (size_t)1024 * 1024;
constexpr size_t W_DN = W_GU + (size_t)2 * 16 * 1024 * 1024;
constexpr size_t W_END = W_DN + (size_t)2 * 16 * 1024 * 512;
constexpr size_t WS_HB = 76 * MiB;
constexpr size_t WS_HB8 = WS_HB + (size_t)M1 * 1024 * 2;
constexpr size_t WS_Z = WS_HB8 + (size_t)M1 * 1024 + 524288;
constexpr size_t WS_T = WS_Z;
constexpr size_t WS_YK = WS_Z;
constexpr size_t WS_OA = WS_Z + (size_t)M1 * ODD_N * 2;
constexpr size_t WS_A2 = WS_OA + (size_t)M1 * 1024 * 2;
constexpr size_t WS_A2M = WS_MISC + 65536;
constexpr size_t WS_ACT = WS_OA;
constexpr size_t WS_LISTW = WS_A2 + (size_t)M1 * 1024;
constexpr size_t WS_END = WS_LISTW + (size_t)16 * M1 * 4;
static_assert(W_END <= WS_HB, "weights fit");
static_assert(WS_END <= (size_t)512 * MiB, "workspace fits 512 MiB");
static_assert(WS_LIST + (size_t)16 * M1 * 4 <= WS_GLR && WS_GLR + (size_t)M1 * 64 <= WS_W, "small buffers");
constexpr float F8_YSCALE = 32.f;
constexpr float F8_WSCALE = 32.f, F8_HSCALE = 4.f, F8_ASCALE = 4.f;
constexpr int F8_WSC = 0x7a7a7a7a, F8_HSC = 0x7d7d7d7d, F8_ASC = 0x7d7d7d7d;
constexpr int CW_CNT = 64;
constexpr int LISTCAP = M1;
constexpr int CW_KN = 256;
constexpr int CW_AQ = 512;

__device__ __forceinline__ float bf2f(unsigned short b) { return __builtin_bit_cast(float, (unsigned)b << 16); }
__device__ __forceinline__ float bflo(unsigned w) { return __builtin_bit_cast(float, w << 16); }
__device__ __forceinline__ float bfhi(unsigned w) { return __builtin_bit_cast(float, w & 0xffff0000u); }
typedef __bf16 bf16x2_t __attribute__((ext_vector_type(2)));
__device__ __forceinline__ unsigned cvt_pk_bf16(float lo, float hi) { const f32x2 v = {lo, hi}; const bf16x2_t b = __builtin_convertvector(v, bf16x2_t); return __builtin_bit_cast(unsigned, b); }
__device__ __forceinline__ unsigned pk2(float lo, float hi) { return cvt_pk_bf16(lo, hi); }
__device__ __forceinline__ unsigned f2bf(float f) { return cvt_pk_bf16(f, 0.f) & 0xffffu; }
__device__ __forceinline__ unsigned pk4_fp8(float a, float b, float c, float d) {
    a = fminf(fmaxf(a, -448.f), 448.f); b = fminf(fmaxf(b, -448.f), 448.f); c = fminf(fmaxf(c, -448.f), 448.f); d = fminf(fmaxf(d, -448.f), 448.f);
    int w = 0; w = __builtin_amdgcn_cvt_pk_fp8_f32(a, b, w, false); w = __builtin_amdgcn_cvt_pk_fp8_f32(c, d, w, true); return (unsigned)w; }
__device__ __forceinline__ void fp8x4_to_f32(unsigned w, float (&o)[4]) { const f32x2 a = __builtin_amdgcn_cvt_pk_f32_fp8((int)w, false), b = __builtin_amdgcn_cvt_pk_f32_fp8((int)w, true); o[0] = a.x; o[1] = a.y; o[2] = b.x; o[3] = b.y; }
__device__ __forceinline__ void lds_dma16(const void* gsrc, unsigned lds_dst) { unsigned keep;
    asm volatile("s_mov_b32 %0, m0\n\ts_mov_b32 m0, %2\n\ts_nop 0\n\tglobal_load_lds_dwordx4 %1, off\n\ts_mov_b32 m0, %0" : "=&s"(keep) : "v"(gsrc), "s"(lds_dst) : "memory"); }
__device__ __forceinline__ float wave_sum(float v) {
#pragma unroll
    for (int o = 1; o < 64; o <<= 1) v += __shfl_xor(v, o);
    return v;
}
__device__ __forceinline__ float wave_max(float v) {
#pragma unroll
    for (int o = 1; o < 64; o <<= 1) v = fmaxf(v, __shfl_xor(v, o));
    return v;
}
struct Ptrs {
    const float *x, *meta, *even_w_in, *pool_w, *pool_scale, *lq1, *lk1, *lq2, *lk2, *subln, *even_w_out, *odd_w_in, *gate_w2, *gate_b, *head_norm, *odd_w_out,
        *ln_mix_g, *ln_mix_b, *ln_ffn_g, *ln_ffn_b, *router_w, *router_bias, *moe_w_gate, *moe_w_up, *moe_w_down;
    float* out; unsigned char* ws;
};
constexpr int LDS_WIDTAB = 131072 + 512;
extern __shared__ __attribute__((aligned(16))) unsigned char lds_dyn_alias_[];
__device__ __forceinline__ unsigned hw_wave_key() { return (unsigned)__builtin_amdgcn_s_getreg((5 << 11) | 4) & 0x3fu; }
__device__ __forceinline__ int tid_opaque(const Ptrs&) {
    unsigned z = 0u; asm volatile("" : "+v"(z));
    const int lane = (int)__builtin_amdgcn_mbcnt_hi(~0u, __builtin_amdgcn_mbcnt_lo(~0u, z));
    const int wid = __builtin_amdgcn_readfirstlane(((const volatile LAS int*)((LAS unsigned char*)lds_dyn_alias_ + LDS_WIDTAB))[hw_wave_key()]);
    return wid * 64 + lane;
}
__device__ __forceinline__ int panel_row0(int pm) { return (pm >> 5) * LB + NMETA + (pm & 31) * 256; }
__device__ __forceinline__ const float* h0_ptr(const Ptrs& P, int row) { const int b = row / LB, p = row - b * LB; return p < NMETA ? P.meta + (size_t)p * D : P.x + ((size_t)b * SEQ + (p - NMETA)) * D; }

namespace pg8 {
constexpr int BM = 256, BK = 64, HALF = 128, HTB = HALF * BK * 2, STAGE_BYTES = 8 * HTB, NXCD = 8, WGM = 8;
__host__ __device__ __forceinline__ int lds_byte(int r, int c) { const int st = (r >> 4) * 2 + (c >> 5), rr = r & 15, cc = c & 31, ob = rr * 64 + cc * 2; return st * 1024 + (ob ^ (((ob >> 9) & 1) << 5)); }
__host__ __device__ __forceinline__ void stage_rc(int b, int& R, int& C) { const int st = b / 1024, sb = b % 1024, swz = sb ^ (((sb >> 9) & 1) << 5); R = (st >> 1) * 16 + swz / 64; C = (st & 1) * 32 + (swz % 64) / 2; }
__host__ __device__ __forceinline__ int perm32(int rho) { const int n = rho >> 4, i = rho & 15; return 8 * (i >> 2) + 4 * n + (i & 3); }
struct Unit { int pm, pn, e, lt, hn, par; };

__device__ __forceinline__ void static_tile(int L, int nM, int nN, int& pm, int& pn) {
    const int nwg = nM * nN; int wgid = L;
    { const int q = nwg / NXCD, r = nwg % NXCD, xcd = wgid % NXCD, off = wgid / NXCD; wgid = (xcd < r ? xcd * (q + 1) : r * (q + 1) + (xcd - r) * q) + off; }
    const int nig = WGM * nN, gid = wgid / nig, fm = gid * WGM, gsz = (nM - fm) < WGM ? (nM - fm) : WGM;
    pm = fm + ((wgid % nig) % gsz); pn = (wgid % nig) / gsz;
}

typedef int v8i32 __attribute__((ext_vector_type(8)));
template <class Epi, class Sched, bool F8 = false, bool HN = false>
__device__ __forceinline__ void gemm_phase(LAS unsigned char* lds, const void* Abase, const void* Bbase, const int KA, const int KB_, const Sched& S, const Epi& E, const int tid, const int sclA = 0x7f7f7f7f, const int sclB = 0x7f7f7f7f) {
    const int wid = __builtin_amdgcn_readfirstlane(tid >> 6), lane = tid & 63, wr = wid >> 2, wc = wid & 3, fr = lane & 15, fq = lane >> 4;
    const int nt = KA / 128;
    unsigned voffB[2];
#pragma unroll
    for (int i = 0; i < 2; ++i) { int R, C; stage_rc(tid * 16 + i * 8192, R, C); const int Rb = Epi::PERM ? ((R & ~31) + perm32(R & 31)) : R;
        voffB[i] = (unsigned)(Rb * KB_ + C * 2); }
    const size_t kstep = (size_t)(BK * 2);
    const size_t hstep = (size_t)HALF * KB_;
    const unsigned ldsw = (unsigned)wid * 1024u;
    const int aoff = lds_byte(wr * 64 + fr, fq * 8), boff = lds_byte(wc * 32 + fr, fq * 8);
#define PG8_SA(b, h) (((b) * 2 + (h)) * HTB)
#define PG8_SB(b, h) ((4 + (b) * 2 + (h)) * HTB)
#define PG8_STAGEB(bufoff, gbase) do { _Pragma("unroll") for (int _i = 0; _i < 2; ++_i) \
        __builtin_amdgcn_global_load_lds((const unsigned*)((const char*)(gbase) + voffB[_i]), (LAS unsigned*)(lds + (bufoff) + ldsw + _i * 8192), 16, 0, 0); } while (0)
#define PG8_STAGEA(bufoff, kbyte, off2) do { _Pragma("unroll") for (int _i = 0; _i < 2; ++_i) \
        __builtin_amdgcn_global_load_lds((const unsigned*)((const char*)Abase + (kbyte) + (off2)[_i]), (LAS unsigned*)(lds + (bufoff) + ldsw + _i * 8192), 16, 0, 0); } while (0)
#define PG8_STAGEA2(bufoff, kbyte, h) do { _Pragma("unroll") for (int _i = 0; _i < 2; ++_i) \
        __builtin_amdgcn_global_load_lds((const unsigned*)((const char*)Abase + (kbyte) + (last ? nxtA[h][_i] : curA[h][_i])), (LAS unsigned*)(lds + (bufoff) + ldsw + _i * 8192), 16, 0, 0); } while (0)
#define PG8_CAT(x0, x1) __builtin_shufflevector(x0, x1, 0, 1, 2, 3, 4, 5, 6, 7)
#define PG8_LDA(dst, b, h) do { _Pragma("unroll") for (int m = 0; m < 4; ++m) { \
        if constexpr (F8) dst##8[m] = __builtin_bit_cast(v8i32, PG8_CAT(*(const LAS u32x4*)(lds + PG8_SA(b, h) + aoff + m * 2048), *(const LAS u32x4*)(lds + PG8_SA(b, h) + aoff + m * 2048 + 1024))); \
        else { _Pragma("unroll") for (int k = 0; k < 2; ++k) dst[m][k] = *(const LAS bf16x8*)(lds + PG8_SA(b, h) + aoff + m * 2048 + k * 1024); } } } while (0)
#define PG8_LDB(dst, b, h) do { _Pragma("unroll") for (int n = 0; n < 2; ++n) { \
        if constexpr (F8) dst##8[n] = __builtin_bit_cast(v8i32, PG8_CAT(*(const LAS u32x4*)(lds + PG8_SB(b, h) + boff + n * 2048), *(const LAS u32x4*)(lds + PG8_SB(b, h) + boff + n * 2048 + 1024))); \
        else { _Pragma("unroll") for (int k = 0; k < 2; ++k) dst[n][k] = *(const LAS bf16x8*)(lds + PG8_SB(b, h) + boff + n * 2048 + k * 1024); } } } while (0)
#define PG8_MMA(ai, bj, At, Bt) do { __builtin_amdgcn_s_setprio(1); _Pragma("unroll") for (int m = 0; m < 4; ++m) _Pragma("unroll") for (int n = 0; n < 2; ++n) { \
        if constexpr (F8) asm volatile("v_mfma_scale_f32_16x16x128_f8f6f4 %0, %1, %2, %0, %3, %4 op_sel_hi:[0,0,0]" : "+v"(acc[ai][bj][m][n]) : "v"(Bt##8[n]), "v"(At##8[m]), "v"(sclB), "v"(sclA));     \
        else { _Pragma("unroll") for (int k = 0; k < 2; ++k) acc[ai][bj][m][n] = __builtin_amdgcn_mfma_f32_16x16x32_bf16(Bt[n][k], At[m][k], acc[ai][bj][m][n], 0, 0, 0); } } __builtin_amdgcn_s_setprio(0); } while (0)
#define PG8_WAIT_V(n) asm volatile("s_waitcnt vmcnt(" #n ")" ::: "memory")
#define PG8_WAIT_L(n) asm volatile("s_waitcnt lgkmcnt(" #n ")" ::: "memory")
#define PG8_BAR __builtin_amdgcn_s_barrier()
#define PG8_SCHED __builtin_amdgcn_sched_barrier(0)
#define PG8_AOFFS(dst, u) do { int tl_ = tid; asm volatile("" : "+v"(tl_));     \
        _Pragma("unroll") for (int _i = 0; _i < 2; ++_i) { int R_, C_; stage_rc(tl_ * 16 + _i * 8192, R_, C_); \
            _Pragma("unroll") for (int _h = 0; _h < 2; ++_h) dst[_h][_i] = (unsigned)S.arow(u, 128 * _h + R_) * (unsigned)KA + (unsigned)C_ * 2u; } } while (0)
    Unit cur, nxt; int ui = 0;
    if (!S.next(0, cur)) return;
    cur.par = 0;
    f32x4 acc[2][2][4][2];
#pragma unroll
    for (int a = 0; a < 2; ++a)
#pragma unroll
        for (int b = 0; b < 2; ++b)
#pragma unroll
            for (int m = 0; m < 4; ++m)
#pragma unroll
                for (int n = 0; n < 2; ++n) acc[a][b][m][n] = (f32x4){0.f, 0.f, 0.f, 0.f};
    bf16x8 At[4][2], B0[2][2], B1[2][2];
    v8i32 At8[4], B08[2], B18[2];
    unsigned curA[2][2], nxtA[2][2];
    if constexpr (Sched::LDSLIST) { if (wid == 0) S.dma_list(cur, (unsigned)__builtin_amdgcn_readfirstlane((int)(unsigned)(size_t)S.ltile), lane);
        asm volatile("s_waitcnt vmcnt(0)" ::: "memory"); PG8_BAR; }
    PG8_AOFFS(curA, cur);
    const char* cB = (const char*)Bbase + S.boff(cur);
    PG8_STAGEB(PG8_SB(0, 0), cB); PG8_STAGEB(PG8_SB(0, 1), cB + hstep); PG8_STAGEA(PG8_SA(0, 0), 0, curA[0]); PG8_STAGEA(PG8_SA(0, 1), 0, curA[1]);
    if (wr == 1) PG8_BAR;
    PG8_WAIT_V(2); PG8_BAR;
    PG8_STAGEB(PG8_SB(1, 0), cB + kstep); PG8_STAGEA(PG8_SA(1, 0), kstep, curA[0]); PG8_STAGEB(PG8_SB(1, 1), cB + hstep + kstep);
    PG8_WAIT_V(6); PG8_BAR;
    for (;;) {
        if constexpr (Epi::META) E.prefetch(cur, S, tid);
        const bool has_next = S.next(ui + 1, nxt); nxt.par = (ui + 1) & 1;
        const char* nB = cB;
        if (has_next) { nB = (const char*)Bbase + S.boff(nxt);
            if constexpr (Sched::LDSLIST) { if (wid == 0) S.dma_list(nxt, (unsigned)__builtin_amdgcn_readfirstlane((int)(unsigned)(size_t)S.ltile), lane); }
            else PG8_AOFFS(nxtA, nxt); }
        else {
#pragma unroll
            for (int h = 0; h < 2; ++h)
#pragma unroll
                for (int i = 0; i < 2; ++i) nxtA[h][i] = curA[h][i];
        }
#pragma unroll 1
        for (int t = 0; t < nt; t += 2) {
            const bool last = (t == nt - 2);
            if constexpr (Sched::LDSLIST) { if (last && has_next) PG8_AOFFS(nxtA, nxt); }
            const size_t k1 = (size_t)(t + 1) * kstep, k2 = last ? 0 : (size_t)(t + 2) * kstep, k3 = k2 + kstep;
            const char* b2 = last ? nB : cB + (size_t)(t + 2) * kstep; const char* b3 = b2 + kstep;
            PG8_LDB(B0, 0, 0); if (!HN || !cur.hn) PG8_LDB(B1, 0, 1); PG8_SCHED; PG8_LDA(At, 0, 0); PG8_STAGEA(PG8_SA(1, 1), k1, curA[1]);
            PG8_WAIT_V(8); PG8_WAIT_L(0); PG8_BAR; PG8_MMA(0, 0, At, B0); if (!HN || !cur.hn) PG8_MMA(0, 1, At, B1); PG8_BAR; PG8_SCHED;
            PG8_LDA(At, 0, 1); PG8_STAGEB(PG8_SB(0, 0), b2); PG8_STAGEB(PG8_SB(0, 1), b2 + hstep); PG8_STAGEA2(PG8_SA(0, 0), k2, 0);
            PG8_WAIT_V(8); PG8_WAIT_L(0); PG8_BAR; PG8_MMA(1, 0, At, B0); if (!HN || !cur.hn) PG8_MMA(1, 1, At, B1); PG8_BAR; PG8_SCHED;
            PG8_LDB(B0, 1, 0); if (!HN || !cur.hn) PG8_LDB(B1, 1, 1); PG8_SCHED; PG8_LDA(At, 1, 0); PG8_STAGEA2(PG8_SA(0, 1), k2, 1);
            PG8_WAIT_V(8); PG8_WAIT_L(0); PG8_BAR; PG8_MMA(0, 0, At, B0); if (!HN || !cur.hn) PG8_MMA(0, 1, At, B1); PG8_BAR; PG8_SCHED;
            PG8_LDA(At, 1, 1); PG8_STAGEB(PG8_SB(1, 0), b3); PG8_STAGEB(PG8_SB(1, 1), b3 + hstep); PG8_STAGEA2(PG8_SA(1, 0), k3, 0);
            PG8_WAIT_V(8); PG8_WAIT_L(0); PG8_BAR; PG8_MMA(1, 0, At, B0); if (!HN || !cur.hn) PG8_MMA(1, 1, At, B1); PG8_BAR; PG8_SCHED;
        }
        if (wr == 0) PG8_BAR;
        if constexpr (F8) asm volatile("s_nop 15\n\ts_nop 15" ::: "memory");
        E(acc, cur, wr, wc, fr, fq, S);
        if (!has_next) break;
#pragma unroll
        for (int a = 0; a < 2; ++a)
#pragma unroll
            for (int b = 0; b < 2; ++b)
#pragma unroll
                for (int m = 0; m < 4; ++m)
#pragma unroll
                    for (int n = 0; n < 2; ++n) acc[a][b][m][n] = (f32x4){0.f, 0.f, 0.f, 0.f};
        cur = nxt; cB = nB; ++ui;
#pragma unroll
        for (int h = 0; h < 2; ++h)
#pragma unroll
            for (int i = 0; i < 2; ++i) curA[h][i] = nxtA[h][i];
        if (wr == 1) PG8_BAR;
    }
    PG8_WAIT_V(0);
    PG8_BAR;
#undef PG8_SA
#undef PG8_SB
#undef PG8_STAGEA
#undef PG8_STAGEA2
#undef PG8_STAGEB
#undef PG8_LDA
#undef PG8_LDB
#undef PG8_MMA
#undef PG8_CAT
#undef PG8_WAIT_V
#undef PG8_WAIT_L
#undef PG8_BAR
#undef PG8_SCHED
#undef PG8_AOFFS
}
}
using pg8::Unit;

struct DenseSched {
    static constexpr bool LDSLIST = false;
    int nN, nTot, G, c, kb;
    __device__ void init(int nN_, int G_, int c_, int kb_ = 2048) { nN = nN_; nTot = NPANEL * nN_; G = G_; c = c_; kb = kb_; }
    __device__ __forceinline__ bool next(int i, Unit& u) const {
        const int L = i * G + c; if (L >= nTot) return false;
        pg8::static_tile(L, NPANEL, nN, u.pm, u.pn); u.e = 0; u.lt = 0; u.hn = 0; return true;
    }
    __device__ __forceinline__ int arow(const Unit& u, int r) const { return panel_row0(u.pm) + r; }
    __device__ __forceinline__ int orow(const Unit& u, int r) const { return panel_row0(u.pm) + r; }
    __device__ __forceinline__ size_t boff(const Unit& u) const { return (size_t)u.pn * 256 * kb; }
};
template <bool GATHER> struct MoeSchedT {
    static constexpr bool LDSLIST = GATHER;
    const LAS int* tstart;
    const LAS int* cnt;
    const int* list;
    const float* listw;
    int nN, G, c, K; size_t wbase;
    const LAS int* ltile;
    __device__ __forceinline__ bool next(int i, Unit& u) const {
        const int cx = (G & 7) ? c : (c & 7) * (G >> 3) + (c >> 3);
        const int L = i * G + cx, ntot = tstart[16] * nN;
        const int R0 = (ntot / G) * G, left = ntot - R0; const bool split = left > 0 && 2 * left <= G;
        int Lu = L, hn = 0, hsel = 0;
        if (split && L >= R0) { const int j = L - R0; if (j >= 2 * left) return false; Lu = R0 + (j >> 1); hn = 1; hsel = j & 1; }
        else if (L >= ntot) return false;
        const int tl = Lu / nN; u.pn = 2 * (Lu - tl * nN) + hsel; u.hn = hn; u.pm = tl; int e = 0;
#pragma unroll
        for (int j = 1; j < 16; ++j) e += (tl >= tstart[j]) ? 1 : 0;
        u.e = e; u.lt = tl - tstart[e]; return true;
    }
    __device__ __forceinline__ void dma_list(const Unit& u, unsigned lds_dst, int lane) const { lds_dma16((const char*)(list + (size_t)u.e * LISTCAP + (size_t)u.lt * 256) + lane * 16, lds_dst); }
    __device__ __forceinline__ void dma_listw(const Unit& u, unsigned lds_dst, int lane) const { lds_dma16((const char*)(listw + (size_t)u.e * LISTCAP + (size_t)u.lt * 256) + lane * 16, lds_dst); }
    __device__ __forceinline__ bool valid(const Unit& u, int r) const { return u.lt * 256 + r < cnt[u.e]; }
    __device__ __forceinline__ int arow(const Unit& u, int r) const {
        if (!GATHER) return u.pm * 256 + r;
        return ltile[valid(u, r) ? r : 0] >> 1; }
    __device__ __forceinline__ size_t boff(const Unit& u) const { return wbase + ((size_t)u.e * 1024 + (size_t)u.pn * 128) * K; }
};

struct EpiBf16 {
    static constexpr bool PERM = true, META = false;
    bf16_t* O; int ldc, ncols; int sc_lo, sc_hi; float sc; unsigned* kn; int kn_lo;
    template <class Sched> __device__ __forceinline__ void operator()(const f32x4 (&acc)[2][2][4][2], const Unit& u, int wr, int wc, int fr, int fq, const Sched& S) const {
        const float s = (u.pn >= sc_lo && u.pn < sc_hi) ? sc : 1.f;
        if (kn && (u.pn == kn_lo || u.pn == kn_lo + 1)) {
#pragma unroll
            for (int bj = 0; bj < 2; ++bj) { float mxs = 0.f;
#pragma unroll
                for (int ai = 0; ai < 2; ++ai)
#pragma unroll
                    for (int m = 0; m < 4; ++m) { const f32x4 v0 = acc[ai][bj][m][0], v1 = acc[ai][bj][m][1];
                        float ss = v0[0] * v0[0] + v0[1] * v0[1] + v0[2] * v0[2] + v0[3] * v0[3] + v1[0] * v1[0] + v1[1] * v1[1] + v1[2] * v1[2] + v1[3] * v1[3];
                        ss += __shfl_xor(ss, 16); ss += __shfl_xor(ss, 32); mxs = fmaxf(mxs, ss); }
                mxs = fmaxf(mxs, __shfl_xor(mxs, 1)); mxs = fmaxf(mxs, __shfl_xor(mxs, 2)); mxs = fmaxf(mxs, __shfl_xor(mxs, 4)); mxs = fmaxf(mxs, __shfl_xor(mxs, 8));
                if (fr == 0 && fq == 0) atomicMax(kn + ((u.pm >> 5) * 8 + (u.pn - kn_lo) * 4 + bj * 2 + (wc >> 1)) * 2 + (wc & 1), __float_as_uint(mxs)); } }
#pragma unroll
        for (int ai = 0; ai < 2; ++ai)
#pragma unroll
            for (int m = 0; m < 4; ++m) { const int orow = S.orow(u, ai * 128 + wr * 64 + m * 16 + fr);
#pragma unroll
                for (int bj = 0; bj < 2; ++bj) { const int col = u.pn * 256 + bj * 128 + wc * 32 + 8 * fq;
                    const f32x4 v0 = acc[ai][bj][m][0] * s, v1 = acc[ai][bj][m][1] * s;
                    u32x4 w; w.x = cvt_pk_bf16(v0[0], v0[1]); w.y = cvt_pk_bf16(v0[2], v0[3]); w.z = cvt_pk_bf16(v1[0], v1[1]); w.w = cvt_pk_bf16(v1[2], v1[3]);
                    if (orow >= 0 && col < ncols) *(u32x4*)(O + (size_t)orow * ldc + col) = w; } }
    }
};
struct EpiResBf16 {
    static constexpr bool PERM = true, META = false;
    const bf16_t* Hb; bf16_t* T;
    template <class Sched> __device__ __forceinline__ void operator()(const f32x4 (&acc)[2][2][4][2], const Unit& u, int wr, int wc, int fr, int fq, const Sched& S) const {
        u32x4 h[2][4][2];
#pragma unroll
        for (int ai = 0; ai < 2; ++ai)
#pragma unroll
            for (int m = 0; m < 4; ++m) { const size_t orow = (size_t)S.orow(u, ai * 128 + wr * 64 + m * 16 + fr);
#pragma unroll
                for (int bj = 0; bj < 2; ++bj) h[ai][m][bj] = *(const u32x4*)(Hb + orow * D + u.pn * 256 + bj * 128 + wc * 32 + 8 * fq); }
        __builtin_amdgcn_sched_barrier(0);
#pragma unroll
        for (int ai = 0; ai < 2; ++ai)
#pragma unroll
            for (int m = 0; m < 4; ++m) { const size_t orow = (size_t)S.orow(u, ai * 128 + wr * 64 + m * 16 + fr);
#pragma unroll
                for (int bj = 0; bj < 2; ++bj) { const int col = u.pn * 256 + bj * 128 + wc * 32 + 8 * fq;
                    const u32x4 hh = h[ai][m][bj]; const f32x4 v0 = acc[ai][bj][m][0], v1 = acc[ai][bj][m][1];
                    u32x4 w; w.x = cvt_pk_bf16(bflo(hh.x) * ALPHA + v0[0], bfhi(hh.x) * ALPHA + v0[1]); w.y = cvt_pk_bf16(bflo(hh.y) * ALPHA + v0[2], bfhi(hh.y) * ALPHA + v0[3]);
                    w.z = cvt_pk_bf16(bflo(hh.z) * ALPHA + v1[0], bfhi(hh.z) * ALPHA + v1[1]); w.w = cvt_pk_bf16(bflo(hh.w) * ALPHA + v1[2], bfhi(hh.w) * ALPHA + v1[3]);
                    *(u32x4*)(T + orow * D + col) = w; } }
    }
};
template <int MODE> __device__ __forceinline__ void meta_gemm(const bf16_t* Hb, const bf16_t* Res, const bf16_t* Bt, int N, bf16_t* O, int ldo, int sc_lo, int sc_hi, float sc, int wg, int nwg, const int tid_, unsigned* knm = nullptr) {
    const int lane = tid_ & 63, wave = __builtin_amdgcn_readfirstlane(tid_ >> 6), tok = lane & 15, kq = lane >> 4;
    for (int tile = wg * 8 + wave; tile < N / 16; tile += nwg * 8) {
        const bf16_t* wp = Bt + (size_t)(tile * 16 + tok) * 1024 + kq * 8; const bf16_t* hp = Hb + (size_t)tok * D + kq * 8;
        f32x4 acc = (f32x4){0.f, 0.f, 0.f, 0.f};
#pragma unroll 16
        for (int k = 0; k < 32; ++k) { const bf16x8 a = *(const bf16x8*)(wp + k * 32), bb = *(const bf16x8*)(hp + k * 32); acc = __builtin_amdgcn_mfma_f32_16x16x32_bf16(a, bb, acc, 0, 0, 0); }
        const int n = tile * 16 + 4 * kq;
        if (MODE == 0 && knm && tile >= 64 && tile < 96) {
            float ss = acc[0] * acc[0] + acc[1] * acc[1] + acc[2] * acc[2] + acc[3] * acc[3]; ss += __shfl_xor(ss, 16); ss += __shfl_xor(ss, 32);
            ss = fmaxf(ss, __shfl_xor(ss, 1)); ss = fmaxf(ss, __shfl_xor(ss, 2)); ss = fmaxf(ss, __shfl_xor(ss, 4)); ss = fmaxf(ss, __shfl_xor(ss, 8));
            if (lane == 0) atomicMax(knm + (tile - 64), __float_as_uint(ss)); }
        if (MODE == 0) { const float f = (n >= sc_lo && n < sc_hi) ? sc : 1.f; u32x2 w; w.x = cvt_pk_bf16(acc[0] * f, acc[1] * f); w.y = cvt_pk_bf16(acc[2] * f, acc[3] * f);
#pragma unroll
            for (int b = 0; b < NB; ++b) *(u32x2*)(O + (size_t)(b * LB + tok) * ldo + n) = w; }
        else { const u32x2 h = *(const u32x2*)(Res + (size_t)tok * D + n); u32x2 w; w.x = cvt_pk_bf16(bflo(h.x) * ALPHA + acc[0], bfhi(h.x) * ALPHA + acc[1]); w.y = cvt_pk_bf16(bflo(h.y) * ALPHA + acc[2], bfhi(h.y) * ALPHA + acc[3]);
#pragma unroll
            for (int b = 0; b < NB; ++b) *(u32x2*)(O + (size_t)(b * LB + tok) * ldo + n) = w; }
    }
}
struct EpiSiluMul {
    static constexpr bool PERM = true, META = false;
    unsigned char* ACT;
    template <class Sched> __device__ __forceinline__ void operator()(const f32x4 (&acc)[2][2][4][2], const Unit& u, int wr, int wc, int fr, int fq, const Sched& S) const {
#pragma unroll
        for (int ai = 0; ai < 2; ++ai)
#pragma unroll
            for (int m = 0; m < 4; ++m) { const size_t arow = (size_t)u.pm * 256 + ai * 128 + wr * 64 + m * 16 + fr;
#pragma unroll
                for (int bj = 0; bj < 2; ++bj) { if (bj == 1 && u.hn) continue; const int col = u.pn * 64 + bj * 64 + wc * 16 + 4 * fq;
                    const f32x4 g = acc[ai][bj][m][0], up = acc[ai][bj][m][1]; float a[4];
#pragma unroll
                    for (int i = 0; i < 4; ++i) a[i] = g[i] * __builtin_amdgcn_rcpf(1.f + __builtin_amdgcn_exp2f(g[i] * -1.44269504f)) * (up[i] * F8_ASCALE);
                    *(unsigned*)(ACT + arow * DEXP + col) = pk4_fp8(a[0], a[1], a[2], a[3]); } }
    }
};
struct EpiScatter {
    static constexpr bool PERM = true, META = true;
    unsigned char* YK; LAS int* ms; LAS float* mw;
    template <class Sched> __device__ __forceinline__ void prefetch(const Unit& u, const Sched& S, int tid) const {
        if (__builtin_amdgcn_readfirstlane(tid >> 6) == 0) { S.dma_list(u, (unsigned)__builtin_amdgcn_readfirstlane((int)(unsigned)(size_t)(ms + u.par * 256)), tid & 63);
            S.dma_listw(u, (unsigned)__builtin_amdgcn_readfirstlane((int)(unsigned)(size_t)(mw + u.par * 256)), tid & 63); } }
    template <class Sched> __device__ __forceinline__ void operator()(const f32x4 (&acc)[2][2][4][2], const Unit& u, int wr, int wc, int fr, int fq, const Sched& S) const {
        int sl[2][4]; float w8[2][4];
#pragma unroll
        for (int ai = 0; ai < 2; ++ai)
#pragma unroll
            for (int m = 0; m < 4; ++m) { const int rt = u.par * 256 + ai * 128 + wr * 64 + m * 16 + fr; sl[ai][m] = ms[rt]; w8[ai][m] = mw[rt] * F8_YSCALE; }
        const int nvalid = S.cnt[u.e] - u.lt * 256;
#pragma unroll
        for (int ai = 0; ai < 2; ++ai)
#pragma unroll
            for (int m = 0; m < 4; ++m) { const int rl = ai * 128 + wr * 64 + m * 16 + fr; const bool ok = rl < nvalid; const int s_ = ok ? sl[ai][m] : 0;
                unsigned char* yrow = YK + ((size_t)(s_ & 1) * M1 + (size_t)(s_ >> 1)) * D + u.pn * 128 + wc * 32 + 8 * fq;
#pragma unroll
                for (int bj = 0; bj < 2; ++bj) {
                    const f32x4 v0 = acc[ai][bj][m][0] * w8[ai][m], v1 = acc[ai][bj][m][1] * w8[ai][m];
                    u32x2 w; w.x = pk4_fp8(v0[0], v0[1], v0[2], v0[3]); w.y = pk4_fp8(v1[0], v1[1], v1[2], v1[3]);
                    if (ok && !(bj == 1 && u.hn)) *(u32x2*)(yrow + bj * 128) = w; } }
    }
};

template <int MODE> __device__ __forceinline__ int wrow_map(int n) { return MODE == 0 ? n : (8 * (n >> 2) + (n & 3) + (MODE == 2 ? 4 : 0)); }
template <int MODE> __device__ __forceinline__ void transpose_item_f8(const float* W, int srcpitch, int K, int N, unsigned char* WT, int dpitch, LAS float* scr, int item, int lane) {
    const int nblk = (N + 31) / 32, kb = item / nblk, nb = item % nblk, k0 = 64 * kb, n0 = 32 * nb;
    { float tmp[32];
#pragma unroll
        for (int i = 0; i < 32; ++i) { const int kk = 2 * i + (lane >> 5), n = n0 + (lane & 31); tmp[i] = n < N ? W[(size_t)(k0 + kk) * srcpitch + n] : 0.f; }
#pragma unroll
        for (int i = 0; i < 32; ++i) scr[(2 * i + (lane >> 5)) * 33 + (lane & 31)] = tmp[i] * F8_WSCALE; }
    asm volatile("s_waitcnt lgkmcnt(0)" ::: "memory");
#pragma unroll
    for (int j = 0; j < 2; ++j) { const int slot = lane + 64 * j, nl = slot >> 2, c = slot & 3; const LAS float* sp = scr + (16 * c) * 33 + nl;
        u32x4 o; o.x = pk4_fp8(sp[0 * 33], sp[1 * 33], sp[2 * 33], sp[3 * 33]); o.y = pk4_fp8(sp[4 * 33], sp[5 * 33], sp[6 * 33], sp[7 * 33]);
        o.z = pk4_fp8(sp[8 * 33], sp[9 * 33], sp[10 * 33], sp[11 * 33]); o.w = pk4_fp8(sp[12 * 33], sp[13 * 33], sp[14 * 33], sp[15 * 33]);
        if (n0 + nl < N) *(u32x4*)(WT + (size_t)wrow_map<MODE>(n0 + nl) * dpitch + k0 + 16 * c) = o; }
    asm volatile("s_waitcnt lgkmcnt(0)" ::: "memory");
}
template <int MODE> __device__ __forceinline__ void transpose_item(const float* W, int srcpitch, int K, int N, bf16_t* WT, int dpitch, int dcol0, LAS float* scr, int item, int lane) {
    const int nblk = (N + 31) / 32, kb = item / nblk, nb = item % nblk, k0 = 64 * kb, n0 = 32 * nb;
    { float tmp[32];
#pragma unroll
        for (int i = 0; i < 32; ++i) { const int kk = 2 * i + (lane >> 5), n = n0 + (lane & 31); tmp[i] = n < N ? W[(size_t)(k0 + kk) * srcpitch + n] : 0.f; }
#pragma unroll
        for (int i = 0; i < 32; ++i) scr[(2 * i + (lane >> 5)) * 33 + (lane & 31)] = tmp[i]; }
    asm volatile("s_waitcnt lgkmcnt(0)" ::: "memory");
    const int c = lane & 7;
#pragma unroll
    for (int j = 0; j < 4; ++j) { const int nl = (lane >> 3) + 8 * j; const LAS float* s = scr + (8 * c) * 33 + nl;
        u32x4 o; o.x = pk2(s[0 * 33], s[1 * 33]); o.y = pk2(s[2 * 33], s[3 * 33]); o.z = pk2(s[4 * 33], s[5 * 33]); o.w = pk2(s[6 * 33], s[7 * 33]);
        if (n0 + nl < N) *(u32x4*)(WT + (size_t)wrow_map<MODE>(n0 + nl) * dpitch + dcol0 + k0 + 8 * c) = o; }
    asm volatile("s_waitcnt lgkmcnt(0)" ::: "memory");
}
constexpr int PI_IN0 = 16 * 64, PI_OUT0 = 8 * 32, PI_OUT08 = 8 * 32, PI_IN1 = 16 * 96, PI_IN18 = 16 * 96, PI_OUT18 = 16 * 32, PI_G = 32 * 256, PI_U = 32 * 256, PI_D = 32 * 256;
constexpr int PREP_EARLY = PI_IN0, PREP_NITEMS = PI_IN0 + PI_OUT0 + PI_OUT08 + PI_IN1 + PI_IN18 + PI_OUT18 + PI_G + PI_U + PI_D;
__device__ __forceinline__ void prep_items(const Ptrs& P, LAS unsigned char* lds, const int it_lo, const int it_hi, const int gw, const int NGW, const int lane, const int wave) {
    LAS float* scr = (LAS float*)(lds + wave * 16384);
    bf16_t* Win0 = (bf16_t*)(P.ws + W_IN0); bf16_t* Wout0 = (bf16_t*)(P.ws + W_OUT0); bf16_t* Win1 = (bf16_t*)(P.ws + W_IN1);
    unsigned char* Wgu = P.ws + W_GU; unsigned char* Wdn = P.ws + W_DN;
    struct ItemD { const float* W; unsigned char* dst; int srcpitch, N, nblk, dpitch, dcol, mode, f8; };
    auto decode = [&](int it, ItemD& d, int& r) {
        r = it;
        if (r < PI_IN0) { d = ItemD{P.even_w_in, (unsigned char*)Win0, EVEN_IN, EVEN_IN, 64, 2048, 0, 0, 0}; return; } r -= PI_IN0;
        if (r < PI_OUT0) { d = ItemD{P.even_w_out + (size_t)512 * 1024, (unsigned char*)Wout0, 1024, 1024, 32, 2048, 1024, 0, 0}; return; } r -= PI_OUT0;
        if (r < PI_OUT08) { d = ItemD{P.even_w_out + (size_t)512 * 1024, P.ws + W_OUT08, 1024, 1024, 32, 1024, 512, 0, 1}; return; } r -= PI_OUT08;
        if (r < PI_IN1) { d = ItemD{P.odd_w_in, (unsigned char*)Win1, ODD_IN, ODD_N, 96, 2048, 0, 0, 0}; return; } r -= PI_IN1;
        if (r < PI_IN18) { d = ItemD{P.odd_w_in, P.ws + W_IN18, ODD_IN, ODD_N, 96, 1024, 0, 0, 1}; return; } r -= PI_IN18;
        if (r < PI_OUT18) { d = ItemD{P.odd_w_out, P.ws + W_OUT18, 1024, 1024, 32, 1024, 0, 0, 1}; return; } r -= PI_OUT18;
        if (r < PI_G) { const int le = r >> 8; r &= 255; d = ItemD{P.moe_w_gate + (size_t)le * 1024 * 512, Wgu + (size_t)le * 1024 * 1024, 512, 512, 16, 1024, 0, 1, 1}; return; } r -= PI_G;
        if (r < PI_U) { const int le = r >> 8; r &= 255; d = ItemD{P.moe_w_up + (size_t)le * 1024 * 512, Wgu + (size_t)le * 1024 * 1024, 512, 512, 16, 1024, 0, 2, 1}; return; } r -= PI_U;
        { const int le = r >> 8; r &= 255; d = ItemD{P.moe_w_down + (size_t)le * 512 * 1024, Wdn + (size_t)le * 1024 * 512, 1024, 1024, 32, 512, 0, 0, 1}; } };
#define PREP_LOAD(d, r, tmp) do { const int kb_ = (r) / (d).nblk, nb_ = (r) % (d).nblk; \
        _Pragma("unroll") for (int i = 0; i < 8; ++i) { const int kk = 8 * i + (lane >> 3), n = 32 * nb_ + 4 * (lane & 7); tmp[i] = *(const f32x4*)((d).W + (size_t)(64 * kb_ + kk) * (d).srcpitch + n); } } while (0)
#define PREP_STORE(d, r, tmp) do { const int kb_ = (r) / (d).nblk, nb_ = (r) % (d).nblk, k0_ = 64 * kb_, n0_ = 32 * nb_; const float sc_ = (d).f8 ? F8_WSCALE : 1.f; \
        _Pragma("unroll") for (int i = 0; i < 8; ++i) { LAS float* wp_ = scr + (8 * i + (lane >> 3)) * 33 + 4 * (lane & 7); wp_[0] = tmp[i][0] * sc_; wp_[1] = tmp[i][1] * sc_; wp_[2] = tmp[i][2] * sc_; wp_[3] = tmp[i][3] * sc_; } \
        asm volatile("s_waitcnt lgkmcnt(0)" ::: "memory"); \
        if ((d).f8) { _Pragma("unroll") for (int j = 0; j < 2; ++j) { const int slot = lane + 64 * j, nl = slot >> 2, c = slot & 3; const LAS float* sp = scr + (16 * c) * 33 + nl; \
                u32x4 o; o.x = pk4_fp8(sp[0 * 33], sp[1 * 33], sp[2 * 33], sp[3 * 33]); o.y = pk4_fp8(sp[4 * 33], sp[5 * 33], sp[6 * 33], sp[7 * 33]); \
                o.z = pk4_fp8(sp[8 * 33], sp[9 * 33], sp[10 * 33], sp[11 * 33]); o.w = pk4_fp8(sp[12 * 33], sp[13 * 33], sp[14 * 33], sp[15 * 33]); \
                const int n = n0_ + nl, rown = (d).mode == 0 ? n : (8 * (n >> 2) + (n & 3) + ((d).mode == 2 ? 4 : 0)); \
                if (n < (d).N) *(u32x4*)((d).dst + (size_t)rown * (d).dpitch + (d).dcol + k0_ + 16 * c) = o; } } \
        else { const int c = lane & 7; \
            _Pragma("unroll") for (int j = 0; j < 4; ++j) { const int nl = (lane >> 3) + 8 * j; const LAS float* sp = scr + (8 * c) * 33 + nl; \
                u32x4 o; o.x = pk2(sp[0 * 33], sp[1 * 33]); o.y = pk2(sp[2 * 33], sp[3 * 33]); o.z = pk2(sp[4 * 33], sp[5 * 33]); o.w = pk2(sp[6 * 33], sp[7 * 33]); \
                if (n0_ + nl < (d).N) *(u32x4*)((d).dst + (size_t)(n0_ + nl) * (d).dpitch + (d).dcol + (size_t)(k0_ + 8 * c) * 2) = o; } } \
        asm volatile("s_waitcnt lgkmcnt(0)" ::: "memory"); } while (0)
#define PREP_TRY(idx, d, r, tmp, ok) do { ok = (idx) < it_hi; decode(ok ? (idx) : it_lo, d, r); PREP_LOAD(d, r, tmp); } while (0)
    { ItemD dA, dB, dC; int rA = 0, rB = 0, rC = 0; f32x4 tA[8], tB[8], tC[8]; bool okA, okB, okC;
        int it = it_lo + gw;
        PREP_TRY(it, dA, rA, tA, okA); PREP_TRY(it + NGW, dB, rB, tB, okB);
        while (okA) {
            PREP_TRY(it + 2 * NGW, dC, rC, tC, okC);
            PREP_STORE(dA, rA, tA);
            if (!okB) break;
            PREP_TRY(it + 3 * NGW, dA, rA, tA, okA);
            PREP_STORE(dB, rB, tB);
            if (!okC) break;
            PREP_TRY(it + 4 * NGW, dB, rB, tB, okB);
            PREP_STORE(dC, rC, tC);
            it += 3 * NGW; } }
#undef PREP_TRY
#undef PREP_LOAD
#undef PREP_STORE
}
__device__ __forceinline__ void prep_fold(const Ptrs& P, const int gw, const int NGW, const int lane) {
    bf16_t* Wout0 = (bf16_t*)(P.ws + W_OUT0);
    for (int it = gw; it < 128 * 16; it += NGW) {
        const int cp0 = (it >> 4) * 4, n = (it & 15) * 64 + lane, g = cp0 >> 7, c0 = cp0 & 127;
        const float* pw = P.pool_w + ((size_t)g * 128 + c0) * 128; const float* ps = P.pool_scale + g * 128; const float* wo = P.even_w_out + (size_t)(g * 128) * 1024 + n;
        float a[4] = {0.f, 0.f, 0.f, 0.f}; float wv[128];
#pragma unroll
        for (int d = 0; d < 128; ++d) wv[d] = wo[(size_t)d * 1024];
        __builtin_amdgcn_sched_barrier(0);
#pragma unroll
        for (int d = 0; d < 128; ++d) { const float w = ps[d] * wv[d];
#pragma unroll
            for (int j = 0; j < 4; ++j) a[j] += pw[j * 128 + d] * w; }
#pragma unroll
        for (int j = 0; j < 4; ++j) { Wout0[(size_t)n * 1024 + cp0 + j] = (bf16_t)f2bf(a[j]); }
        *(unsigned*)(P.ws + W_OUT08 + (size_t)n * 1024 + cp0) = pk4_fp8(a[0] * F8_WSCALE, a[1] * F8_WSCALE, a[2] * F8_WSCALE, a[3] * F8_WSCALE);
    }
}
__device__ __forceinline__ void stage_prep(const Ptrs& P, LAS unsigned char* lds, int wg, int nwg) {
    const int tid = tid_opaque(P), lane = tid & 63, wave = __builtin_amdgcn_readfirstlane(tid >> 6);
    const int gw = wg * 8 + wave, NGW = nwg * 8;
    prep_items(P, lds, 0, nwg == 256 ? PREP_EARLY : PREP_NITEMS, gw, NGW, lane, wave);
    if (nwg != 256) prep_fold(P, gw, NGW, lane);
    bf16_t* Hb = (bf16_t*)(P.ws + WS_HB);
    for (int row0 = gw * 4; row0 < M1; row0 += NGW * 4) { f32x4 v[4][4];
#pragma unroll
        for (int q = 0; q < 4; ++q) { const f32x4* xr = (const f32x4*)h0_ptr(P, row0 + q) + lane;
#pragma unroll
            for (int j = 0; j < 4; ++j) v[q][j] = xr[64 * j]; }
#pragma unroll
        for (int q = 0; q < 4; ++q) { unsigned long long* o8 = (unsigned long long*)(Hb + (size_t)(row0 + q) * D) + lane;
#pragma unroll
            for (int j = 0; j < 4; ++j) o8[64 * j] = (unsigned long long)pk2(v[q][j].x, v[q][j].y) | ((unsigned long long)pk2(v[q][j].z, v[q][j].w) << 32); } }
    if (wg == 0 && tid == 0) { float s1 = 0.f, s2 = 0.f; for (int i = 0; i < 64; ++i) { s1 += P.lq1[i] * P.lk1[i]; s2 += P.lq2[i] * P.lk2[i]; }
        ((float*)(P.ws + WS_MISC))[0] = __expf(s1) - __expf(s2) + LAMBDA_INIT; }
}

template <int W> __device__ __forceinline__ void pool_block(const bf16_t* Z, unsigned char* A28, bf16_t* A2m, int row0, int p0, int col) {
    u32x4 v[W + 15];
#pragma unroll
    for (int k = 0; k < W + 15; ++k) v[k] = (p0 - (W - 1) + k >= 0) ? *(const u32x4*)(Z + (size_t)(row0 - (W - 1) + k) * EVEN_IN + col) : (u32x4){0u, 0u, 0u, 0u};
    float s[8];
#pragma unroll
    for (int i = 0; i < 8; ++i) s[i] = 0.f;
#pragma unroll
    for (int k = 0; k < W - 1; ++k) { s[0] += bflo(v[k].x); s[1] += bfhi(v[k].x); s[2] += bflo(v[k].y); s[3] += bfhi(v[k].y); s[4] += bflo(v[k].z); s[5] += bfhi(v[k].z); s[6] += bflo(v[k].w); s[7] += bfhi(v[k].w); }
#pragma unroll
    for (int r = 0; r < 16; ++r) { const u32x4 in = v[W - 1 + r];
        s[0] += bflo(in.x); s[1] += bfhi(in.x); s[2] += bflo(in.y); s[3] += bfhi(in.y); s[4] += bflo(in.z); s[5] += bfhi(in.z); s[6] += bflo(in.w); s[7] += bfhi(in.w);
        const int p = p0 + r; const float inv = 1.f / (float)((p + 1) < W ? (p + 1) : W);
        const float dv[8] = {s[0] * inv - bflo(in.x), s[1] * inv - bfhi(in.x), s[2] * inv - bflo(in.y), s[3] * inv - bfhi(in.y), s[4] * inv - bflo(in.z), s[5] * inv - bfhi(in.z), s[6] * inv - bflo(in.w), s[7] * inv - bfhi(in.w)};
        const int row = row0 + r;
        if (p < NMETA) { u32x4 o; o.x = pk2(dv[0], dv[1]); o.y = pk2(dv[2], dv[3]); o.z = pk2(dv[4], dv[5]); o.w = pk2(dv[6], dv[7]); *(u32x4*)(A2m + (size_t)((row / LB) * NMETA + p) * D + col) = o; }
        else { u32x2 o; o.x = pk4_fp8(dv[0] * F8_ASCALE, dv[1] * F8_ASCALE, dv[2] * F8_ASCALE, dv[3] * F8_ASCALE); o.y = pk4_fp8(dv[4] * F8_ASCALE, dv[5] * F8_ASCALE, dv[6] * F8_ASCALE, dv[7] * F8_ASCALE); *(u32x2*)(A28 + (size_t)row * D + col) = o; }
        const u32x4 out = v[r];
        s[0] -= bflo(out.x); s[1] -= bfhi(out.x); s[2] -= bflo(out.y); s[3] -= bfhi(out.y); s[4] -= bflo(out.z); s[5] -= bfhi(out.z); s[6] -= bflo(out.w); s[7] -= bfhi(out.w); }
}
__device__ __forceinline__ void stage_pool(const Ptrs& P, int wg, int nwg) {
    const bf16_t* Z = (const bf16_t*)(P.ws + WS_Z); unsigned char* A28 = P.ws + WS_A2; bf16_t* A2m = (bf16_t*)(P.ws + WS_A2M);
    const int tid_ = tid_opaque(P), lane = tid_ & 63; const int gwv = __builtin_amdgcn_readfirstlane(wg * 8 + (tid_ >> 6)), NGW = nwg * 8;
    for (int it = gwv; it < (M1 / 64) * 4; it += NGW) { const int gi = it & 3, blk = (it >> 2) * 4 + (lane >> 4), row0 = blk * 16, p0 = row0 % LB, col = gi * 128 + (lane & 15) * 8;
        if (gi == 0) pool_block<2>(Z, A28, A2m, row0, p0, col); else if (gi == 1) pool_block<4>(Z, A28, A2m, row0, p0, col);
        else if (gi == 2) pool_block<8>(Z, A28, A2m, row0, p0, col); else pool_block<16>(Z, A28, A2m, row0, p0, col); }
}

__device__ __forceinline__ void route16(const float (&lg)[16], const float* bias, int& e0, int& e1, float& w0, float& w1) {
    float mx = lg[0];
#pragma unroll
    for (int e = 1; e < 16; ++e) mx = fmaxf(mx, lg[e]);
    float p[16], sum = 0.f;
#pragma unroll
    for (int e = 0; e < 16; ++e) { p[e] = __expf(lg[e] - mx); sum += p[e]; }
    const float inv = 1.f / sum; float sel[16];
#pragma unroll
    for (int e = 0; e < 16; ++e) { p[e] *= inv; sel[e] = p[e] + bias[e]; }
    int gbest = 0; float gsb = -3.0e38f; int bi0 = 0, bi1 = 1; float bp0 = 0.f, bp1 = 0.f;
#pragma unroll
    for (int g = 0; g < 4; ++g) {
        int i0 = 0; float m0 = sel[4 * g];
#pragma unroll
        for (int i = 1; i < 4; ++i) if (sel[4 * g + i] > m0) { m0 = sel[4 * g + i]; i0 = i; }
        int i1 = (i0 == 0) ? 1 : 0; float m1 = (i0 == 0) ? sel[4 * g + 1] : sel[4 * g];
#pragma unroll
        for (int i = 1; i < 4; ++i) if (i != i0 && i != ((i0 == 0) ? 1 : 0) && sel[4 * g + i] > m1) { m1 = sel[4 * g + i]; i1 = i; }
        const float gs = m0 + m1;
        float q0 = 0.f, q1 = 0.f;
#pragma unroll
        for (int i = 0; i < 4; ++i) { q0 = (i == i0) ? p[4 * g + i] : q0; q1 = (i == i1) ? p[4 * g + i] : q1; }
        if (gs > gsb) { gsb = gs; gbest = g; bi0 = i0; bi1 = i1; bp0 = q0; bp1 = q1; }
    }
    e0 = gbest * 4 + bi0; e1 = gbest * 4 + bi1; const float ws = 1.f / (bp0 + bp1); w0 = bp0 * ws; w1 = bp1 * ws;
}

constexpr int LN_WROW = 80, LN_LGS = 1024 * LN_WROW, LN_CNT = LN_LGS + 8 * 256, LN_ENT = LN_CNT + 128, LN_GB = 90112;
template <int MODE> __device__ __forceinline__ void stage_ln(const Ptrs& P, LAS unsigned char* lds, int wg, int nwg) {
    constexpr int LAYER = MODE & 1; constexpr bool MIX = MODE < 2, MATV = MODE != 3, ROUTE = MODE < 2;
    const int tid = tid_opaque(P), lane = tid & 63, wave = __builtin_amdgcn_readfirstlane(tid >> 6);
    constexpr int O_TL = 0, TLP = 2064, O_PD = 66560, O_ST = 99328, O_SE = 99584, O_CE = 99648;
    constexpr int O_GB = ROUTE ? 100352 : LN_GB, O_LGS = ROUTE ? 108544 : LN_LGS, O_CNT = ROUTE ? 110592 : LN_CNT, O_ENT = ROUTE ? 110720 : LN_ENT;
    LAS float* lgs = (LAS float*)(lds + O_LGS) + wave * 64; LAS int* lcnt = (LAS int*)(lds + O_CNT); LAS int* lbase = lcnt + 16; LAS int* ent = (LAS int*)(lds + O_ENT); LAS float* entw = (LAS float*)(lds + O_ENT + 2048);
    int R = (((M1 + nwg - 1) / nwg) + 3) & ~3, r0 = wg * R, r1 = (r0 + R) < M1 ? (r0 + R) : M1;
    if ((MODE == 1 || MODE == 3) && nwg == 256) { R = 128; r0 = (wg >> 6) * LB + NMETA + (wg & 63) * 128; r1 = r0 + 128; }
    if (MODE == 2) { const float* src = MODE == 2 ? P.odd_w_in + ODD_N : P.router_w; const int stride = MODE == 2 ? ODD_IN : 16;
        for (int i = tid; i < 4096; i += 512) { const int cc = i >> 2, q4 = i & 3; const int lrow = (cc >> 9) * 512 + (cc & 7) * 64 + ((cc & 511) >> 3);
            *(LAS f32x4*)(lds + lrow * LN_WROW + q4 * 16) = *(const f32x4*)(src + (size_t)cc * stride + q4 * 4); } }
    if (ROUTE) { if (tid < 16) lcnt[tid] = 0; for (int i = tid; i < 2 * R; i += 512) ent[i] = -1; }
    { const float* gb_ = (tid < 256 ? (MIX ? P.ln_mix_g : P.ln_ffn_g) : (MIX ? P.ln_mix_b : P.ln_ffn_b)) + LAYER * D; const int i_ = tid & 255, hf_ = i_ >> 7, q_ = (i_ >> 6) & 1, ln_ = i_ & 63;
        ((LAS f32x4*)(lds + O_GB))[tid] = *(const f32x4*)(gb_ + hf_ * 512 + ln_ * 8 + q_ * 4); }
    bf16x8 bw[8];
    if (ROUTE) { const float* gp_ = P.ln_mix_g + LAYER * D; const float* bp_ = P.ln_mix_b + LAYER * D;
        const int n_ = lane & 31, kh_ = lane >> 5, e_ = n_ & 15; const bool lo_ = n_ >= 16;
#pragma unroll
        for (int ks = 0; ks < 8; ++ks) { unsigned hw[8];
#pragma unroll
            for (int j = 0; j < 8; ++j) { const int k_ = 128 * wave + 16 * ks + 8 * kh_ + j; const float wv = gp_[k_] * P.router_w[k_ * 16 + e_]; const unsigned hb_ = cvt_pk_bf16(wv, 0.f) & 0xffffu;
                const float res_ = wv - __uint_as_float(hb_ << 16); hw[j] = lo_ ? (cvt_pk_bf16(res_, 0.f) & 0xffffu) : hb_; }
            const u32x4 pk_ = (u32x4){hw[0] | (hw[1] << 16), hw[2] | (hw[3] << 16), hw[4] | (hw[5] << 16), hw[6] | (hw[7] << 16)}; bw[ks] = __builtin_bit_cast(bf16x8, pk_); }
        { const int e2_ = tid & 15, part_ = tid >> 4; float s_ = 0.f, c_ = 0.f;
            for (int k_ = part_ * 32; k_ < part_ * 32 + 32; ++k_) { const float wr_ = P.router_w[k_ * 16 + e2_]; s_ += gp_[k_] * wr_; c_ += bp_[k_] * wr_; }
            ((LAS float*)(lds + O_PD))[part_ * 16 + e2_] = s_; ((LAS float*)(lds + O_PD))[512 + part_ * 16 + e2_] = c_; }
        __syncthreads();
        if (tid < 32) { const int e2_ = tid & 15; const int which_ = tid >> 4; float a_ = 0.f; for (int p_ = 0; p_ < 32; ++p_) a_ += ((LAS float*)(lds + O_PD))[which_ * 512 + p_ * 16 + e2_]; ((LAS float*)(lds + (which_ ? O_CE : O_SE)))[e2_] = a_; } }
    __syncthreads();
    bf16_t* Hb = (bf16_t*)(P.ws + WS_HB); const bf16_t* T = (const bf16_t*)(P.ws + WS_T); const unsigned char* YK = P.ws + WS_YK; float* RW = (float*)(P.ws + WS_RW); float* GLR = (float*)(P.ws + WS_GLR);
    u32x4 raw[4][2], ry[4][2];
#define LN_LDRAW(q0n) do { _Pragma("unroll") for (int j = 0; j < 4; ++j) { const int rr_ = (q0n) + j, rw_ = rr_ < r1 ? rr_ : r1 - 1; \
        _Pragma("unroll") for (int hf = 0; hf < 2; ++hf) { const size_t off_ = (size_t)rw_ * D + hf * 512 + lane * 8; \
            if (MIX) raw[j][hf] = *(const u32x4*)(T + off_); \
            else { raw[j][hf] = *(const u32x4*)(Hb + off_); const u32x2 y0_ = *(const u32x2*)(YK + off_), y1_ = *(const u32x2*)(YK + (size_t)M1 * D + off_); ry[j][hf] = (u32x4){y0_.x, y0_.y, y1_.x, y1_.y}; } } } } while (0)
    const int qend = ROUTE ? r0 + 32 * ((r1 - r0 + 31) / 32) : r1;
    if (ROUTE || r0 + 4 * wave < r1) LN_LDRAW(r0 + 4 * wave);
    for (int q0 = r0 + 4 * wave; q0 < qend; q0 += 32) {
        float x[4][16]; bool act[4]; int rows[4];
#pragma unroll
        for (int j = 0; j < 4; ++j) { const int rr = q0 + j; rows[j] = rr < r1 ? rr : r1 - 1; const int p = rows[j] % LB; act[j] = rr < r1 && !((MODE == 1 || MODE == 3) && p < NMETA); }
#pragma unroll
        for (int j = 0; j < 4; ++j)
#pragma unroll
            for (int hf = 0; hf < 2; ++hf) {
                if (MIX) { const u32x4 t = raw[j][hf];
                    x[j][hf * 8 + 0] = bflo(t.x); x[j][hf * 8 + 1] = bfhi(t.x); x[j][hf * 8 + 2] = bflo(t.y); x[j][hf * 8 + 3] = bfhi(t.y); x[j][hf * 8 + 4] = bflo(t.z); x[j][hf * 8 + 5] = bfhi(t.z); x[j][hf * 8 + 6] = bflo(t.w); x[j][hf * 8 + 7] = bfhi(t.w); }
                else { const u32x4 h = raw[j][hf], yy = ry[j][hf];
                    float a0[4], a1[4], b0[4], b1[4]; fp8x4_to_f32(yy.x, a0); fp8x4_to_f32(yy.y, a1); fp8x4_to_f32(yy.z, b0); fp8x4_to_f32(yy.w, b1);
                    constexpr float ys = 1.f / F8_YSCALE;
                    x[j][hf * 8 + 0] = bflo(h.x) * ALPHA + (a0[0] + b0[0]) * ys; x[j][hf * 8 + 1] = bfhi(h.x) * ALPHA + (a0[1] + b0[1]) * ys;
                    x[j][hf * 8 + 2] = bflo(h.y) * ALPHA + (a0[2] + b0[2]) * ys; x[j][hf * 8 + 3] = bfhi(h.y) * ALPHA + (a0[3] + b0[3]) * ys;
                    x[j][hf * 8 + 4] = bflo(h.z) * ALPHA + (a1[0] + b1[0]) * ys; x[j][hf * 8 + 5] = bfhi(h.z) * ALPHA + (a1[1] + b1[1]) * ys;
                    x[j][hf * 8 + 6] = bflo(h.w) * ALPHA + (a1[2] + b1[2]) * ys; x[j][hf * 8 + 7] = bfhi(h.w) * ALPHA + (a1[3] + b1[3]) * ys; } }
        if (ROUTE) {
#pragma unroll
            for (int j = 0; j < 4; ++j)
#pragma unroll
                for (int hf = 0; hf < 2; ++hf) *(LAS u32x4*)(lds + O_TL + (4 * wave + j) * TLP + hf * 1024 + lane * 16) = raw[j][hf]; }
        __builtin_amdgcn_sched_barrier(0);
        if (ROUTE || q0 + 32 < r1) LN_LDRAW(q0 + 32);
        float mean[4], rstd[4];
#pragma unroll
        for (int j = 0; j < 4; ++j) { float sm = 0.f;
#pragma unroll
            for (int i = 0; i < 16; ++i) sm += x[j][i];
            mean[j] = sm; }
#pragma unroll
        for (int o = 1; o < 64; o <<= 1) {
#pragma unroll
            for (int j = 0; j < 4; ++j) mean[j] += __shfl_xor(mean[j], o); }
#pragma unroll
        for (int j = 0; j < 4; ++j) { mean[j] *= (1.f / D); float s2 = 0.f;
#pragma unroll
            for (int i = 0; i < 16; ++i) { x[j][i] -= mean[j]; s2 += x[j][i] * x[j][i]; }
            rstd[j] = s2; }
#pragma unroll
        for (int o = 1; o < 64; o <<= 1) {
#pragma unroll
            for (int j = 0; j < 4; ++j) rstd[j] += __shfl_xor(rstd[j], o); }
#pragma unroll
        for (int j = 0; j < 4; ++j) rstd[j] = 1.f / sqrtf(rstd[j] * (1.f / D) + LN_EPS);
        {
#pragma unroll
            for (int hf = 0; hf < 2; ++hf)
#pragma unroll
                for (int q = 0; q < 2; ++q) { const f32x4 g4 = ((const LAS f32x4*)(lds + O_GB))[(hf * 2 + q) * 64 + lane], b4 = ((const LAS f32x4*)(lds + O_GB))[256 + (hf * 2 + q) * 64 + lane];
#pragma unroll
                    for (int e = 0; e < 4; ++e)
#pragma unroll
                        for (int j = 0; j < 4; ++j) x[j][hf * 8 + q * 4 + e] = x[j][hf * 8 + q * 4 + e] * rstd[j] * g4[e] + b4[e]; } }
#pragma unroll
        for (int j = 0; j < 4; ++j) {
            if (act[j]) {
                if (MODE != 3) {
#pragma unroll
                    for (int hf = 0; hf < 2; ++hf) { u32x4 w; w.x = pk2(x[j][hf * 8], x[j][hf * 8 + 1]); w.y = pk2(x[j][hf * 8 + 2], x[j][hf * 8 + 3]); w.z = pk2(x[j][hf * 8 + 4], x[j][hf * 8 + 5]); w.w = pk2(x[j][hf * 8 + 6], x[j][hf * 8 + 7]);
                        *(u32x4*)(Hb + (size_t)rows[j] * D + hf * 512 + lane * 8) = w;
                        if (ROUTE || MODE == 2) { u32x2 w8; w8.x = pk4_fp8(x[j][hf * 8] * F8_HSCALE, x[j][hf * 8 + 1] * F8_HSCALE, x[j][hf * 8 + 2] * F8_HSCALE, x[j][hf * 8 + 3] * F8_HSCALE);
                            w8.y = pk4_fp8(x[j][hf * 8 + 4] * F8_HSCALE, x[j][hf * 8 + 5] * F8_HSCALE, x[j][hf * 8 + 6] * F8_HSCALE, x[j][hf * 8 + 7] * F8_HSCALE);
                            *(u32x2*)(P.ws + WS_HB8 + (size_t)rows[j] * D + hf * 512 + lane * 8) = w8; } } }
                else { const int b = rows[j] / LB, p = rows[j] - b * LB; float* orow = P.out + ((size_t)b * SEQ + (p - NMETA)) * D;
#pragma unroll
                    for (int hf = 0; hf < 2; ++hf)
#pragma unroll
                        for (int q = 0; q < 2; ++q) *(f32x4*)(orow + hf * 512 + lane * 8 + q * 4) = (f32x4){x[j][hf * 8 + q * 4], x[j][hf * 8 + q * 4 + 1], x[j][hf * 8 + q * 4 + 2], x[j][hf * 8 + q * 4 + 3]}; } } }
        if (ROUTE) {
            asm volatile("s_waitcnt lgkmcnt(0)\n\ts_barrier" ::: "memory");
            f32x16 dacc = f32x16{};
            { const LAS unsigned char* ap_ = lds + O_TL + (lane & 31) * TLP + (128 * wave + 8 * (lane >> 5)) * 2;
#pragma unroll
                for (int ks = 0; ks < 8; ++ks) { const bf16x8 a_ = *(const LAS bf16x8*)(ap_ + ks * 32); dacc = __builtin_amdgcn_mfma_f32_32x32x16_bf16(a_, bw[ks], dacc, 0, 0, 0); } }
            { LAS float* pd_ = (LAS float*)(lds + O_PD) + wave * 1024 + (lane & 31);
#pragma unroll
                for (int r = 0; r < 16; ++r) pd_[(((r & 3) + 8 * (r >> 2)) + 4 * (lane >> 5)) * 32] = dacc[r]; }
            if (lane == 0) {
#pragma unroll
                for (int j = 0; j < 4; ++j) { ((LAS float*)(lds + O_ST))[(4 * wave + j) * 2] = mean[j]; ((LAS float*)(lds + O_ST))[(4 * wave + j) * 2 + 1] = rstd[j]; } }
            asm volatile("s_waitcnt lgkmcnt(0)\n\ts_barrier" ::: "memory");
            { const int rw_ = 4 * wave + (lane >> 4), e_ = lane & 15; const LAS float* pd_ = (const LAS float*)(lds + O_PD) + rw_ * 32 + e_; float pre = 0.f;
#pragma unroll
                for (int w_ = 0; w_ < 8; ++w_) pre += pd_[w_ * 1024] + pd_[w_ * 1024 + 16];
                const float mr_ = ((const LAS float*)(lds + O_ST))[rw_ * 2], rs_ = ((const LAS float*)(lds + O_ST))[rw_ * 2 + 1];
                lgs[lane] = rs_ * (pre - mr_ * ((const LAS float*)(lds + O_SE))[e_]) + ((const LAS float*)(lds + O_CE))[e_]; }
            asm volatile("s_waitcnt lgkmcnt(0)" ::: "memory");
            { const int j = lane >> 4; float lg[16];
#pragma unroll
                for (int e4 = 0; e4 < 4; ++e4) { const f32x4 t4 = *(const LAS f32x4*)(lgs + j * 16 + e4 * 4); lg[e4 * 4] = t4.x; lg[e4 * 4 + 1] = t4.y; lg[e4 * 4 + 2] = t4.z; lg[e4 * 4 + 3] = t4.w; }
                int e0, e1; float w0, w1; route16(lg, P.router_bias, e0, e1, w0, w1);
                bool a_ = false;
#pragma unroll
                for (int jj = 0; jj < 4; ++jj) a_ = (jj == j) ? act[jj] : a_;
                if (a_ && (lane & 15) == 0) { const int row = q0 + j; const int li0 = atomicAdd((int*)&lcnt[e0], 1), li1 = atomicAdd((int*)&lcnt[e1], 1);
                    ent[2 * (row - r0)] = e0 | (li0 << 8); ent[2 * (row - r0) + 1] = e1 | (li1 << 8); entw[2 * (row - r0)] = w0; entw[2 * (row - r0) + 1] = w1; }
                asm volatile("s_waitcnt lgkmcnt(0)" ::: "memory"); }
        }
        if (MODE == 2) {
            float fin[2];
#define LN_DPP(v_, ctrl_) __builtin_bit_cast(float, __builtin_amdgcn_update_dpp(0, __builtin_bit_cast(int, (v_)), (ctrl_), 0xf, 0xf, false))
#pragma unroll
            for (int h8 = 0; h8 < 2; ++h8) {
                f32x2 v2[16];
#pragma unroll
                for (int i = 0; i < 16; ++i) v2[i] = (f32x2){0.f, 0.f};
#pragma unroll
                for (int hf = 0; hf < 2; ++hf)
#pragma unroll
                    for (int i = 0; i < 8; ++i) { const LAS f32x4* wp = (const LAS f32x4*)(lds + (hf * 512 + i * 64 + lane) * LN_WROW + h8 * 32); const f32x4 wa = wp[0], wb = wp[1];
                        const f32x2 w0 = (f32x2){wa.x, wa.y}, w1 = (f32x2){wa.z, wa.w}, w2 = (f32x2){wb.x, wb.y}, w3 = (f32x2){wb.z, wb.w};
#pragma unroll
                        for (int j = 0; j < 4; ++j) { const float hv = x[j][hf * 8 + i]; const f32x2 h2 = (f32x2){hv, hv};
                            v2[j * 4] = __builtin_elementwise_fma(h2, w0, v2[j * 4]); v2[j * 4 + 1] = __builtin_elementwise_fma(h2, w1, v2[j * 4 + 1]);
                            v2[j * 4 + 2] = __builtin_elementwise_fma(h2, w2, v2[j * 4 + 2]); v2[j * 4 + 3] = __builtin_elementwise_fma(h2, w3, v2[j * 4 + 3]); } }
                float v[32];
#pragma unroll
                for (int i = 0; i < 16; ++i) { v[2 * i] = v2[i].x; v[2 * i + 1] = v2[i].y; }
#pragma unroll
                for (int i = 0; i < 16; ++i) { const auto r = __builtin_amdgcn_permlane32_swap(__float_as_uint(v[i]), __float_as_uint(v[i + 16]), false, false); const unsigned r0 = r[0], r1 = r[1];
                    v[i] = __uint_as_float(r0) + __uint_as_float(r1); }
#pragma unroll
                for (int i = 0; i < 8; ++i) { const auto r = __builtin_amdgcn_permlane16_swap(__float_as_uint(v[i]), __float_as_uint(v[i + 8]), false, false); const unsigned r0 = r[0], r1 = r[1];
                    v[i] = __uint_as_float(r0) + __uint_as_float(r1); }
                const bool b3 = (lane & 8) != 0, b2 = (lane & 4) != 0, b1 = (lane & 2) != 0;
#pragma unroll
                for (int i = 0; i < 4; ++i) { const float keep = b3 ? v[i + 4] : v[i], send = b3 ? v[i] : v[i + 4]; v[i] = keep + LN_DPP(send, 0x128); }
#pragma unroll
                for (int i = 0; i < 2; ++i) { const float keep = b2 ? v[i + 2] : v[i], send = b2 ? v[i] : v[i + 2]; v[i] = keep + LN_DPP(send, 0x141); }
                { const float keep = b1 ? v[1] : v[0], send = b1 ? v[0] : v[1]; v[0] = keep + LN_DPP(send, 0x1b); }
                v[0] += LN_DPP(v[0], 0xb1);
                fin[h8] = v[0];
                __builtin_amdgcn_sched_barrier(0);
            }
#undef LN_DPP
            const int oute = (lane & 1) * 8 + ((lane >> 1) & 7); const float outv = (lane & 1) ? fin[1] : fin[0];
            if (MODE != 2) { lgs[(lane >> 4) * 16 + oute] = outv; asm volatile("s_waitcnt lgkmcnt(0)" ::: "memory"); }
            if (MODE == 2) { const int j = lane >> 4; bool a_ = false;
#pragma unroll
                for (int jj = 0; jj < 4; ++jj) a_ = (jj == j) ? act[jj] : a_;
                if (a_) GLR[(size_t)(q0 + j) * 16 + oute] = outv; }
            else {
                const int j = lane >> 4; float lg[16];
#pragma unroll
                for (int e4 = 0; e4 < 4; ++e4) { const f32x4 t4 = *(const LAS f32x4*)(lgs + j * 16 + e4 * 4); lg[e4 * 4] = t4.x; lg[e4 * 4 + 1] = t4.y; lg[e4 * 4 + 2] = t4.z; lg[e4 * 4 + 3] = t4.w; }
                int e0, e1; float w0, w1; route16(lg, P.router_bias, e0, e1, w0, w1);
                bool a_ = false;
#pragma unroll
                for (int jj = 0; jj < 4; ++jj) a_ = (jj == j) ? act[jj] : a_;
                if (a_ && (lane & 15) == 0) { const int row = q0 + j; const int li0 = atomicAdd((int*)&lcnt[e0], 1), li1 = atomicAdd((int*)&lcnt[e1], 1);
                    ent[2 * (row - r0)] = e0 | (li0 << 8); ent[2 * (row - r0) + 1] = e1 | (li1 << 8); entw[2 * (row - r0)] = w0; entw[2 * (row - r0) + 1] = w1; }
                asm volatile("s_waitcnt lgkmcnt(0)" ::: "memory");
            }
        }
    }
    if (ROUTE) {
        __syncthreads();
        unsigned* gcnt = (unsigned*)(P.ws + WS_CTL) + CW_CNT + 64 * LAYER;
        if (tid < 16) lbase[tid] = (int)atomicAdd(gcnt + tid, (unsigned)lcnt[tid]);
        __syncthreads();
        int* list = (int*)(P.ws + WS_LIST); float* listw = (float*)(P.ws + WS_LISTW);
        for (int i = tid; i < 2 * (r1 - r0); i += 512) { const int en = ent[i]; if (en >= 0) { const int e = en & 0xff, li = en >> 8; const size_t at = (size_t)e * LISTCAP + lbase[e] + li; list[at] = (r0 + (i >> 1)) * 2 + (i & 1); listw[at] = entw[i]; } }
    }
    __syncthreads();
}

__device__ __forceinline__ void attn_naive_item(const Ptrs& P, int row, int h, LAS float* qs, int lane) {
    const bf16_t* Z = (const bf16_t*)(P.ws + WS_Z); bf16_t* A2m = (bf16_t*)(P.ws + WS_A2M);
    const int b = row / LB, p = row - b * LB, rowb = b * LB;
    const bf16_t* zq = Z + (size_t)row * EVEN_IN + 512 + h * 128;
    qs[lane] = bf2f(zq[lane]); qs[64 + lane] = bf2f(zq[64 + lane]);
    asm volatile("s_waitcnt lgkmcnt(0)" ::: "memory");
    const float slope2 = exp2f(-2.f * (float)(h + 1)) * LOG2E;
    float m0 = -INFINITY, m1 = -INFINITY, l0 = 0.f, l1 = 0.f, o00 = 0.f, o01 = 0.f, o10 = 0.f, o11 = 0.f;
    for (int j0 = 0; j0 <= p; j0 += 64) {
        const int j = j0 + lane; const bool valid = j <= p; float s0 = -INFINITY, s1 = -INFINITY;
        if (valid) { const u32x4* kr = (const u32x4*)(Z + (size_t)(rowb + j) * EVEN_IN + 1024 + h * 128); float d0 = 0.f, d1 = 0.f;
#pragma unroll
            for (int c = 0; c < 8; ++c) { const u32x4 kv = kr[c]; const LAS float* q = qs + 8 * c;
                d0 += q[0] * bflo(kv.x) + q[1] * bfhi(kv.x) + q[2] * bflo(kv.y) + q[3] * bfhi(kv.y) + q[4] * bflo(kv.z) + q[5] * bfhi(kv.z) + q[6] * bflo(kv.w) + q[7] * bfhi(kv.w); }
#pragma unroll
            for (int c = 8; c < 16; ++c) { const u32x4 kv = kr[c]; const LAS float* q = qs + 8 * c;
                d1 += q[0] * bflo(kv.x) + q[1] * bfhi(kv.x) + q[2] * bflo(kv.y) + q[3] * bfhi(kv.y) + q[4] * bflo(kv.z) + q[5] * bfhi(kv.z) + q[6] * bflo(kv.w) + q[7] * bfhi(kv.w); }
            const float bias = -slope2 * (float)(p - j); s0 = d0 + bias; s1 = d1 + bias; }
        const float mn0 = fmaxf(m0, wave_max(s0)), mn1 = fmaxf(m1, wave_max(s1));
        const float f0 = exp2f(m0 - mn0), f1 = exp2f(m1 - mn1);
        const float p0 = valid ? exp2f(s0 - mn0) : 0.f, p1 = valid ? exp2f(s1 - mn1) : 0.f;
        l0 = l0 * f0 + wave_sum(p0); l1 = l1 * f1 + wave_sum(p1); o00 *= f0; o01 *= f0; o10 *= f1; o11 *= f1; m0 = mn0; m1 = mn1;
        const int nk = (p - j0 + 1) < 64 ? (p - j0 + 1) : 64;
        const bf16_t* vr = Z + (size_t)(rowb + j0) * EVEN_IN + 1536 + h * 128 + lane;
        for (int jj = 0; jj < nk; ++jj) { const float a0 = __shfl(p0, jj), a1 = __shfl(p1, jj); const float v0 = bf2f(vr[(size_t)jj * EVEN_IN]), v1 = bf2f(vr[(size_t)jj * EVEN_IN + 64]);
            o00 += a0 * v0; o01 += a0 * v1; o10 += a1 * v0; o11 += a1 * v1; }
    }
    const float lam = ((const float*)(P.ws + WS_MISC))[0];
    const float a0 = o00 / l0 - lam * o10 / l1, a1 = o01 / l0 - lam * o11 / l1;
    const float r = 1.f / sqrtf(wave_sum(a0 * a0 + a1 * a1) * (1.f / 128.f) + RMS_EPS);
    bf16_t* o = A2m + (size_t)(b * NMETA + p) * D + 512 + h * 128;
    o[lane] = (bf16_t)f2bf(a0 * r * P.subln[lane] * (1.f - LAMBDA_INIT)); o[64 + lane] = (bf16_t)f2bf(a1 * r * P.subln[64 + lane] * (1.f - LAMBDA_INIT));
}

namespace att {
typedef short s16x4 __attribute__((ext_vector_type(4)));
typedef short v4i16_t __attribute__((ext_vector_type(4)));
constexpr int KSLOT = 8192, VSLOT = 16384, NBUF = 2;
constexpr int LDS_K = 0, LDS_V = NBUF * KSLOT, LDS_WS = LDS_V + NBUF * VSLOT, LDS_OST = LDS_WS + 2048, LDS_TOTAL = LDS_OST + 8 * 8192;
static_assert(LDS_TOTAL <= 131072, "attention LDS");
constexpr float THR = 8.f;
__device__ __forceinline__ int crow(int r, int hi) { return (r & 3) + 8 * (r >> 2) + 4 * hi; }
__device__ __forceinline__ float swapmax(float v) { auto rr = __builtin_amdgcn_permlane32_swap(__float_as_uint(v), __float_as_uint(v), false, false); return fmaxf(__uint_as_float(rr[0]), __uint_as_float(rr[1])); }
__device__ __forceinline__ float swapsum(float v) { auto rr = __builtin_amdgcn_permlane32_swap(__float_as_uint(v), __float_as_uint(v), false, false); return __uint_as_float(rr[0]) + __uint_as_float(rr[1]); }
#define VTR_A(dst, base, off) asm volatile("ds_read_b64_tr_b16 %0, %1 offset:%2" : "=v"(dst) : "v"(base), "n"(off))
#define VTR_WAIT(n, a, b) asm volatile("s_waitcnt lgkmcnt(%2)" : "+v"(a), "+v"(b) : "n"(n))
__device__ __forceinline__ s16x4 vtr(const LAS unsigned char* p) { return __builtin_bit_cast(s16x4, __builtin_amdgcn_ds_read_tr16_b64_v4i16((LAS v4i16_t*)p)); }

__device__ __forceinline__ void glds16(const void* gsrc, unsigned lds_dst) { unsigned keep;
    asm volatile("s_mov_b32 %0, m0\n\ts_mov_b32 m0, %2\n\ts_nop 0\n\tglobal_load_lds_dwordx4 %1, off\n\ts_mov_b32 m0, %0" : "=&s"(keep) : "v"(gsrc), "s"(lds_dst) : "memory"); }
#define ATT_WAITBAR() asm volatile("s_waitcnt vmcnt(0) lgkmcnt(0)\n\ts_barrier" ::: "memory")
#define ATT_WAITBAR_N(n) asm volatile("s_waitcnt vmcnt(" #n ") lgkmcnt(0)\n\ts_barrier" ::: "memory")
constexpr int PD = 3, K4 = PD + 1, V3 = PD + 2;
constexpr int L2_K = 0, L2_V = K4 * KSLOT, L2_WS = L2_V + V3 * VSLOT, L2_TOTAL = L2_WS + 2048, L2_OST = 0;
static_assert(L2_TOTAL + 128 <= 131072 && 8 * 8192 <= L2_WS, "attention v2 LDS");
__device__ __forceinline__ unsigned short bfr(float f) { return (unsigned short)f2bf(f); }
__device__ __forceinline__ void attn_unit(const Ptrs& P, LAS unsigned char* lds, int b, int vh, int qb) {
    const int tid = tid_opaque(P), lane = tid & 63, r32 = lane & 31, hi = lane >> 5; const int wid = __builtin_amdgcn_readfirstlane(tid >> 6);
    const bf16_t* Z = (const bf16_t*)(P.ws + WS_Z); bf16_t* Ob = (bf16_t*)(P.ws + WS_OA);
    const int rowb = b * LB, hd = vh >> 1;
    const int qrow0 = rowb + NMETA + 256 * qb + 32 * wid;
    const bf16_t* Kc = Z + 1024 + vh * 64; const bf16_t* Vc = Z + 1536 + hd * 128;
    const float slope2 = __uint_as_float(__builtin_amdgcn_readfirstlane(__float_as_uint(exp2f(-2.f * (float)(hd + 1)) * LOG2E)));
    LAS float* wsf = (LAS float*)(lds + L2_WS) + wid * 64;
    bf16x8 qr[4];
    { const bf16_t* qp = Z + (size_t)(qrow0 + r32) * EVEN_IN + 512 + vh * 64 + hi * 8;
#pragma unroll
        for (int ks = 0; ks < 4; ++ks) qr[ks] = *(const bf16x8*)(qp + ks * 16); }
#define ATT_KROW0(i) (((i) >= NR) ? rowb : rowb + NMETA + 64 * (4 * qb + 3 - (i)))
#define ATT_PK0(i) (((i) >= NR) ? 0 : NMETA + 64 * (4 * qb + 3 - (i)))
#define ATT_DMA(i) do { const int kr0_ = ATT_KROW0(i); const int ks_ = (i) % K4, vs_ = (i) % V3; \
        glds16(Kc + (size_t)(kr0_ + krow_) * EVEN_IN + kchk_ * 8, (unsigned)__builtin_amdgcn_readfirstlane((int)(lds0 + L2_K + ks_ * KSLOT + wid * 1024))); \
        _Pragma("unroll") for (int i_ = 0; i_ < 2; ++i_) { const int pc_ = wid * 2 + i_, db_ = pc_ >> 2, rg_ = pc_ & 3; \
            glds16(Vc + (size_t)(kr0_ + 16 * rg_ + (lane >> 2)) * EVEN_IN + db_ * 32 + (lane & 3) * 8, (unsigned)__builtin_amdgcn_readfirstlane((int)(lds0 + L2_V + vs_ * VSLOT + pc_ * 1024))); } } while (0)
    const unsigned lds0 = (unsigned)(size_t)lds;
    const int krow_ = 8 * wid + (lane >> 3), kchk_ = (lane & 7) ^ ((krow_ >> 1) & 7);
    int koff[4];
#pragma unroll
    for (int ks = 0; ks < 4; ++ks) koff[ks] = r32 * 128 + (((2 * ks + hi) ^ ((r32 >> 1) & 7)) << 4);
    int NR = 1 << 30, NT;
    ATT_DMA(0); ATT_DMA(1); ATT_DMA(2);
    { float qs = 0.f;
#pragma unroll
        for (int ks = 0; ks < 4; ++ks) { const u32x4 w = __builtin_bit_cast(u32x4, qr[ks]);
#pragma unroll
            for (int j = 0; j < 4; ++j) { const float a_ = bflo(w[j]), b_ = bfhi(w[j]); qs += a_ * a_ + b_ * b_; } }
        qs = swapsum(qs);
#pragma unroll
        for (int o_ = 1; o_ < 32; o_ <<= 1) qs = fmaxf(qs, __shfl_xor(qs, o_));
        if (lane == 0) wsf[0] = qs;
        ATT_WAITBAR();
        float q2 = 0.f;
#pragma unroll
        for (int w_ = 0; w_ < 8; ++w_) q2 = fmaxf(q2, ((LAS float*)(lds + L2_WS))[w_ * 64]);
        const unsigned* kn = (const unsigned*)(P.ws + WS_CTL) + CW_KN;
        const int kl_ = lane < 6 ? lane : 0; const unsigned kw_ = __hip_atomic_load(kn + (kl_ < 2 ? (b * 8 + vh) * 2 + kl_ : 64 + vh * 4 + (kl_ - 2)), __ATOMIC_RELAXED, __HIP_MEMORY_SCOPE_AGENT);
        const float k2r = __uint_as_float(__builtin_amdgcn_readlane(kw_, 0)) + __uint_as_float(__builtin_amdgcn_readlane(kw_, 1));
        const float k2m = __uint_as_float(__builtin_amdgcn_readlane(kw_, 2)) + __uint_as_float(__builtin_amdgcn_readlane(kw_, 3)) + __uint_as_float(__builtin_amdgcn_readlane(kw_, 4)) + __uint_as_float(__builtin_amdgcn_readlane(kw_, 5));
        const float QK = sqrtf(q2 * fmaxf(k2r, k2m) * 1.02f) * 1.01f + 1.f;
        const float dist = (151.f + 2.f * QK) / slope2;
        int tskip = (int)floorf(((float)(256 * qb - 63) - dist) * (1.f / 64.f)); tskip = tskip < -1 ? -1 : tskip;
        NR = 4 * qb + 3 - tskip; const bool hasm = (float)(NMETA + 256 * qb - 15) <= dist;
        NR = __builtin_amdgcn_readfirstlane(NR); NT = NR + (__builtin_amdgcn_readfirstlane((int)hasm) ? 1 : 0); }
    const int qrel = 32 * wid + r32, pq = NMETA + 256 * qb + qrel;
    float l = 0.f, cin = 0.f;
#define ATT_SETC() do { } while (0)
    f32x16 o[4];
#pragma unroll
    for (int d = 0; d < 4; ++d) o[d] = f32x16{};
    u32x4 pw[4];
    f32x16 p0, p1;
    const LAS unsigned char* vpl = lds + L2_V + ((lane >> 4) & 1) * 32 + (lane & 3) * 8 + (4 * hi + ((lane & 15) >> 2)) * 64;
#define ATT_QK(i) do { bf16x8 kf_[8];     \
        { const LAS unsigned char* kb_ = lds + L2_K + ((i) % K4) * KSLOT; \
          _Pragma("unroll") for (int ks = 0; ks < 4; ++ks) { kf_[2 * ks] = *(const LAS bf16x8*)(kb_ + koff[ks]); kf_[2 * ks + 1] = *(const LAS bf16x8*)(kb_ + koff[ks] + 4096); } } \
        __builtin_amdgcn_sched_barrier(0); \
        { const float cl_ = slope2 * (float)(ATT_PK0(i) + 4 * hi - pq) + cin, s32_ = 32.f * slope2; \
          _Pragma("unroll") for (int r = 0; r < 16; ++r) { p0[r] = fmaf(slope2, (float)((r & 3) + 8 * (r >> 2)), cl_); p1[r] = p0[r] + s32_; } } \
        _Pragma("unroll") for (int ks = 0; ks < 4; ++ks) { \
            p0 = __builtin_amdgcn_mfma_f32_32x32x16_bf16(kf_[2 * ks], qr[ks], p0, 0, 0, 0); p1 = __builtin_amdgcn_mfma_f32_32x32x16_bf16(kf_[2 * ks + 1], qr[ks], p1, 0, 0, 0); } \
        if ((i) < 4 || (i) >= NR) { const int lim_ = (((i) >= NR) ? 15 : qrel - 64 * (3 - (i))) - 4 * hi;     \
            _Pragma("unroll") for (int r = 0; r < 16; ++r) { const int kv = (r & 3) + 8 * (r >> 2); if (kv > lim_) p0[r] = -INFINITY; if (kv + 32 > lim_) p1[r] = -INFINITY; } } } while (0)
#define ATT_PV(vslot) do { const LAS unsigned char* vp_ = vpl + (vslot) * VSLOT; \
        _Pragma("unroll") for (int s2_ = 0; s2_ < 4; ++s2_) { s16x4 vq_[8]; \
            _Pragma("unroll") for (int d = 0; d < 4; ++d) { vq_[2 * d] = vtr(vp_ + d * 4096 + s2_ * 1024); vq_[2 * d + 1] = vtr(vp_ + d * 4096 + s2_ * 1024 + 512); } \
            _Pragma("unroll") for (int d = 0; d < 4; ++d) { const bf16x8 vf = (bf16x8){vq_[2 * d][0], vq_[2 * d][1], vq_[2 * d][2], vq_[2 * d][3], vq_[2 * d + 1][0], vq_[2 * d + 1][1], vq_[2 * d + 1][2], vq_[2 * d + 1][3]}; \
                o[d] = __builtin_amdgcn_mfma_f32_32x32x16_bf16(__builtin_bit_cast(bf16x8, pw[s2_]), vf, o[d], 0, 0, 0); } } } while (0)
#define ATT_ROWMAX(mx) do { float a_ = fmaxf(p0[0], p1[0]); _Pragma("unroll") for (int r = 1; r < 16; ++r) a_ = fmaxf(a_, fmaxf(p0[r], p1[r])); mx = swapmax(a_); } while (0)
#define ATT_IMAX(im) do { int a_ = __float_as_int(p0[0]); _Pragma("unroll") for (int r = 1; r < 16; ++r) { const int b_ = __float_as_int(p0[r]); a_ = a_ > b_ ? a_ : b_; } \
        _Pragma("unroll") for (int r = 0; r < 16; ++r) { const int b_ = __float_as_int(p1[r]); a_ = a_ > b_ ? a_ : b_; } im = a_; } while (0)
#define ATT_EXP_PACK() do { float sacc = 0.f; \
        _Pragma("unroll") for (int r = 0; r < 16; ++r) { p0[r] = __builtin_amdgcn_exp2f(p0[r]); p1[r] = __builtin_amdgcn_exp2f(p1[r]); sacc += p0[r] + p1[r]; } \
        l += sacc; \
        _Pragma("unroll") for (int j = 0; j < 4; ++j) { pw[0][j] = cvt_pk_bf16(p0[2 * j], p0[2 * j + 1]); pw[1][j] = cvt_pk_bf16(p0[8 + 2 * j], p0[8 + 2 * j + 1]); \
            pw[2][j] = cvt_pk_bf16(p1[2 * j], p1[2 * j + 1]); pw[3][j] = cvt_pk_bf16(p1[8 + 2 * j], p1[8 + 2 * j + 1]); } } while (0)
    f32x16 q0, q1;
    ATT_WAITBAR_N(6);
    ATT_QK(0);
    { float mx; ATT_ROWMAX(mx); const float d0 = fmaxf(mx, -256.f); cin -= d0;
#pragma unroll
        for (int r = 0; r < 16; ++r) { p0[r] = __builtin_amdgcn_exp2f(p0[r] - d0); p1[r] = __builtin_amdgcn_exp2f(p1[r] - d0); } }
#define ATT_PACK4(O0, O1, g) do { const int b_ = (((g) >> 1) * 8 + ((g) & 1) * 4) & 15; \
        if ((g) < 4) { pw[(g) >> 1][2 * ((g) & 1)] = cvt_pk_bf16(O0[b_], O0[b_ + 1]); pw[(g) >> 1][2 * ((g) & 1) + 1] = cvt_pk_bf16(O0[b_ + 2], O0[b_ + 3]); sacc += (O0[b_] + O0[b_ + 1]) + (O0[b_ + 2] + O0[b_ + 3]); } \
        else { pw[(g) >> 1][2 * ((g) & 1)] = cvt_pk_bf16(O1[b_], O1[b_ + 1]); pw[(g) >> 1][2 * ((g) & 1) + 1] = cvt_pk_bf16(O1[b_ + 2], O1[b_ + 3]); sacc += (O1[b_] + O1[b_ + 1]) + (O1[b_ + 2] + O1[b_ + 3]); } \
        asm volatile("" : "+v"(pw[(g) >> 1][2 * ((g) & 1)]), "+v"(pw[(g) >> 1][2 * ((g) & 1) + 1]), "+v"(sacc)); } while (0)
#define ATT_STEP(i, N0, N1, O0, O1) do { \
        { bf16x8 kf_[8]; float sacc = 0.f; \
          { const LAS unsigned char* kb_ = lds + L2_K + ((i) % K4) * KSLOT; \
            _Pragma("unroll") for (int ks = 0; ks < 4; ++ks) { kf_[2 * ks] = *(const LAS bf16x8*)(kb_ + koff[ks]); kf_[2 * ks + 1] = *(const LAS bf16x8*)(kb_ + koff[ks] + 4096); } } \
          __builtin_amdgcn_sched_barrier(0); \
          { const float cl_ = slope2 * (float)(ATT_PK0(i) + 4 * hi - pq) + cin, s32_ = 32.f * slope2; \
            _Pragma("unroll") for (int r = 0; r < 16; ++r) { N0[r] = fmaf(slope2, (float)((r & 3) + 8 * (r >> 2)), cl_); N1[r] = N0[r] + s32_; } } \
          _Pragma("unroll") for (int ks = 0; ks < 4; ++ks) { \
              N0 = __builtin_amdgcn_mfma_f32_32x32x16_bf16(kf_[2 * ks], qr[ks], N0, 0, 0, 0); ATT_PACK4(O0, O1, 2 * ks); __builtin_amdgcn_sched_barrier(0); \
              N1 = __builtin_amdgcn_mfma_f32_32x32x16_bf16(kf_[2 * ks + 1], qr[ks], N1, 0, 0, 0); ATT_PACK4(O0, O1, 2 * ks + 1); __builtin_amdgcn_sched_barrier(0); } \
          l += sacc; \
          if ((i) < 4 || (i) >= NR) { const int lim_ = (((i) >= NR) ? 15 : qrel - 64 * (3 - (i))) - 4 * hi; \
              _Pragma("unroll") for (int r = 0; r < 16; ++r) { const int kv = (r & 3) + 8 * (r >> 2); if (kv > lim_) N0[r] = -INFINITY; if (kv + 32 > lim_) N1[r] = -INFINITY; } } } \
        unsigned vp_ = (unsigned)(size_t)vpl + (unsigned)((((i) - 1) % V3) * VSLOT); asm volatile("" : "+v"(vp_)); \
        s16x4 vq[2][8]; \
        _Pragma("unroll") for (int d = 0; d < 4; ++d) { VTR_A(vq[0][2 * d], vp_, d * 4096); VTR_A(vq[0][2 * d + 1], vp_, d * 4096 + 512); } \
        __builtin_amdgcn_sched_barrier(0); \
        int imx; { int a_ = __float_as_int(N0[0]); _Pragma("unroll") for (int r = 1; r < 16; ++r) { const int b_ = __float_as_int(N0[r]); a_ = a_ > b_ ? a_ : b_; } \
            _Pragma("unroll") for (int r = 0; r < 16; ++r) { const int b_ = __float_as_int(N1[r]); a_ = a_ > b_ ? a_ : b_; } imx = a_; } \
        if (__any(imx > __builtin_bit_cast(int, THR))) { \
            float mx; { float a_ = fmaxf(N0[0], N1[0]); _Pragma("unroll") for (int r = 1; r < 16; ++r) a_ = fmaxf(a_, fmaxf(N0[r], N1[r])); mx = swapmax(a_); } \
            const float dl = ceilf(fmaxf(mx, 0.f)), f = __builtin_amdgcn_exp2f(-dl); cin -= dl; l *= f; \
            if (hi == 0) wsf[r32] = f; \
            asm volatile("s_waitcnt lgkmcnt(0)" ::: "memory"); \
            _Pragma("unroll") for (int r = 0; r < 16; ++r) { const float fr_ = wsf[crow(r, hi)]; N0[r] -= dl; N1[r] -= dl; \
                _Pragma("unroll") for (int d = 0; d < 4; ++d) o[d][r] *= fr_; } \
            const unsigned du = (unsigned)dl; \
            _Pragma("unroll") for (int s2_ = 0; s2_ < 4; ++s2_) _Pragma("unroll") for (int j = 0; j < 4; ++j) { const unsigned w = pw[s2_][j]; unsigned lo = w & 0xffffu, hh = w >> 16; \
                    lo = (((lo >> 7) & 0xffu) > du) ? lo - (du << 7) : 0u; hh = (((hh >> 7) & 0xffu) > du) ? hh - (du << 7) : 0u; pw[s2_][j] = lo | (hh << 16); } \
        } \
        _Pragma("unroll") for (int s2_ = 0; s2_ < 4; ++s2_) { \
            if (s2_ < 3) { _Pragma("unroll") for (int d = 0; d < 4; ++d) { VTR_A(vq[(s2_ + 1) & 1][2 * d], vp_, d * 4096 + (s2_ + 1) * 1024); VTR_A(vq[(s2_ + 1) & 1][2 * d + 1], vp_, d * 4096 + (s2_ + 1) * 1024 + 512); } } \
            __builtin_amdgcn_sched_barrier(0); \
            _Pragma("unroll") for (int d = 0; d < 4; ++d) { VTR_WAIT((s2_ < 3 ? 8 : 0) + 6 - 2 * d, vq[s2_ & 1][2 * d], vq[s2_ & 1][2 * d + 1]); \
                const s16x4 lo = vq[s2_ & 1][2 * d], h4 = vq[s2_ & 1][2 * d + 1]; \
                const bf16x8 vf = (bf16x8){lo[0], lo[1], lo[2], lo[3], h4[0], h4[1], h4[2], h4[3]}; \
                o[d] = __builtin_amdgcn_mfma_f32_32x32x16_bf16(__builtin_bit_cast(bf16x8, pw[s2_]), vf, o[d], 0, 0, 0); \
                const int e_ = s2_ * 4 + d; \
                if (e_ < 8) { float x0_ = __builtin_amdgcn_exp2f(N0[2 * e_]), x1_ = __builtin_amdgcn_exp2f(N0[2 * e_ + 1]); asm volatile("" : "+v"(x0_), "+v"(x1_)); N0[2 * e_] = x0_; N0[2 * e_ + 1] = x1_; }     \
                else { float x0_ = __builtin_amdgcn_exp2f(N1[(2 * e_) & 15]), x1_ = __builtin_amdgcn_exp2f(N1[(2 * e_ + 1) & 15]); asm volatile("" : "+v"(x0_), "+v"(x1_)); N1[(2 * e_) & 15] = x0_; N1[(2 * e_ + 1) & 15] = x1_; } } \
            __builtin_amdgcn_sched_barrier(0); } } while (0)
    { int i = 1;
        for (; i + 1 < NT; i += 2) { ATT_WAITBAR_N(0); if (i + 2 < NT) ATT_DMA(i + 2); if (i + 3 < NT) ATT_DMA(i + 3);
            ATT_STEP(i, q0, q1, p0, p1); ATT_STEP(i + 1, p0, p1, q0, q1); }
        if (i < NT) { ATT_WAITBAR_N(0); ATT_STEP(i, q0, q1, p0, p1); float sacc = 0.f;
#pragma unroll
            for (int g = 0; g < 8; ++g) ATT_PACK4(q0, q1, g);
            l += sacc; }
        else { float sacc = 0.f;
#pragma unroll
            for (int g = 0; g < 8; ++g) ATT_PACK4(p0, p1, g);
            l += sacc; } }
#undef ATT_STEP
#undef ATT_PACK4
    ATT_PV((NT - 1) % V3);
    l = swapsum(l);
    if (hi == 0) wsf[32 + r32] = l;
    ATT_WAITBAR();
    LAS bf16_t* stg = (LAS bf16_t*)(lds + L2_OST + wid * 8192);
    int lane_e = lane; asm volatile("" : "+v"(lane_e));
    const int r32e = lane_e & 31, hie = lane_e >> 5;
#pragma unroll
    for (int r = 0; r < 16; ++r) { const int orow = crow(r, hie); const float rl = 1.f / wsf[32 + orow];
#pragma unroll
        for (int d = 0; d < 4; ++d) stg[orow * 128 + d * 32 + r32e] = (bf16_t)f2bf(o[d][r] * rl); }
    asm volatile("s_waitcnt lgkmcnt(0)" ::: "memory");
#pragma unroll
    for (int i = 0; i < 8; ++i) { const int row = i * 4 + (lane_e >> 4), ch = lane_e & 15; const u32x4 v = *(const LAS u32x4*)(stg + row * 128 + ch * 8);
        *(u32x4*)(Ob + (size_t)(qrow0 + row) * D + vh * 128 + ch * 8) = v; }
    ATT_WAITBAR();
#undef ATT_DMA
#undef ATT_KROW0
#undef ATT_PK0
#undef ATT_QK
#undef ATT_PV
#undef ATT_ROWMAX
#undef ATT_IMAX
#undef ATT_EXP_PACK
#undef ATT_SETC
}
}

__device__ __forceinline__ void stage_attn(const Ptrs& P, LAS unsigned char* lds, int wg, int nwg, int flags) {
    const int tid_ = tid_opaque(P); const int lane = tid_ & 63, wave = __builtin_amdgcn_readfirstlane(tid_ >> 6);
    if (!(flags & 2)) { LAS float* qs = (LAS float*)(lds) + wave * 128;
        for (int it = wg * 8 + wave; it < NB * NMETA * 4; it += nwg * 8) { const int rr = it >> 2; attn_naive_item(P, (rr >> 4) * LB + (rr & 15), it & 3, qs, lane); }
        }
    __syncthreads();
    if (nwg == 256 && wg >= 192 && !(flags & 2)) { prep_items(P, lds, PREP_EARLY, PREP_NITEMS, (wg - 192) * 8 + wave, 64 * 8, lane, wave); prep_fold(P, (wg - 192) * 8 + wave, 64 * 8, lane); __syncthreads(); }
    if (flags & 1) return;
    unsigned* qhead = (unsigned*)(P.ws + WS_CTL) + CW_AQ; LAS int* qslot = (LAS int*)(lds + att::L2_TOTAL + 64);
    for (;;) {
        if (tid_ == 0) qslot[0] = (int)atomicAdd(qhead, 1u);
        __syncthreads();
        const int L = __builtin_amdgcn_readfirstlane(qslot[0]);
        __syncthreads();
        if (L >= 1024) break;
        int b, vh, qb;
        if (L < 512) { qb = 31 - (L >> 4); b = (L >> 2) & 3; vh = 4 + (L & 3); }
        else { const int j = L & 255; qb = 31 - (j >> 3); b = (j >> 1) & 3; vh = (L < 768 ? 2 : 0) + (j & 1); }
        att::attn_unit(P, lds, b, vh, qb); }
}
__device__ __forceinline__ void stage_combine(const Ptrs& P, int wg, int nwg) {
    const int tid_ = tid_opaque(P); const int lane = tid_ & 63, wave = __builtin_amdgcn_readfirstlane(tid_ >> 6); const bf16_t* Ob = (const bf16_t*)(P.ws + WS_OA); unsigned char* A28 = P.ws + WS_A2;
    const float lam = ((const float*)(P.ws + WS_MISC))[0]; const int h = lane >> 4, c = (lane & 15) * 8;
    float sw[8];
#pragma unroll
    for (int j = 0; j < 8; ++j) sw[j] = P.subln[c + j] * (1.f - LAMBDA_INIT);
    for (int rr0 = (wg * 8 + wave) * 4; rr0 < NB * SEQ; rr0 += nwg * 8 * 4) {
        u32x4 av[4], bv[4];
#pragma unroll
        for (int q = 0; q < 4; ++q) { const int rr = rr0 + q, row = (rr >> 13) * LB + NMETA + (rr & 8191);
            av[q] = *(const u32x4*)(Ob + (size_t)row * D + (2 * h) * 128 + c); bv[q] = *(const u32x4*)(Ob + (size_t)row * D + (2 * h + 1) * 128 + c); }
#pragma unroll
        for (int q = 0; q < 4; ++q) { const int rr = rr0 + q, row = (rr >> 13) * LB + NMETA + (rr & 8191); const u32x4 a = av[q], bb = bv[q];
            float v[8]; v[0] = bflo(a.x) - lam * bflo(bb.x); v[1] = bfhi(a.x) - lam * bfhi(bb.x); v[2] = bflo(a.y) - lam * bflo(bb.y); v[3] = bfhi(a.y) - lam * bfhi(bb.y);
            v[4] = bflo(a.z) - lam * bflo(bb.z); v[5] = bfhi(a.z) - lam * bfhi(bb.z); v[6] = bflo(a.w) - lam * bflo(bb.w); v[7] = bfhi(a.w) - lam * bfhi(bb.w);
            float ss = 0.f;
#pragma unroll
            for (int j = 0; j < 8; ++j) ss += v[j] * v[j];
            ss += __shfl_xor(ss, 1); ss += __shfl_xor(ss, 2); ss += __shfl_xor(ss, 4); ss += __shfl_xor(ss, 8);
            const float r = 1.f / sqrtf(ss * (1.f / 128.f) + RMS_EPS);
            const float rr_ = r * F8_ASCALE; u32x2 o; o.x = pk4_fp8(v[0] * rr_ * sw[0], v[1] * rr_ * sw[1], v[2] * rr_ * sw[2], v[3] * rr_ * sw[3]); o.y = pk4_fp8(v[4] * rr_ * sw[4], v[5] * rr_ * sw[5], v[6] * rr_ * sw[6], v[7] * rr_ * sw[7]);
            *(u32x2*)(A28 + (size_t)row * D + 512 + h * 128 + c) = o; } }
}

namespace gla {
 using att::s16x4; using att::vtr; using att::crow;
constexpr int LQD = 0, LKD = 16384, LKW = 32768, LP = 49152, LV = 58368, LOS = 91136, LEB = 124928, LHN = LEB + 1024, LGL = LHN + 1024, LEND = LGL + 4096;
static_assert(LEND <= 131072, "gla LDS");
constexpr int PST = 144, OST = 528;
constexpr size_t U_BYTES = (size_t)128 * 256 * 4;
__device__ __forceinline__ float* u_slot(const Ptrs& P, int bh, int seg) { return (float*)(P.ws + WS_OA + ((size_t)bh * 16 + seg) * U_BYTES); }
__device__ __forceinline__ float* a_slot(const Ptrs& P, int bh, int seg) { return (float*)(P.ws + WS_OA + (size_t)256 * U_BYTES) + ((size_t)bh * 16 + seg) * 128; }
__device__ __forceinline__ float* eb_slot(const Ptrs& P, int b, int cidx) { return (float*)(P.ws + WS_OA + (size_t)256 * U_BYTES + 262144) + ((size_t)b * 129 + cidx) * 512; }

constexpr int PRE_W2 = 0, PRE_TOT = 32768;
__device__ __forceinline__ void pre_chunk(const Ptrs& P, LAS unsigned char* lds, int tid, int r0, int nrows, float* eb, const float (&gb)[8]) {
    const int lane = tid & 63; const int w = __builtin_amdgcn_readfirstlane(tid >> 6);
    bf16_t* Z = (bf16_t*)(P.ws + WS_Z); const float* GLR = (const float*)(P.ws + WS_GLR); LAS float* gl = (LAS float*)(lds + LGL);
    const LAS f32x4* w2l = (const LAS f32x4*)(lds + PRE_W2); LAS f32x4* totl = (LAS f32x4*)(lds + PRE_TOT);
    const int nact = nrows >> 3; const bool act = w < nact;
    bf16_t* zr = Z + (size_t)(r0 + 8 * w) * ODD_N + 8 * lane;
#define PRE_BAR() asm volatile("s_waitcnt lgkmcnt(0)\n\ts_barrier" ::: "memory")
    u32x4 qv[8], kv[8];
    const f32x4 glr = ((const f32x4*)(GLR + (size_t)r0 * 16))[tid & 255];
    __builtin_amdgcn_sched_barrier(0);
#pragma unroll
    for (int t = 0; t < 8; ++t) { qv[t] = *(const u32x4*)(zr + (size_t)t * ODD_N); kv[t] = *(const u32x4*)(zr + (size_t)t * ODD_N + 512); }
    __builtin_amdgcn_sched_barrier(0);
    ((LAS f32x4*)gl)[tid & 255] = glr;
    PRE_BAR();
    float cum[8][8];
    if (act) {
        f32x2 c2[8][4];
#pragma unroll
        for (int t = 0; t < 8; ++t)
#pragma unroll
            for (int cp = 0; cp < 4; ++cp) c2[t][cp] = (f32x2){gb[2 * cp], gb[2 * cp + 1]};
#pragma unroll
        for (int j4 = 0; j4 < 4; ++j4) { f32x4 glv[8];
#pragma unroll
            for (int t = 0; t < 8; ++t) glv[t] = ((const LAS f32x4*)gl)[(8 * w + t) * 4 + j4];
#pragma unroll
            for (int jj = 0; jj < 4; ++jj) { const f32x4 wa = w2l[((4 * j4 + jj) * 2 + 0) * 64 + lane], wb = w2l[((4 * j4 + jj) * 2 + 1) * 64 + lane];
#pragma unroll
                for (int t = 0; t < 8; ++t) { const float sg = glv[t][jj]; const f32x2 s2 = (f32x2){sg, sg};
                    c2[t][0] = __builtin_elementwise_fma(s2, (f32x2){wa[0], wa[1]}, c2[t][0]); c2[t][1] = __builtin_elementwise_fma(s2, (f32x2){wa[2], wa[3]}, c2[t][1]);
                    c2[t][2] = __builtin_elementwise_fma(s2, (f32x2){wb[0], wb[1]}, c2[t][2]); c2[t][3] = __builtin_elementwise_fma(s2, (f32x2){wb[2], wb[3]}, c2[t][3]); } } }
#pragma unroll
        for (int t = 0; t < 8; ++t)
#pragma unroll
            for (int cp = 0; cp < 4; ++cp) { cum[t][2 * cp] = c2[t][cp].x; cum[t][2 * cp + 1] = c2[t][cp].y; }
#pragma unroll
        for (int ch = 0; ch < 8; ++ch) { float run = 0.f;
#pragma unroll
            for (int t = 0; t < 8; ++t) { const float g = cum[t][ch]; run += (fminf(g, 0.f) - 0.69314718f * __builtin_amdgcn_logf(1.f + __builtin_amdgcn_exp2f(fabsf(g) * -1.44269504f))) * (1.f / 16.f); cum[t][ch] = run; } }
        totl[(w * 2 + 0) * 64 + lane] = (f32x4){cum[7][0], cum[7][1], cum[7][2], cum[7][3]}; totl[(w * 2 + 1) * 64 + lane] = (f32x4){cum[7][4], cum[7][5], cum[7][6], cum[7][7]};
    }
    PRE_BAR();
    if (act) {
        float off[8];
#pragma unroll
        for (int ch = 0; ch < 8; ++ch) off[ch] = 0.f;
        for (int pw_ = 0; pw_ < w; ++pw_) { const f32x4 a = totl[(pw_ * 2 + 0) * 64 + lane], b = totl[(pw_ * 2 + 1) * 64 + lane];
            off[0] += a[0]; off[1] += a[1]; off[2] += a[2]; off[3] += a[3]; off[4] += b[0]; off[5] += b[1]; off[6] += b[2]; off[7] += b[3]; }
#pragma unroll
        for (int t = 0; t < 8; ++t) { float e[8], ie[8];
#pragma unroll
            for (int ch = 0; ch < 8; ++ch) { e[ch] = __builtin_amdgcn_exp2f((off[ch] + cum[t][ch]) * 1.44269504f); ie[ch] = __builtin_amdgcn_rcpf(e[ch]); }
            const u32x4 q = qv[t], k = kv[t]; u32x4 qo, ko;
            qo.x = cvt_pk_bf16(bflo(q.x) * e[0], bfhi(q.x) * e[1]); qo.y = cvt_pk_bf16(bflo(q.y) * e[2], bfhi(q.y) * e[3]); qo.z = cvt_pk_bf16(bflo(q.z) * e[4], bfhi(q.z) * e[5]); qo.w = cvt_pk_bf16(bflo(q.w) * e[6], bfhi(q.w) * e[7]);
            ko.x = cvt_pk_bf16(bflo(k.x) * ie[0], bfhi(k.x) * ie[1]); ko.y = cvt_pk_bf16(bflo(k.y) * ie[2], bfhi(k.y) * ie[3]); ko.z = cvt_pk_bf16(bflo(k.z) * ie[4], bfhi(k.z) * ie[5]); ko.w = cvt_pk_bf16(bflo(k.w) * ie[6], bfhi(k.w) * ie[7]);
            *(u32x4*)(zr + (size_t)t * ODD_N) = qo; *(u32x4*)(zr + (size_t)t * ODD_N + 512) = ko; }
        if (w == nact - 1) {
            *(f32x4*)(eb + 8 * lane) = (f32x4){__expf(off[0] + cum[7][0]), __expf(off[1] + cum[7][1]), __expf(off[2] + cum[7][2]), __expf(off[3] + cum[7][3])};
            *(f32x4*)(eb + 8 * lane + 4) = (f32x4){__expf(off[4] + cum[7][4]), __expf(off[5] + cum[7][5]), __expf(off[6] + cum[7][6]), __expf(off[7] + cum[7][7])}; }
    }
    PRE_BAR();
#undef PRE_BAR
}
__device__ __forceinline__ void stage_pre(const Ptrs& P, LAS unsigned char* lds, int wg, int nwg) {
    const int tid = tid_opaque(P); const int lane = tid & 63;
    for (int idx = tid; idx < 2048; idx += 512) { const int j = idx >> 7, hf = (idx >> 6) & 1, ln = idx & 63; ((LAS f32x4*)(lds + PRE_W2))[idx] = *(const f32x4*)(P.gate_w2 + j * 512 + 8 * ln + 4 * hf); }
    float gb[8];
    { const f32x4 a = *(const f32x4*)(P.gate_b + 8 * lane), b = *(const f32x4*)(P.gate_b + 8 * lane + 4); gb[0] = a[0]; gb[1] = a[1]; gb[2] = a[2]; gb[3] = a[3]; gb[4] = b[0]; gb[5] = b[1]; gb[6] = b[2]; gb[7] = b[3]; }
    __syncthreads();
    for (int it = wg; it < NB * 128; it += nwg) { const int b = it >> 7, j = it & 127, rowb = b * LB;
        if (j == 0) pre_chunk(P, lds, tid, rowb, NMETA, eb_slot(P, b, 0), gb);
        pre_chunk(P, lds, tid, rowb + NMETA + 64 * j, 64, eb_slot(P, b, j + 1), gb); }
}

__device__ __forceinline__ void segment_state(const Ptrs& P, LAS unsigned char* lds, int bh, int seg) {
    const int tid = tid_opaque(P), lane = tid & 63, r32 = lane & 31, hi = lane >> 5; const int wid = __builtin_amdgcn_readfirstlane(tid >> 6);
    const int b = bh >> 2, h = bh & 3, rowb = b * LB;
    const bf16_t* Z = (const bf16_t*)(P.ws + WS_Z);
    constexpr int BUF = 49152, BV = 0, BKW = 32768, BEB = 98304;
    const unsigned lds0 = (unsigned)(size_t)lds;
    f32x16 S[4];
#pragma unroll
    for (int cb = 0; cb < 4; ++cb) S[cb] = f32x16{};
    const int nch = 8 + (seg == 0 ? 1 : 0);
    const LAS unsigned char* trb = lds + ((lane >> 4) & 1) * 32 + (lane & 3) * 8 + (8 * hi + ((lane & 15) >> 2)) * 64;
#define GS_R0(ch) ((seg == 0 && (ch) == 0) ? rowb : rowb + NMETA + 64 * (seg * 8 + (ch) - (seg == 0 ? 1 : 0)))
#define GS_ISSUE(ch) do { const int r0_ = GS_R0(ch), bo_ = ((ch) & 1) * BUF; \
        _Pragma("unroll") for (int i_ = 0; i_ < 4; ++i_) { const int pc = wid * 4 + i_, db = pc >> 2, rg = pc & 3; \
            att::glds16(Z + (size_t)(r0_ + 16 * rg + (lane >> 2)) * ODD_N + 1024 + h * 256 + db * 32 + (lane & 3) * 8, (unsigned)__builtin_amdgcn_readfirstlane((int)(lds0 + bo_ + BV + pc * 1024))); } \
        _Pragma("unroll") for (int i_ = 0; i_ < 2; ++i_) { const int pc = wid * 2 + i_, cb = pc >> 2, rg = pc & 3; \
            att::glds16(Z + (size_t)(r0_ + 16 * rg + (lane >> 2)) * ODD_N + 512 + h * 128 + cb * 32 + (lane & 3) * 8, (unsigned)__builtin_amdgcn_readfirstlane((int)(lds0 + bo_ + BKW + pc * 1024))); } \
        if (wid == 0) { const int cidx_ = (seg == 0 && (ch) == 0) ? 0 : seg * 8 + (ch) - (seg == 0 ? 1 : 0) + 1; \
            att::glds16(eb_slot(P, b, cidx_) + h * 128 + lane * 4, (unsigned)__builtin_amdgcn_readfirstlane((int)(lds0 + BEB + ((ch) & 1) * 1024))); } } while (0)
    GS_ISSUE(0); GS_ISSUE(1);
    float aprod = 1.f;
    for (int ch = 0; ch < nch; ++ch) {
        const int bo = (ch & 1) * BUF; const bool metac = (seg == 0 && ch == 0);
        if (ch + 1 < nch) { if (wid == 0) asm volatile("s_waitcnt vmcnt(7) lgkmcnt(0)\n\ts_barrier" ::: "memory"); else asm volatile("s_waitcnt vmcnt(6) lgkmcnt(0)\n\ts_barrier" ::: "memory"); }
        else asm volatile("s_waitcnt vmcnt(0) lgkmcnt(0)\n\ts_barrier" ::: "memory");
        const LAS float* eB = (const LAS float*)(lds + BEB + (ch & 1) * 1024);
        if (tid < 128) aprod *= eB[tid];
        const int nks = metac ? 1 : 4;
        bf16x8 vf[4];
#pragma unroll
        for (int ks = 0; ks < 4; ++ks) { const s16x4 lo = vtr(trb + bo + BV + (wid * 4 + ks) * 1024), h4 = vtr(trb + bo + BV + (wid * 4 + ks) * 1024 + 256); vf[ks] = (bf16x8){lo[0], lo[1], lo[2], lo[3], h4[0], h4[1], h4[2], h4[3]}; }
#pragma unroll
        for (int cb = 0; cb < 4; ++cb) {
#pragma unroll
            for (int ks = 0; ks < 4; ++ks) if (ks < nks) { const s16x4 lo = vtr(trb + bo + BKW + (cb * 4 + ks) * 1024), h4 = vtr(trb + bo + BKW + (cb * 4 + ks) * 1024 + 256);
                const bf16x8 kf = (bf16x8){lo[0], lo[1], lo[2], lo[3], h4[0], h4[1], h4[2], h4[3]};
                S[cb] = __builtin_amdgcn_mfma_f32_32x32x16_bf16(kf, vf[ks], S[cb], 0, 0, 0); }
#pragma unroll
            for (int g = 0; g < 4; ++g) { const f32x4 e4 = *(const LAS f32x4*)(eB + 32 * cb + 8 * g + 4 * hi); S[cb][4 * g] *= e4.x; S[cb][4 * g + 1] *= e4.y; S[cb][4 * g + 2] *= e4.z; S[cb][4 * g + 3] *= e4.w; } }
        asm volatile("s_waitcnt lgkmcnt(0)\n\ts_barrier" ::: "memory");
        if (ch + 2 < nch) GS_ISSUE(ch + 2);
    }
#undef GS_ISSUE
#undef GS_R0
    float* u = u_slot(P, bh, seg);
#pragma unroll
    for (int cb = 0; cb < 4; ++cb)
#pragma unroll
        for (int r = 0; r < 16; ++r) u[(size_t)(32 * cb + crow(r, hi)) * 256 + 32 * wid + r32] = S[cb][r];
    if (tid < 128) a_slot(P, bh, seg)[tid] = aprod;
    asm volatile("s_waitcnt vmcnt(0) lgkmcnt(0)\n\ts_barrier" ::: "memory");
}
__device__ __forceinline__ void segment_out(const Ptrs& P, LAS unsigned char* lds, int bh, int seg) {
    const int tid = tid_opaque(P), lane = tid & 63, r32 = lane & 31, hi = lane >> 5; const int wid = __builtin_amdgcn_readfirstlane(tid >> 6);
    const int b = bh >> 2, h = bh & 3, rowb = b * LB;
    const bf16_t* Z = (const bf16_t*)(P.ws + WS_Z); unsigned char* A28 = P.ws + WS_A2;
    LAS float* eB = (LAS float*)(lds + LEB); LAS float* hnl = (LAS float*)(lds + LHN);
    if (tid < 256) hnl[tid] = P.head_norm[tid];
    f32x16 S[4];
    if (seg > 0) { const float* u = u_slot(P, bh, seg - 1);
#pragma unroll
        for (int cb = 0; cb < 4; ++cb)
#pragma unroll
            for (int r = 0; r < 16; ++r) S[cb][r] = u[(size_t)(32 * cb + crow(r, hi)) * 256 + 32 * wid + r32]; }
    else {
#pragma unroll
        for (int cb = 0; cb < 4; ++cb) S[cb] = f32x16{}; }
    const int nch = 8 + (seg == 0 ? 1 : 0);
    const unsigned lds0 = (unsigned)(size_t)lds;
    const LAS unsigned char* trb = lds + ((lane >> 4) & 1) * 32 + (lane & 3) * 8 + (8 * hi + ((lane & 15) >> 2)) * 64;
#define GO_META(ch) (seg == 0 && (ch) == 0)
#define GO_R0(ch) (GO_META(ch) ? rowb : rowb + NMETA + 64 * (seg * 8 + (ch) - (seg == 0 ? 1 : 0)))
#define GO_CIDX(ch) (GO_META(ch) ? 0 : seg * 8 + (ch) - (seg == 0 ? 1 : 0) + 1)
#define GO_ISSUE_A(ch) do { const int r0_ = GO_R0(ch); \
        _Pragma("unroll") for (int i_ = 0; i_ < 4; ++i_) { const int pc = wid * 4 + i_, db = pc >> 2, rg = pc & 3; \
            att::glds16(Z + (size_t)(r0_ + 16 * rg + (lane >> 2)) * ODD_N + 1024 + h * 256 + db * 32 + (lane & 3) * 8, (unsigned)__builtin_amdgcn_readfirstlane((int)(lds0 + LV + pc * 1024))); } \
        if (!GO_META(ch)) { _Pragma("unroll") for (int i_ = 0; i_ < 2; ++i_) { const int chk = wid * 2 + i_; \
            att::glds16(Z + (size_t)(r0_ + lane) * ODD_N + h * 128 + chk * 8, (unsigned)__builtin_amdgcn_readfirstlane((int)(lds0 + LQD + chk * 1024))); \
            att::glds16(Z + (size_t)(r0_ + lane) * ODD_N + 512 + h * 128 + chk * 8, (unsigned)__builtin_amdgcn_readfirstlane((int)(lds0 + LKD + chk * 1024))); } } } while (0)
#define GO_ISSUE_B(ch) do { const int r0_ = GO_R0(ch); \
        _Pragma("unroll") for (int i_ = 0; i_ < 2; ++i_) { const int pc = wid * 2 + i_, cb = pc >> 2, rg = pc & 3; \
            att::glds16(Z + (size_t)(r0_ + 16 * rg + (lane >> 2)) * ODD_N + 512 + h * 128 + cb * 32 + (lane & 3) * 8, (unsigned)__builtin_amdgcn_readfirstlane((int)(lds0 + LKW + pc * 1024))); } \
        if (wid == 0) att::glds16(eb_slot(P, b, GO_CIDX(ch)) + h * 128 + lane * 4, (unsigned)__builtin_amdgcn_readfirstlane((int)(lds0 + LEB))); } while (0)
    GO_ISSUE_A(0); GO_ISSUE_B(0);
    for (int ch = 0; ch < nch; ++ch) {
        const bool outc = !GO_META(ch); const int r0 = GO_R0(ch);
        asm volatile("s_waitcnt vmcnt(0) lgkmcnt(0)\n\ts_barrier" ::: "memory");
        u32x4 rgv[4];
        if (outc) { const u32x4* rgp = (const u32x4*)(Z + (size_t)(r0 + (tid >> 3)) * ODD_N + 2048 + h * 256 + (tid & 7) * 32);
#pragma unroll
            for (int q = 0; q < 4; ++q) rgv[q] = rgp[q]; }
        f32x16 o[2];
        if (outc) {
            if (wid < 4) { const int sb = wid & 1, tb = wid >> 1; f32x16 x = f32x16{};
                if (!(sb == 1 && tb == 0)) {
#pragma unroll
                    for (int ks = 0; ks < 8; ++ks) { const bf16x8 a = *(const LAS bf16x8*)(lds + LKD + (2 * ks + hi) * 1024 + (32 * sb + r32) * 16), bq = *(const LAS bf16x8*)(lds + LQD + (2 * ks + hi) * 1024 + (32 * tb + r32) * 16);
                        x = __builtin_amdgcn_mfma_f32_32x32x16_bf16(a, bq, x, 0, 0, 0); }
                    if (sb == tb) {
#pragma unroll
                        for (int r = 0; r < 16; ++r) if (crow(r, hi) > r32) x[r] = 0.f; }
                }
#pragma unroll
                for (int g = 0; g < 4; ++g) { u32x2 w; w.x = cvt_pk_bf16(x[4 * g], x[4 * g + 1]); w.y = cvt_pk_bf16(x[4 * g + 2], x[4 * g + 3]);
                    *(LAS u32x2*)(lds + LP + (32 * tb + r32) * PST + (32 * sb + 8 * g + 4 * hi) * 2) = w; } }
            o[0] = f32x16{}; o[1] = f32x16{};
#pragma unroll
            for (int cb = 0; cb < 4; ++cb)
#pragma unroll
                for (int s2 = 0; s2 < 2; ++s2) { u32x4 sw;
#pragma unroll
                    for (int j = 0; j < 4; ++j) sw[j] = cvt_pk_bf16(S[cb][8 * s2 + 2 * j], S[cb][8 * s2 + 2 * j + 1]);
                    const int kst = 2 * cb + s2;
#pragma unroll
                    for (int tb = 0; tb < 2; ++tb) { const LAS unsigned char* ap = lds + LQD + (2 * kst) * 1024 + (32 * tb + r32) * 16 + 8 * hi;
                        const u32x2 a0 = *(const LAS u32x2*)ap, a1 = *(const LAS u32x2*)(ap + 1024); const u32x4 a = (u32x4){a0.x, a0.y, a1.x, a1.y};
                        o[tb] = __builtin_amdgcn_mfma_f32_32x32x16_bf16(__builtin_bit_cast(bf16x8, a), __builtin_bit_cast(bf16x8, sw), o[tb], 0, 0, 0); } }
        }
        const int nks = outc ? 4 : 1;
        bf16x8 vf[4];
#pragma unroll
        for (int ks = 0; ks < 4; ++ks) { const s16x4 lo = vtr(trb + LV + (wid * 4 + ks) * 1024), h4 = vtr(trb + LV + (wid * 4 + ks) * 1024 + 256); vf[ks] = (bf16x8){lo[0], lo[1], lo[2], lo[3], h4[0], h4[1], h4[2], h4[3]}; }
        asm volatile("s_waitcnt lgkmcnt(0)\n\ts_barrier" ::: "memory");
        if (outc) asm volatile("" :: "v"(rgv[0]), "v"(rgv[1]), "v"(rgv[2]), "v"(rgv[3]));
        if (ch + 1 < nch) GO_ISSUE_A(ch + 1);
        if (outc) {
#pragma unroll
            for (int ks = 0; ks < 4; ++ks)
#pragma unroll
                for (int tb = 0; tb < 2; ++tb) { const bf16x8 a = *(const LAS bf16x8*)(lds + LP + (32 * tb + r32) * PST + (16 * ks + 8 * hi) * 2);
                    o[tb] = __builtin_amdgcn_mfma_f32_32x32x16_bf16(a, vf[ks], o[tb], 0, 0, 0); }
#pragma unroll
            for (int tb = 0; tb < 2; ++tb)
#pragma unroll
                for (int r = 0; r < 16; ++r) *(LAS bf16_t*)(lds + LOS + (32 * tb + crow(r, hi)) * OST + (32 * wid + r32) * 2) = (bf16_t)f2bf(o[tb][r]);
        }
#pragma unroll
        for (int cb = 0; cb < 4; ++cb) {
#pragma unroll
            for (int ks = 0; ks < 4; ++ks) if (ks < nks) { const s16x4 lo = vtr(trb + LKW + (cb * 4 + ks) * 1024), h4 = vtr(trb + LKW + (cb * 4 + ks) * 1024 + 256);
                const bf16x8 kf = (bf16x8){lo[0], lo[1], lo[2], lo[3], h4[0], h4[1], h4[2], h4[3]};
                S[cb] = __builtin_amdgcn_mfma_f32_32x32x16_bf16(kf, vf[ks], S[cb], 0, 0, 0); }
#pragma unroll
            for (int g = 0; g < 4; ++g) { const f32x4 e4 = *(const LAS f32x4*)(eB + 32 * cb + 8 * g + 4 * hi); S[cb][4 * g] *= e4.x; S[cb][4 * g + 1] *= e4.y; S[cb][4 * g + 2] *= e4.z; S[cb][4 * g + 3] *= e4.w; } }
        asm volatile("s_waitcnt lgkmcnt(0)\n\ts_barrier" ::: "memory");
        if (ch + 1 < nch) GO_ISSUE_B(ch + 1);
        if (outc) {
            const int t = tid >> 3, j8 = tid & 7; const size_t row = (size_t)(r0 + t);
            float ss = 0.f;
#pragma unroll
            for (int q = 0; q < 4; ++q) { const u32x4 a = *(const LAS u32x4*)(lds + LOS + t * OST + j8 * 64 + q * 16);
                const float v0 = bflo(a.x), v1 = bfhi(a.x), v2 = bflo(a.y), v3 = bfhi(a.y), v4 = bflo(a.z), v5 = bfhi(a.z), v6 = bflo(a.w), v7 = bfhi(a.w);
                ss += v0 * v0 + v1 * v1 + v2 * v2 + v3 * v3 + v4 * v4 + v5 * v5 + v6 * v6 + v7 * v7; }
            ss += __shfl_xor(ss, 1); ss += __shfl_xor(ss, 2); ss += __shfl_xor(ss, 4);
            const float rn = 1.f / sqrtf(ss * (1.f / 256.f) + RMS_EPS);
            u32x2* dst = (u32x2*)(A28 + row * D + h * 256 + j8 * 32);
#pragma unroll
            for (int q = 0; q < 4; ++q) { const u32x4 a = *(const LAS u32x4*)(lds + LOS + t * OST + j8 * 64 + q * 16);
                const float v[8] = {bflo(a.x), bfhi(a.x), bflo(a.y), bfhi(a.y), bflo(a.z), bfhi(a.z), bflo(a.w), bfhi(a.w)};
                const u32x4 g4 = rgv[q]; const float gv[8] = {bflo(g4.x), bfhi(g4.x), bflo(g4.y), bfhi(g4.y), bflo(g4.z), bfhi(g4.z), bflo(g4.w), bfhi(g4.w)}; float y[8];
#pragma unroll
                for (int e = 0; e < 8; ++e) y[e] = v[e] * (rn * F8_ASCALE) * hnl[j8 * 32 + 8 * q + e] * (gv[e] * __builtin_amdgcn_rcpf(1.f + __expf(-gv[e])));
                u32x2 w; w.x = pk4_fp8(y[0], y[1], y[2], y[3]); w.y = pk4_fp8(y[4], y[5], y[6], y[7]); dst[q] = w;
                __builtin_amdgcn_sched_barrier(0); }
        }
    }
    asm volatile("s_waitcnt vmcnt(0) lgkmcnt(0)\n\ts_barrier" ::: "memory");
#undef GO_META
#undef GO_R0
#undef GO_CIDX
#undef GO_ISSUE_A
#undef GO_ISSUE_B
}
template <bool OUT> __device__ __forceinline__ void segment(const Ptrs& P, LAS unsigned char* lds, int bh, int seg) {
    const int tid = tid_opaque(P), lane = tid & 63, r32 = lane & 31, hi = lane >> 5; const int wid = __builtin_amdgcn_readfirstlane(tid >> 6);
    const int b = bh >> 2, h = bh & 3, rowb = b * LB;
    const bf16_t* Z = (const bf16_t*)(P.ws + WS_Z); unsigned char* A28 = P.ws + WS_A2;
    LAS float* eB = (LAS float*)(lds + LEB); LAS float* hnl = (LAS float*)(lds + LHN);
    if (OUT && tid < 256) hnl[tid] = P.head_norm[tid];
    f32x16 S[4];
    if (OUT && seg > 0) { const float* u = u_slot(P, bh, seg - 1);
#pragma unroll
        for (int cb = 0; cb < 4; ++cb)
#pragma unroll
            for (int r = 0; r < 16; ++r) S[cb][r] = u[(size_t)(32 * cb + crow(r, hi)) * 256 + 32 * wid + r32]; }
    else {
#pragma unroll
        for (int cb = 0; cb < 4; ++cb) S[cb] = f32x16{}; }
    float aprod = 1.f;
    const int nch = 8 + (seg == 0 ? 1 : 0);
    const LAS unsigned char* trb = lds + ((lane >> 4) & 1) * 32 + (lane & 3) * 8 + (8 * hi + ((lane & 15) >> 2)) * 64;
    for (int ch = 0; ch < nch; ++ch) {
        const bool metac = (seg == 0 && ch == 0);
        const int cj = seg * 8 + ch - (seg == 0 ? 1 : 0);
        const int r0 = metac ? rowb : rowb + NMETA + 64 * cj;
        const float* ebg = eb_slot(P, b, metac ? 0 : cj + 1) + h * 128;
#pragma unroll
        for (int i_ = 0; i_ < 4; ++i_) { const int pc = wid * 4 + i_, db = pc >> 2, rg = pc & 3;
            __builtin_amdgcn_global_load_lds((const unsigned*)(Z + (size_t)(r0 + 16 * rg + (lane >> 2)) * ODD_N + 1024 + h * 256 + db * 32 + (lane & 3) * 8), (LAS unsigned*)(lds + LV + pc * 1024), 16, 0, 0); }
#pragma unroll
        for (int i_ = 0; i_ < 2; ++i_) { const int pc = wid * 2 + i_, cb = pc >> 2, rg = pc & 3;
            __builtin_amdgcn_global_load_lds((const unsigned*)(Z + (size_t)(r0 + 16 * rg + (lane >> 2)) * ODD_N + 512 + h * 128 + cb * 32 + (lane & 3) * 8), (LAS unsigned*)(lds + LKW + pc * 1024), 16, 0, 0); }
        const bool outc = OUT && !metac;
        u32x4 rgv[4];
        if (outc) { const u32x4* rgp = (const u32x4*)(Z + (size_t)(r0 + (tid >> 3)) * ODD_N + 2048 + h * 256 + (tid & 7) * 32);
#pragma unroll
            for (int q = 0; q < 4; ++q) rgv[q] = rgp[q]; }
        if (outc) {
#pragma unroll
            for (int i_ = 0; i_ < 2; ++i_) { const int chk = wid * 2 + i_;
                __builtin_amdgcn_global_load_lds((const unsigned*)(Z + (size_t)(r0 + lane) * ODD_N + h * 128 + chk * 8), (LAS unsigned*)(lds + LQD + chk * 1024), 16, 0, 0);
                __builtin_amdgcn_global_load_lds((const unsigned*)(Z + (size_t)(r0 + lane) * ODD_N + 512 + h * 128 + chk * 8), (LAS unsigned*)(lds + LKD + chk * 1024), 16, 0, 0); } }
        if (tid < 128) { const float e = ebg[tid]; eB[tid] = e; aprod *= e; }
        __syncthreads();
        f32x16 o[2];
        if (outc) {
            if (wid < 4) { const int sb = wid & 1, tb = wid >> 1; f32x16 x = f32x16{};
                if (!(sb == 1 && tb == 0)) {
#pragma unroll
                    for (int ks = 0; ks < 8; ++ks) { const bf16x8 a = *(const LAS bf16x8*)(lds + LKD + (2 * ks + hi) * 1024 + (32 * sb + r32) * 16), bq = *(const LAS bf16x8*)(lds + LQD + (2 * ks + hi) * 1024 + (32 * tb + r32) * 16);
                        x = __builtin_amdgcn_mfma_f32_32x32x16_bf16(a, bq, x, 0, 0, 0); }
                    if (sb == tb) {
#pragma unroll
                        for (int r = 0; r < 16; ++r) if (crow(r, hi) > r32) x[r] = 0.f; }
                }
#pragma unroll
                for (int g = 0; g < 4; ++g) { u32x2 w; w.x = cvt_pk_bf16(x[4 * g], x[4 * g + 1]); w.y = cvt_pk_bf16(x[4 * g + 2], x[4 * g + 3]);
                    *(LAS u32x2*)(lds + LP + (32 * tb + r32) * PST + (32 * sb + 8 * g + 4 * hi) * 2) = w; } }
            o[0] = f32x16{}; o[1] = f32x16{};
#pragma unroll
            for (int cb = 0; cb < 4; ++cb)
#pragma unroll
                for (int s2 = 0; s2 < 2; ++s2) { u32x4 sw;
#pragma unroll
                    for (int j = 0; j < 4; ++j) sw[j] = cvt_pk_bf16(S[cb][8 * s2 + 2 * j], S[cb][8 * s2 + 2 * j + 1]);
                    const int kst = 2 * cb + s2;
#pragma unroll
                    for (int tb = 0; tb < 2; ++tb) { const LAS unsigned char* ap = lds + LQD + (2 * kst) * 1024 + (32 * tb + r32) * 16 + 8 * hi;
                        const u32x2 a0 = *(const LAS u32x2*)ap, a1 = *(const LAS u32x2*)(ap + 1024); const u32x4 a = (u32x4){a0.x, a0.y, a1.x, a1.y};
                        o[tb] = __builtin_amdgcn_mfma_f32_32x32x16_bf16(__builtin_bit_cast(bf16x8, a), __builtin_bit_cast(bf16x8, sw), o[tb], 0, 0, 0); } }
            __syncthreads();
        }
        const int nks = metac ? 1 : 4;
        bf16x8 vf[4];
#pragma unroll
        for (int ks = 0; ks < 4; ++ks) { const s16x4 lo = vtr(trb + LV + (wid * 4 + ks) * 1024), h4 = vtr(trb + LV + (wid * 4 + ks) * 1024 + 256); vf[ks] = (bf16x8){lo[0], lo[1], lo[2], lo[3], h4[0], h4[1], h4[2], h4[3]}; }
        if (outc) {
#pragma unroll
            for (int ks = 0; ks < 4; ++ks)
#pragma unroll
                for (int tb = 0; tb < 2; ++tb) { const bf16x8 a = *(const LAS bf16x8*)(lds + LP + (32 * tb + r32) * PST + (16 * ks + 8 * hi) * 2);
                    o[tb] = __builtin_amdgcn_mfma_f32_32x32x16_bf16(a, vf[ks], o[tb], 0, 0, 0); }
#pragma unroll
            for (int tb = 0; tb < 2; ++tb)
#pragma unroll
                for (int r = 0; r < 16; ++r) *(LAS bf16_t*)(lds + LOS + (32 * tb + crow(r, hi)) * OST + (32 * wid + r32) * 2) = (bf16_t)f2bf(o[tb][r]);
        }
#pragma unroll
        for (int cb = 0; cb < 4; ++cb) {
#pragma unroll
            for (int ks = 0; ks < 4; ++ks) if (ks < nks) { const s16x4 lo = vtr(trb + LKW + (cb * 4 + ks) * 1024), h4 = vtr(trb + LKW + (cb * 4 + ks) * 1024 + 256);
                const bf16x8 kf = (bf16x8){lo[0], lo[1], lo[2], lo[3], h4[0], h4[1], h4[2], h4[3]};
                S[cb] = __builtin_amdgcn_mfma_f32_32x32x16_bf16(kf, vf[ks], S[cb], 0, 0, 0); }
#pragma unroll
            for (int g = 0; g < 4; ++g) { const f32x4 e4 = *(const LAS f32x4*)(eB + 32 * cb + 8 * g + 4 * hi); S[cb][4 * g] *= e4.x; S[cb][4 * g + 1] *= e4.y; S[cb][4 * g + 2] *= e4.z; S[cb][4 * g + 3] *= e4.w; } }
        __syncthreads();
        if (outc) {
            const int t = tid >> 3, j8 = tid & 7; const size_t row = (size_t)(r0 + t);
            float ss = 0.f;
#pragma unroll
            for (int q = 0; q < 4; ++q) { const u32x4 a = *(const LAS u32x4*)(lds + LOS + t * OST + j8 * 64 + q * 16);
                const float v0 = bflo(a.x), v1 = bfhi(a.x), v2 = bflo(a.y), v3 = bfhi(a.y), v4 = bflo(a.z), v5 = bfhi(a.z), v6 = bflo(a.w), v7 = bfhi(a.w);
                ss += v0 * v0 + v1 * v1 + v2 * v2 + v3 * v3 + v4 * v4 + v5 * v5 + v6 * v6 + v7 * v7; }
            ss += __shfl_xor(ss, 1); ss += __shfl_xor(ss, 2); ss += __shfl_xor(ss, 4);
            const float rn = 1.f / sqrtf(ss * (1.f / 256.f) + RMS_EPS);
            u32x2* dst = (u32x2*)(A28 + row * D + h * 256 + j8 * 32);
#pragma unroll
            for (int q = 0; q < 4; ++q) { const u32x4 a = *(const LAS u32x4*)(lds + LOS + t * OST + j8 * 64 + q * 16);
                const float v[8] = {bflo(a.x), bfhi(a.x), bflo(a.y), bfhi(a.y), bflo(a.z), bfhi(a.z), bflo(a.w), bfhi(a.w)};
                const u32x4 g4 = rgv[q]; const float gv[8] = {bflo(g4.x), bfhi(g4.x), bflo(g4.y), bfhi(g4.y), bflo(g4.z), bfhi(g4.z), bflo(g4.w), bfhi(g4.w)}; float y[8];
#pragma unroll
                for (int e = 0; e < 8; ++e) y[e] = v[e] * (rn * F8_ASCALE) * hnl[j8 * 32 + 8 * q + e] * (gv[e] * __builtin_amdgcn_rcpf(1.f + __expf(-gv[e])));
                u32x2 w; w.x = pk4_fp8(y[0], y[1], y[2], y[3]); w.y = pk4_fp8(y[4], y[5], y[6], y[7]); dst[q] = w;
                __builtin_amdgcn_sched_barrier(0); }
        }
    }
    if (!OUT) { float* u = u_slot(P, bh, seg);
#pragma unroll
        for (int cb = 0; cb < 4; ++cb)
#pragma unroll
            for (int r = 0; r < 16; ++r) u[(size_t)(32 * cb + crow(r, hi)) * 256 + 32 * wid + r32] = S[cb][r];
        if (tid < 128) a_slot(P, bh, seg)[tid] = aprod; }
    __syncthreads();
}
}
template <bool OUT> __device__ __forceinline__ void stage_gla_seg(const Ptrs& P, LAS unsigned char* lds, int wg, int nwg) {
    for (int u = wg; u < 256; u += nwg) { if constexpr (OUT) gla::segment_out(P, lds, u >> 4, u & 15); else gla::segment_state(P, lds, u >> 4, u & 15); }
}
__device__ __forceinline__ void stage_gla_scan(const Ptrs& P, int wg, int nwg) {
    const int tid_ = tid_opaque(P);
    for (int idx = wg * 512 + tid_; idx < 16 * 32768; idx += nwg * 512) { const int bh = idx >> 15, e = idx & 32767, cch = e >> 8;
        float uv[15], av[15];
#pragma unroll
        for (int sg = 0; sg < 15; ++sg) { uv[sg] = gla::u_slot(P, bh, sg)[e]; av[sg] = gla::a_slot(P, bh, sg)[cch]; }
        float Sv = 0.f;
#pragma unroll
        for (int sg = 0; sg < 15; ++sg) { Sv = av[sg] * Sv + uv[sg]; gla::u_slot(P, bh, sg)[e] = Sv; } }
}

#define XB_TMO      128
#define XB_XCNT(j)  (256  + 64 * (j))
#define XB_XSUB(j)  (1280 + 64 * (j))
#define XB_XGEN(j)  (2304 + 64 * (j))
#define XB_TOP      3328
#define XB_TOPGEN   3392
#define XCD_BAR_WORDS 3456
#define XB_SPIN_CAP (1u << 18)
__device__ __forceinline__ unsigned xb_ld(unsigned* p)              { return __hip_atomic_load(p, __ATOMIC_RELAXED, __HIP_MEMORY_SCOPE_AGENT); }
__device__ __forceinline__ unsigned xb_add(unsigned* p, unsigned v) { return __hip_atomic_fetch_add(p, v, __ATOMIC_RELAXED, __HIP_MEMORY_SCOPE_AGENT); }
__device__ __forceinline__ unsigned xb_xcc_id() { return (unsigned)__builtin_amdgcn_s_getreg((3 << 11) | 20) & 0xFu; }
#define XB_SPIN(cond, bar) do { unsigned _sp = 0; while (cond) { __builtin_amdgcn_s_sleep(1); \
    if ((++_sp & 255u) == 0u) { if (xb_ld(&(bar)[XB_TMO])) break; if (_sp > XB_SPIN_CAP) { atomicAdd(&(bar)[XB_TMO], 1u); break; } } } } while (0)
struct XcdBarrier { unsigned* bar; unsigned x; volatile LAS unsigned* st; };
__device__ __forceinline__ XcdBarrier xcd_barrier_post(unsigned* bar, volatile LAS unsigned* st, const bool t0) {
    XcdBarrier b; b.bar = bar; b.x = xb_xcc_id(); b.st = st;
    if (t0) (void)xb_add(&bar[XB_XCNT(b.x)], 1u);
    return b;
}
__device__ __forceinline__ void xcd_barrier_complete(unsigned* bar, unsigned x, unsigned& nloc, unsigned& nx) {
    const unsigned G = gridDim.x * gridDim.y * gridDim.z;
    unsigned sum, cnt, mine, sp = 0u;
    for (;;) {
        sum = 0u; cnt = 0u; mine = 0u;
#pragma unroll
        for (unsigned j = 0; j < 16; ++j) { const unsigned c = xb_ld(&bar[XB_XCNT(j)]); sum += c; cnt += (c > 0u) ? 1u : 0u; mine = (j == x) ? c : mine; }
        if (sum == G) break;
        __builtin_amdgcn_s_sleep(1);
        if ((++sp & 255u) == 0u) { if (xb_ld(&bar[XB_TMO])) break; if (sp > XB_SPIN_CAP) { atomicAdd(&bar[XB_TMO], 1u); break; } }
    }
    nloc = mine > 0u ? mine : 1u; nx = cnt > 0u ? cnt : 1u;
}
__device__ __forceinline__ void xcd_barrier(const XcdBarrier& b, const bool t0) {
    asm volatile("s_waitcnt vmcnt(0)" ::: "memory");
    __syncthreads();
    if (t0) {
        unsigned* bar = b.bar;
        __builtin_amdgcn_s_waitcnt(0);
        unsigned nloc = b.st[0], nx = b.st[1];
        if (nloc == 0u) { xcd_barrier_complete(bar, b.x, nloc, nx); b.st[0] = nloc; b.st[1] = nx; }
        const unsigned old = xb_add(&bar[XB_XSUB(b.x)], 1u);
        const unsigned gen = old / nloc;
        if (old + 1u == (gen + 1u) * nloc) {
            __builtin_amdgcn_fence(__ATOMIC_RELEASE, "agent");
            asm volatile("s_waitcnt vmcnt(0)" ::: "memory");
            const unsigned og = xb_add(&bar[XB_TOP], 1u);
            const unsigned tg = og / nx;
            if (og + 1u == (tg + 1u) * nx) xb_add(&bar[XB_TOPGEN], 1u);
            else XB_SPIN(xb_ld(&bar[XB_TOPGEN]) == tg, bar);
            __builtin_amdgcn_fence(__ATOMIC_ACQUIRE, "agent");
            xb_add(&bar[XB_XGEN(b.x)], 1u);
            asm volatile("s_waitcnt vmcnt(0)" ::: "memory");
        } else {
            XB_SPIN(xb_ld(&bar[XB_XGEN(b.x)]) == gen, bar);
            __builtin_amdgcn_fence(__ATOMIC_ACQUIRE, "agent");
            asm volatile("s_waitcnt vmcnt(0)" ::: "memory");
        }
    }
    __syncthreads();
}

constexpr int LDS_BYTES = 147456;
constexpr int LDS_CTL = 131072;
constexpr int CW_BAR = 4096;
enum GemmKind { G_IN0 = 0, G_OUT0, G_GU0, G_DN0, G_IN1, G_OUT1, G_GU1, G_DN1 };
__device__ __forceinline__ void moe_setup(const Ptrs& P, int layer, LAS int* tstart, LAS int* cnt, const int tid) {
    if (tid < 64) { const unsigned* g = (const unsigned*)(P.ws + WS_CTL) + CW_CNT + 64 * layer;
        const int c = tid < 16 ? (int)__hip_atomic_load(g + tid, __ATOMIC_RELAXED, __HIP_MEMORY_SCOPE_AGENT) : 0; const int tiles = (c + 255) >> 8; int incl = tiles;
#pragma unroll
        for (int d = 1; d < 16; d <<= 1) { const int o = __shfl_up(incl, d); if (tid >= d) incl += o; }
        if (tid < 16) { cnt[tid] = c; tstart[tid] = incl - tiles; }
        if (tid == 15) tstart[16] = incl; }
    __syncthreads();
}
template <int KIND> __device__ __forceinline__ void stage_gemm(const Ptrs& P, LAS unsigned char* lds, int wg, int nwg) {
    const int tid = tid_opaque(P);
    LAS unsigned char* ring = lds; LAS int* tstart = (LAS int*)(lds + LDS_CTL + 256); LAS int* cnt = (LAS int*)(lds + LDS_CTL + 384);
    const bf16_t* Hb = (const bf16_t*)(P.ws + WS_HB); bf16_t* Z = (bf16_t*)(P.ws + WS_Z); const unsigned char* A28 = P.ws + WS_A2; const bf16_t* A2m = (const bf16_t*)(P.ws + WS_A2M); bf16_t* T = (bf16_t*)(P.ws + WS_T);
    unsigned char* ACT = P.ws + WS_ACT; unsigned char* YK = P.ws + WS_YK;
    if constexpr (KIND == G_IN0) { meta_gemm<0>(Hb, Hb, (const bf16_t*)(P.ws + W_IN0), EVEN_IN, Z, EVEN_IN, 512, 1024, QSCALE0, wg, nwg, tid, (unsigned*)(P.ws + WS_CTL) + CW_KN + 64);
        DenseSched S; S.init(EVEN_IN / 256, nwg, wg); EpiBf16 E{Z, EVEN_IN, EVEN_IN, 2, 4, QSCALE0, (unsigned*)(P.ws + WS_CTL) + CW_KN, 4};
        pg8::gemm_phase(ring, Hb, P.ws + W_IN0, 2048, 2048, S, E, tid); }
    else if constexpr (KIND == G_OUT0) { meta_gemm<1>(A2m, Hb, (const bf16_t*)(P.ws + W_OUT0), 1024, T, D, 0, 0, 1.f, wg, nwg, tid);
        DenseSched S; S.init(4, nwg, wg, 1024); EpiResBf16 E{Hb, T};
        pg8::gemm_phase<EpiResBf16, DenseSched, true>(ring, A28, P.ws + W_OUT08, 1024, 1024, S, E, tid, F8_ASC, F8_WSC); }
    else if constexpr (KIND == G_IN1) { meta_gemm<0>(Hb, Hb, (const bf16_t*)(P.ws + W_IN1), ODD_N, Z, ODD_N, 0, 512, QSCALE1, wg, nwg, tid);
        DenseSched S; S.init(ODD_N / 256, nwg, wg, 1024); EpiBf16 E{Z, ODD_N, ODD_N, 0, 2, QSCALE1, nullptr, 0};
        pg8::gemm_phase<EpiBf16, DenseSched, true>(ring, P.ws + WS_HB8, P.ws + W_IN18, 1024, 1024, S, E, tid, F8_HSC, F8_WSC); }
    else if constexpr (KIND == G_OUT1) { DenseSched S; S.init(4, nwg, wg, 1024); EpiResBf16 E{Hb, T};
        pg8::gemm_phase<EpiResBf16, DenseSched, true>(ring, A28, P.ws + W_OUT18, 1024, 1024, S, E, tid, F8_ASC, F8_WSC); }
    else if constexpr (KIND == G_GU0 || KIND == G_GU1) { constexpr int layer = KIND == G_GU0 ? 0 : 1; moe_setup(P, layer, tstart, cnt, tid);
        MoeSchedT<true> S{tstart, cnt, (const int*)(P.ws + WS_LIST), (const float*)(P.ws + WS_LISTW), 4, nwg, wg, 1024, (size_t)layer * 16 * 1024 * 1024, (const LAS int*)(lds + LDS_CTL + 1024)}; EpiSiluMul E{ACT};
        pg8::gemm_phase<EpiSiluMul, MoeSchedT<true>, true, true>(ring, P.ws + WS_HB8, P.ws + W_GU, 1024, 1024, S, E, tid, F8_HSC, F8_WSC); }
    else { constexpr int layer = KIND == G_DN0 ? 0 : 1; moe_setup(P, layer, tstart, cnt, tid);
        MoeSchedT<false> S{tstart, cnt, (const int*)(P.ws + WS_LIST), (const float*)(P.ws + WS_LISTW), 4, nwg, wg, 512, (size_t)layer * 16 * 1024 * 512, nullptr}; EpiScatter E{YK, (LAS int*)(lds + LDS_CTL + 1024), (LAS float*)(lds + LDS_CTL + 3072)};
        pg8::gemm_phase<EpiScatter, MoeSchedT<false>, true, true>(ring, ACT, P.ws + W_DN, 512, 512, S, E, tid, F8_ASC, F8_WSC); }
}

constexpr int NPHASE = 19;
struct Args { Ptrs P; int lo, hi, flags, pad; };
__global__ void __launch_bounds__(512, 2) mega(Args a) {
    extern __shared__ __attribute__((aligned(16))) unsigned char lds_[];
    LAS unsigned char* lds = (LAS unsigned char*)lds_;
    const Ptrs& P = a.P;
    const int wg = blockIdx.x, nwg = gridDim.x, lo = a.lo, hi = a.hi;
    for (int u = threadIdx.x; u < (LDS_BYTES - LDS_CTL) / 4; u += 512) ((LAS unsigned*)(lds + LDS_CTL))[u] = 0u;
    __syncthreads();
    if ((threadIdx.x & 63) == 0) ((volatile LAS int*)(lds + LDS_WIDTAB))[hw_wave_key()] = (int)(threadIdx.x >> 6);
    __syncthreads();
    XcdBarrier bar; bar.bar = (unsigned*)(P.ws + WS_CTL) + CW_BAR; bar.x = 0; bar.st = nullptr;
    const bool multi = (hi - lo) > 1;
    if (multi) bar = xcd_barrier_post((unsigned*)(P.ws + WS_CTL) + CW_BAR, (volatile LAS unsigned*)(lds + LDS_CTL) + 8, tid_opaque(P) == 0);
#define IN(k) (lo <= (k) && (k) < hi)
#define SEAM(k) do { if (IN(k) && IN((k) + 1)) xcd_barrier(bar, tid_opaque(P) == 0); } while (0)
#define RUN(k, ...) do { if (IN(k)) { __VA_ARGS__; } SEAM(k); } while (0)
    RUN(0, stage_prep(P, lds, wg, nwg));
    RUN(1, stage_gemm<G_IN0>(P, lds, wg, nwg));
    RUN(2, if (!(a.flags & 2)) stage_pool(P, wg, nwg); stage_attn(P, lds, wg, nwg, a.flags));
    RUN(3, stage_combine(P, wg, nwg));
    RUN(4, stage_gemm<G_OUT0>(P, lds, wg, nwg));
    RUN(5, stage_ln<0>(P, lds, wg, nwg));
    RUN(6, stage_gemm<G_GU0>(P, lds, wg, nwg));
    RUN(7, stage_gemm<G_DN0>(P, lds, wg, nwg));
    RUN(8, stage_ln<2>(P, lds, wg, nwg));
    RUN(9, stage_gemm<G_IN1>(P, lds, wg, nwg));
    RUN(10, gla::stage_pre(P, lds, wg, nwg));
    RUN(11, stage_gla_seg<false>(P, lds, wg, nwg));
    RUN(12, stage_gla_scan(P, wg, nwg));
    RUN(13, stage_gla_seg<true>(P, lds, wg, nwg));
    RUN(14, stage_gemm<G_OUT1>(P, lds, wg, nwg));
    RUN(15, stage_ln<1>(P, lds, wg, nwg));
    RUN(16, stage_gemm<G_GU1>(P, lds, wg, nwg));
    RUN(17, stage_gemm<G_DN1>(P, lds, wg, nwg));
    RUN(18, stage_ln<3>(P, lds, wg, nwg));
#undef RUN
#undef IN
#undef SEAM
}

#ifndef MK_MULTI
#define MK_MULTI 0
#endif
extern "C" void kernel_launch(void* const* d_in, const int* in_sizes, int n_in, void* d_out, int out_size, void* d_ws, size_t ws_size, hipStream_t stream) {
    static int grid = 0;
    if (grid == 0) {
        if (n_in != 25 || ws_size < WS_END || out_size != NB * SEQ * D) { fprintf(stderr, "kernel_launch: bad args n_in %d ws %zu (need %zu) out %d\n", n_in, ws_size, (size_t)WS_END, out_size); grid = -1; return; }
        int dev = 0, cus = 0, per_cu = 0;
        if (hipGetDevice(&dev) != hipSuccess || hipDeviceGetAttribute(&cus, hipDeviceAttributeMultiprocessorCount, dev) != hipSuccess) { grid = -1; return; }
        if (hipFuncSetAttribute((const void*)mega, hipFuncAttributeMaxDynamicSharedMemorySize, LDS_BYTES) != hipSuccess) { fprintf(stderr, "kernel_launch: hipFuncSetAttribute failed\n"); grid = -1; return; }
        if (hipOccupancyMaxActiveBlocksPerMultiprocessor(&per_cu, (const void*)mega, 512, LDS_BYTES) != hipSuccess || per_cu < 1) { fprintf(stderr, "kernel_launch: occupancy query says %d blocks/CU\n", per_cu); (void)hipGetLastError(); grid = -1; return; }
        grid = cus;
    }
    if (grid < 0) return;
    (void)hipMemsetAsync((char*)d_ws + WS_CTL, 0, CTL_BYTES, stream);
    Args a{};
    const float** pp = (const float**)&a.P;
    for (int i = 0; i < 25; ++i) pp[i] = (const float*)d_in[i];
    a.P.out = (float*)d_out; a.P.ws = (unsigned char*)d_ws;
#if MK_MULTI
    for (int k = 0; k < NPHASE; ++k) { a.lo = k; a.hi = k + 1; for (int r = 0; r < 1 + (int)((PROBE_DUP >> k) & 1u); ++r) { a.flags = r ? PROBE_FLAGS : 0; hipLaunchKernelGGL(mega, dim3(grid), dim3(512), LDS_BYTES, stream, a); } }
#else
    a.lo = 0; a.hi = NPHASE; hipLaunchKernelGGL(mega, dim3(grid), dim3(512), LDS_BYTES, stream, a);
#endif
}
```

```cpp
#include <hip/hip_runtime.h>
#include <cstdio>
#include <cstdint>

#ifndef PROBE_FLAGS
#define PROBE_FLAGS 0
#endif
#ifndef PROBE_DUP
#define PROBE_DUP 0u
#endif
#define GAS __attribute__((address_space(1)))
#define LAS __attribute__((address_space(3)))
typedef unsigned short bf16_t;
typedef short bf16x8 __attribute__((ext_vector_type(8)));
typedef float f32x4 __attribute__((ext_vector_type(4)));
typedef float f32x2 __attribute__((ext_vector_type(2)));
typedef float f32x16 __attribute__((ext_vector_type(16)));
typedef unsigned u32x4 __attribute__((ext_vector_type(4)));
typedef unsigned u32x2 __attribute__((ext_vector_type(2)));

constexpr int D = 1024, NB = 4, SEQ = 8192, NMETA = 16;
constexpr int LB = SEQ + NMETA;
constexpr int M1 = NB * LB;
constexpr int NPANEL = NB * SEQ / 256;
constexpr int EVEN_IN = 2048, ODD_IN = 3088, ODD_N = 3072;
constexpr int NEXP = 16, DEXP = 512;
constexpr float ALPHA = 1.41421356237f;
constexpr float LN_EPS = 1e-5f, RMS_EPS = 1e-6f;
constexpr float LOG2E = 1.4426950408889634f;
constexpr float QSCALE0 = 0.125f * LOG2E;
constexpr float QSCALE1 = 0.08838834764831845f;
constexpr float LAMBDA_INIT = 0.2f;

constexpr size_t MiB = 1u << 20;
constexpr size_t WS_CTL = 0;
constexpr size_t CTL_BYTES = 1 * MiB;
constexpr size_t WS_MISC = 1 * MiB;
constexpr size_t WS_RW = 2 * MiB;
constexpr size_t WS_LIST = 3 * MiB;
constexpr size_t WS_GLR = 5 * MiB + 262144;
constexpr size_t WS_W = 8 * MiB;
constexpr size_t W_IN0 = WS_W;
constexpr size_t W_OUT0 = W_IN0 + (size_t)2048 * 1024 * 2;
constexpr size_t W_IN1 = W_OUT0 + (size_t)1024 * 1024 * 2;
constexpr size_t W_IN18 = W_IN1 + (size_t)ODD_N * 1024 * 2;
constexpr size_t W_OUT1 = W_IN18 + (size_t)ODD_N * 1024;
constexpr size_t W_OUT08 = W_OUT1 + (size_t)1024 * 1024 * 2;
constexpr size_t W_OUT18 = W_OUT08 + (size_t)1024 * 1024;
constexpr size_t W_GU = W_OUT18 + (size_t)1024 * 1024;
constexpr size_t W_DN = W_GU + (size_t)2 * 16 * 1024 * 1024;
constexpr size_t W_END = W_DN + (size_t)2 * 16 * 1024 * 512;
constexpr size_t WS_HB = 76 * MiB;
constexpr size_t WS_HB8 = WS_HB + (size_t)M1 * 1024 * 2;
constexpr size_t WS_Z = WS_HB8 + (size_t)M1 * 1024 + 524288;
constexpr size_t WS_T = WS_Z;
constexpr size_t WS_YK = WS_Z;
constexpr size_t WS_OA = WS_Z + (size_t)M1 * ODD_N * 2;
constexpr size_t WS_A2 = WS_OA + (size_t)M1 * 1024 * 2;
constexpr size_t WS_A2M = WS_MISC + 65536;
constexpr size_t WS_ACT = WS_OA;
constexpr size_t WS_LISTW = WS_A2 + (size_t)M1 * 1024;
constexpr size_t WS_END = WS_LISTW + (size_t)16 * M1 * 4;
static_assert(W_END <= WS_HB, "weights fit");
static_assert(WS_END <= (size_t)512 * MiB, "workspace fits 512 MiB");
static_assert(WS_LIST + (size_t)16 * M1 * 4 <= WS_GLR && WS_GLR + (size_t)M1 * 64 <= WS_W, "small buffers");
constexpr float F8_YSCALE = 32.f;
constexpr float F8_WSCALE = 32.f, F8_HSCALE = 4.f, F8_ASCALE = 4.f;
constexpr int F8_WSC = 0x7a7a7a7a, F8_HSC = 0x7d7d7d7d, F8_ASC = 0x7d7d7d7d;
constexpr int CW_CNT = 64;
constexpr int LISTCAP = M1;
constexpr int CW_KN = 256;
constexpr int CW_AQ = 512;

__device__ __forceinline__ float bf2f(unsigned short b) { return __builtin_bit_cast(float, (unsigned)b << 16); }
__device__ __forceinline__ float bflo(unsigned w) { return __builtin_bit_cast(float, w << 16); }
__device__ __forceinline__ float bfhi(unsigned w) { return __builtin_bit_cast(float, w & 0xffff0000u); }
typedef __bf16 bf16x2_t __attribute__((ext_vector_type(2)));
__device__ __forceinline__ unsigned cvt_pk_bf16(float lo, float hi) { const f32x2 v = {lo, hi}; const bf16x2_t b = __builtin_convertvector(v, bf16x2_t); return __builtin_bit_cast(unsigned, b); }
__device__ __forceinline__ unsigned pk2(float lo, float hi) { return cvt_pk_bf16(lo, hi); }
__device__ __forceinline__ unsigned f2bf(float f) { return cvt_pk_bf16(f, 0.f) & 0xffffu; }
__device__ __forceinline__ unsigned pk4_fp8(float a, float b, float c, float d) {
    a = fminf(fmaxf(a, -448.f), 448.f); b = fminf(fmaxf(b, -448.f), 448.f); c = fminf(fmaxf(c, -448.f), 448.f); d = fminf(fmaxf(d, -448.f), 448.f);
    int w = 0; w = __builtin_amdgcn_cvt_pk_fp8_f32(a, b, w, false); w = __builtin_amdgcn_cvt_pk_fp8_f32(c, d, w, true); return (unsigned)w; }
__device__ __forceinline__ void fp8x4_to_f32(unsigned w, float (&o)[4]) { const f32x2 a = __builtin_amdgcn_cvt_pk_f32_fp8((int)w, false), b = __builtin_amdgcn_cvt_pk_f32_fp8((int)w, true); o[0] = a.x; o[1] = a.y; o[2] = b.x; o[3] = b.y; }
__device__ __forceinline__ void lds_dma16(const void* gsrc, unsigned lds_dst) { unsigned keep;
    asm volatile("s_mov_b32 %0, m0\n\ts_mov_b32 m0, %2\n\ts_nop 0\n\tglobal_load_lds_dwordx4 %1, off\n\ts_mov_b32 m0, %0" : "=&s"(keep) : "v"(gsrc), "s"(lds_dst) : "memory"); }
__device__ __forceinline__ float wave_sum(float v) {
#pragma unroll
    for (int o = 1; o < 64; o <<= 1) v += __shfl_xor(v, o);
    return v;
}
__device__ __forceinline__ float wave_max(float v) {
#pragma unroll
    for (int o = 1; o < 64; o <<= 1) v = fmaxf(v, __shfl_xor(v, o));
    return v;
}
struct Ptrs {
    const float *x, *meta, *even_w_in, *pool_w, *pool_scale, *lq1, *lk1, *lq2, *lk2, *subln, *even_w_out, *odd_w_in, *gate_w2, *gate_b, *head_norm, *odd_w_out,
        *ln_mix_g, *ln_mix_b, *ln_ffn_g, *ln_ffn_b, *router_w, *router_bias, *moe_w_gate, *moe_w_up, *moe_w_down;
    float* out; unsigned char* ws;
};
constexpr int LDS_WIDTAB = 131072 + 512;
extern __shared__ __attribute__((aligned(16))) unsigned char lds_dyn_alias_[];
__device__ __forceinline__ unsigned hw_wave_key() { return (unsigned)__builtin_amdgcn_s_getreg((5 << 11) | 4) & 0x3fu; }
__device__ __forceinline__ int tid_opaque(const Ptrs&) {
    unsigned z = 0u; asm volatile("" : "+v"(z));
    const int lane = (int)__builtin_amdgcn_mbcnt_hi(~0u, __builtin_amdgcn_mbcnt_lo(~0u, z));
    const int wid = __builtin_amdgcn_readfirstlane(((const volatile LAS int*)((LAS unsigned char*)lds_dyn_alias_ + LDS_WIDTAB))[hw_wave_key()]);
    return wid * 64 + lane;
}
__device__ __forceinline__ int panel_row0(int pm) { return (pm >> 5) * LB + NMETA + (pm & 31) * 256; }
__device__ __forceinline__ const float* h0_ptr(const Ptrs& P, int row) { const int b = row / LB, p = row - b * LB; return p < NMETA ? P.meta + (size_t)p * D : P.x + ((size_t)b * SEQ + (p - NMETA)) * D; }

namespace pg8 {
constexpr int BM = 256, BK = 64, HALF = 128, HTB = HALF * BK * 2, STAGE_BYTES = 8 * HTB, NXCD = 8, WGM = 8;
__host__ __device__ __forceinline__ int lds_byte(int r, int c) { const int st = (r >> 4) * 2 + (c >> 5), rr = r & 15, cc = c & 31, ob = rr * 64 + cc * 2; return st * 1024 + (ob ^ (((ob >> 9) & 1) << 5)); }
__host__ __device__ __forceinline__ void stage_rc(int b, int& R, int& C) { const int st = b / 1024, sb = b % 1024, swz = sb ^ (((sb >> 9) & 1) << 5); R = (st >> 1) * 16 + swz / 64; C = (st & 1) * 32 + (swz % 64) / 2; }
__host__ __device__ __forceinline__ int perm32(int rho) { const int n = rho >> 4, i = rho & 15; return 8 * (i >> 2) + 4 * n + (i & 3); }
struct Unit { int pm, pn, e, lt, hn, par; };

__device__ __forceinline__ void static_tile(int L, int nM, int nN, int& pm, int& pn) {
    const int nwg = nM * nN; int wgid = L;
    { const int q = nwg / NXCD, r = nwg % NXCD, xcd = wgid % NXCD, off = wgid / NXCD; wgid = (xcd < r ? xcd * (q + 1) : r * (q + 1) + (xcd - r) * q) + off; }
    const int nig = WGM * nN, gid = wgid / nig, fm = gid * WGM, gsz = (nM - fm) < WGM ? (nM - fm) : WGM;
    pm = fm + ((wgid % nig) % gsz); pn = (wgid % nig) / gsz;
}

typedef int v8i32 __attribute__((ext_vector_type(8)));
template <class Epi, class Sched, bool F8 = false, bool HN = false>
__device__ __forceinline__ void gemm_phase(LAS unsigned char* lds, const void* Abase, const void* Bbase, const int KA, const int KB_, const Sched& S, const Epi& E, const int tid, const int sclA = 0x7f7f7f7f, const int sclB = 0x7f7f7f7f) {
    const int wid = __builtin_amdgcn_readfirstlane(tid >> 6), lane = tid & 63, wr = wid >> 2, wc = wid & 3, fr = lane & 15, fq = lane >> 4;
    const int nt = KA / 128;
    unsigned voffB[2];
#pragma unroll
    for (int i = 0; i < 2; ++i) { int R, C; stage_rc(tid * 16 + i * 8192, R, C); const int Rb = Epi::PERM ? ((R & ~31) + perm32(R & 31)) : R;
        voffB[i] = (unsigned)(Rb * KB_ + C * 2); }
    const size_t kstep = (size_t)(BK * 2);
    const size_t hstep = (size_t)HALF * KB_;
    const unsigned ldsw = (unsigned)wid * 1024u;
    const int aoff = lds_byte(wr * 64 + fr, fq * 8), boff = lds_byte(wc * 32 + fr, fq * 8);
#define PG8_SA(b, h) (((b) * 2 + (h)) * HTB)
#define PG8_SB(b, h) ((4 + (b) * 2 + (h)) * HTB)
#define PG8_STAGEB(bufoff, gbase) do { _Pragma("unroll") for (int _i = 0; _i < 2; ++_i) \
        __builtin_amdgcn_global_load_lds((const unsigned*)((const char*)(gbase) + voffB[_i]), (LAS unsigned*)(lds + (bufoff) + ldsw + _i * 8192), 16, 0, 0); } while (0)
#define PG8_STAGEA(bufoff, kbyte, off2) do { _Pragma("unroll") for (int _i = 0; _i < 2; ++_i) \
        __builtin_amdgcn_global_load_lds((const unsigned*)((const char*)Abase + (kbyte) + (off2)[_i]), (LAS unsigned*)(lds + (bufoff) + ldsw + _i * 8192), 16, 0, 0); } while (0)
#define PG8_STAGEA2(bufoff, kbyte, h) do { _Pragma("unroll") for (int _i = 0; _i < 2; ++_i) \
        __builtin_amdgcn_global_load_lds((const unsigned*)((const char*)Abase + (kbyte) + (last ? nxtA[h][_i] : curA[h][_i])), (LAS unsigned*)(lds + (bufoff) + ldsw + _i * 8192), 16, 0, 0); } while (0)
#define PG8_CAT(x0, x1) __builtin_shufflevector(x0, x1, 0, 1, 2, 3, 4, 5, 6, 7)
#define PG8_LDA(dst, b, h) do { _Pragma("unroll") for (int m = 0; m < 4; ++m) { \
        if constexpr (F8) dst##8[m] = __builtin_bit_cast(v8i32, PG8_CAT(*(const LAS u32x4*)(lds + PG8_SA(b, h) + aoff + m * 2048), *(const LAS u32x4*)(lds + PG8_SA(b, h) + aoff + m * 2048 + 1024))); \
        else { _Pragma("unroll") for (int k = 0; k < 2; ++k) dst[m][k] = *(const LAS bf16x8*)(lds + PG8_SA(b, h) + aoff + m * 2048 + k * 1024); } } } while (0)
#define PG8_LDB(dst, b, h) do { _Pragma("unroll") for (int n = 0; n < 2; ++n) { \
        if constexpr (F8) dst##8[n] = __builtin_bit_cast(v8i32, PG8_CAT(*(const LAS u32x4*)(lds + PG8_SB(b, h) + boff + n * 2048), *(const LAS u32x4*)(lds + PG8_SB(b, h) + boff + n * 2048 + 1024))); \
        else { _Pragma("unroll") for (int k = 0; k < 2; ++k) dst[n][k] = *(const LAS bf16x8*)(lds + PG8_SB(b, h) + boff + n * 2048 + k * 1024); } } } while (0)
#define PG8_MMA(ai, bj, At, Bt) do { __builtin_amdgcn_s_setprio(1); _Pragma("unroll") for (int m = 0; m < 4; ++m) _Pragma("unroll") for (int n = 0; n < 2; ++n) { \
        if constexpr (F8) asm volatile("v_mfma_scale_f32_16x16x128_f8f6f4 %0, %1, %2, %0, %3, %4 op_sel_hi:[0,0,0]" : "+v"(acc[ai][bj][m][n]) : "v"(Bt##8[n]), "v"(At##8[m]), "v"(sclB), "v"(sclA));     \
        else { _Pragma("unroll") for (int k = 0; k < 2; ++k) acc[ai][bj][m][n] = __builtin_amdgcn_mfma_f32_16x16x32_bf16(Bt[n][k], At[m][k], acc[ai][bj][m][n], 0, 0, 0); } } __builtin_amdgcn_s_setprio(0); } while (0)
#define PG8_WAIT_V(n) asm volatile("s_waitcnt vmcnt(" #n ")" ::: "memory")
#define PG8_WAIT_L(n) asm volatile("s_waitcnt lgkmcnt(" #n ")" ::: "memory")
#define PG8_BAR __builtin_amdgcn_s_barrier()
#define PG8_SCHED __builtin_amdgcn_sched_barrier(0)
#define PG8_AOFFS(dst, u) do { int tl_ = tid; asm volatile("" : "+v"(tl_));     \
        _Pragma("unroll") for (int _i = 0; _i < 2; ++_i) { int R_, C_; stage_rc(tl_ * 16 + _i * 8192, R_, C_); \
            _Pragma("unroll") for (int _h = 0; _h < 2; ++_h) dst[_h][_i] = (unsigned)S.arow(u, 128 * _h + R_) * (unsigned)KA + (unsigned)C_ * 2u; } } while (0)
    Unit cur, nxt; int ui = 0;
    if (!S.next(0, cur)) return;
    cur.par = 0;
    f32x4 acc[2][2][4][2];
#pragma unroll
    for (int a = 0; a < 2; ++a)
#pragma unroll
        for (int b = 0; b < 2; ++b)
#pragma unroll
            for (int m = 0; m < 4; ++m)
#pragma unroll
                for (int n = 0; n < 2; ++n) acc[a][b][m][n] = (f32x4){0.f, 0.f, 0.f, 0.f};
    bf16x8 At[4][2], B0[2][2], B1[2][2];
    v8i32 At8[4], B08[2], B18[2];
    unsigned curA[2][2], nxtA[2][2];
    if constexpr (Sched::LDSLIST) { if (wid == 0) S.dma_list(cur, (unsigned)__builtin_amdgcn_readfirstlane((int)(unsigned)(size_t)S.ltile), lane);
        asm volatile("s_waitcnt vmcnt(0)" ::: "memory"); PG8_BAR; }
    PG8_AOFFS(curA, cur);
    const char* cB = (const char*)Bbase + S.boff(cur);
    PG8_STAGEB(PG8_SB(0, 0), cB); PG8_STAGEB(PG8_SB(0, 1), cB + hstep); PG8_STAGEA(PG8_SA(0, 0), 0, curA[0]); PG8_STAGEA(PG8_SA(0, 1), 0, curA[1]);
    if (wr == 1) PG8_BAR;
    PG8_WAIT_V(2); PG8_BAR;
    PG8_STAGEB(PG8_SB(1, 0), cB + kstep); PG8_STAGEA(PG8_SA(1, 0), kstep, curA[0]); PG8_STAGEB(PG8_SB(1, 1), cB + hstep + kstep);
    PG8_WAIT_V(6); PG8_BAR;
    for (;;) {
        if constexpr (Epi::META) E.prefetch(cur, S, tid);
        const bool has_next = S.next(ui + 1, nxt); nxt.par = (ui + 1) & 1;
        const char* nB = cB;
        if (has_next) { nB = (const char*)Bbase + S.boff(nxt);
            if constexpr (Sched::LDSLIST) { if (wid == 0) S.dma_list(nxt, (unsigned)__builtin_amdgcn_readfirstlane((int)(unsigned)(size_t)S.ltile), lane); }
            else PG8_AOFFS(nxtA, nxt); }
        else {
#pragma unroll
            for (int h = 0; h < 2; ++h)
#pragma unroll
                for (int i = 0; i < 2; ++i) nxtA[h][i] = curA[h][i];
        }
#pragma unroll 1
        for (int t = 0; t < nt; t += 2) {
            const bool last = (t == nt - 2);
            if constexpr (Sched::LDSLIST) { if (last && has_next) PG8_AOFFS(nxtA, nxt); }
            const size_t k1 = (size_t)(t + 1) * kstep, k2 = last ? 0 : (size_t)(t + 2) * kstep, k3 = k2 + kstep;
            const char* b2 = last ? nB : cB + (size_t)(t + 2) * kstep; const char* b3 = b2 + kstep;
            PG8_LDB(B0, 0, 0); if (!HN || !cur.hn) PG8_LDB(B1, 0, 1); PG8_SCHED; PG8_LDA(At, 0, 0); PG8_STAGEA(PG8_SA(1, 1), k1, curA[1]);
            PG8_WAIT_V(8); PG8_WAIT_L(0); PG8_BAR; PG8_MMA(0, 0, At, B0); if (!HN || !cur.hn) PG8_MMA(0, 1, At, B1); PG8_BAR; PG8_SCHED;
            PG8_LDA(At, 0, 1); PG8_STAGEB(PG8_SB(0, 0), b2); PG8_STAGEB(PG8_SB(0, 1), b2 + hstep); PG8_STAGEA2(PG8_SA(0, 0), k2, 0);
            PG8_WAIT_V(8); PG8_WAIT_L(0); PG8_BAR; PG8_MMA(1, 0, At, B0); if (!HN || !cur.hn) PG8_MMA(1, 1, At, B1); PG8_BAR; PG8_SCHED;
            PG8_LDB(B0, 1, 0); if (!HN || !cur.hn) PG8_LDB(B1, 1, 1); PG8_SCHED; PG8_LDA(At, 1, 0); PG8_STAGEA2(PG8_SA(0, 1), k2, 1);
            PG8_WAIT_V(8); PG8_WAIT_L(0); PG8_BAR; PG8_MMA(0, 0, At, B0); if (!HN || !cur.hn) PG8_MMA(0, 1, At, B1); PG8_BAR; PG8_SCHED;
            PG8_LDA(At, 1, 1); PG8_STAGEB(PG8_SB(1, 0), b3); PG8_STAGEB(PG8_SB(1, 1), b3 + hstep); PG8_STAGEA2(PG8_SA(1, 0), k3, 0);
            PG8_WAIT_V(8); PG8_WAIT_L(0); PG8_BAR; PG8_MMA(1, 0, At, B0); if (!HN || !cur.hn) PG8_MMA(1, 1, At, B1); PG8_BAR; PG8_SCHED;
        }
        if (wr == 0) PG8_BAR;
        if constexpr (F8) asm volatile("s_nop 15\n\ts_nop 15" ::: "memory");
        E(acc, cur, wr, wc, fr, fq, S);
        if (!has_next) break;
#pragma unroll
        for (int a = 0; a < 2; ++a)
#pragma unroll
            for (int b = 0; b < 2; ++b)
#pragma unroll
                for (int m = 0; m < 4; ++m)
#pragma unroll
                    for (int n = 0; n < 2; ++n) acc[a][b][m][n] = (f32x4){0.f, 0.f, 0.f, 0.f};
        cur = nxt; cB = nB; ++ui;
#pragma unroll
        for (int h = 0; h < 2; ++h)
#pragma unroll
            for (int i = 0; i < 2; ++i) curA[h][i] = nxtA[h][i];
        if (wr == 1) PG8_BAR;
    }
    PG8_WAIT_V(0);
    PG8_BAR;
#undef PG8_SA
#undef PG8_SB
#undef PG8_STAGEA
#undef PG8_STAGEA2
#undef PG8_STAGEB
#undef PG8_LDA
#undef PG8_LDB
#undef PG8_MMA
#undef PG8_CAT
#undef PG8_WAIT_V
#undef PG8_WAIT_L
#undef PG8_BAR
#undef PG8_SCHED
#undef PG8_AOFFS
}
}
using pg8::Unit;

struct DenseSched {
    static constexpr bool LDSLIST = false;
    int nN, nTot, G, c, kb;
    __device__ void init(int nN_, int G_, int c_, int kb_ = 2048) { nN = nN_; nTot = NPANEL * nN_; G = G_; c = c_; kb = kb_; }
    __device__ __forceinline__ bool next(int i, Unit& u) const {
        const int L = i * G + c; if (L >= nTot) return false;
        pg8::static_tile(L, NPANEL, nN, u.pm, u.pn); u.e = 0; u.lt = 0; u.hn = 0; return true;
    }
    __device__ __forceinline__ int arow(const Unit& u, int r) const { return panel_row0(u.pm) + r; }
    __device__ __forceinline__ int orow(const Unit& u, int r) const { return panel_row0(u.pm) + r; }
    __device__ __forceinline__ size_t boff(const Unit& u) const { return (size_t)u.pn * 256 * kb; }
};
template <bool GATHER> struct MoeSchedT {
    static constexpr bool LDSLIST = GATHER;
    const LAS int* tstart;
    const LAS int* cnt;
    const int* list;
    const float* listw;
    int nN, G, c, K; size_t wbase;
    const LAS int* ltile;
    __device__ __forceinline__ bool next(int i, Unit& u) const {
        const int cx = (G & 7) ? c : (c & 7) * (G >> 3) + (c >> 3);
        const int L = i * G + cx, ntot = tstart[16] * nN;
        const int R0 = (ntot / G) * G, left = ntot - R0; const bool split = left > 0 && 2 * left <= G;
        int Lu = L, hn = 0, hsel = 0;
        if (split && L >= R0) { const int j = L - R0; if (j >= 2 * left) return false; Lu = R0 + (j >> 1); hn = 1; hsel = j & 1; }
        else if (L >= ntot) return false;
        const int tl = Lu / nN; u.pn = 2 * (Lu - tl * nN) + hsel; u.hn = hn; u.pm = tl; int e = 0;
#pragma unroll
        for (int j = 1; j < 16; ++j) e += (tl >= tstart[j]) ? 1 : 0;
        u.e = e; u.lt = tl - tstart[e]; return true;
    }
    __device__ __forceinline__ void dma_list(const Unit& u, unsigned lds_dst, int lane) const { lds_dma16((const char*)(list + (size_t)u.e * LISTCAP + (size_t)u.lt * 256) + lane * 16, lds_dst); }
    __device__ __forceinline__ void dma_listw(const Unit& u, unsigned lds_dst, int lane) const { lds_dma16((const char*)(listw + (size_t)u.e * LISTCAP + (size_t)u.lt * 256) + lane * 16, lds_dst); }
    __device__ __forceinline__ bool valid(const Unit& u, int r) const { return u.lt * 256 + r < cnt[u.e]; }
    __device__ __forceinline__ int arow(const Unit& u, int r) const {
        if (!GATHER) return u.pm * 256 + r;
        return ltile[valid(u, r) ? r : 0] >> 1; }
    __device__ __forceinline__ size_t boff(const Unit& u) const { return wbase + ((size_t)u.e * 1024 + (size_t)u.pn * 128) * K; }
};

struct EpiBf16 {
    static constexpr bool PERM = true, META = false;
    bf16_t* O; int ldc, ncols; int sc_lo, sc_hi; float sc; unsigned* kn; int kn_lo;
    template <class Sched> __device__ __forceinline__ void operator()(const f32x4 (&acc)[2][2][4][2], const Unit& u, int wr, int wc, int fr, int fq, const Sched& S) const {
        const float s = (u.pn >= sc_lo && u.pn < sc_hi) ? sc : 1.f;
        if (kn && (u.pn == kn_lo || u.pn == kn_lo + 1)) {
#pragma unroll
            for (int bj = 0; bj < 2; ++bj) { float mxs = 0.f;
#pragma unroll
                for (int ai = 0; ai < 2; ++ai)
#pragma unroll
                    for (int m = 0; m < 4; ++m) { const f32x4 v0 = acc[ai][bj][m][0], v1 = acc[ai][bj][m][1];
                        float ss = v0[0] * v0[0] + v0[1] * v0[1] + v0[2] * v0[2] + v0[3] * v0[3] + v1[0] * v1[0] + v1[1] * v1[1] + v1[2] * v1[2] + v1[3] * v1[3];
                        ss += __shfl_xor(ss, 16); ss += __shfl_xor(ss, 32); mxs = fmaxf(mxs, ss); }
                mxs = fmaxf(mxs, __shfl_xor(mxs, 1)); mxs = fmaxf(mxs, __shfl_xor(mxs, 2)); mxs = fmaxf(mxs, __shfl_xor(mxs, 4)); mxs = fmaxf(mxs, __shfl_xor(mxs, 8));
                if (fr == 0 && fq == 0) atomicMax(kn + ((u.pm >> 5) * 8 + (u.pn - kn_lo) * 4 + bj * 2 + (wc >> 1)) * 2 + (wc & 1), __float_as_uint(mxs)); } }
#pragma unroll
        for (int ai = 0; ai < 2; ++ai)
#pragma unroll
            for (int m = 0; m < 4; ++m) { const int orow = S.orow(u, ai * 128 + wr * 64 + m * 16 + fr);
#pragma unroll
                for (int bj = 0; bj < 2; ++bj) { const int col = u.pn * 256 + bj * 128 + wc * 32 + 8 * fq;
                    const f32x4 v0 = acc[ai][bj][m][0] * s, v1 = acc[ai][bj][m][1] * s;
                    u32x4 w; w.x = cvt_pk_bf16(v0[0], v0[1]); w.y = cvt_pk_bf16(v0[2], v0[3]); w.z = cvt_pk_bf16(v1[0], v1[1]); w.w = cvt_pk_bf16(v1[2], v1[3]);
                    if (orow >= 0 && col < ncols) *(u32x4*)(O + (size_t)orow * ldc + col) = w; } }
    }
};
struct EpiResBf16 {
    static constexpr bool PERM = true, META = false;
    const bf16_t* Hb; bf16_t* T;
    template <class Sched> __device__ __forceinline__ void operator()(const f32x4 (&acc)[2][2][4][2], const Unit& u, int wr, int wc, int fr, int fq, const Sched& S) const {
        u32x4 h[2][4][2];
#pragma unroll
        for (int ai = 0; ai < 2; ++ai)
#pragma unroll
            for (int m = 0; m < 4; ++m) { const size_t orow = (size_t)S.orow(u, ai * 128 + wr * 64 + m * 16 + fr);
#pragma unroll
                for (int bj = 0; bj < 2; ++bj) h[ai][m][bj] = *(const u32x4*)(Hb + orow * D + u.pn * 256 + bj * 128 + wc * 32 + 8 * fq); }
        __builtin_amdgcn_sched_barrier(0);
#pragma unroll
        for (int ai = 0; ai < 2; ++ai)
#pragma unroll
            for (int m = 0; m < 4; ++m) { const size_t orow = (size_t)S.orow(u, ai * 128 + wr * 64 + m * 16 + fr);
#pragma unroll
                for (int bj = 0; bj < 2; ++bj) { const int col = u.pn * 256 + bj * 128 + wc * 32 + 8 * fq;
                    const u32x4 hh = h[ai][m][bj]; const f32x4 v0 = acc[ai][bj][m][0], v1 = acc[ai][bj][m][1];
                    u32x4 w; w.x = cvt_pk_bf16(bflo(hh.x) * ALPHA + v0[0], bfhi(hh.x) * ALPHA + v0[1]); w.y = cvt_pk_bf16(bflo(hh.y) * ALPHA + v0[2], bfhi(hh.y) * ALPHA + v0[3]);
                    w.z = cvt_pk_bf16(bflo(hh.z) * ALPHA + v1[0], bfhi(hh.z) * ALPHA + v1[1]); w.w = cvt_pk_bf16(bflo(hh.w) * ALPHA + v1[2], bfhi(hh.w) * ALPHA + v1[3]);
                    *(u32x4*)(T + orow * D + col) = w; } }
    }
};
template <int MODE> __device__ __forceinline__ void meta_gemm(const bf16_t* Hb, const bf16_t* Res, const bf16_t* Bt, int N, bf16_t* O, int ldo, int sc_lo, int sc_hi, float sc, int wg, int nwg, const int tid_, unsigned* knm = nullptr) {
    const int lane = tid_ & 63, wave = __builtin_amdgcn_readfirstlane(tid_ >> 6), tok = lane & 15, kq = lane >> 4;
    for (int tile = wg * 8 + wave; tile < N / 16; tile += nwg * 8) {
        const bf16_t* wp = Bt + (size_t)(tile * 16 + tok) * 1024 + kq * 8; const bf16_t* hp = Hb + (size_t)tok * D + kq * 8;
        f32x4 acc = (f32x4){0.f, 0.f, 0.f, 0.f};
#pragma unroll 16
        for (int k = 0; k < 32; ++k) { const bf16x8 a = *(const bf16x8*)(wp + k * 32), bb = *(const bf16x8*)(hp + k * 32); acc = __builtin_amdgcn_mfma_f32_16x16x32_bf16(a, bb, acc, 0, 0, 0); }
        const int n = tile * 16 + 4 * kq;
        if (MODE == 0 && knm && tile >= 64 && tile < 96) {
            float ss = acc[0] * acc[0] + acc[1] * acc[1] + acc[2] * acc[2] + acc[3] * acc[3]; ss += __shfl_xor(ss, 16); ss += __shfl_xor(ss, 32);
            ss = fmaxf(ss, __shfl_xor(ss, 1)); ss = fmaxf(ss, __shfl_xor(ss, 2)); ss = fmaxf(ss, __shfl_xor(ss, 4)); ss = fmaxf(ss, __shfl_xor(ss, 8));
            if (lane == 0) atomicMax(knm + (tile - 64), __float_as_uint(ss)); }
        if (MODE == 0) { const float f = (n >= sc_lo && n < sc_hi) ? sc : 1.f; u32x2 w; w.x = cvt_pk_bf16(acc[0] * f, acc[1] * f); w.y = cvt_pk_bf16(acc[2] * f, acc[3] * f);
#pragma unroll
            for (int b = 0; b < NB; ++b) *(u32x2*)(O + (size_t)(b * LB + tok) * ldo + n) = w; }
        else { const u32x2 h = *(const u32x2*)(Res + (size_t)tok * D + n); u32x2 w; w.x = cvt_pk_bf16(bflo(h.x) * ALPHA + acc[0], bfhi(h.x) * ALPHA + acc[1]); w.y = cvt_pk_bf16(bflo(h.y) * ALPHA + acc[2], bfhi(h.y) * ALPHA + acc[3]);
#pragma unroll
            for (int b = 0; b < NB; ++b) *(u32x2*)(O + (size_t)(b * LB + tok) * ldo + n) = w; }
    }
}
struct EpiSiluMul {
    static constexpr bool PERM = true, META = false;
    unsigned char* ACT;
    template <class Sched> __device__ __forceinline__ void operator()(const f32x4 (&acc)[2][2][4][2], const Unit& u, int wr, int wc, int fr, int fq, const Sched& S) const {
#pragma unroll
        for (int ai = 0; ai < 2; ++ai)
#pragma unroll
            for (int m = 0; m < 4; ++m) { const size_t arow = (size_t)u.pm * 256 + ai * 128 + wr * 64 + m * 16 + fr;
#pragma unroll
                for (int bj = 0; bj < 2; ++bj) { if (bj == 1 && u.hn) continue; const int col = u.pn * 64 + bj * 64 + wc * 16 + 4 * fq;
                    const f32x4 g = acc[ai][bj][m][0], up = acc[ai][bj][m][1]; float a[4];
#pragma unroll
                    for (int i = 0; i < 4; ++i) a[i] = g[i] * __builtin_amdgcn_rcpf(1.f + __builtin_amdgcn_exp2f(g[i] * -1.44269504f)) * (up[i] * F8_ASCALE);
                    *(unsigned*)(ACT + arow * DEXP + col) = pk4_fp8(a[0], a[1], a[2], a[3]); } }
    }
};
struct EpiScatter {
    static constexpr bool PERM = true, META = true;
    unsigned char* YK; LAS int* ms; LAS float* mw;
    template <class Sched> __device__ __forceinline__ void prefetch(const Unit& u, const Sched& S, int tid) const {
        if (__builtin_amdgcn_readfirstlane(tid >> 6) == 0) { S.dma_list(u, (unsigned)__builtin_amdgcn_readfirstlane((int)(unsigned)(size_t)(ms + u.par * 256)), tid & 63);
            S.dma_listw(u, (unsigned)__builtin_amdgcn_readfirstlane((int)(unsigned)(size_t)(mw + u.par * 256)), tid & 63); } }
    template <class Sched> __device__ __forceinline__ void operator()(const f32x4 (&acc)[2][2][4][2], const Unit& u, int wr, int wc, int fr, int fq, const Sched& S) const {
        int sl[2][4]; float w8[2][4];
#pragma unroll
        for (int ai = 0; ai < 2; ++ai)
#pragma unroll
            for (int m = 0; m < 4; ++m) { const int rt = u.par * 256 + ai * 128 + wr * 64 + m * 16 + fr; sl[ai][m] = ms[rt]; w8[ai][m] = mw[rt] * F8_YSCALE; }
        const int nvalid = S.cnt[u.e] - u.lt * 256;
#pragma unroll
        for (int ai = 0; ai < 2; ++ai)
#pragma unroll
            for (int m = 0; m < 4; ++m) { const int rl = ai * 128 + wr * 64 + m * 16 + fr; const bool ok = rl < nvalid; const int s_ = ok ? sl[ai][m] : 0;
                unsigned char* yrow = YK + ((size_t)(s_ & 1) * M1 + (size_t)(s_ >> 1)) * D + u.pn * 128 + wc * 32 + 8 * fq;
#pragma unroll
                for (int bj = 0; bj < 2; ++bj) {
                    const f32x4 v0 = acc[ai][bj][m][0] * w8[ai][m], v1 = acc[ai][bj][m][1] * w8[ai][m];
                    u32x2 w; w.x = pk4_fp8(v0[0], v0[1], v0[2], v0[3]); w.y = pk4_fp8(v1[0], v1[1], v1[2], v1[3]);
                    if (ok && !(bj == 1 && u.hn)) *(u32x2*)(yrow + bj * 128) = w; } }
    }
};

template <int MODE> __device__ __forceinline__ int wrow_map(int n) { return MODE == 0 ? n : (8 * (n >> 2) + (n & 3) + (MODE == 2 ? 4 : 0)); }
template <int MODE> __device__ __forceinline__ void transpose_item_f8(const float* W, int srcpitch, int K, int N, unsigned char* WT, int dpitch, LAS float* scr, int item, int lane) {
    const int nblk = (N + 31) / 32, kb = item / nblk, nb = item % nblk, k0 = 64 * kb, n0 = 32 * nb;
    { float tmp[32];
#pragma unroll
        for (int i = 0; i < 32; ++i) { const int kk = 2 * i + (lane >> 5), n = n0 + (lane & 31); tmp[i] = n < N ? W[(size_t)(k0 + kk) * srcpitch + n] : 0.f; }
#pragma unroll
        for (int i = 0; i < 32; ++i) scr[(2 * i + (lane >> 5)) * 33 + (lane & 31)] = tmp[i] * F8_WSCALE; }
    asm volatile("s_waitcnt lgkmcnt(0)" ::: "memory");
#pragma unroll
    for (int j = 0; j < 2; ++j) { const int slot = lane + 64 * j, nl = slot >> 2, c = slot & 3; const LAS float* sp = scr + (16 * c) * 33 + nl;
        u32x4 o; o.x = pk4_fp8(sp[0 * 33], sp[1 * 33], sp[2 * 33], sp[3 * 33]); o.y = pk4_fp8(sp[4 * 33], sp[5 * 33], sp[6 * 33], sp[7 * 33]);
        o.z = pk4_fp8(sp[8 * 33], sp[9 * 33], sp[10 * 33], sp[11 * 33]); o.w = pk4_fp8(sp[12 * 33], sp[13 * 33], sp[14 * 33], sp[15 * 33]);
        if (n0 + nl < N) *(u32x4*)(WT + (size_t)wrow_map<MODE>(n0 + nl) * dpitch + k0 + 16 * c) = o; }
    asm volatile("s_waitcnt lgkmcnt(0)" ::: "memory");
}
template <int MODE> __device__ __forceinline__ void transpose_item(const float* W, int srcpitch, int K, int N, bf16_t* WT, int dpitch, int dcol0, LAS float* scr, int item, int lane) {
    const int nblk = (N + 31) / 32, kb = item / nblk, nb = item % nblk, k0 = 64 * kb, n0 = 32 * nb;
    { float tmp[32];
#pragma unroll
        for (int i = 0; i < 32; ++i) { const int kk = 2 * i + (lane >> 5), n = n0 + (lane & 31); tmp[i] = n < N ? W[(size_t)(k0 + kk) * srcpitch + n] : 0.f; }
#pragma unroll
        for (int i = 0; i < 32; ++i) scr[(2 * i + (lane >> 5)) * 33 + (lane & 31)] = tmp[i]; }
    asm volatile("s_waitcnt lgkmcnt(0)" ::: "memory");
    const int c = lane & 7;
#pragma unroll
    for (int j = 0; j < 4; ++j) { const int nl = (lane >> 3) + 8 * j; const LAS float* s = scr + (8 * c) * 33 + nl;
        u32x4 o; o.x = pk2(s[0 * 33], s[1 * 33]); o.y = pk2(s[2 * 33], s[3 * 33]); o.z = pk2(s[4 * 33], s[5 * 33]); o.w = pk2(s[6 * 33], s[7 * 33]);
        if (n0 + nl < N) *(u32x4*)(WT + (size_t)wrow_map<MODE>(n0 + nl) * dpitch + dcol0 + k0 + 8 * c) = o; }
    asm volatile("s_waitcnt lgkmcnt(0)" ::: "memory");
}
constexpr int PI_IN0 = 16 * 64, PI_OUT0 = 8 * 32, PI_OUT08 = 8 * 32, PI_IN1 = 16 * 96, PI_IN18 = 16 * 96, PI_OUT18 = 16 * 32, PI_G = 32 * 256, PI_U = 32 * 256, PI_D = 32 * 256;
constexpr int PREP_EARLY = PI_IN0, PREP_NITEMS = PI_IN0 + PI_OUT0 + PI_OUT08 + PI_IN1 + PI_IN18 + PI_OUT18 + PI_G + PI_U + PI_D;
__device__ __forceinline__ void prep_items(const Ptrs& P, LAS unsigned char* lds, const int it_lo, const int it_hi, const int gw, const int NGW, const int lane, const int wave) {
    LAS float* scr = (LAS float*)(lds + wave * 16384);
    bf16_t* Win0 = (bf16_t*)(P.ws + W_IN0); bf16_t* Wout0 = (bf16_t*)(P.ws + W_OUT0); bf16_t* Win1 = (bf16_t*)(P.ws + W_IN1);
    unsigned char* Wgu = P.ws + W_GU; unsigned char* Wdn = P.ws + W_DN;
    struct ItemD { const float* W; unsigned char* dst; int srcpitch, N, nblk, dpitch, dcol, mode, f8; };
    auto decode = [&](int it, ItemD& d, int& r) {
        r = it;
        if (r < PI_IN0) { d = ItemD{P.even_w_in, (unsigned char*)Win0, EVEN_IN, EVEN_IN, 64, 2048, 0, 0, 0}; return; } r -= PI_IN0;
        if (r < PI_OUT0) { d = ItemD{P.even_w_out + (size_t)512 * 1024, (unsigned char*)Wout0, 1024, 1024, 32, 2048, 1024, 0, 0}; return; } r -= PI_OUT0;
        if (r < PI_OUT08) { d = ItemD{P.even_w_out + (size_t)512 * 1024, P.ws + W_OUT08, 1024, 1024, 32, 1024, 512, 0, 1}; return; } r -= PI_OUT08;
        if (r < PI_IN1) { d = ItemD{P.odd_w_in, (unsigned char*)Win1, ODD_IN, ODD_N, 96, 2048, 0, 0, 0}; return; } r -= PI_IN1;
        if (r < PI_IN18) { d = ItemD{P.odd_w_in, P.ws + W_IN18, ODD_IN, ODD_N, 96, 1024, 0, 0, 1}; return; } r -= PI_IN18;
        if (r < PI_OUT18) { d = ItemD{P.odd_w_out, P.ws + W_OUT18, 1024, 1024, 32, 1024, 0, 0, 1}; return; } r -= PI_OUT18;
        if (r < PI_G) { const int le = r >> 8; r &= 255; d = ItemD{P.moe_w_gate + (size_t)le * 1024 * 512, Wgu + (size_t)le * 1024 * 1024, 512, 512, 16, 1024, 0, 1, 1}; return; } r -= PI_G;
        if (r < PI_U) { const int le = r >> 8; r &= 255; d = ItemD{P.moe_w_up + (size_t)le * 1024 * 512, Wgu + (size_t)le * 1024 * 1024, 512, 512, 16, 1024, 0, 2, 1}; return; } r -= PI_U;
        { const int le = r >> 8; r &= 255; d = ItemD{P.moe_w_down + (size_t)le * 512 * 1024, Wdn + (size_t)le * 1024 * 512, 1024, 1024, 32, 512, 0, 0, 1}; } };
#define PREP_LOAD(d, r, tmp) do { const int kb_ = (r) / (d).nblk, nb_ = (r) % (d).nblk; \
        _Pragma("unroll") for (int i = 0; i < 8; ++i) { const int kk = 8 * i + (lane >> 3), n = 32 * nb_ + 4 * (lane & 7); tmp[i] = *(const f32x4*)((d).W + (size_t)(64 * kb_ + kk) * (d).srcpitch + n); } } while (0)
#define PREP_STORE(d, r, tmp) do { const int kb_ = (r) / (d).nblk, nb_ = (r) % (d).nblk, k0_ = 64 * kb_, n0_ = 32 * nb_; const float sc_ = (d).f8 ? F8_WSCALE : 1.f; \
        _Pragma("unroll") for (int i = 0; i < 8; ++i) { LAS float* wp_ = scr + (8 * i + (lane >> 3)) * 33 + 4 * (lane & 7); wp_[0] = tmp[i][0] * sc_; wp_[1] = tmp[i][1] * sc_; wp_[2] = tmp[i][2] * sc_; wp_[3] = tmp[i][3] * sc_; } \
        asm volatile("s_waitcnt lgkmcnt(0)" ::: "memory"); \
        if ((d).f8) { _Pragma("unroll") for (int j = 0; j < 2; ++j) { const int slot = lane + 64 * j, nl = slot >> 2, c = slot & 3; const LAS float* sp = scr + (16 * c) * 33 + nl; \
                u32x4 o; o.x = pk4_fp8(sp[0 * 33], sp[1 * 33], sp[2 * 33], sp[3 * 33]); o.y = pk4_fp8(sp[4 * 33], sp[5 * 33], sp[6 * 33], sp[7 * 33]); \
                o.z = pk4_fp8(sp[8 * 33], sp[9 * 33], sp[10 * 33], sp[11 * 33]); o.w = pk4_fp8(sp[12 * 33], sp[13 * 33], sp[14 * 33], sp[15 * 33]); \
                const int n = n0_ + nl, rown = (d).mode == 0 ? n : (8 * (n >> 2) + (n & 3) + ((d).mode == 2 ? 4 : 0)); \
                if (n < (d).N) *(u32x4*)((d).dst + (size_t)rown * (d).dpitch + (d).dcol + k0_ + 16 * c) = o; } } \
        else { const int c = lane & 7; \
            _Pragma("unroll") for (int j = 0; j < 4; ++j) { const int nl = (lane >> 3) + 8 * j; const LAS float* sp = scr + (8 * c) * 33 + nl; \
                u32x4 o; o.x = pk2(sp[0 * 33], sp[1 * 33]); o.y = pk2(sp[2 * 33], sp[3 * 33]); o.z = pk2(sp[4 * 33], sp[5 * 33]); o.w = pk2(sp[6 * 33], sp[7 * 33]); \
                if (n0_ + nl < (d).N) *(u32x4*)((d).dst + (size_t)(n0_ + nl) * (d).dpitch + (d).dcol + (size_t)(k0_ + 8 * c) * 2) = o; } } \
        asm volatile("s_waitcnt lgkmcnt(0)" ::: "memory"); } while (0)
#define PREP_TRY(idx, d, r, tmp, ok) do { ok = (idx) < it_hi; decode(ok ? (idx) : it_lo, d, r); PREP_LOAD(d, r, tmp); } while (0)
    { ItemD dA, dB, dC; int rA = 0, rB = 0, rC = 0; f32x4 tA[8], tB[8], tC[8]; bool okA, okB, okC;
        int it = it_lo + gw;
        PREP_TRY(it, dA, rA, tA, okA); PREP_TRY(it + NGW, dB, rB, tB, okB);
        while (okA) {
            PREP_TRY(it + 2 * NGW, dC, rC, tC, okC);
            PREP_STORE(dA, rA, tA);
            if (!okB) break;
            PREP_TRY(it + 3 * NGW, dA, rA, tA, okA);
            PREP_STORE(dB, rB, tB);
            if (!okC) break;
            PREP_TRY(it + 4 * NGW, dB, rB, tB, okB);
            PREP_STORE(dC, rC, tC);
            it += 3 * NGW; } }
#undef PREP_TRY
#undef PREP_LOAD
#undef PREP_STORE
}
__device__ __forceinline__ void prep_fold(const Ptrs& P, const int gw, const int NGW, const int lane) {
    bf16_t* Wout0 = (bf16_t*)(P.ws + W_OUT0);
    for (int it = gw; it < 128 * 16; it += NGW) {
        const int cp0 = (it >> 4) * 4, n = (it & 15) * 64 + lane, g = cp0 >> 7, c0 = cp0 & 127;
        const float* pw = P.pool_w + ((size_t)g * 128 + c0) * 128; const float* ps = P.pool_scale + g * 128; const float* wo = P.even_w_out + (size_t)(g * 128) * 1024 + n;
        float a[4] = {0.f, 0.f, 0.f, 0.f}; float wv[128];
#pragma unroll
        for (int d = 0; d < 128; ++d) wv[d] = wo[(size_t)d * 1024];
        __builtin_amdgcn_sched_barrier(0);
#pragma unroll
        for (int d = 0; d < 128; ++d) { const float w = ps[d] * wv[d];
#pragma unroll
            for (int j = 0; j < 4; ++j) a[j] += pw[j * 128 + d] * w; }
#pragma unroll
        for (int j = 0; j < 4; ++j) { Wout0[(size_t)n * 1024 + cp0 + j] = (bf16_t)f2bf(a[j]); }
        *(unsigned*)(P.ws + W_OUT08 + (size_t)n * 1024 + cp0) = pk4_fp8(a[0] * F8_WSCALE, a[1] * F8_WSCALE, a[2] * F8_WSCALE, a[3] * F8_WSCALE);
    }
}
__device__ __forceinline__ void stage_prep(const Ptrs& P, LAS unsigned char* lds, int wg, int nwg) {
    const int tid = tid_opaque(P), lane = tid & 63, wave = __builtin_amdgcn_readfirstlane(tid >> 6);
    const int gw = wg * 8 + wave, NGW = nwg * 8;
    prep_items(P, lds, 0, nwg == 256 ? PREP_EARLY : PREP_NITEMS, gw, NGW, lane, wave);
    if (nwg != 256) prep_fold(P, gw, NGW, lane);
    bf16_t* Hb = (bf16_t*)(P.ws + WS_HB);
    for (int row0 = gw * 4; row0 < M1; row0 += NGW * 4) { f32x4 v[4][4];
#pragma unroll
        for (int q = 0; q < 4; ++q) { const f32x4* xr = (const f32x4*)h0_ptr(P, row0 + q) + lane;
#pragma unroll
            for (int j = 0; j < 4; ++j) v[q][j] = xr[64 * j]; }
#pragma unroll
        for (int q = 0; q < 4; ++q) { unsigned long long* o8 = (unsigned long long*)(Hb + (size_t)(row0 + q) * D) + lane;
#pragma unroll
            for (int j = 0; j < 4; ++j) o8[64 * j] = (unsigned long long)pk2(v[q][j].x, v[q][j].y) | ((unsigned long long)pk2(v[q][j].z, v[q][j].w) << 32); } }
    if (wg == 0 && tid == 0) { float s1 = 0.f, s2 = 0.f; for (int i = 0; i < 64; ++i) { s1 += P.lq1[i] * P.lk1[i]; s2 += P.lq2[i] * P.lk2[i]; }
        ((float*)(P.ws + WS_MISC))[0] = __expf(s1) - __expf(s2) + LAMBDA_INIT; }
}

template <int W> __device__ __forceinline__ void pool_block(const bf16_t* Z, unsigned char* A28, bf16_t* A2m, int row0, int p0, int col) {
    u32x4 v[W + 15];
#pragma unroll
    for (int k = 0; k < W + 15; ++k) v[k] = (p0 - (W - 1) + k >= 0) ? *(const u32x4*)(Z + (size_t)(row0 - (W - 1) + k) * EVEN_IN + col) : (u32x4){0u, 0u, 0u, 0u};
    float s[8];
#pragma unroll
    for (int i = 0; i < 8; ++i) s[i] = 0.f;
#pragma unroll
    for (int k = 0; k < W - 1; ++k) { s[0] += bflo(v[k].x); s[1] += bfhi(v[k].x); s[2] += bflo(v[k].y); s[3] += bfhi(v[k].y); s[4] += bflo(v[k].z); s[5] += bfhi(v[k].z); s[6] += bflo(v[k].w); s[7] += bfhi(v[k].w); }
#pragma unroll
    for (int r = 0; r < 16; ++r) { const u32x4 in = v[W - 1 + r];
        s[0] += bflo(in.x); s[1] += bfhi(in.x); s[2] += bflo(in.y); s[3] += bfhi(in.y); s[4] += bflo(in.z); s[5] += bfhi(in.z); s[6] += bflo(in.w); s[7] += bfhi(in.w);
        const int p = p0 + r; const float inv = 1.f / (float)((p + 1) < W ? (p + 1) : W);
        const float dv[8] = {s[0] * inv - bflo(in.x), s[1] * inv - bfhi(in.x), s[2] * inv - bflo(in.y), s[3] * inv - bfhi(in.y), s[4] * inv - bflo(in.z), s[5] * inv - bfhi(in.z), s[6] * inv - bflo(in.w), s[7] * inv - bfhi(in.w)};
        const int row = row0 + r;
        if (p < NMETA) { u32x4 o; o.x = pk2(dv[0], dv[1]); o.y = pk2(dv[2], dv[3]); o.z = pk2(dv[4], dv[5]); o.w = pk2(dv[6], dv[7]); *(u32x4*)(A2m + (size_t)((row / LB) * NMETA + p) * D + col) = o; }
        else { u32x2 o; o.x = pk4_fp8(dv[0] * F8_ASCALE, dv[1] * F8_ASCALE, dv[2] * F8_ASCALE, dv[3] * F8_ASCALE); o.y = pk4_fp8(dv[4] * F8_ASCALE, dv[5] * F8_ASCALE, dv[6] * F8_ASCALE, dv[7] * F8_ASCALE); *(u32x2*)(A28 + (size_t)row * D + col) = o; }
        const u32x4 out = v[r];
        s[0] -= bflo(out.x); s[1] -= bfhi(out.x); s[2] -= bflo(out.y); s[3] -= bfhi(out.y); s[4] -= bflo(out.z); s[5] -= bfhi(out.z); s[6] -= bflo(out.w); s[7] -= bfhi(out.w); }
}
__device__ __forceinline__ void stage_pool(const Ptrs& P, int wg, int nwg) {
    const bf16_t* Z = (const bf16_t*)(P.ws + WS_Z); unsigned char* A28 = P.ws + WS_A2; bf16_t* A2m = (bf16_t*)(P.ws + WS_A2M);
    const int tid_ = tid_opaque(P), lane = tid_ & 63; const int gwv = __builtin_amdgcn_readfirstlane(wg * 8 + (tid_ >> 6)), NGW = nwg * 8;
    for (int it = gwv; it < (M1 / 64) * 4; it += NGW) { const int gi = it & 3, blk = (it >> 2) * 4 + (lane >> 4), row0 = blk * 16, p0 = row0 % LB, col = gi * 128 + (lane & 15) * 8;
        if (gi == 0) pool_block<2>(Z, A28, A2m, row0, p0, col); else if (gi == 1) pool_block<4>(Z, A28, A2m, row0, p0, col);
        else if (gi == 2) pool_block<8>(Z, A28, A2m, row0, p0, col); else pool_block<16>(Z, A28, A2m, row0, p0, col); }
}

__device__ __forceinline__ void route16(const float (&lg)[16], const float* bias, int& e0, int& e1, float& w0, float& w1) {
    float mx = lg[0];
#pragma unroll
    for (int e = 1; e < 16; ++e) mx = fmaxf(mx, lg[e]);
    float p[16], sum = 0.f;
#pragma unroll
    for (int e = 0; e < 16; ++e) { p[e] = __builtin_amdgcn_exp2f((lg[e] - mx) * 1.44269504f); sum += p[e]; }
    const float inv = 1.f / sum; float sel[16];
#pragma unroll
    for (int e = 0; e < 16; ++e) { p[e] *= inv; sel[e] = p[e] + bias[e]; }
    int gbest = 0; float gsb = -3.0e38f; int bi0 = 0, bi1 = 1; float bp0 = 0.f, bp1 = 0.f;
#pragma unroll
    for (int g = 0; g < 4; ++g) {
        int i0 = 0; float m0 = sel[4 * g];
#pragma unroll
        for (int i = 1; i < 4; ++i) if (sel[4 * g + i] > m0) { m0 = sel[4 * g + i]; i0 = i; }
        int i1 = (i0 == 0) ? 1 : 0; float m1 = (i0 == 0) ? sel[4 * g + 1] : sel[4 * g];
#pragma unroll
        for (int i = 1; i < 4; ++i) if (i != i0 && i != ((i0 == 0) ? 1 : 0) && sel[4 * g + i] > m1) { m1 = sel[4 * g + i]; i1 = i; }
        const float gs = m0 + m1;
        float q0 = 0.f, q1 = 0.f;
#pragma unroll
        for (int i = 0; i < 4; ++i) { q0 = (i == i0) ? p[4 * g + i] : q0; q1 = (i == i1) ? p[4 * g + i] : q1; }
        if (gs > gsb) { gsb = gs; gbest = g; bi0 = i0; bi1 = i1; bp0 = q0; bp1 = q1; }
    }
    e0 = gbest * 4 + bi0; e1 = gbest * 4 + bi1; const float ws = 1.f / (bp0 + bp1); w0 = bp0 * ws; w1 = bp1 * ws;
}

constexpr int LN_WROW = 80, LN_LGS = 1024 * LN_WROW, LN_CNT = LN_LGS + 8 * 256, LN_ENT = LN_CNT + 128, LN_GB = 90112;
template <int MODE> __device__ __forceinline__ void stage_ln(const Ptrs& P, LAS unsigned char* lds, int wg, int nwg) {
    constexpr int LAYER = MODE & 1; constexpr bool MIX = MODE < 2, MATV = MODE != 3, ROUTE = MODE < 2;
    const int tid = tid_opaque(P), lane = tid & 63, wave = __builtin_amdgcn_readfirstlane(tid >> 6);
    constexpr int O_TL = 0, TLP = 2064, O_PD = 66560, O_ST = 99328, O_SE = 99584, O_CE = 99648;
    constexpr int O_GB = ROUTE ? 100352 : LN_GB, O_LGS = ROUTE ? 108544 : LN_LGS, O_CNT = ROUTE ? 110592 : LN_CNT, O_ENT = ROUTE ? 110720 : LN_ENT;
    LAS float* lgs = (LAS float*)(lds + O_LGS) + wave * 64; LAS int* lcnt = (LAS int*)(lds + O_CNT); LAS int* lbase = lcnt + 16; LAS int* ent = (LAS int*)(lds + O_ENT); LAS float* entw = (LAS float*)(lds + O_ENT + 2048);
    int R = (((M1 + nwg - 1) / nwg) + 3) & ~3, r0 = wg * R, r1 = (r0 + R) < M1 ? (r0 + R) : M1;
    if ((MODE == 1 || MODE == 3) && nwg == 256) { R = 128; r0 = (wg >> 6) * LB + NMETA + (wg & 63) * 128; r1 = r0 + 128; }
    if (MODE == 2) { const float* src = MODE == 2 ? P.odd_w_in + ODD_N : P.router_w; const int stride = MODE == 2 ? ODD_IN : 16;
        for (int i = tid; i < 4096; i += 512) { const int cc = i >> 2, q4 = i & 3; const int lrow = (cc >> 9) * 512 + (cc & 7) * 64 + ((cc & 511) >> 3);
            *(LAS f32x4*)(lds + lrow * LN_WROW + q4 * 16) = *(const f32x4*)(src + (size_t)cc * stride + q4 * 4); } }
    if (ROUTE) { if (tid < 16) lcnt[tid] = 0; for (int i = tid; i < 2 * R; i += 512) ent[i] = -1; }
    { const float* gb_ = (tid < 256 ? (MIX ? P.ln_mix_g : P.ln_ffn_g) : (MIX ? P.ln_mix_b : P.ln_ffn_b)) + LAYER * D; const int i_ = tid & 255, hf_ = i_ >> 7, q_ = (i_ >> 6) & 1, ln_ = i_ & 63;
        ((LAS f32x4*)(lds + O_GB))[tid] = *(const f32x4*)(gb_ + hf_ * 512 + ln_ * 8 + q_ * 4); }
    bf16x8 bw[8];
    if (ROUTE) { const float* gp_ = P.ln_mix_g + LAYER * D; const float* bp_ = P.ln_mix_b + LAYER * D;
        const int n_ = lane & 31, kh_ = lane >> 5, e_ = n_ & 15; const bool lo_ = n_ >= 16;
#pragma unroll
        for (int ks = 0; ks < 8; ++ks) { unsigned hw[8];
#pragma unroll
            for (int j = 0; j < 8; ++j) { const int k_ = 128 * wave + 16 * ks + 8 * kh_ + j; const float wv = gp_[k_] * P.router_w[k_ * 16 + e_]; const unsigned hb_ = cvt_pk_bf16(wv, 0.f) & 0xffffu;
                const float res_ = wv - __uint_as_float(hb_ << 16); hw[j] = lo_ ? (cvt_pk_bf16(res_, 0.f) & 0xffffu) : hb_; }
            const u32x4 pk_ = (u32x4){hw[0] | (hw[1] << 16), hw[2] | (hw[3] << 16), hw[4] | (hw[5] << 16), hw[6] | (hw[7] << 16)}; bw[ks] = __builtin_bit_cast(bf16x8, pk_); }
        { const int e2_ = tid & 15, part_ = tid >> 4; float s_ = 0.f, c_ = 0.f;
            for (int k_ = part_ * 32; k_ < part_ * 32 + 32; ++k_) { const float wr_ = P.router_w[k_ * 16 + e2_]; s_ += gp_[k_] * wr_; c_ += bp_[k_] * wr_; }
            ((LAS float*)(lds + O_PD))[part_ * 16 + e2_] = s_; ((LAS float*)(lds + O_PD))[512 + part_ * 16 + e2_] = c_; }
        __syncthreads();
        if (tid < 32) { const int e2_ = tid & 15; const int which_ = tid >> 4; float a_ = 0.f; for (int p_ = 0; p_ < 32; ++p_) a_ += ((LAS float*)(lds + O_PD))[which_ * 512 + p_ * 16 + e2_]; ((LAS float*)(lds + (which_ ? O_CE : O_SE)))[e2_] = a_; } }
    __syncthreads();
    bf16_t* Hb = (bf16_t*)(P.ws + WS_HB); const bf16_t* T = (const bf16_t*)(P.ws + WS_T); const unsigned char* YK = P.ws + WS_YK; float* RW = (float*)(P.ws + WS_RW); float* GLR = (float*)(P.ws + WS_GLR);
    u32x4 raw[4][2], ry[4][2];
#define LN_LDRAW(q0n) do { _Pragma("unroll") for (int j = 0; j < 4; ++j) { const int rr_ = (q0n) + j, rw_ = rr_ < r1 ? rr_ : r1 - 1; \
        _Pragma("unroll") for (int hf = 0; hf < 2; ++hf) { const size_t off_ = (size_t)rw_ * D + hf * 512 + lane * 8; \
            if (MIX) raw[j][hf] = *(const u32x4*)(T + off_); \
            else { raw[j][hf] = *(const u32x4*)(Hb + off_); const u32x2 y0_ = *(const u32x2*)(YK + off_), y1_ = *(const u32x2*)(YK + (size_t)M1 * D + off_); ry[j][hf] = (u32x4){y0_.x, y0_.y, y1_.x, y1_.y}; } } } } while (0)
    const int qend = ROUTE ? r0 + 32 * ((r1 - r0 + 31) / 32) : r1;
    if (ROUTE || r0 + 4 * wave < r1) LN_LDRAW(r0 + 4 * wave);
    for (int q0 = r0 + 4 * wave; q0 < qend; q0 += 32) {
        float x[4][16]; bool act[4]; int rows[4];
#pragma unroll
        for (int j = 0; j < 4; ++j) { const int rr = q0 + j; rows[j] = rr < r1 ? rr : r1 - 1; const int p = rows[j] % LB; act[j] = rr < r1 && !((MODE == 1 || MODE == 3) && p < NMETA); }
#pragma unroll
        for (int j = 0; j < 4; ++j)
#pragma unroll
            for (int hf = 0; hf < 2; ++hf) {
                if (MIX) { const u32x4 t = raw[j][hf];
                    x[j][hf * 8 + 0] = bflo(t.x); x[j][hf * 8 + 1] = bfhi(t.x); x[j][hf * 8 + 2] = bflo(t.y); x[j][hf * 8 + 3] = bfhi(t.y); x[j][hf * 8 + 4] = bflo(t.z); x[j][hf * 8 + 5] = bfhi(t.z); x[j][hf * 8 + 6] = bflo(t.w); x[j][hf * 8 + 7] = bfhi(t.w); }
                else { const u32x4 h = raw[j][hf], yy = ry[j][hf];
                    float a0[4], a1[4], b0[4], b1[4]; fp8x4_to_f32(yy.x, a0); fp8x4_to_f32(yy.y, a1); fp8x4_to_f32(yy.z, b0); fp8x4_to_f32(yy.w, b1);
                    constexpr float ys = 1.f / F8_YSCALE;
                    x[j][hf * 8 + 0] = bflo(h.x) * ALPHA + (a0[0] + b0[0]) * ys; x[j][hf * 8 + 1] = bfhi(h.x) * ALPHA + (a0[1] + b0[1]) * ys;
                    x[j][hf * 8 + 2] = bflo(h.y) * ALPHA + (a0[2] + b0[2]) * ys; x[j][hf * 8 + 3] = bfhi(h.y) * ALPHA + (a0[3] + b0[3]) * ys;
                    x[j][hf * 8 + 4] = bflo(h.z) * ALPHA + (a1[0] + b1[0]) * ys; x[j][hf * 8 + 5] = bfhi(h.z) * ALPHA + (a1[1] + b1[1]) * ys;
                    x[j][hf * 8 + 6] = bflo(h.w) * ALPHA + (a1[2] + b1[2]) * ys; x[j][hf * 8 + 7] = bfhi(h.w) * ALPHA + (a1[3] + b1[3]) * ys; } }
        if (ROUTE) {
#pragma unroll
            for (int j = 0; j < 4; ++j)
#pragma unroll
                for (int hf = 0; hf < 2; ++hf) *(LAS u32x4*)(lds + O_TL + (4 * wave + j) * TLP + hf * 1024 + lane * 16) = raw[j][hf]; }
        __builtin_amdgcn_sched_barrier(0);
        if (ROUTE || q0 + 32 < r1) LN_LDRAW(q0 + 32);
        float mean[4], rstd[4];
#pragma unroll
        for (int j = 0; j < 4; ++j) { float sm = 0.f;
#pragma unroll
            for (int i = 0; i < 16; ++i) sm += x[j][i];
            mean[j] = sm; }
#pragma unroll
        for (int o = 1; o < 64; o <<= 1) {
#pragma unroll
            for (int j = 0; j < 4; ++j) mean[j] += __shfl_xor(mean[j], o); }
#pragma unroll
        for (int j = 0; j < 4; ++j) { mean[j] *= (1.f / D); float s2 = 0.f;
#pragma unroll
            for (int i = 0; i < 16; ++i) { x[j][i] -= mean[j]; s2 += x[j][i] * x[j][i]; }
            rstd[j] = s2; }
#pragma unroll
        for (int o = 1; o < 64; o <<= 1) {
#pragma unroll
            for (int j = 0; j < 4; ++j) rstd[j] += __shfl_xor(rstd[j], o); }
#pragma unroll
        for (int j = 0; j < 4; ++j) rstd[j] = __builtin_amdgcn_rsqf(rstd[j] * (1.f / D) + LN_EPS);
        {
#pragma unroll
            for (int hf = 0; hf < 2; ++hf)
#pragma unroll
                for (int q = 0; q < 2; ++q) { const f32x4 g4 = ((const LAS f32x4*)(lds + O_GB))[(hf * 2 + q) * 64 + lane], b4 = ((const LAS f32x4*)(lds + O_GB))[256 + (hf * 2 + q) * 64 + lane];
#pragma unroll
                    for (int e = 0; e < 4; ++e)
#pragma unroll
                        for (int j = 0; j < 4; ++j) x[j][hf * 8 + q * 4 + e] = x[j][hf * 8 + q * 4 + e] * rstd[j] * g4[e] + b4[e]; } }
#pragma unroll
        for (int j = 0; j < 4; ++j) {
            if (act[j]) {
                if (MODE != 3) {
#pragma unroll
                    for (int hf = 0; hf < 2; ++hf) { u32x4 w; w.x = pk2(x[j][hf * 8], x[j][hf * 8 + 1]); w.y = pk2(x[j][hf * 8 + 2], x[j][hf * 8 + 3]); w.z = pk2(x[j][hf * 8 + 4], x[j][hf * 8 + 5]); w.w = pk2(x[j][hf * 8 + 6], x[j][hf * 8 + 7]);
                        *(u32x4*)(Hb + (size_t)rows[j] * D + hf * 512 + lane * 8) = w;
                        if (ROUTE || MODE == 2) { u32x2 w8; w8.x = pk4_fp8(x[j][hf * 8] * F8_HSCALE, x[j][hf * 8 + 1] * F8_HSCALE, x[j][hf * 8 + 2] * F8_HSCALE, x[j][hf * 8 + 3] * F8_HSCALE);
                            w8.y = pk4_fp8(x[j][hf * 8 + 4] * F8_HSCALE, x[j][hf * 8 + 5] * F8_HSCALE, x[j][hf * 8 + 6] * F8_HSCALE, x[j][hf * 8 + 7] * F8_HSCALE);
                            *(u32x2*)(P.ws + WS_HB8 + (size_t)rows[j] * D + hf * 512 + lane * 8) = w8; } } }
                else { const int b = rows[j] / LB, p = rows[j] - b * LB; float* orow = P.out + ((size_t)b * SEQ + (p - NMETA)) * D;
#pragma unroll
                    for (int hf = 0; hf < 2; ++hf)
#pragma unroll
                        for (int q = 0; q < 2; ++q) *(f32x4*)(orow + hf * 512 + lane * 8 + q * 4) = (f32x4){x[j][hf * 8 + q * 4], x[j][hf * 8 + q * 4 + 1], x[j][hf * 8 + q * 4 + 2], x[j][hf * 8 + q * 4 + 3]}; } } }
        if (ROUTE) {
            asm volatile("s_waitcnt lgkmcnt(0)\n\ts_barrier" ::: "memory");
            f32x16 dacc = f32x16{};
            { const LAS unsigned char* ap_ = lds + O_TL + (lane & 31) * TLP + (128 * wave + 8 * (lane >> 5)) * 2;
#pragma unroll
                for (int ks = 0; ks < 8; ++ks) { const bf16x8 a_ = *(const LAS bf16x8*)(ap_ + ks * 32); dacc = __builtin_amdgcn_mfma_f32_32x32x16_bf16(a_, bw[ks], dacc, 0, 0, 0); } }
            { LAS float* pd_ = (LAS float*)(lds + O_PD) + wave * 1024 + (lane & 31);
#pragma unroll
                for (int r = 0; r < 16; ++r) pd_[(((r & 3) + 8 * (r >> 2)) + 4 * (lane >> 5)) * 32] = dacc[r]; }
            if (lane == 0) {
#pragma unroll
                for (int j = 0; j < 4; ++j) { ((LAS float*)(lds + O_ST))[(4 * wave + j) * 2] = mean[j]; ((LAS float*)(lds + O_ST))[(4 * wave + j) * 2 + 1] = rstd[j]; } }
            asm volatile("s_waitcnt lgkmcnt(0)\n\ts_barrier" ::: "memory");
            { const int rw_ = 4 * wave + (lane >> 4), e_ = lane & 15; const LAS float* pd_ = (const LAS float*)(lds + O_PD) + rw_ * 32 + e_; float pre = 0.f;
#pragma unroll
                for (int w_ = 0; w_ < 8; ++w_) pre += pd_[w_ * 1024] + pd_[w_ * 1024 + 16];
                const float mr_ = ((const LAS float*)(lds + O_ST))[rw_ * 2], rs_ = ((const LAS float*)(lds + O_ST))[rw_ * 2 + 1];
                lgs[lane] = rs_ * (pre - mr_ * ((const LAS float*)(lds + O_SE))[e_]) + ((const LAS float*)(lds + O_CE))[e_]; }
            asm volatile("s_waitcnt lgkmcnt(0)" ::: "memory");
            { const int j = lane >> 4; float lg[16];
#pragma unroll
                for (int e4 = 0; e4 < 4; ++e4) { const f32x4 t4 = *(const LAS f32x4*)(lgs + j * 16 + e4 * 4); lg[e4 * 4] = t4.x; lg[e4 * 4 + 1] = t4.y; lg[e4 * 4 + 2] = t4.z; lg[e4 * 4 + 3] = t4.w; }
                int e0, e1; float w0, w1; route16(lg, P.router_bias, e0, e1, w0, w1);
                bool a_ = false;
#pragma unroll
                for (int jj = 0; jj < 4; ++jj) a_ = (jj == j) ? act[jj] : a_;
                if (a_ && (lane & 15) == 0) { const int row = q0 + j; const int li0 = atomicAdd((int*)&lcnt[e0], 1), li1 = atomicAdd((int*)&lcnt[e1], 1);
                    ent[2 * (row - r0)] = e0 | (li0 << 8); ent[2 * (row - r0) + 1] = e1 | (li1 << 8); entw[2 * (row - r0)] = w0; entw[2 * (row - r0) + 1] = w1; }
                asm volatile("s_waitcnt lgkmcnt(0)" ::: "memory"); }
        }
        if (MODE == 2) {
            float fin[2];
#define LN_DPP(v_, ctrl_) __builtin_bit_cast(float, __builtin_amdgcn_update_dpp(0, __builtin_bit_cast(int, (v_)), (ctrl_), 0xf, 0xf, false))
#pragma unroll
            for (int h8 = 0; h8 < 2; ++h8) {
                f32x2 v2[16];
#pragma unroll
                for (int i = 0; i < 16; ++i) v2[i] = (f32x2){0.f, 0.f};
#pragma unroll
                for (int hf = 0; hf < 2; ++hf)
#pragma unroll
                    for (int i = 0; i < 8; ++i) { const LAS f32x4* wp = (const LAS f32x4*)(lds + (hf * 512 + i * 64 + lane) * LN_WROW + h8 * 32); const f32x4 wa = wp[0], wb = wp[1];
                        const f32x2 w0 = (f32x2){wa.x, wa.y}, w1 = (f32x2){wa.z, wa.w}, w2 = (f32x2){wb.x, wb.y}, w3 = (f32x2){wb.z, wb.w};
#pragma unroll
                        for (int j = 0; j < 4; ++j) { const float hv = x[j][hf * 8 + i]; const f32x2 h2 = (f32x2){hv, hv};
                            v2[j * 4] = __builtin_elementwise_fma(h2, w0, v2[j * 4]); v2[j * 4 + 1] = __builtin_elementwise_fma(h2, w1, v2[j * 4 + 1]);
                            v2[j * 4 + 2] = __builtin_elementwise_fma(h2, w2, v2[j * 4 + 2]); v2[j * 4 + 3] = __builtin_elementwise_fma(h2, w3, v2[j * 4 + 3]); } }
                float v[32];
#pragma unroll
                for (int i = 0; i < 16; ++i) { v[2 * i] = v2[i].x; v[2 * i + 1] = v2[i].y; }
#pragma unroll
                for (int i = 0; i < 16; ++i) { const auto r = __builtin_amdgcn_permlane32_swap(__float_as_uint(v[i]), __float_as_uint(v[i + 16]), false, false); const unsigned r0 = r[0], r1 = r[1];
                    v[i] = __uint_as_float(r0) + __uint_as_float(r1); }
#pragma unroll
                for (int i = 0; i < 8; ++i) { const auto r = __builtin_amdgcn_permlane16_swap(__float_as_uint(v[i]), __float_as_uint(v[i + 8]), false, false); const unsigned r0 = r[0], r1 = r[1];
                    v[i] = __uint_as_float(r0) + __uint_as_float(r1); }
                const bool b3 = (lane & 8) != 0, b2 = (lane & 4) != 0, b1 = (lane & 2) != 0;
#pragma unroll
                for (int i = 0; i < 4; ++i) { const float keep = b3 ? v[i + 4] : v[i], send = b3 ? v[i] : v[i + 4]; v[i] = keep + LN_DPP(send, 0x128); }
#pragma unroll
                for (int i = 0; i < 2; ++i) { const float keep = b2 ? v[i + 2] : v[i], send = b2 ? v[i] : v[i + 2]; v[i] = keep + LN_DPP(send, 0x141); }
                { const float keep = b1 ? v[1] : v[0], send = b1 ? v[0] : v[1]; v[0] = keep + LN_DPP(send, 0x1b); }
                v[0] += LN_DPP(v[0], 0xb1);
                fin[h8] = v[0];
                __builtin_amdgcn_sched_barrier(0);
            }
#undef LN_DPP
            const int oute = (lane & 1) * 8 + ((lane >> 1) & 7); const float outv = (lane & 1) ? fin[1] : fin[0];
            if (MODE != 2) { lgs[(lane >> 4) * 16 + oute] = outv; asm volatile("s_waitcnt lgkmcnt(0)" ::: "memory"); }
            if (MODE == 2) { const int j = lane >> 4; bool a_ = false;
#pragma unroll
                for (int jj = 0; jj < 4; ++jj) a_ = (jj == j) ? act[jj] : a_;
                if (a_) GLR[(size_t)(q0 + j) * 16 + oute] = outv; }
            else {
                const int j = lane >> 4; float lg[16];
#pragma unroll
                for (int e4 = 0; e4 < 4; ++e4) { const f32x4 t4 = *(const LAS f32x4*)(lgs + j * 16 + e4 * 4); lg[e4 * 4] = t4.x; lg[e4 * 4 + 1] = t4.y; lg[e4 * 4 + 2] = t4.z; lg[e4 * 4 + 3] = t4.w; }
                int e0, e1; float w0, w1; route16(lg, P.router_bias, e0, e1, w0, w1);
                bool a_ = false;
#pragma unroll
                for (int jj = 0; jj < 4; ++jj) a_ = (jj == j) ? act[jj] : a_;
                if (a_ && (lane & 15) == 0) { const int row = q0 + j; const int li0 = atomicAdd((int*)&lcnt[e0], 1), li1 = atomicAdd((int*)&lcnt[e1], 1);
                    ent[2 * (row - r0)] = e0 | (li0 << 8); ent[2 * (row - r0) + 1] = e1 | (li1 << 8); entw[2 * (row - r0)] = w0; entw[2 * (row - r0) + 1] = w1; }
                asm volatile("s_waitcnt lgkmcnt(0)" ::: "memory");
            }
        }
    }
    if (ROUTE) {
        __syncthreads();
        unsigned* gcnt = (unsigned*)(P.ws + WS_CTL) + CW_CNT + 64 * LAYER;
        if (tid < 16) lbase[tid] = (int)atomicAdd(gcnt + tid, (unsigned)lcnt[tid]);
        __syncthreads();
        int* list = (int*)(P.ws + WS_LIST); float* listw = (float*)(P.ws + WS_LISTW);
        for (int i = tid; i < 2 * (r1 - r0); i += 512) { const int en = ent[i]; if (en >= 0) { const int e = en & 0xff, li = en >> 8; const size_t at = (size_t)e * LISTCAP + lbase[e] + li; list[at] = (r0 + (i >> 1)) * 2 + (i & 1); listw[at] = entw[i]; } }
    }
    __syncthreads();
}

__device__ __forceinline__ void attn_naive_item(const Ptrs& P, int row, int h, LAS float* qs, int lane) {
    const bf16_t* Z = (const bf16_t*)(P.ws + WS_Z); bf16_t* A2m = (bf16_t*)(P.ws + WS_A2M);
    const int b = row / LB, p = row - b * LB, rowb = b * LB;
    const bf16_t* zq = Z + (size_t)row * EVEN_IN + 512 + h * 128;
    qs[lane] = bf2f(zq[lane]); qs[64 + lane] = bf2f(zq[64 + lane]);
    asm volatile("s_waitcnt lgkmcnt(0)" ::: "memory");
    const float slope2 = exp2f(-2.f * (float)(h + 1)) * LOG2E;
    float m0 = -INFINITY, m1 = -INFINITY, l0 = 0.f, l1 = 0.f, o00 = 0.f, o01 = 0.f, o10 = 0.f, o11 = 0.f;
    for (int j0 = 0; j0 <= p; j0 += 64) {
        const int j = j0 + lane; const bool valid = j <= p; float s0 = -INFINITY, s1 = -INFINITY;
        if (valid) { const u32x4* kr = (const u32x4*)(Z + (size_t)(rowb + j) * EVEN_IN + 1024 + h * 128); float d0 = 0.f, d1 = 0.f;
#pragma unroll
            for (int c = 0; c < 8; ++c) { const u32x4 kv = kr[c]; const LAS float* q = qs + 8 * c;
                d0 += q[0] * bflo(kv.x) + q[1] * bfhi(kv.x) + q[2] * bflo(kv.y) + q[3] * bfhi(kv.y) + q[4] * bflo(kv.z) + q[5] * bfhi(kv.z) + q[6] * bflo(kv.w) + q[7] * bfhi(kv.w); }
#pragma unroll
            for (int c = 8; c < 16; ++c) { const u32x4 kv = kr[c]; const LAS float* q = qs + 8 * c;
                d1 += q[0] * bflo(kv.x) + q[1] * bfhi(kv.x) + q[2] * bflo(kv.y) + q[3] * bfhi(kv.y) + q[4] * bflo(kv.z) + q[5] * bfhi(kv.z) + q[6] * bflo(kv.w) + q[7] * bfhi(kv.w); }
            const float bias = -slope2 * (float)(p - j); s0 = d0 + bias; s1 = d1 + bias; }
        const float mn0 = fmaxf(m0, wave_max(s0)), mn1 = fmaxf(m1, wave_max(s1));
        const float f0 = exp2f(m0 - mn0), f1 = exp2f(m1 - mn1);
        const float p0 = valid ? exp2f(s0 - mn0) : 0.f, p1 = valid ? exp2f(s1 - mn1) : 0.f;
        l0 = l0 * f0 + wave_sum(p0); l1 = l1 * f1 + wave_sum(p1); o00 *= f0; o01 *= f0; o10 *= f1; o11 *= f1; m0 = mn0; m1 = mn1;
        const int nk = (p - j0 + 1) < 64 ? (p - j0 + 1) : 64;
        const bf16_t* vr = Z + (size_t)(rowb + j0) * EVEN_IN + 1536 + h * 128 + lane;
        for (int jj = 0; jj < nk; ++jj) { const float a0 = __shfl(p0, jj), a1 = __shfl(p1, jj); const float v0 = bf2f(vr[(size_t)jj * EVEN_IN]), v1 = bf2f(vr[(size_t)jj * EVEN_IN + 64]);
            o00 += a0 * v0; o01 += a0 * v1; o10 += a1 * v0; o11 += a1 * v1; }
    }
    const float lam = ((const float*)(P.ws + WS_MISC))[0];
    const float a0 = o00 / l0 - lam * o10 / l1, a1 = o01 / l0 - lam * o11 / l1;
    const float r = 1.f / sqrtf(wave_sum(a0 * a0 + a1 * a1) * (1.f / 128.f) + RMS_EPS);
    bf16_t* o = A2m + (size_t)(b * NMETA + p) * D + 512 + h * 128;
    o[lane] = (bf16_t)f2bf(a0 * r * P.subln[lane] * (1.f - LAMBDA_INIT)); o[64 + lane] = (bf16_t)f2bf(a1 * r * P.subln[64 + lane] * (1.f - LAMBDA_INIT));
}

namespace att {
typedef short s16x4 __attribute__((ext_vector_type(4)));
typedef short v4i16_t __attribute__((ext_vector_type(4)));
constexpr int KSLOT = 8192, VSLOT = 16384, NBUF = 2;
constexpr int LDS_K = 0, LDS_V = NBUF * KSLOT, LDS_WS = LDS_V + NBUF * VSLOT, LDS_OST = LDS_WS + 2048, LDS_TOTAL = LDS_OST + 8 * 8192;
static_assert(LDS_TOTAL <= 131072, "attention LDS");
constexpr float THR = 8.f;
__device__ __forceinline__ int crow(int r, int hi) { return (r & 3) + 8 * (r >> 2) + 4 * hi; }
__device__ __forceinline__ float swapmax(float v) { auto rr = __builtin_amdgcn_permlane32_swap(__float_as_uint(v), __float_as_uint(v), false, false); return fmaxf(__uint_as_float(rr[0]), __uint_as_float(rr[1])); }
__device__ __forceinline__ float swapsum(float v) { auto rr = __builtin_amdgcn_permlane32_swap(__float_as_uint(v), __float_as_uint(v), false, false); return __uint_as_float(rr[0]) + __uint_as_float(rr[1]); }
#define VTR_A(dst, base, off) asm volatile("ds_read_b64_tr_b16 %0, %1 offset:%2" : "=v"(dst) : "v"(base), "n"(off))
#define VTR_WAIT(n, a, b) asm volatile("s_waitcnt lgkmcnt(%2)" : "+v"(a), "+v"(b) : "n"(n))
__device__ __forceinline__ s16x4 vtr(const LAS unsigned char* p) { return __builtin_bit_cast(s16x4, __builtin_amdgcn_ds_read_tr16_b64_v4i16((LAS v4i16_t*)p)); }

__device__ __forceinline__ void glds16(const void* gsrc, unsigned lds_dst) { unsigned keep;
    asm volatile("s_mov_b32 %0, m0\n\ts_mov_b32 m0, %2\n\ts_nop 0\n\tglobal_load_lds_dwordx4 %1, off\n\ts_mov_b32 m0, %0" : "=&s"(keep) : "v"(gsrc), "s"(lds_dst) : "memory"); }
#define ATT_WAITBAR() asm volatile("s_waitcnt vmcnt(0) lgkmcnt(0)\n\ts_barrier" ::: "memory")
#define ATT_WAITBAR_N(n) asm volatile("s_waitcnt vmcnt(" #n ") lgkmcnt(0)\n\ts_barrier" ::: "memory")
constexpr int PD = 3, K4 = PD + 1, V3 = PD + 2;
constexpr int L2_K = 0, L2_V = K4 * KSLOT, L2_WS = L2_V + V3 * VSLOT, L2_TOTAL = L2_WS + 2048, L2_OST = 0;
static_assert(L2_TOTAL + 128 <= 131072 && 8 * 8192 <= L2_WS, "attention v2 LDS");
__device__ __forceinline__ unsigned short bfr(float f) { return (unsigned short)f2bf(f); }
__device__ __forceinline__ void attn_unit(const Ptrs& P, LAS unsigned char* lds, int b, int vh, int qb) {
    const int tid = tid_opaque(P), lane = tid & 63, r32 = lane & 31, hi = lane >> 5; const int wid = __builtin_amdgcn_readfirstlane(tid >> 6);
    const bf16_t* Z = (const bf16_t*)(P.ws + WS_Z); bf16_t* Ob = (bf16_t*)(P.ws + WS_OA);
    const int rowb = b * LB, hd = vh >> 1;
    const int qrow0 = rowb + NMETA + 256 * qb + 32 * wid;
    const bf16_t* Kc = Z + 1024 + vh * 64; const bf16_t* Vc = Z + 1536 + hd * 128;
    const float slope2 = __uint_as_float(__builtin_amdgcn_readfirstlane(__float_as_uint(exp2f(-2.f * (float)(hd + 1)) * LOG2E)));
    LAS float* wsf = (LAS float*)(lds + L2_WS) + wid * 64;
    bf16x8 qr[4];
    { const bf16_t* qp = Z + (size_t)(qrow0 + r32) * EVEN_IN + 512 + vh * 64 + hi * 8;
#pragma unroll
        for (int ks = 0; ks < 4; ++ks) qr[ks] = *(const bf16x8*)(qp + ks * 16); }
#define ATT_KROW0(i) (((i) >= NR) ? rowb : rowb + NMETA + 64 * (4 * qb + 3 - (i)))
#define ATT_PK0(i) (((i) >= NR) ? 0 : NMETA + 64 * (4 * qb + 3 - (i)))
#define ATT_DMA(i) do { const int kr0_ = ATT_KROW0(i); const int ks_ = (i) % K4, vs_ = (i) % V3; \
        glds16(Kc + (size_t)(kr0_ + krow_) * EVEN_IN + kchk_ * 8, (unsigned)__builtin_amdgcn_readfirstlane((int)(lds0 + L2_K + ks_ * KSLOT + wid * 1024))); \
        _Pragma("unroll") for (int i_ = 0; i_ < 2; ++i_) { const int pc_ = wid * 2 + i_, db_ = pc_ >> 2, rg_ = pc_ & 3; \
            glds16(Vc + (size_t)(kr0_ + 16 * rg_ + (lane >> 2)) * EVEN_IN + db_ * 32 + (lane & 3) * 8, (unsigned)__builtin_amdgcn_readfirstlane((int)(lds0 + L2_V + vs_ * VSLOT + pc_ * 1024))); } } while (0)
    const unsigned lds0 = (unsigned)(size_t)lds;
    const int krow_ = 8 * wid + (lane >> 3), kchk_ = (lane & 7) ^ ((krow_ >> 1) & 7);
    int koff[4];
#pragma unroll
    for (int ks = 0; ks < 4; ++ks) koff[ks] = r32 * 128 + (((2 * ks + hi) ^ ((r32 >> 1) & 7)) << 4);
    int NR = 1 << 30, NT;
    ATT_DMA(0); ATT_DMA(1); ATT_DMA(2);
    { float qs = 0.f;
#pragma unroll
        for (int ks = 0; ks < 4; ++ks) { const u32x4 w = __builtin_bit_cast(u32x4, qr[ks]);
#pragma unroll
            for (int j = 0; j < 4; ++j) { const float a_ = bflo(w[j]), b_ = bfhi(w[j]); qs += a_ * a_ + b_ * b_; } }
        qs = swapsum(qs);
#pragma unroll
        for (int o_ = 1; o_ < 32; o_ <<= 1) qs = fmaxf(qs, __shfl_xor(qs, o_));
        if (lane == 0) wsf[0] = qs;
        ATT_WAITBAR();
        float q2 = 0.f;
#pragma unroll
        for (int w_ = 0; w_ < 8; ++w_) q2 = fmaxf(q2, ((LAS float*)(lds + L2_WS))[w_ * 64]);
        const unsigned* kn = (const unsigned*)(P.ws + WS_CTL) + CW_KN;
        const int kl_ = lane < 6 ? lane : 0; const unsigned kw_ = __hip_atomic_load(kn + (kl_ < 2 ? (b * 8 + vh) * 2 + kl_ : 64 + vh * 4 + (kl_ - 2)), __ATOMIC_RELAXED, __HIP_MEMORY_SCOPE_AGENT);
        const float k2r = __uint_as_float(__builtin_amdgcn_readlane(kw_, 0)) + __uint_as_float(__builtin_amdgcn_readlane(kw_, 1));
        const float k2m = __uint_as_float(__builtin_amdgcn_readlane(kw_, 2)) + __uint_as_float(__builtin_amdgcn_readlane(kw_, 3)) + __uint_as_float(__builtin_amdgcn_readlane(kw_, 4)) + __uint_as_float(__builtin_amdgcn_readlane(kw_, 5));
        const float QK = sqrtf(q2 * fmaxf(k2r, k2m) * 1.02f) * 1.01f + 1.f;
        const float dist = (151.f + 2.f * QK) / slope2;
        int tskip = (int)floorf(((float)(256 * qb - 63) - dist) * (1.f / 64.f)); tskip = tskip < -1 ? -1 : tskip;
        NR = 4 * qb + 3 - tskip; const bool hasm = (float)(NMETA + 256 * qb - 15) <= dist;
        NR = __builtin_amdgcn_readfirstlane(NR); NT = NR + (__builtin_amdgcn_readfirstlane((int)hasm) ? 1 : 0); }
    const int qrel = 32 * wid + r32, pq = NMETA + 256 * qb + qrel;
    float l = 0.f, cin = 0.f;
#define ATT_SETC() do { } while (0)
    f32x16 o[4];
#pragma unroll
    for (int d = 0; d < 4; ++d) o[d] = f32x16{};
    u32x4 pw[4];
    f32x16 p0, p1;
    const LAS unsigned char* vpl = lds + L2_V + ((lane >> 4) & 1) * 32 + (lane & 3) * 8 + (4 * hi + ((lane & 15) >> 2)) * 64;
#define ATT_QK(i) do { bf16x8 kf_[8];     \
        { const LAS unsigned char* kb_ = lds + L2_K + ((i) % K4) * KSLOT; \
          _Pragma("unroll") for (int ks = 0; ks < 4; ++ks) { kf_[2 * ks] = *(const LAS bf16x8*)(kb_ + koff[ks]); kf_[2 * ks + 1] = *(const LAS bf16x8*)(kb_ + koff[ks] + 4096); } } \
        __builtin_amdgcn_sched_barrier(0); \
        { const float cl_ = slope2 * (float)(ATT_PK0(i) + 4 * hi - pq) + cin, s32_ = 32.f * slope2; \
          _Pragma("unroll") for (int r = 0; r < 16; ++r) { p0[r] = fmaf(slope2, (float)((r & 3) + 8 * (r >> 2)), cl_); p1[r] = p0[r] + s32_; } } \
        _Pragma("unroll") for (int ks = 0; ks < 4; ++ks) { \
            p0 = __builtin_amdgcn_mfma_f32_32x32x16_bf16(kf_[2 * ks], qr[ks], p0, 0, 0, 0); p1 = __builtin_amdgcn_mfma_f32_32x32x16_bf16(kf_[2 * ks + 1], qr[ks], p1, 0, 0, 0); } \
        if ((i) < 4 || (i) >= NR) { const int lim_ = (((i) >= NR) ? 15 : qrel - 64 * (3 - (i))) - 4 * hi;     \
            _Pragma("unroll") for (int r = 0; r < 16; ++r) { const int kv = (r & 3) + 8 * (r >> 2); if (kv > lim_) p0[r] = -INFINITY; if (kv + 32 > lim_) p1[r] = -INFINITY; } } } while (0)
#define ATT_PV(vslot) do { const LAS unsigned char* vp_ = vpl + (vslot) * VSLOT; \
        _Pragma("unroll") for (int s2_ = 0; s2_ < 4; ++s2_) { s16x4 vq_[8]; \
            _Pragma("unroll") for (int d = 0; d < 4; ++d) { vq_[2 * d] = vtr(vp_ + d * 4096 + s2_ * 1024); vq_[2 * d + 1] = vtr(vp_ + d * 4096 + s2_ * 1024 + 512); } \
            _Pragma("unroll") for (int d = 0; d < 4; ++d) { const bf16x8 vf = (bf16x8){vq_[2 * d][0], vq_[2 * d][1], vq_[2 * d][2], vq_[2 * d][3], vq_[2 * d + 1][0], vq_[2 * d + 1][1], vq_[2 * d + 1][2], vq_[2 * d + 1][3]}; \
                o[d] = __builtin_amdgcn_mfma_f32_32x32x16_bf16(__builtin_bit_cast(bf16x8, pw[s2_]), vf, o[d], 0, 0, 0); } } } while (0)
#define ATT_ROWMAX(mx) do { float a_ = fmaxf(p0[0], p1[0]); _Pragma("unroll") for (int r = 1; r < 16; ++r) a_ = fmaxf(a_, fmaxf(p0[r], p1[r])); mx = swapmax(a_); } while (0)
#define ATT_IMAX(im) do { int a_ = __float_as_int(p0[0]); _Pragma("unroll") for (int r = 1; r < 16; ++r) { const int b_ = __float_as_int(p0[r]); a_ = a_ > b_ ? a_ : b_; } \
        _Pragma("unroll") for (int r = 0; r < 16; ++r) { const int b_ = __float_as_int(p1[r]); a_ = a_ > b_ ? a_ : b_; } im = a_; } while (0)
#define ATT_EXP_PACK() do { float sacc = 0.f; \
        _Pragma("unroll") for (int r = 0; r < 16; ++r) { p0[r] = __builtin_amdgcn_exp2f(p0[r]); p1[r] = __builtin_amdgcn_exp2f(p1[r]); sacc += p0[r] + p1[r]; } \
        l += sacc; \
        _Pragma("unroll") for (int j = 0; j < 4; ++j) { pw[0][j] = cvt_pk_bf16(p0[2 * j], p0[2 * j + 1]); pw[1][j] = cvt_pk_bf16(p0[8 + 2 * j], p0[8 + 2 * j + 1]); \
            pw[2][j] = cvt_pk_bf16(p1[2 * j], p1[2 * j + 1]); pw[3][j] = cvt_pk_bf16(p1[8 + 2 * j], p1[8 + 2 * j + 1]); } } while (0)
    f32x16 q0, q1;
    ATT_WAITBAR_N(6);
    ATT_QK(0);
    { float mx; ATT_ROWMAX(mx); const float d0 = fmaxf(mx, -256.f); cin -= d0;
#pragma unroll
        for (int r = 0; r < 16; ++r) { p0[r] = __builtin_amdgcn_exp2f(p0[r] - d0); p1[r] = __builtin_amdgcn_exp2f(p1[r] - d0); } }
#define ATT_PACK4(O0, O1, g) do { const int b_ = (((g) >> 1) * 8 + ((g) & 1) * 4) & 15; \
        if ((g) < 4) { pw[(g) >> 1][2 * ((g) & 1)] = cvt_pk_bf16(O0[b_], O0[b_ + 1]); pw[(g) >> 1][2 * ((g) & 1) + 1] = cvt_pk_bf16(O0[b_ + 2], O0[b_ + 3]); sacc += (O0[b_] + O0[b_ + 1]) + (O0[b_ + 2] + O0[b_ + 3]); } \
        else { pw[(g) >> 1][2 * ((g) & 1)] = cvt_pk_bf16(O1[b_], O1[b_ + 1]); pw[(g) >> 1][2 * ((g) & 1) + 1] = cvt_pk_bf16(O1[b_ + 2], O1[b_ + 3]); sacc += (O1[b_] + O1[b_ + 1]) + (O1[b_ + 2] + O1[b_ + 3]); } \
        asm volatile("" : "+v"(pw[(g) >> 1][2 * ((g) & 1)]), "+v"(pw[(g) >> 1][2 * ((g) & 1) + 1]), "+v"(sacc)); } while (0)
#define ATT_STEP(i, N0, N1, O0, O1) do { \
        { bf16x8 kf_[8]; float sacc = 0.f; \
          { const LAS unsigned char* kb_ = lds + L2_K + ((i) % K4) * KSLOT; \
            _Pragma("unroll") for (int ks = 0; ks < 4; ++ks) { kf_[2 * ks] = *(const LAS bf16x8*)(kb_ + koff[ks]); kf_[2 * ks + 1] = *(const LAS bf16x8*)(kb_ + koff[ks] + 4096); } } \
          __builtin_amdgcn_sched_barrier(0); \
          { const float cl_ = slope2 * (float)(ATT_PK0(i) + 4 * hi - pq) + cin, s32_ = 32.f * slope2; \
            _Pragma("unroll") for (int r = 0; r < 16; ++r) { N0[r] = fmaf(slope2, (float)((r & 3) + 8 * (r >> 2)), cl_); N1[r] = N0[r] + s32_; } } \
          _Pragma("unroll") for (int ks = 0; ks < 4; ++ks) { \
              N0 = __builtin_amdgcn_mfma_f32_32x32x16_bf16(kf_[2 * ks], qr[ks], N0, 0, 0, 0); ATT_PACK4(O0, O1, 2 * ks); __builtin_amdgcn_sched_barrier(0); \
              N1 = __builtin_amdgcn_mfma_f32_32x32x16_bf16(kf_[2 * ks + 1], qr[ks], N1, 0, 0, 0); ATT_PACK4(O0, O1, 2 * ks + 1); __builtin_amdgcn_sched_barrier(0); } \
          l += sacc; \
          if ((i) < 4 || (i) >= NR) { const int lim_ = (((i) >= NR) ? 15 : qrel - 64 * (3 - (i))) - 4 * hi; \
              _Pragma("unroll") for (int r = 0; r < 16; ++r) { const int kv = (r & 3) + 8 * (r >> 2); if (kv > lim_) N0[r] = -INFINITY; if (kv + 32 > lim_) N1[r] = -INFINITY; } } } \
        unsigned vp_ = (unsigned)(size_t)vpl + (unsigned)((((i) - 1) % V3) * VSLOT); asm volatile("" : "+v"(vp_)); \
        s16x4 vq[2][8]; \
        _Pragma("unroll") for (int d = 0; d < 4; ++d) { VTR_A(vq[0][2 * d], vp_, d * 4096); VTR_A(vq[0][2 * d + 1], vp_, d * 4096 + 512); } \
        __builtin_amdgcn_sched_barrier(0); \
        int imx; { int a_ = __float_as_int(N0[0]); _Pragma("unroll") for (int r = 1; r < 16; ++r) { const int b_ = __float_as_int(N0[r]); a_ = a_ > b_ ? a_ : b_; } \
            _Pragma("unroll") for (int r = 0; r < 16; ++r) { const int b_ = __float_as_int(N1[r]); a_ = a_ > b_ ? a_ : b_; } imx = a_; } \
        if (__any(imx > __builtin_bit_cast(int, THR))) { \
            float mx; { float a_ = fmaxf(N0[0], N1[0]); _Pragma("unroll") for (int r = 1; r < 16; ++r) a_ = fmaxf(a_, fmaxf(N0[r], N1[r])); mx = swapmax(a_); } \
            const float dl = ceilf(fmaxf(mx, 0.f)), f = __builtin_amdgcn_exp2f(-dl); cin -= dl; l *= f; \
            if (hi == 0) wsf[r32] = f; \
            asm volatile("s_waitcnt lgkmcnt(0)" ::: "memory"); \
            _Pragma("unroll") for (int r = 0; r < 16; ++r) { const float fr_ = wsf[crow(r, hi)]; N0[r] -= dl; N1[r] -= dl; \
                _Pragma("unroll") for (int d = 0; d < 4; ++d) o[d][r] *= fr_; } \
            const unsigned du = (unsigned)dl; \
            _Pragma("unroll") for (int s2_ = 0; s2_ < 4; ++s2_) _Pragma("unroll") for (int j = 0; j < 4; ++j) { const unsigned w = pw[s2_][j]; unsigned lo = w & 0xffffu, hh = w >> 16; \
                    lo = (((lo >> 7) & 0xffu) > du) ? lo - (du << 7) : 0u; hh = (((hh >> 7) & 0xffu) > du) ? hh - (du << 7) : 0u; pw[s2_][j] = lo | (hh << 16); } \
        } \
        _Pragma("unroll") for (int s2_ = 0; s2_ < 4; ++s2_) { \
            if (s2_ < 3) { _Pragma("unroll") for (int d = 0; d < 4; ++d) { VTR_A(vq[(s2_ + 1) & 1][2 * d], vp_, d * 4096 + (s2_ + 1) * 1024); VTR_A(vq[(s2_ + 1) & 1][2 * d + 1], vp_, d * 4096 + (s2_ + 1) * 1024 + 512); } } \
            __builtin_amdgcn_sched_barrier(0); \
            _Pragma("unroll") for (int d = 0; d < 4; ++d) { VTR_WAIT((s2_ < 3 ? 8 : 0) + 6 - 2 * d, vq[s2_ & 1][2 * d], vq[s2_ & 1][2 * d + 1]); \
                const s16x4 lo = vq[s2_ & 1][2 * d], h4 = vq[s2_ & 1][2 * d + 1]; \
                const bf16x8 vf = (bf16x8){lo[0], lo[1], lo[2], lo[3], h4[0], h4[1], h4[2], h4[3]}; \
                o[d] = __builtin_amdgcn_mfma_f32_32x32x16_bf16(__builtin_bit_cast(bf16x8, pw[s2_]), vf, o[d], 0, 0, 0); \
                const int e_ = s2_ * 4 + d; \
                if (e_ < 8) { float x0_ = __builtin_amdgcn_exp2f(N0[2 * e_]), x1_ = __builtin_amdgcn_exp2f(N0[2 * e_ + 1]); asm volatile("" : "+v"(x0_), "+v"(x1_)); N0[2 * e_] = x0_; N0[2 * e_ + 1] = x1_; }     \
                else { float x0_ = __builtin_amdgcn_exp2f(N1[(2 * e_) & 15]), x1_ = __builtin_amdgcn_exp2f(N1[(2 * e_ + 1) & 15]); asm volatile("" : "+v"(x0_), "+v"(x1_)); N1[(2 * e_) & 15] = x0_; N1[(2 * e_ + 1) & 15] = x1_; } } \
            __builtin_amdgcn_sched_barrier(0); } } while (0)
    { int i = 1;
        for (; i + 1 < NT; i += 2) { ATT_WAITBAR_N(0); if (i + 2 < NT) ATT_DMA(i + 2); if (i + 3 < NT) ATT_DMA(i + 3);
            ATT_STEP(i, q0, q1, p0, p1); ATT_STEP(i + 1, p0, p1, q0, q1); }
        if (i < NT) { ATT_WAITBAR_N(0); ATT_STEP(i, q0, q1, p0, p1); float sacc = 0.f;
#pragma unroll
            for (int g = 0; g < 8; ++g) ATT_PACK4(q0, q1, g);
            l += sacc; }
        else { float sacc = 0.f;
#pragma unroll
            for (int g = 0; g < 8; ++g) ATT_PACK4(p0, p1, g);
            l += sacc; } }
#undef ATT_STEP
#undef ATT_PACK4
    ATT_PV((NT - 1) % V3);
    l = swapsum(l);
    if (hi == 0) wsf[32 + r32] = l;
    ATT_WAITBAR();
    LAS bf16_t* stg = (LAS bf16_t*)(lds + L2_OST + wid * 8192);
    int lane_e = lane; asm volatile("" : "+v"(lane_e));
    const int r32e = lane_e & 31, hie = lane_e >> 5;
#pragma unroll
    for (int r = 0; r < 16; ++r) { const int orow = crow(r, hie); const float rl = 1.f / wsf[32 + orow];
#pragma unroll
        for (int d = 0; d < 4; ++d) stg[orow * 128 + d * 32 + r32e] = (bf16_t)f2bf(o[d][r] * rl); }
    asm volatile("s_waitcnt lgkmcnt(0)" ::: "memory");
#pragma unroll
    for (int i = 0; i < 8; ++i) { const int row = i * 4 + (lane_e >> 4), ch = lane_e & 15; const u32x4 v = *(const LAS u32x4*)(stg + row * 128 + ch * 8);
        *(u32x4*)(Ob + (size_t)(qrow0 + row) * D + vh * 128 + ch * 8) = v; }
    ATT_WAITBAR();
#undef ATT_DMA
#undef ATT_KROW0
#undef ATT_PK0
#undef ATT_QK
#undef ATT_PV
#undef ATT_ROWMAX
#undef ATT_IMAX
#undef ATT_EXP_PACK
#undef ATT_SETC
}
}

__device__ __forceinline__ void stage_attn(const Ptrs& P, LAS unsigned char* lds, int wg, int nwg, int flags) {
    const int tid_ = tid_opaque(P); const int lane = tid_ & 63, wave = __builtin_amdgcn_readfirstlane(tid_ >> 6);
    if (!(flags & 2)) { LAS float* qs = (LAS float*)(lds) + wave * 128;
        for (int it = wg * 8 + wave; it < NB * NMETA * 4; it += nwg * 8) { const int rr = it >> 2; attn_naive_item(P, (rr >> 4) * LB + (rr & 15), it & 3, qs, lane); }
        }
    __syncthreads();
    if (nwg == 256 && wg >= 192 && !(flags & 2)) { prep_items(P, lds, PREP_EARLY, PREP_NITEMS, (wg - 192) * 8 + wave, 64 * 8, lane, wave); prep_fold(P, (wg - 192) * 8 + wave, 64 * 8, lane); __syncthreads(); }
    if (flags & 1) return;
    unsigned* qhead = (unsigned*)(P.ws + WS_CTL) + CW_AQ; LAS int* qslot = (LAS int*)(lds + att::L2_TOTAL + 64);
    for (;;) {
        if (tid_ == 0) qslot[0] = (int)atomicAdd(qhead, 1u);
        __syncthreads();
        const int L = __builtin_amdgcn_readfirstlane(qslot[0]);
        __syncthreads();
        if (L >= 1024) break;
        int b, vh, qb;
        if (L < 512) { qb = 31 - (L >> 4); b = (L >> 2) & 3; vh = 4 + (L & 3); }
        else { const int j = L & 255; qb = 31 - (j >> 3); b = (j >> 1) & 3; vh = (L < 768 ? 2 : 0) + (j & 1); }
        att::attn_unit(P, lds, b, vh, qb); }
}
__device__ __forceinline__ void stage_combine(const Ptrs& P, int wg, int nwg) {
    const int tid_ = tid_opaque(P); const int lane = tid_ & 63, wave = __builtin_amdgcn_readfirstlane(tid_ >> 6); const bf16_t* Ob = (const bf16_t*)(P.ws + WS_OA); unsigned char* A28 = P.ws + WS_A2;
    const float lam = ((const float*)(P.ws + WS_MISC))[0]; const int h = lane >> 4, c = (lane & 15) * 8;
    float sw[8];
#pragma unroll
    for (int j = 0; j < 8; ++j) sw[j] = P.subln[c + j] * (1.f - LAMBDA_INIT);
    for (int rr0 = (wg * 8 + wave) * 4; rr0 < NB * SEQ; rr0 += nwg * 8 * 4) {
        u32x4 av[4], bv[4];
#pragma unroll
        for (int q = 0; q < 4; ++q) { const int rr = rr0 + q, row = (rr >> 13) * LB + NMETA + (rr & 8191);
            av[q] = *(const u32x4*)(Ob + (size_t)row * D + (2 * h) * 128 + c); bv[q] = *(const u32x4*)(Ob + (size_t)row * D + (2 * h + 1) * 128 + c); }
#pragma unroll
        for (int q = 0; q < 4; ++q) { const int rr = rr0 + q, row = (rr >> 13) * LB + NMETA + (rr & 8191); const u32x4 a = av[q], bb = bv[q];
            float v[8]; v[0] = bflo(a.x) - lam * bflo(bb.x); v[1] = bfhi(a.x) - lam * bfhi(bb.x); v[2] = bflo(a.y) - lam * bflo(bb.y); v[3] = bfhi(a.y) - lam * bfhi(bb.y);
            v[4] = bflo(a.z) - lam * bflo(bb.z); v[5] = bfhi(a.z) - lam * bfhi(bb.z); v[6] = bflo(a.w) - lam * bflo(bb.w); v[7] = bfhi(a.w) - lam * bfhi(bb.w);
            float ss = 0.f;
#pragma unroll
            for (int j = 0; j < 8; ++j) ss += v[j] * v[j];
            ss += __shfl_xor(ss, 1); ss += __shfl_xor(ss, 2); ss += __shfl_xor(ss, 4); ss += __shfl_xor(ss, 8);
            const float r = __builtin_amdgcn_rsqf(ss * (1.f / 128.f) + RMS_EPS);
            const float rr_ = r * F8_ASCALE; u32x2 o; o.x = pk4_fp8(v[0] * rr_ * sw[0], v[1] * rr_ * sw[1], v[2] * rr_ * sw[2], v[3] * rr_ * sw[3]); o.y = pk4_fp8(v[4] * rr_ * sw[4], v[5] * rr_ * sw[5], v[6] * rr_ * sw[6], v[7] * rr_ * sw[7]);
            *(u32x2*)(A28 + (size_t)row * D + 512 + h * 128 + c) = o; } }
}

namespace gla {
 using att::s16x4; using att::vtr; using att::crow;
constexpr int LQD = 0, LKD = 16384, LKW = 32768, LP = 49152, LV = 58368, LOS = 91136, LEB = 124928, LHN = LEB + 1024, LGL = LHN + 1024, LEND = LGL + 4096;
static_assert(LEND <= 131072, "gla LDS");
constexpr int PST = 144, OST = 528;
constexpr size_t U_BYTES = (size_t)128 * 256 * 4;
__device__ __forceinline__ float* u_slot(const Ptrs& P, int bh, int seg) { return (float*)(P.ws + WS_OA + ((size_t)bh * 16 + seg) * U_BYTES); }
__device__ __forceinline__ float* a_slot(const Ptrs& P, int bh, int seg) { return (float*)(P.ws + WS_OA + (size_t)256 * U_BYTES) + ((size_t)bh * 16 + seg) * 128; }
__device__ __forceinline__ float* eb_slot(const Ptrs& P, int b, int cidx) { return (float*)(P.ws + WS_OA + (size_t)256 * U_BYTES + 262144) + ((size_t)b * 129 + cidx) * 512; }

constexpr int PRE_W2 = 0, PRE_TOT = 32768;
__device__ __forceinline__ void pre_chunk(const Ptrs& P, LAS unsigned char* lds, int tid, int r0, int nrows, float* eb, const float (&gb)[8]) {
    const int lane = tid & 63; const int w = __builtin_amdgcn_readfirstlane(tid >> 6);
    bf16_t* Z = (bf16_t*)(P.ws + WS_Z); const float* GLR = (const float*)(P.ws + WS_GLR); LAS float* gl = (LAS float*)(lds + LGL);
    const LAS f32x4* w2l = (const LAS f32x4*)(lds + PRE_W2); LAS f32x4* totl = (LAS f32x4*)(lds + PRE_TOT);
    const int nact = nrows >> 3; const bool act = w < nact;
    bf16_t* zr = Z + (size_t)(r0 + 8 * w) * ODD_N + 8 * lane;
#define PRE_BAR() asm volatile("s_waitcnt lgkmcnt(0)\n\ts_barrier" ::: "memory")
    u32x4 qv[8], kv[8];
    const f32x4 glr = ((const f32x4*)(GLR + (size_t)r0 * 16))[tid & 255];
    __builtin_amdgcn_sched_barrier(0);
#pragma unroll
    for (int t = 0; t < 8; ++t) { qv[t] = *(const u32x4*)(zr + (size_t)t * ODD_N); kv[t] = *(const u32x4*)(zr + (size_t)t * ODD_N + 512); }
    __builtin_amdgcn_sched_barrier(0);
    ((LAS f32x4*)gl)[tid & 255] = glr;
    PRE_BAR();
    float cum[8][8];
    if (act) {
        f32x2 c2[8][4];
#pragma unroll
        for (int t = 0; t < 8; ++t)
#pragma unroll
            for (int cp = 0; cp < 4; ++cp) c2[t][cp] = (f32x2){gb[2 * cp], gb[2 * cp + 1]};
#pragma unroll
        for (int j4 = 0; j4 < 4; ++j4) { f32x4 glv[8];
#pragma unroll
            for (int t = 0; t < 8; ++t) glv[t] = ((const LAS f32x4*)gl)[(8 * w + t) * 4 + j4];
#pragma unroll
            for (int jj = 0; jj < 4; ++jj) { const f32x4 wa = w2l[((4 * j4 + jj) * 2 + 0) * 64 + lane], wb = w2l[((4 * j4 + jj) * 2 + 1) * 64 + lane];
#pragma unroll
                for (int t = 0; t < 8; ++t) { const float sg = glv[t][jj]; const f32x2 s2 = (f32x2){sg, sg};
                    c2[t][0] = __builtin_elementwise_fma(s2, (f32x2){wa[0], wa[1]}, c2[t][0]); c2[t][1] = __builtin_elementwise_fma(s2, (f32x2){wa[2], wa[3]}, c2[t][1]);
                    c2[t][2] = __builtin_elementwise_fma(s2, (f32x2){wb[0], wb[1]}, c2[t][2]); c2[t][3] = __builtin_elementwise_fma(s2, (f32x2){wb[2], wb[3]}, c2[t][3]); } } }
#pragma unroll
        for (int t = 0; t < 8; ++t)
#pragma unroll
            for (int cp = 0; cp < 4; ++cp) { cum[t][2 * cp] = c2[t][cp].x; cum[t][2 * cp + 1] = c2[t][cp].y; }
#pragma unroll
        for (int ch = 0; ch < 8; ++ch) { float run = 0.f;
#pragma unroll
            for (int t = 0; t < 8; ++t) { const float g = cum[t][ch]; run += (fminf(g, 0.f) - 0.69314718f * __builtin_amdgcn_logf(1.f + __builtin_amdgcn_exp2f(fabsf(g) * -1.44269504f))) * (1.f / 16.f); cum[t][ch] = run; } }
        totl[(w * 2 + 0) * 64 + lane] = (f32x4){cum[7][0], cum[7][1], cum[7][2], cum[7][3]}; totl[(w * 2 + 1) * 64 + lane] = (f32x4){cum[7][4], cum[7][5], cum[7][6], cum[7][7]};
    }
    PRE_BAR();
    if (act) {
        float off[8];
#pragma unroll
        for (int ch = 0; ch < 8; ++ch) off[ch] = 0.f;
        for (int pw_ = 0; pw_ < w; ++pw_) { const f32x4 a = totl[(pw_ * 2 + 0) * 64 + lane], b = totl[(pw_ * 2 + 1) * 64 + lane];
            off[0] += a[0]; off[1] += a[1]; off[2] += a[2]; off[3] += a[3]; off[4] += b[0]; off[5] += b[1]; off[6] += b[2]; off[7] += b[3]; }
#pragma unroll
        for (int t = 0; t < 8; ++t) { float e[8], ie[8];
#pragma unroll
            for (int ch = 0; ch < 8; ++ch) { e[ch] = __builtin_amdgcn_exp2f((off[ch] + cum[t][ch]) * 1.44269504f); ie[ch] = __builtin_amdgcn_rcpf(e[ch]); }
            const u32x4 q = qv[t], k = kv[t]; u32x4 qo, ko;
            qo.x = cvt_pk_bf16(bflo(q.x) * e[0], bfhi(q.x) * e[1]); qo.y = cvt_pk_bf16(bflo(q.y) * e[2], bfhi(q.y) * e[3]); qo.z = cvt_pk_bf16(bflo(q.z) * e[4], bfhi(q.z) * e[5]); qo.w = cvt_pk_bf16(bflo(q.w) * e[6], bfhi(q.w) * e[7]);
            ko.x = cvt_pk_bf16(bflo(k.x) * ie[0], bfhi(k.x) * ie[1]); ko.y = cvt_pk_bf16(bflo(k.y) * ie[2], bfhi(k.y) * ie[3]); ko.z = cvt_pk_bf16(bflo(k.z) * ie[4], bfhi(k.z) * ie[5]); ko.w = cvt_pk_bf16(bflo(k.w) * ie[6], bfhi(k.w) * ie[7]);
            *(u32x4*)(zr + (size_t)t * ODD_N) = qo; *(u32x4*)(zr + (size_t)t * ODD_N + 512) = ko; }
        if (w == nact - 1) {
            *(f32x4*)(eb + 8 * lane) = (f32x4){__expf(off[0] + cum[7][0]), __expf(off[1] + cum[7][1]), __expf(off[2] + cum[7][2]), __expf(off[3] + cum[7][3])};
            *(f32x4*)(eb + 8 * lane + 4) = (f32x4){__expf(off[4] + cum[7][4]), __expf(off[5] + cum[7][5]), __expf(off[6] + cum[7][6]), __expf(off[7] + cum[7][7])}; }
    }
    PRE_BAR();
#undef PRE_BAR
}
__device__ __forceinline__ void stage_pre(const Ptrs& P, LAS unsigned char* lds, int wg, int nwg) {
    const int tid = tid_opaque(P); const int lane = tid & 63;
    for (int idx = tid; idx < 2048; idx += 512) { const int j = idx >> 7, hf = (idx >> 6) & 1, ln = idx & 63; ((LAS f32x4*)(lds + PRE_W2))[idx] = *(const f32x4*)(P.gate_w2 + j * 512 + 8 * ln + 4 * hf); }
    float gb[8];
    { const f32x4 a = *(const f32x4*)(P.gate_b + 8 * lane), b = *(const f32x4*)(P.gate_b + 8 * lane + 4); gb[0] = a[0]; gb[1] = a[1]; gb[2] = a[2]; gb[3] = a[3]; gb[4] = b[0]; gb[5] = b[1]; gb[6] = b[2]; gb[7] = b[3]; }
    __syncthreads();
    for (int it = wg; it < NB * 128; it += nwg) { const int b = it >> 7, j = it & 127, rowb = b * LB;
        if (j == 0) pre_chunk(P, lds, tid, rowb, NMETA, eb_slot(P, b, 0), gb);
        pre_chunk(P, lds, tid, rowb + NMETA + 64 * j, 64, eb_slot(P, b, j + 1), gb); }
}

__device__ __forceinline__ void segment_state(const Ptrs& P, LAS unsigned char* lds, int bh, int seg) {
    const int tid = tid_opaque(P), lane = tid & 63, r32 = lane & 31, hi = lane >> 5; const int wid = __builtin_amdgcn_readfirstlane(tid >> 6);
    const int b = bh >> 2, h = bh & 3, rowb = b * LB;
    const bf16_t* Z = (const bf16_t*)(P.ws + WS_Z);
    constexpr int BUF = 49152, BV = 0, BKW = 32768, BEB = 98304;
    const unsigned lds0 = (unsigned)(size_t)lds;
    f32x16 S[4];
#pragma unroll
    for (int cb = 0; cb < 4; ++cb) S[cb] = f32x16{};
    const int nch = 8 + (seg == 0 ? 1 : 0);
    const LAS unsigned char* trb = lds + ((lane >> 4) & 1) * 32 + (lane & 3) * 8 + (8 * hi + ((lane & 15) >> 2)) * 64;
#define GS_R0(ch) ((seg == 0 && (ch) == 0) ? rowb : rowb + NMETA + 64 * (seg * 8 + (ch) - (seg == 0 ? 1 : 0)))
#define GS_ISSUE(ch) do { const int r0_ = GS_R0(ch), bo_ = ((ch) & 1) * BUF; \
        _Pragma("unroll") for (int i_ = 0; i_ < 4; ++i_) { const int pc = wid * 4 + i_, db = pc >> 2, rg = pc & 3; \
            att::glds16(Z + (size_t)(r0_ + 16 * rg + (lane >> 2)) * ODD_N + 1024 + h * 256 + db * 32 + (lane & 3) * 8, (unsigned)__builtin_amdgcn_readfirstlane((int)(lds0 + bo_ + BV + pc * 1024))); } \
        _Pragma("unroll") for (int i_ = 0; i_ < 2; ++i_) { const int pc = wid * 2 + i_, cb = pc >> 2, rg = pc & 3; \
            att::glds16(Z + (size_t)(r0_ + 16 * rg + (lane >> 2)) * ODD_N + 512 + h * 128 + cb * 32 + (lane & 3) * 8, (unsigned)__builtin_amdgcn_readfirstlane((int)(lds0 + bo_ + BKW + pc * 1024))); } \
        if (wid == 0) { const int cidx_ = (seg == 0 && (ch) == 0) ? 0 : seg * 8 + (ch) - (seg == 0 ? 1 : 0) + 1; \
            att::glds16(eb_slot(P, b, cidx_) + h * 128 + lane * 4, (unsigned)__builtin_amdgcn_readfirstlane((int)(lds0 + BEB + ((ch) & 1) * 1024))); } } while (0)
    GS_ISSUE(0); GS_ISSUE(1);
    float aprod = 1.f;
    for (int ch = 0; ch < nch; ++ch) {
        const int bo = (ch & 1) * BUF; const bool metac = (seg == 0 && ch == 0);
        if (ch + 1 < nch) { if (wid == 0) asm volatile("s_waitcnt vmcnt(7) lgkmcnt(0)\n\ts_barrier" ::: "memory"); else asm volatile("s_waitcnt vmcnt(6) lgkmcnt(0)\n\ts_barrier" ::: "memory"); }
        else asm volatile("s_waitcnt vmcnt(0) lgkmcnt(0)\n\ts_barrier" ::: "memory");
        const LAS float* eB = (const LAS float*)(lds + BEB + (ch & 1) * 1024);
        if (tid < 128) aprod *= eB[tid];
        const int nks = metac ? 1 : 4;
        bf16x8 vf[4];
#pragma unroll
        for (int ks = 0; ks < 4; ++ks) { const s16x4 lo = vtr(trb + bo + BV + (wid * 4 + ks) * 1024), h4 = vtr(trb + bo + BV + (wid * 4 + ks) * 1024 + 256); vf[ks] = (bf16x8){lo[0], lo[1], lo[2], lo[3], h4[0], h4[1], h4[2], h4[3]}; }
#pragma unroll
        for (int cb = 0; cb < 4; ++cb) {
#pragma unroll
            for (int ks = 0; ks < 4; ++ks) if (ks < nks) { const s16x4 lo = vtr(trb + bo + BKW + (cb * 4 + ks) * 1024), h4 = vtr(trb + bo + BKW + (cb * 4 + ks) * 1024 + 256);
                const bf16x8 kf = (bf16x8){lo[0], lo[1], lo[2], lo[3], h4[0], h4[1], h4[2], h4[3]};
                S[cb] = __builtin_amdgcn_mfma_f32_32x32x16_bf16(kf, vf[ks], S[cb], 0, 0, 0); }
#pragma unroll
            for (int g = 0; g < 4; ++g) { const f32x4 e4 = *(const LAS f32x4*)(eB + 32 * cb + 8 * g + 4 * hi); S[cb][4 * g] *= e4.x; S[cb][4 * g + 1] *= e4.y; S[cb][4 * g + 2] *= e4.z; S[cb][4 * g + 3] *= e4.w; } }
        asm volatile("s_waitcnt lgkmcnt(0)\n\ts_barrier" ::: "memory");
        if (ch + 2 < nch) GS_ISSUE(ch + 2);
    }
#undef GS_ISSUE
#undef GS_R0
    float* u = u_slot(P, bh, seg);
#pragma unroll
    for (int cb = 0; cb < 4; ++cb)
#pragma unroll
        for (int r = 0; r < 16; ++r) u[(size_t)(32 * cb + crow(r, hi)) * 256 + 32 * wid + r32] = S[cb][r];
    if (tid < 128) a_slot(P, bh, seg)[tid] = aprod;
    asm volatile("s_waitcnt vmcnt(0) lgkmcnt(0)\n\ts_barrier" ::: "memory");
}
__device__ __forceinline__ void segment_out(const Ptrs& P, LAS unsigned char* lds, int bh, int seg) {
    const int tid = tid_opaque(P), lane = tid & 63, r32 = lane & 31, hi = lane >> 5; const int wid = __builtin_amdgcn_readfirstlane(tid >> 6);
    const int b = bh >> 2, h = bh & 3, rowb = b * LB;
    const bf16_t* Z = (const bf16_t*)(P.ws + WS_Z); unsigned char* A28 = P.ws + WS_A2;
    LAS float* eB = (LAS float*)(lds + LEB); LAS float* hnl = (LAS float*)(lds + LHN);
    if (tid < 256) hnl[tid] = P.head_norm[tid];
    f32x16 S[4];
    if (seg > 0) { const float* u = u_slot(P, bh, seg - 1);
#pragma unroll
        for (int cb = 0; cb < 4; ++cb)
#pragma unroll
            for (int r = 0; r < 16; ++r) S[cb][r] = u[(size_t)(32 * cb + crow(r, hi)) * 256 + 32 * wid + r32]; }
    else {
#pragma unroll
        for (int cb = 0; cb < 4; ++cb) S[cb] = f32x16{}; }
    const int nch = 8 + (seg == 0 ? 1 : 0);
    const unsigned lds0 = (unsigned)(size_t)lds;
    const LAS unsigned char* trb = lds + ((lane >> 4) & 1) * 32 + (lane & 3) * 8 + (8 * hi + ((lane & 15) >> 2)) * 64;
#define GO_META(ch) (seg == 0 && (ch) == 0)
#define GO_R0(ch) (GO_META(ch) ? rowb : rowb + NMETA + 64 * (seg * 8 + (ch) - (seg == 0 ? 1 : 0)))
#define GO_CIDX(ch) (GO_META(ch) ? 0 : seg * 8 + (ch) - (seg == 0 ? 1 : 0) + 1)
#define GO_ISSUE_A(ch) do { const int r0_ = GO_R0(ch); \
        _Pragma("unroll") for (int i_ = 0; i_ < 4; ++i_) { const int pc = wid * 4 + i_, db = pc >> 2, rg = pc & 3; \
            att::glds16(Z + (size_t)(r0_ + 16 * rg + (lane >> 2)) * ODD_N + 1024 + h * 256 + db * 32 + (lane & 3) * 8, (unsigned)__builtin_amdgcn_readfirstlane((int)(lds0 + LV + pc * 1024))); } \
        if (!GO_META(ch)) { _Pragma("unroll") for (int i_ = 0; i_ < 2; ++i_) { const int chk = wid * 2 + i_; \
            att::glds16(Z + (size_t)(r0_ + lane) * ODD_N + h * 128 + chk * 8, (unsigned)__builtin_amdgcn_readfirstlane((int)(lds0 + LQD + chk * 1024))); \
            att::glds16(Z + (size_t)(r0_ + lane) * ODD_N + 512 + h * 128 + chk * 8, (unsigned)__builtin_amdgcn_readfirstlane((int)(lds0 + LKD + chk * 1024))); } } } while (0)
#define GO_ISSUE_B(ch) do { const int r0_ = GO_R0(ch); \
        _Pragma("unroll") for (int i_ = 0; i_ < 2; ++i_) { const int pc = wid * 2 + i_, cb = pc >> 2, rg = pc & 3; \
            att::glds16(Z + (size_t)(r0_ + 16 * rg + (lane >> 2)) * ODD_N + 512 + h * 128 + cb * 32 + (lane & 3) * 8, (unsigned)__builtin_amdgcn_readfirstlane((int)(lds0 + LKW + pc * 1024))); } \
        if (wid == 0) att::glds16(eb_slot(P, b, GO_CIDX(ch)) + h * 128 + lane * 4, (unsigned)__builtin_amdgcn_readfirstlane((int)(lds0 + LEB))); } while (0)
    GO_ISSUE_A(0); GO_ISSUE_B(0);
    for (int ch = 0; ch < nch; ++ch) {
        const bool outc = !GO_META(ch); const int r0 = GO_R0(ch);
        asm volatile("s_waitcnt vmcnt(0) lgkmcnt(0)\n\ts_barrier" ::: "memory");
        u32x4 rgv[4];
        if (outc) { const u32x4* rgp = (const u32x4*)(Z + (size_t)(r0 + (tid >> 3)) * ODD_N + 2048 + h * 256 + (tid & 7) * 32);
#pragma unroll
            for (int q = 0; q < 4; ++q) rgv[q] = rgp[q]; }
        f32x16 o[2];
        if (outc) {
            if (wid < 4) { const int sb = wid & 1, tb = wid >> 1; f32x16 x = f32x16{};
                if (!(sb == 1 && tb == 0)) {
#pragma unroll
                    for (int ks = 0; ks < 8; ++ks) { const bf16x8 a = *(const LAS bf16x8*)(lds + LKD + (2 * ks + hi) * 1024 + (32 * sb + r32) * 16), bq = *(const LAS bf16x8*)(lds + LQD + (2 * ks + hi) * 1024 + (32 * tb + r32) * 16);
                        x = __builtin_amdgcn_mfma_f32_32x32x16_bf16(a, bq, x, 0, 0, 0); }
                    if (sb == tb) {
#pragma unroll
                        for (int r = 0; r < 16; ++r) if (crow(r, hi) > r32) x[r] = 0.f; }
                }
#pragma unroll
                for (int g = 0; g < 4; ++g) { u32x2 w; w.x = cvt_pk_bf16(x[4 * g], x[4 * g + 1]); w.y = cvt_pk_bf16(x[4 * g + 2], x[4 * g + 3]);
                    *(LAS u32x2*)(lds + LP + (32 * tb + r32) * PST + (32 * sb + 8 * g + 4 * hi) * 2) = w; } }
            o[0] = f32x16{}; o[1] = f32x16{};
#pragma unroll
            for (int cb = 0; cb < 4; ++cb)
#pragma unroll
                for (int s2 = 0; s2 < 2; ++s2) { u32x4 sw;
#pragma unroll
                    for (int j = 0; j < 4; ++j) sw[j] = cvt_pk_bf16(S[cb][8 * s2 + 2 * j], S[cb][8 * s2 + 2 * j + 1]);
                    const int kst = 2 * cb + s2;
#pragma unroll
                    for (int tb = 0; tb < 2; ++tb) { const LAS unsigned char* ap = lds + LQD + (2 * kst) * 1024 + (32 * tb + r32) * 16 + 8 * hi;
                        const u32x2 a0 = *(const LAS u32x2*)ap, a1 = *(const LAS u32x2*)(ap + 1024); const u32x4 a = (u32x4){a0.x, a0.y, a1.x, a1.y};
                        o[tb] = __builtin_amdgcn_mfma_f32_32x32x16_bf16(__builtin_bit_cast(bf16x8, a), __builtin_bit_cast(bf16x8, sw), o[tb], 0, 0, 0); } }
        }
        const int nks = outc ? 4 : 1;
        bf16x8 vf[4];
#pragma unroll
        for (int ks = 0; ks < 4; ++ks) { const s16x4 lo = vtr(trb + LV + (wid * 4 + ks) * 1024), h4 = vtr(trb + LV + (wid * 4 + ks) * 1024 + 256); vf[ks] = (bf16x8){lo[0], lo[1], lo[2], lo[3], h4[0], h4[1], h4[2], h4[3]}; }
        asm volatile("s_waitcnt lgkmcnt(0)\n\ts_barrier" ::: "memory");
        if (outc) asm volatile("" :: "v"(rgv[0]), "v"(rgv[1]), "v"(rgv[2]), "v"(rgv[3]));
        if (ch + 1 < nch) GO_ISSUE_A(ch + 1);
        if (outc) {
#pragma unroll
            for (int ks = 0; ks < 4; ++ks)
#pragma unroll
                for (int tb = 0; tb < 2; ++tb) { const bf16x8 a = *(const LAS bf16x8*)(lds + LP + (32 * tb + r32) * PST + (16 * ks + 8 * hi) * 2);
                    o[tb] = __builtin_amdgcn_mfma_f32_32x32x16_bf16(a, vf[ks], o[tb], 0, 0, 0); }
#pragma unroll
            for (int tb = 0; tb < 2; ++tb)
#pragma unroll
                for (int r = 0; r < 16; ++r) *(LAS bf16_t*)(lds + LOS + (32 * tb + crow(r, hi)) * OST + (32 * wid + r32) * 2) = (bf16_t)f2bf(o[tb][r]);
        }
#pragma unroll
        for (int cb = 0; cb < 4; ++cb) {
#pragma unroll
            for (int ks = 0; ks < 4; ++ks) if (ks < nks) { const s16x4 lo = vtr(trb + LKW + (cb * 4 + ks) * 1024), h4 = vtr(trb + LKW + (cb * 4 + ks) * 1024 + 256);
                const bf16x8 kf = (bf16x8){lo[0], lo[1], lo[2], lo[3], h4[0], h4[1], h4[2], h4[3]};
                S[cb] = __builtin_amdgcn_mfma_f32_32x32x16_bf16(kf, vf[ks], S[cb], 0, 0, 0); }
#pragma unroll
            for (int g = 0; g < 4; ++g) { const f32x4 e4 = *(const LAS f32x4*)(eB + 32 * cb + 8 * g + 4 * hi); S[cb][4 * g] *= e4.x; S[cb][4 * g + 1] *= e4.y; S[cb][4 * g + 2] *= e4.z; S[cb][4 * g + 3] *= e4.w; } }
        asm volatile("s_waitcnt lgkmcnt(0)\n\ts_barrier" ::: "memory");
        if (ch + 1 < nch) GO_ISSUE_B(ch + 1);
        if (outc) {
            const int t = tid >> 3, j8 = tid & 7; const size_t row = (size_t)(r0 + t);
            float ss = 0.f;
#pragma unroll
            for (int q = 0; q < 4; ++q) { const u32x4 a = *(const LAS u32x4*)(lds + LOS + t * OST + j8 * 64 + q * 16);
                const float v0 = bflo(a.x), v1 = bfhi(a.x), v2 = bflo(a.y), v3 = bfhi(a.y), v4 = bflo(a.z), v5 = bfhi(a.z), v6 = bflo(a.w), v7 = bfhi(a.w);
                ss += v0 * v0 + v1 * v1 + v2 * v2 + v3 * v3 + v4 * v4 + v5 * v5 + v6 * v6 + v7 * v7; }
            ss += __shfl_xor(ss, 1); ss += __shfl_xor(ss, 2); ss += __shfl_xor(ss, 4);
            const float rn = __builtin_amdgcn_rsqf(ss * (1.f / 256.f) + RMS_EPS);
            u32x2* dst = (u32x2*)(A28 + row * D + h * 256 + j8 * 32);
#pragma unroll
            for (int q = 0; q < 4; ++q) { const u32x4 a = *(const LAS u32x4*)(lds + LOS + t * OST + j8 * 64 + q * 16);
                const float v[8] = {bflo(a.x), bfhi(a.x), bflo(a.y), bfhi(a.y), bflo(a.z), bfhi(a.z), bflo(a.w), bfhi(a.w)};
                const u32x4 g4 = rgv[q]; const float gv[8] = {bflo(g4.x), bfhi(g4.x), bflo(g4.y), bfhi(g4.y), bflo(g4.z), bfhi(g4.z), bflo(g4.w), bfhi(g4.w)}; float y[8];
#pragma unroll
                for (int e = 0; e < 8; ++e) y[e] = v[e] * (rn * F8_ASCALE) * hnl[j8 * 32 + 8 * q + e] * (gv[e] * __builtin_amdgcn_rcpf(1.f + __builtin_amdgcn_exp2f(gv[e] * -1.44269504f)));
                u32x2 w; w.x = pk4_fp8(y[0], y[1], y[2], y[3]); w.y = pk4_fp8(y[4], y[5], y[6], y[7]); dst[q] = w;
                __builtin_amdgcn_sched_barrier(0); }
        }
    }
    asm volatile("s_waitcnt vmcnt(0) lgkmcnt(0)\n\ts_barrier" ::: "memory");
#undef GO_META
#undef GO_R0
#undef GO_CIDX
#undef GO_ISSUE_A
#undef GO_ISSUE_B
}
template <bool OUT> __device__ __forceinline__ void segment(const Ptrs& P, LAS unsigned char* lds, int bh, int seg) {
    const int tid = tid_opaque(P), lane = tid & 63, r32 = lane & 31, hi = lane >> 5; const int wid = __builtin_amdgcn_readfirstlane(tid >> 6);
    const int b = bh >> 2, h = bh & 3, rowb = b * LB;
    const bf16_t* Z = (const bf16_t*)(P.ws + WS_Z); unsigned char* A28 = P.ws + WS_A2;
    LAS float* eB = (LAS float*)(lds + LEB); LAS float* hnl = (LAS float*)(lds + LHN);
    if (OUT && tid < 256) hnl[tid] = P.head_norm[tid];
    f32x16 S[4];
    if (OUT && seg > 0) { const float* u = u_slot(P, bh, seg - 1);
#pragma unroll
        for (int cb = 0; cb < 4; ++cb)
#pragma unroll
            for (int r = 0; r < 16; ++r) S[cb][r] = u[(size_t)(32 * cb + crow(r, hi)) * 256 + 32 * wid + r32]; }
    else {
#pragma unroll
        for (int cb = 0; cb < 4; ++cb) S[cb] = f32x16{}; }
    float aprod = 1.f;
    const int nch = 8 + (seg == 0 ? 1 : 0);
    const LAS unsigned char* trb = lds + ((lane >> 4) & 1) * 32 + (lane & 3) * 8 + (8 * hi + ((lane & 15) >> 2)) * 64;
    for (int ch = 0; ch < nch; ++ch) {
        const bool metac = (seg == 0 && ch == 0);
        const int cj = seg * 8 + ch - (seg == 0 ? 1 : 0);
        const int r0 = metac ? rowb : rowb + NMETA + 64 * cj;
        const float* ebg = eb_slot(P, b, metac ? 0 : cj + 1) + h * 128;
#pragma unroll
        for (int i_ = 0; i_ < 4; ++i_) { const int pc = wid * 4 + i_, db = pc >> 2, rg = pc & 3;
            __builtin_amdgcn_global_load_lds((const unsigned*)(Z + (size_t)(r0 + 16 * rg + (lane >> 2)) * ODD_N + 1024 + h * 256 + db * 32 + (lane & 3) * 8), (LAS unsigned*)(lds + LV + pc * 1024), 16, 0, 0); }
#pragma unroll
        for (int i_ = 0; i_ < 2; ++i_) { const int pc = wid * 2 + i_, cb = pc >> 2, rg = pc & 3;
            __builtin_amdgcn_global_load_lds((const unsigned*)(Z + (size_t)(r0 + 16 * rg + (lane >> 2)) * ODD_N + 512 + h * 128 + cb * 32 + (lane & 3) * 8), (LAS unsigned*)(lds + LKW + pc * 1024), 16, 0, 0); }
        const bool outc = OUT && !metac;
        u32x4 rgv[4];
        if (outc) { const u32x4* rgp = (const u32x4*)(Z + (size_t)(r0 + (tid >> 3)) * ODD_N + 2048 + h * 256 + (tid & 7) * 32);
#pragma unroll
            for (int q = 0; q < 4; ++q) rgv[q] = rgp[q]; }
        if (outc) {
#pragma unroll
            for (int i_ = 0; i_ < 2; ++i_) { const int chk = wid * 2 + i_;
                __builtin_amdgcn_global_load_lds((const unsigned*)(Z + (size_t)(r0 + lane) * ODD_N + h * 128 + chk * 8), (LAS unsigned*)(lds + LQD + chk * 1024), 16, 0, 0);
                __builtin_amdgcn_global_load_lds((const unsigned*)(Z + (size_t)(r0 + lane) * ODD_N + 512 + h * 128 + chk * 8), (LAS unsigned*)(lds + LKD + chk * 1024), 16, 0, 0); } }
        if (tid < 128) { const float e = ebg[tid]; eB[tid] = e; aprod *= e; }
        __syncthreads();
        f32x16 o[2];
        if (outc) {
            if (wid < 4) { const int sb = wid & 1, tb = wid >> 1; f32x16 x = f32x16{};
                if (!(sb == 1 && tb == 0)) {
#pragma unroll
                    for (int ks = 0; ks < 8; ++ks) { const bf16x8 a = *(const LAS bf16x8*)(lds + LKD + (2 * ks + hi) * 1024 + (32 * sb + r32) * 16), bq = *(const LAS bf16x8*)(lds + LQD + (2 * ks + hi) * 1024 + (32 * tb + r32) * 16);
                        x = __builtin_amdgcn_mfma_f32_32x32x16_bf16(a, bq, x, 0, 0, 0); }
                    if (sb == tb) {
#pragma unroll
                        for (int r = 0; r < 16; ++r) if (crow(r, hi) > r32) x[r] = 0.f; }
                }
#pragma unroll
                for (int g = 0; g < 4; ++g) { u32x2 w; w.x = cvt_pk_bf16(x[4 * g], x[4 * g + 1]); w.y = cvt_pk_bf16(x[4 * g + 2], x[4 * g + 3]);
                    *(LAS u32x2*)(lds + LP + (32 * tb + r32) * PST + (32 * sb + 8 * g + 4 * hi) * 2) = w; } }
            o[0] = f32x16{}; o[1] = f32x16{};
#pragma unroll
            for (int cb = 0; cb < 4; ++cb)
#pragma unroll
                for (int s2 = 0; s2 < 2; ++s2) { u32x4 sw;
#pragma unroll
                    for (int j = 0; j < 4; ++j) sw[j] = cvt_pk_bf16(S[cb][8 * s2 + 2 * j], S[cb][8 * s2 + 2 * j + 1]);
                    const int kst = 2 * cb + s2;
#pragma unroll
                    for (int tb = 0; tb < 2; ++tb) { const LAS unsigned char* ap = lds + LQD + (2 * kst) * 1024 + (32 * tb + r32) * 16 + 8 * hi;
                        const u32x2 a0 = *(const LAS u32x2*)ap, a1 = *(const LAS u32x2*)(ap + 1024); const u32x4 a = (u32x4){a0.x, a0.y, a1.x, a1.y};
                        o[tb] = __builtin_amdgcn_mfma_f32_32x32x16_bf16(__builtin_bit_cast(bf16x8, a), __builtin_bit_cast(bf16x8, sw), o[tb], 0, 0, 0); } }
            __syncthreads();
        }
        const int nks = metac ? 1 : 4;
        bf16x8 vf[4];
#pragma unroll
        for (int ks = 0; ks < 4; ++ks) { const s16x4 lo = vtr(trb + LV + (wid * 4 + ks) * 1024), h4 = vtr(trb + LV + (wid * 4 + ks) * 1024 + 256); vf[ks] = (bf16x8){lo[0], lo[1], lo[2], lo[3], h4[0], h4[1], h4[2], h4[3]}; }
        if (outc) {
#pragma unroll
            for (int ks = 0; ks < 4; ++ks)
#pragma unroll
                for (int tb = 0; tb < 2; ++tb) { const bf16x8 a = *(const LAS bf16x8*)(lds + LP + (32 * tb + r32) * PST + (16 * ks + 8 * hi) * 2);
                    o[tb] = __builtin_amdgcn_mfma_f32_32x32x16_bf16(a, vf[ks], o[tb], 0, 0, 0); }
#pragma unroll
            for (int tb = 0; tb < 2; ++tb)
#pragma unroll
                for (int r = 0; r < 16; ++r) *(LAS bf16_t*)(lds + LOS + (32 * tb + crow(r, hi)) * OST + (32 * wid + r32) * 2) = (bf16_t)f2bf(o[tb][r]);
        }
#pragma unroll
        for (int cb = 0; cb < 4; ++cb) {
#pragma unroll
            for (int ks = 0; ks < 4; ++ks) if (ks < nks) { const s16x4 lo = vtr(trb + LKW + (cb * 4 + ks) * 1024), h4 = vtr(trb + LKW + (cb * 4 + ks) * 1024 + 256);
                const bf16x8 kf = (bf16x8){lo[0], lo[1], lo[2], lo[3], h4[0], h4[1], h4[2], h4[3]};
                S[cb] = __builtin_amdgcn_mfma_f32_32x32x16_bf16(kf, vf[ks], S[cb], 0, 0, 0); }
#pragma unroll
            for (int g = 0; g < 4; ++g) { const f32x4 e4 = *(const LAS f32x4*)(eB + 32 * cb + 8 * g + 4 * hi); S[cb][4 * g] *= e4.x; S[cb][4 * g + 1] *= e4.y; S[cb][4 * g + 2] *= e4.z; S[cb][4 * g + 3] *= e4.w; } }
        __syncthreads();
        if (outc) {
            const int t = tid >> 3, j8 = tid & 7; const size_t row = (size_t)(r0 + t);
            float ss = 0.f;
#pragma unroll
            for (int q = 0; q < 4; ++q) { const u32x4 a = *(const LAS u32x4*)(lds + LOS + t * OST + j8 * 64 + q * 16);
                const float v0 = bflo(a.x), v1 = bfhi(a.x), v2 = bflo(a.y), v3 = bfhi(a.y), v4 = bflo(a.z), v5 = bfhi(a.z), v6 = bflo(a.w), v7 = bfhi(a.w);
                ss += v0 * v0 + v1 * v1 + v2 * v2 + v3 * v3 + v4 * v4 + v5 * v5 + v6 * v6 + v7 * v7; }
            ss += __shfl_xor(ss, 1); ss += __shfl_xor(ss, 2); ss += __shfl_xor(ss, 4);
            const float rn = __builtin_amdgcn_rsqf(ss * (1.f / 256.f) + RMS_EPS);
            u32x2* dst = (u32x2*)(A28 + row * D + h * 256 + j8 * 32);
#pragma unroll
            for (int q = 0; q < 4; ++q) { const u32x4 a = *(const LAS u32x4*)(lds + LOS + t * OST + j8 * 64 + q * 16);
                const float v[8] = {bflo(a.x), bfhi(a.x), bflo(a.y), bfhi(a.y), bflo(a.z), bfhi(a.z), bflo(a.w), bfhi(a.w)};
                const u32x4 g4 = rgv[q]; const float gv[8] = {bflo(g4.x), bfhi(g4.x), bflo(g4.y), bfhi(g4.y), bflo(g4.z), bfhi(g4.z), bflo(g4.w), bfhi(g4.w)}; float y[8];
#pragma unroll
                for (int e = 0; e < 8; ++e) y[e] = v[e] * (rn * F8_ASCALE) * hnl[j8 * 32 + 8 * q + e] * (gv[e] * __builtin_amdgcn_rcpf(1.f + __builtin_amdgcn_exp2f(gv[e] * -1.44269504f)));
                u32x2 w; w.x = pk4_fp8(y[0], y[1], y[2], y[3]); w.y = pk4_fp8(y[4], y[5], y[6], y[7]); dst[q] = w;
                __builtin_amdgcn_sched_barrier(0); }
        }
    }
    if (!OUT) { float* u = u_slot(P, bh, seg);
#pragma unroll
        for (int cb = 0; cb < 4; ++cb)
#pragma unroll
            for (int r = 0; r < 16; ++r) u[(size_t)(32 * cb + crow(r, hi)) * 256 + 32 * wid + r32] = S[cb][r];
        if (tid < 128) a_slot(P, bh, seg)[tid] = aprod; }
    __syncthreads();
}
}
template <bool OUT> __device__ __forceinline__ void stage_gla_seg(const Ptrs& P, LAS unsigned char* lds, int wg, int nwg) {
    for (int u = wg; u < 256; u += nwg) { if constexpr (OUT) gla::segment_out(P, lds, u >> 4, u & 15); else gla::segment_state(P, lds, u >> 4, u & 15); }
}
__device__ __forceinline__ void stage_gla_scan(const Ptrs& P, int wg, int nwg) {
    const int tid_ = tid_opaque(P);
    for (int idx = wg * 512 + tid_; idx < 16 * 32768; idx += nwg * 512) { const int bh = idx >> 15, e = idx & 32767, cch = e >> 8;
        float uv[15], av[15];
#pragma unroll
        for (int sg = 0; sg < 15; ++sg) { uv[sg] = gla::u_slot(P, bh, sg)[e]; av[sg] = gla::a_slot(P, bh, sg)[cch]; }
        float Sv = 0.f;
#pragma unroll
        for (int sg = 0; sg < 15; ++sg) { Sv = av[sg] * Sv + uv[sg]; gla::u_slot(P, bh, sg)[e] = Sv; } }
}

#define XB_TMO      128
#define XB_XCNT(j)  (256  + 64 * (j))
#define XB_XSUB(j)  (1280 + 64 * (j))
#define XB_XGEN(j)  (2304 + 64 * (j))
#define XB_TOP      3328
#define XB_TOPGEN   3392
#define XCD_BAR_WORDS 3456
#define XB_SPIN_CAP (1u << 18)
__device__ __forceinline__ unsigned xb_ld(unsigned* p)              { return __hip_atomic_load(p, __ATOMIC_RELAXED, __HIP_MEMORY_SCOPE_AGENT); }
__device__ __forceinline__ unsigned xb_add(unsigned* p, unsigned v) { return __hip_atomic_fetch_add(p, v, __ATOMIC_RELAXED, __HIP_MEMORY_SCOPE_AGENT); }
__device__ __forceinline__ unsigned xb_xcc_id() { return (unsigned)__builtin_amdgcn_s_getreg((3 << 11) | 20) & 0xFu; }
#define XB_SPIN(cond, bar) do { unsigned _sp = 0; while (cond) { __builtin_amdgcn_s_sleep(1); \
    if ((++_sp & 255u) == 0u) { if (xb_ld(&(bar)[XB_TMO])) break; if (_sp > XB_SPIN_CAP) { atomicAdd(&(bar)[XB_TMO], 1u); break; } } } } while (0)
struct XcdBarrier { unsigned* bar; unsigned x; volatile LAS unsigned* st; };
__device__ __forceinline__ XcdBarrier xcd_barrier_post(unsigned* bar, volatile LAS unsigned* st, const bool t0) {
    XcdBarrier b; b.bar = bar; b.x = xb_xcc_id(); b.st = st;
    if (t0) (void)xb_add(&bar[XB_XCNT(b.x)], 1u);
    return b;
}
__device__ __forceinline__ void xcd_barrier_complete(unsigned* bar, unsigned x, unsigned& nloc, unsigned& nx) {
    const unsigned G = gridDim.x * gridDim.y * gridDim.z;
    unsigned sum, cnt, mine, sp = 0u;
    for (;;) {
        sum = 0u; cnt = 0u; mine = 0u;
#pragma unroll
        for (unsigned j = 0; j < 16; ++j) { const unsigned c = xb_ld(&bar[XB_XCNT(j)]); sum += c; cnt += (c > 0u) ? 1u : 0u; mine = (j == x) ? c : mine; }
        if (sum == G) break;
        __builtin_amdgcn_s_sleep(1);
        if ((++sp & 255u) == 0u) { if (xb_ld(&bar[XB_TMO])) break; if (sp > XB_SPIN_CAP) { atomicAdd(&bar[XB_TMO], 1u); break; } }
    }
    nloc = mine > 0u ? mine : 1u; nx = cnt > 0u ? cnt : 1u;
}
__device__ __forceinline__ void xcd_barrier(const XcdBarrier& b, const bool t0) {
    asm volatile("s_waitcnt vmcnt(0)" ::: "memory");
    __syncthreads();
    if (t0) {
        unsigned* bar = b.bar;
        __builtin_amdgcn_s_waitcnt(0);
        unsigned nloc = b.st[0], nx = b.st[1];
        if (nloc == 0u) { xcd_barrier_complete(bar, b.x, nloc, nx); b.st[0] = nloc; b.st[1] = nx; }
        const unsigned old = xb_add(&bar[XB_XSUB(b.x)], 1u);
        const unsigned gen = old / nloc;
        if (old + 1u == (gen + 1u) * nloc) {
            __builtin_amdgcn_fence(__ATOMIC_RELEASE, "agent");
            asm volatile("s_waitcnt vmcnt(0)" ::: "memory");
            const unsigned og = xb_add(&bar[XB_TOP], 1u);
            const unsigned tg = og / nx;
            if (og + 1u == (tg + 1u) * nx) xb_add(&bar[XB_TOPGEN], 1u);
            else XB_SPIN(xb_ld(&bar[XB_TOPGEN]) == tg, bar);
            __builtin_amdgcn_fence(__ATOMIC_ACQUIRE, "agent");
            xb_add(&bar[XB_XGEN(b.x)], 1u);
            asm volatile("s_waitcnt vmcnt(0)" ::: "memory");
        } else {
            XB_SPIN(xb_ld(&bar[XB_XGEN(b.x)]) == gen, bar);
            __builtin_amdgcn_fence(__ATOMIC_ACQUIRE, "agent");
            asm volatile("s_waitcnt vmcnt(0)" ::: "memory");
        }
    }
    __syncthreads();
}

constexpr int LDS_BYTES = 147456;
constexpr int LDS_CTL = 131072;
constexpr int CW_BAR = 4096;
enum GemmKind { G_IN0 = 0, G_OUT0, G_GU0, G_DN0, G_IN1, G_OUT1, G_GU1, G_DN1 };
__device__ __forceinline__ void moe_setup(const Ptrs& P, int layer, LAS int* tstart, LAS int* cnt, const int tid) {
    if (tid < 64) { const unsigned* g = (const unsigned*)(P.ws + WS_CTL) + CW_CNT + 64 * layer;
        const int c = tid < 16 ? (int)__hip_atomic_load(g + tid, __ATOMIC_RELAXED, __HIP_MEMORY_SCOPE_AGENT) : 0; const int tiles = (c + 255) >> 8; int incl = tiles;
#pragma unroll
        for (int d = 1; d < 16; d <<= 1) { const int o = __shfl_up(incl, d); if (tid >= d) incl += o; }
        if (tid < 16) { cnt[tid] = c; tstart[tid] = incl - tiles; }
        if (tid == 15) tstart[16] = incl; }
    __syncthreads();
}
template <int KIND> __device__ __forceinline__ void stage_gemm(const Ptrs& P, LAS unsigned char* lds, int wg, int nwg) {
    const int tid = tid_opaque(P);
    LAS unsigned char* ring = lds; LAS int* tstart = (LAS int*)(lds + LDS_CTL + 256); LAS int* cnt = (LAS int*)(lds + LDS_CTL + 384);
    const bf16_t* Hb = (const bf16_t*)(P.ws + WS_HB); bf16_t* Z = (bf16_t*)(P.ws + WS_Z); const unsigned char* A28 = P.ws + WS_A2; const bf16_t* A2m = (const bf16_t*)(P.ws + WS_A2M); bf16_t* T = (bf16_t*)(P.ws + WS_T);
    unsigned char* ACT = P.ws + WS_ACT; unsigned char* YK = P.ws + WS_YK;
    if constexpr (KIND == G_IN0) { meta_gemm<0>(Hb, Hb, (const bf16_t*)(P.ws + W_IN0), EVEN_IN, Z, EVEN_IN, 512, 1024, QSCALE0, wg, nwg, tid, (unsigned*)(P.ws + WS_CTL) + CW_KN + 64);
        DenseSched S; S.init(EVEN_IN / 256, nwg, wg); EpiBf16 E{Z, EVEN_IN, EVEN_IN, 2, 4, QSCALE0, (unsigned*)(P.ws + WS_CTL) + CW_KN, 4};
        pg8::gemm_phase(ring, Hb, P.ws + W_IN0, 2048, 2048, S, E, tid); }
    else if constexpr (KIND == G_OUT0) { meta_gemm<1>(A2m, Hb, (const bf16_t*)(P.ws + W_OUT0), 1024, T, D, 0, 0, 1.f, wg, nwg, tid);
        DenseSched S; S.init(4, nwg, wg, 1024); EpiResBf16 E{Hb, T};
        pg8::gemm_phase<EpiResBf16, DenseSched, true>(ring, A28, P.ws + W_OUT08, 1024, 1024, S, E, tid, F8_ASC, F8_WSC); }
    else if constexpr (KIND == G_IN1) { meta_gemm<0>(Hb, Hb, (const bf16_t*)(P.ws + W_IN1), ODD_N, Z, ODD_N, 0, 512, QSCALE1, wg, nwg, tid);
        DenseSched S; S.init(ODD_N / 256, nwg, wg, 1024); EpiBf16 E{Z, ODD_N, ODD_N, 0, 2, QSCALE1, nullptr, 0};
        pg8::gemm_phase<EpiBf16, DenseSched, true>(ring, P.ws + WS_HB8, P.ws + W_IN18, 1024, 1024, S, E, tid, F8_HSC, F8_WSC); }
    else if constexpr (KIND == G_OUT1) { DenseSched S; S.init(4, nwg, wg, 1024); EpiResBf16 E{Hb, T};
        pg8::gemm_phase<EpiResBf16, DenseSched, true>(ring, A28, P.ws + W_OUT18, 1024, 1024, S, E, tid, F8_ASC, F8_WSC); }
    else if constexpr (KIND == G_GU0 || KIND == G_GU1) { constexpr int layer = KIND == G_GU0 ? 0 : 1; moe_setup(P, layer, tstart, cnt, tid);
        MoeSchedT<true> S{tstart, cnt, (const int*)(P.ws + WS_LIST), (const float*)(P.ws + WS_LISTW), 4, nwg, wg, 1024, (size_t)layer * 16 * 1024 * 1024, (const LAS int*)(lds + LDS_CTL + 1024)}; EpiSiluMul E{ACT};
        pg8::gemm_phase<EpiSiluMul, MoeSchedT<true>, true, true>(ring, P.ws + WS_HB8, P.ws + W_GU, 1024, 1024, S, E, tid, F8_HSC, F8_WSC); }
    else { constexpr int layer = KIND == G_DN0 ? 0 : 1; moe_setup(P, layer, tstart, cnt, tid);
        MoeSchedT<false> S{tstart, cnt, (const int*)(P.ws + WS_LIST), (const float*)(P.ws + WS_LISTW), 4, nwg, wg, 512, (size_t)layer * 16 * 1024 * 512, nullptr}; EpiScatter E{YK, (LAS int*)(lds + LDS_CTL + 1024), (LAS float*)(lds + LDS_CTL + 3072)};
        pg8::gemm_phase<EpiScatter, MoeSchedT<false>, true, true>(ring, ACT, P.ws + W_DN, 512, 512, S, E, tid, F8_ASC, F8_WSC); }
}

constexpr int NPHASE = 19;
struct Args { Ptrs P; int lo, hi, flags, pad; };
__global__ void __launch_bounds__(512, 2) mega(Args a) {
    extern __shared__ __attribute__((aligned(16))) unsigned char lds_[];
    LAS unsigned char* lds = (LAS unsigned char*)lds_;
    const Ptrs& P = a.P;
    const int wg = blockIdx.x, nwg = gridDim.x, lo = a.lo, hi = a.hi;
    for (int u = threadIdx.x; u < (LDS_BYTES - LDS_CTL) / 4; u += 512) ((LAS unsigned*)(lds + LDS_CTL))[u] = 0u;
    __syncthreads();
    if ((threadIdx.x & 63) == 0) ((volatile LAS int*)(lds + LDS_WIDTAB))[hw_wave_key()] = (int)(threadIdx.x >> 6);
    __syncthreads();
    XcdBarrier bar; bar.bar = (unsigned*)(P.ws + WS_CTL) + CW_BAR; bar.x = 0; bar.st = nullptr;
    const bool multi = (hi - lo) > 1;
    if (multi) bar = xcd_barrier_post((unsigned*)(P.ws + WS_CTL) + CW_BAR, (volatile LAS unsigned*)(lds + LDS_CTL) + 8, tid_opaque(P) == 0);
#define IN(k) (lo <= (k) && (k) < hi)
#define SEAM(k) do { if (IN(k) && IN((k) + 1)) xcd_barrier(bar, tid_opaque(P) == 0); } while (0)
#define RUN(k, ...) do { if (IN(k)) { __VA_ARGS__; } SEAM(k); } while (0)
    RUN(0, stage_prep(P, lds, wg, nwg));
    RUN(1, stage_gemm<G_IN0>(P, lds, wg, nwg));
    RUN(2, if (!(a.flags & 2)) stage_pool(P, wg, nwg); stage_attn(P, lds, wg, nwg, a.flags));
    RUN(3, stage_combine(P, wg, nwg));
    RUN(4, stage_gemm<G_OUT0>(P, lds, wg, nwg));
    RUN(5, stage_ln<0>(P, lds, wg, nwg));
    RUN(6, stage_gemm<G_GU0>(P, lds, wg, nwg));
    RUN(7, stage_gemm<G_DN0>(P, lds, wg, nwg));
    RUN(8, stage_ln<2>(P, lds, wg, nwg));
    RUN(9, stage_gemm<G_IN1>(P, lds, wg, nwg));
    RUN(10, gla::stage_pre(P, lds, wg, nwg));
    RUN(11, stage_gla_seg<false>(P, lds, wg, nwg));
    RUN(12, stage_gla_scan(P, wg, nwg));
    RUN(13, stage_gla_seg<true>(P, lds, wg, nwg));
    RUN(14, stage_gemm<G_OUT1>(P, lds, wg, nwg));
    RUN(15, stage_ln<1>(P, lds, wg, nwg));
    RUN(16, stage_gemm<G_GU1>(P, lds, wg, nwg));
    RUN(17, stage_gemm<G_DN1>(P, lds, wg, nwg));
    RUN(18, stage_ln<3>(P, lds, wg, nwg));
#undef RUN
#undef IN
#undef SEAM
}

#ifndef MK_MULTI
#define MK_MULTI 0
#endif
extern "C" void kernel_launch(void* const* d_in, const int* in_sizes, int n_in, void* d_out, int out_size, void* d_ws, size_t ws_size, hipStream_t stream) {
    static int grid = 0;
    if (grid == 0) {
        if (n_in != 25 || ws_size < WS_END || out_size != NB * SEQ * D) { fprintf(stderr, "kernel_launch: bad args n_in %d ws %zu (need %zu) out %d\n", n_in, ws_size, (size_t)WS_END, out_size); grid = -1; return; }
        int dev = 0, cus = 0, per_cu = 0;
        if (hipGetDevice(&dev) != hipSuccess || hipDeviceGetAttribute(&cus, hipDeviceAttributeMultiprocessorCount, dev) != hipSuccess) { grid = -1; return; }
        if (hipFuncSetAttribute((const void*)mega, hipFuncAttributeMaxDynamicSharedMemorySize, LDS_BYTES) != hipSuccess) { fprintf(stderr, "kernel_launch: hipFuncSetAttribute failed\n"); grid = -1; return; }
        if (hipOccupancyMaxActiveBlocksPerMultiprocessor(&per_cu, (const void*)mega, 512, LDS_BYTES) != hipSuccess || per_cu < 1) { fprintf(stderr, "kernel_launch: occupancy query says %d blocks/CU\n", per_cu); (void)hipGetLastError(); grid = -1; return; }
        grid = cus;
    }
    if (grid < 0) return;
    (void)hipMemsetAsync((char*)d_ws + WS_CTL, 0, CTL_BYTES, stream);
    Args a{};
    const float** pp = (const float**)&a.P;
    for (int i = 0; i < 25; ++i) pp[i] = (const float*)d_in[i];
    a.P.out = (float*)d_out; a.P.ws = (unsigned char*)d_ws;
#if MK_MULTI
    for (int k = 0; k < NPHASE; ++k) { a.lo = k; a.hi = k + 1; for (int r = 0; r < 1 + (int)((PROBE_DUP >> k) & 1u); ++r) { a.flags = r ? PROBE_FLAGS : 0; hipLaunchKernelGGL(mega, dim3(grid), dim3(512), LDS_BYTES, stream, a); } }
#else
    a.lo = 0; a.hi = NPHASE; hipLaunchKernelGGL(mega, dim3(grid), dim3(512), LDS_BYTES, stream, a);
#endif
}
```

```cpp
#include <hip/hip_runtime.h>
#include <cstdio>
#include <cstdint>

#ifndef PROBE_FLAGS
#define PROBE_FLAGS 0
#endif
#ifndef PROBE_DUP
#define PROBE_DUP 0u
#endif
#define GAS __attribute__((address_space(1)))
#define LAS __attribute__((address_space(3)))
typedef unsigned short bf16_t;
typedef short bf16x8 __attribute__((ext_vector_type(8)));
typedef float f32x4 __attribute__((ext_vector_type(4)));
typedef float f32x2 __attribute__((ext_vector_type(2)));
typedef float f32x16 __attribute__((ext_vector_type(16)));
typedef unsigned u32x4 __attribute__((ext_vector_type(4)));
typedef unsigned u32x2 __attribute__((ext_vector_type(2)));

constexpr int D = 1024, NB = 4, SEQ = 8192, NMETA = 16;
constexpr int LB = SEQ + NMETA;
constexpr int M1 = NB * LB;
constexpr int NPANEL = NB * SEQ / 256;
constexpr int EVEN_IN = 2048, ODD_IN = 3088, ODD_N = 3072;
constexpr int NEXP = 16, DEXP = 512;
constexpr float ALPHA = 1.41421356237f;
constexpr float LN_EPS = 1e-5f, RMS_EPS = 1e-6f;
constexpr float LOG2E = 1.4426950408889634f;
constexpr float QSCALE0 = 0.125f * LOG2E;
constexpr float QSCALE1 = 0.08838834764831845f;
constexpr float LAMBDA_INIT = 0.2f;

constexpr size_t MiB = 1u << 20;
constexpr size_t WS_CTL = 0;
constexpr size_t CTL_BYTES = 1 * MiB;
constexpr size_t WS_MISC = 1 * MiB;
constexpr size_t WS_RW = 2 * MiB;
constexpr size_t WS_LIST = 3 * MiB;
constexpr size_t WS_GLR = 5 * MiB + 262144;
constexpr size_t WS_W = 8 * MiB;
constexpr size_t W_IN0 = WS_W;
constexpr size_t W_OUT0 = W_IN0 + (size_t)2048 * 1024 * 2;
constexpr size_t W_IN1 = W_OUT0 + (size_t)1024 * 1024 * 2;
constexpr size_t W_IN18 = W_IN1 + (size_t)ODD_N * 1024 * 2;
constexpr size_t W_OUT1 = W_IN18 + (size_t)ODD_N * 1024;
constexpr size_t W_OUT08 = W_OUT1 + (size_t)1024 * 1024 * 2;
constexpr size_t W_OUT18 = W_OUT08 + (size_t)1024 * 1024;
constexpr size_t W_GU = W_OUT18 + (size_t)1024 * 1024;
constexpr size_t W_DN = W_GU + (size_t)2 * 16 * 1024 * 1024;
constexpr size_t W_END = W_DN + (size_t)2 * 16 * 1024 * 512;
constexpr size_t WS_HB = 76 * MiB;
constexpr size_t WS_HB8 = WS_HB + (size_t)M1 * 1024 * 2;
constexpr size_t WS_Z = WS_HB8 + (size_t)M1 * 1024 + 524288;
constexpr size_t WS_T = WS_Z;
constexpr size_t WS_YK = WS_Z;
constexpr size_t WS_OA = WS_Z + (size_t)M1 * ODD_N * 2;
constexpr size_t WS_A2 = WS_OA + (size_t)M1 * 1024 * 2;
constexpr size_t WS_A2M = WS_MISC + 65536;
constexpr size_t WS_ACT = WS_OA;
constexpr size_t WS_LISTW = WS_A2 + (size_t)M1 * 1024;
constexpr size_t WS_END = WS_LISTW + (size_t)16 * M1 * 4;
static_assert(W_END <= WS_HB, "weights fit");
static_assert(WS_END <= (size_t)512 * MiB, "workspace fits 512 MiB");
static_assert(WS_LIST + (size_t)16 * M1 * 4 <= WS_GLR && WS_GLR + (size_t)M1 * 64 <= WS_W, "small buffers");
constexpr float F8_YSCALE = 32.f;
constexpr float F8_WSCALE = 32.f, F8_HSCALE = 4.f, F8_ASCALE = 4.f;
constexpr int F8_WSC = 0x7a7a7a7a, F8_HSC = 0x7d7d7d7d, F8_ASC = 0x7d7d7d7d;
constexpr int CW_CNT = 64;
constexpr int LISTCAP = M1;
constexpr int CW_KN = 256;
constexpr int CW_AQ = 512;

__device__ __forceinline__ float bf2f(unsigned short b) { return __builtin_bit_cast(float, (unsigned)b << 16); }
__device__ __forceinline__ float bflo(unsigned w) { return __builtin_bit_cast(float, w << 16); }
__device__ __forceinline__ float bfhi(unsigned w) { return __builtin_bit_cast(float, w & 0xffff0000u); }
typedef __bf16 bf16x2_t __attribute__((ext_vector_type(2)));
__device__ __forceinline__ unsigned cvt_pk_bf16(float lo, float hi) { const f32x2 v = {lo, hi}; const bf16x2_t b = __builtin_convertvector(v, bf16x2_t); return __builtin_bit_cast(unsigned, b); }
__device__ __forceinline__ unsigned pk2(float lo, float hi) { return cvt_pk_bf16(lo, hi); }
__device__ __forceinline__ unsigned f2bf(float f) { return cvt_pk_bf16(f, 0.f) & 0xffffu; }
__device__ __forceinline__ unsigned pk4_fp8(float a, float b, float c, float d) {
    a = fminf(fmaxf(a, -448.f), 448.f); b = fminf(fmaxf(b, -448.f), 448.f); c = fminf(fmaxf(c, -448.f), 448.f); d = fminf(fmaxf(d, -448.f), 448.f);
    int w = 0; w = __builtin_amdgcn_cvt_pk_fp8_f32(a, b, w, false); w = __builtin_amdgcn_cvt_pk_fp8_f32(c, d, w, true); return (unsigned)w; }
__device__ __forceinline__ void fp8x4_to_f32(unsigned w, float (&o)[4]) { const f32x2 a = __builtin_amdgcn_cvt_pk_f32_fp8((int)w, false), b = __builtin_amdgcn_cvt_pk_f32_fp8((int)w, true); o[0] = a.x; o[1] = a.y; o[2] = b.x; o[3] = b.y; }
__device__ __forceinline__ void lds_dma16(const void* gsrc, unsigned lds_dst) { unsigned keep;
    asm volatile("s_mov_b32 %0, m0\n\ts_mov_b32 m0, %2\n\ts_nop 0\n\tglobal_load_lds_dwordx4 %1, off\n\ts_mov_b32 m0, %0" : "=&s"(keep) : "v"(gsrc), "s"(lds_dst) : "memory"); }
__device__ __forceinline__ void wave_sum4(float (&v)[4]) {
    const auto r02 = __builtin_amdgcn_permlane32_swap(__float_as_uint(v[0]), __float_as_uint(v[2]), false, false); const unsigned x0 = r02[0], x1 = r02[1];
    const auto r13 = __builtin_amdgcn_permlane32_swap(__float_as_uint(v[1]), __float_as_uint(v[3]), false, false); const unsigned y0 = r13[0], y1 = r13[1];
    const float a0 = __uint_as_float(x0) + __uint_as_float(x1), a1 = __uint_as_float(y0) + __uint_as_float(y1);
    const auto rb = __builtin_amdgcn_permlane16_swap(__float_as_uint(a0), __float_as_uint(a1), false, false); const unsigned z0 = rb[0], z1 = rb[1];
    float b = __uint_as_float(z0) + __uint_as_float(z1);
#define WS4_DPP(x_, c_) __builtin_bit_cast(float, __builtin_amdgcn_update_dpp(0, __builtin_bit_cast(int, (x_)), (c_), 0xf, 0xf, false))
    b += WS4_DPP(b, 0x128); b += WS4_DPP(b, 0x141); b += WS4_DPP(b, 0x1b); b += WS4_DPP(b, 0xb1);
#undef WS4_DPP
    const int bi = __builtin_bit_cast(int, b);
    v[0] = __builtin_bit_cast(float, __builtin_amdgcn_readlane(bi, 0)); v[1] = __builtin_bit_cast(float, __builtin_amdgcn_readlane(bi, 16));
    v[2] = __builtin_bit_cast(float, __builtin_amdgcn_readlane(bi, 32)); v[3] = __builtin_bit_cast(float, __builtin_amdgcn_readlane(bi, 48));
}
__device__ __forceinline__ float wave_sum(float v) {
#pragma unroll
    for (int o = 1; o < 64; o <<= 1) v += __shfl_xor(v, o);
    return v;
}
__device__ __forceinline__ float wave_max(float v) {
#pragma unroll
    for (int o = 1; o < 64; o <<= 1) v = fmaxf(v, __shfl_xor(v, o));
    return v;
}
struct Ptrs {
    const float *x, *meta, *even_w_in, *pool_w, *pool_scale, *lq1, *lk1, *lq2, *lk2, *subln, *even_w_out, *odd_w_in, *gate_w2, *gate_b, *head_norm, *odd_w_out,
        *ln_mix_g, *ln_mix_b, *ln_ffn_g, *ln_ffn_b, *router_w, *router_bias, *moe_w_gate, *moe_w_up, *moe_w_down;
    float* out; unsigned char* ws;
};
constexpr int LDS_WIDTAB = 131072 + 512;
extern __shared__ __attribute__((aligned(16))) unsigned char lds_dyn_alias_[];
__device__ __forceinline__ unsigned hw_wave_key() { return (unsigned)__builtin_amdgcn_s_getreg((5 << 11) | 4) & 0x3fu; }
__device__ __forceinline__ int tid_opaque(const Ptrs&) {
    unsigned z = 0u; asm volatile("" : "+v"(z));
    const int lane = (int)__builtin_amdgcn_mbcnt_hi(~0u, __builtin_amdgcn_mbcnt_lo(~0u, z));
    const int wid = __builtin_amdgcn_readfirstlane(((const volatile LAS int*)((LAS unsigned char*)lds_dyn_alias_ + LDS_WIDTAB))[hw_wave_key()]);
    return wid * 64 + lane;
}
__device__ __forceinline__ int panel_row0(int pm) { return (pm >> 5) * LB + NMETA + (pm & 31) * 256; }
__device__ __forceinline__ const float* h0_ptr(const Ptrs& P, int row) { const int b = row / LB, p = row - b * LB; return p < NMETA ? P.meta + (size_t)p * D : P.x + ((size_t)b * SEQ + (p - NMETA)) * D; }

namespace pg8 {
constexpr int BM = 256, BK = 64, HALF = 128, HTB = HALF * BK * 2, STAGE_BYTES = 8 * HTB, NXCD = 8, WGM = 8;
__host__ __device__ __forceinline__ int lds_byte(int r, int c) { const int st = (r >> 4) * 2 + (c >> 5), rr = r & 15, cc = c & 31, ob = rr * 64 + cc * 2; return st * 1024 + (ob ^ (((ob >> 9) & 1) << 5)); }
__host__ __device__ __forceinline__ void stage_rc(int b, int& R, int& C) { const int st = b / 1024, sb = b % 1024, swz = sb ^ (((sb >> 9) & 1) << 5); R = (st >> 1) * 16 + swz / 64; C = (st & 1) * 32 + (swz % 64) / 2; }
__host__ __device__ __forceinline__ int perm32(int rho) { const int n = rho >> 4, i = rho & 15; return 8 * (i >> 2) + 4 * n + (i & 3); }
struct Unit { int pm, pn, e, lt, hn, par; };

__device__ __forceinline__ void static_tile(int L, int nM, int nN, int& pm, int& pn) {
    const int nwg = nM * nN; int wgid = L;
    { const int q = nwg / NXCD, r = nwg % NXCD, xcd = wgid % NXCD, off = wgid / NXCD; wgid = (xcd < r ? xcd * (q + 1) : r * (q + 1) + (xcd - r) * q) + off; }
    const int nig = WGM * nN, gid = wgid / nig, fm = gid * WGM, gsz = (nM - fm) < WGM ? (nM - fm) : WGM;
    pm = fm + ((wgid % nig) % gsz); pn = (wgid % nig) / gsz;
}

typedef int v8i32 __attribute__((ext_vector_type(8)));
template <class Epi, class Sched, bool F8 = false, bool HN = false>
__device__ __forceinline__ void gemm_phase(LAS unsigned char* lds, const void* Abase, const void* Bbase, const int KA, const int KB_, const Sched& S, const Epi& E, const int tid, const int sclA = 0x7f7f7f7f, const int sclB = 0x7f7f7f7f) {
    const int wid = __builtin_amdgcn_readfirstlane(tid >> 6), lane = tid & 63, wr = wid >> 2, wc = wid & 3, fr = lane & 15, fq = lane >> 4;
    const int nt = KA / 128;
    unsigned voffB[2];
#pragma unroll
    for (int i = 0; i < 2; ++i) { int R, C; stage_rc(tid * 16 + i * 8192, R, C); const int Rb = Epi::PERM ? ((R & ~31) + perm32(R & 31)) : R;
        voffB[i] = (unsigned)(Rb * KB_ + C * 2); }
    const size_t kstep = (size_t)(BK * 2);
    const size_t hstep = (size_t)HALF * KB_;
    const unsigned ldsw = (unsigned)wid * 1024u;
    const int aoff = lds_byte(wr * 64 + fr, fq * 8), boff = lds_byte(wc * 32 + fr, fq * 8);
#define PG8_SA(b, h) (((b) * 2 + (h)) * HTB)
#define PG8_SB(b, h) ((4 + (b) * 2 + (h)) * HTB)
#define PG8_STAGEB(bufoff, gbase) do { _Pragma("unroll") for (int _i = 0; _i < 2; ++_i) \
        __builtin_amdgcn_global_load_lds((const unsigned*)((const char*)(gbase) + voffB[_i]), (LAS unsigned*)(lds + (bufoff) + ldsw + _i * 8192), 16, 0, 0); } while (0)
#define PG8_STAGEA(bufoff, kbyte, off2) do { _Pragma("unroll") for (int _i = 0; _i < 2; ++_i) \
        __builtin_amdgcn_global_load_lds((const unsigned*)((const char*)Abase + (kbyte) + (off2)[_i]), (LAS unsigned*)(lds + (bufoff) + ldsw + _i * 8192), 16, 0, 0); } while (0)
#define PG8_STAGEA2(bufoff, kbyte, h) do { _Pragma("unroll") for (int _i = 0; _i < 2; ++_i) \
        __builtin_amdgcn_global_load_lds((const unsigned*)((const char*)Abase + (kbyte) + (last ? nxtA[h][_i] : curA[h][_i])), (LAS unsigned*)(lds + (bufoff) + ldsw + _i * 8192), 16, 0, 0); } while (0)
#define PG8_CAT(x0, x1) __builtin_shufflevector(x0, x1, 0, 1, 2, 3, 4, 5, 6, 7)
#define PG8_LDA(dst, b, h) do { _Pragma("unroll") for (int m = 0; m < 4; ++m) { \
        if constexpr (F8) dst##8[m] = __builtin_bit_cast(v8i32, PG8_CAT(*(const LAS u32x4*)(lds + PG8_SA(b, h) + aoff + m * 2048), *(const LAS u32x4*)(lds + PG8_SA(b, h) + aoff + m * 2048 + 1024))); \
        else { _Pragma("unroll") for (int k = 0; k < 2; ++k) dst[m][k] = *(const LAS bf16x8*)(lds + PG8_SA(b, h) + aoff + m * 2048 + k * 1024); } } } while (0)
#define PG8_LDB(dst, b, h) do { _Pragma("unroll") for (int n = 0; n < 2; ++n) { \
        if constexpr (F8) dst##8[n] = __builtin_bit_cast(v8i32, PG8_CAT(*(const LAS u32x4*)(lds + PG8_SB(b, h) + boff + n * 2048), *(const LAS u32x4*)(lds + PG8_SB(b, h) + boff + n * 2048 + 1024))); \
        else { _Pragma("unroll") for (int k = 0; k < 2; ++k) dst[n][k] = *(const LAS bf16x8*)(lds + PG8_SB(b, h) + boff + n * 2048 + k * 1024); } } } while (0)
#define PG8_MMA(ai, bj, At, Bt) do { __builtin_amdgcn_s_setprio(1); _Pragma("unroll") for (int m = 0; m < 4; ++m) _Pragma("unroll") for (int n = 0; n < 2; ++n) { \
        if constexpr (F8) asm volatile("v_mfma_scale_f32_16x16x128_f8f6f4 %0, %1, %2, %0, %3, %4 op_sel_hi:[0,0,0]" : "+v"(acc[ai][bj][m][n]) : "v"(Bt##8[n]), "v"(At##8[m]), "v"(sclB), "v"(sclA));     \
        else { _Pragma("unroll") for (int k = 0; k < 2; ++k) acc[ai][bj][m][n] = __builtin_amdgcn_mfma_f32_16x16x32_bf16(Bt[n][k], At[m][k], acc[ai][bj][m][n], 0, 0, 0); } } __builtin_amdgcn_s_setprio(0); } while (0)
#define PG8_WAIT_V(n) asm volatile("s_waitcnt vmcnt(" #n ")" ::: "memory")
#define PG8_WAIT_L(n) asm volatile("s_waitcnt lgkmcnt(" #n ")" ::: "memory")
#define PG8_BAR __builtin_amdgcn_s_barrier()
#define PG8_SCHED __builtin_amdgcn_sched_barrier(0)
#define PG8_AOFFS(dst, u) do { int tl_ = tid; asm volatile("" : "+v"(tl_));     \
        _Pragma("unroll") for (int _i = 0; _i < 2; ++_i) { int R_, C_; stage_rc(tl_ * 16 + _i * 8192, R_, C_); \
            _Pragma("unroll") for (int _h = 0; _h < 2; ++_h) dst[_h][_i] = (unsigned)S.arow(u, 128 * _h + R_) * (unsigned)KA + (unsigned)C_ * 2u; } } while (0)
    Unit cur, nxt; int ui = 0;
    if (!S.next(0, cur)) return;
    cur.par = 0;
    f32x4 acc[2][2][4][2];
#pragma unroll
    for (int a = 0; a < 2; ++a)
#pragma unroll
        for (int b = 0; b < 2; ++b)
#pragma unroll
            for (int m = 0; m < 4; ++m)
#pragma unroll
                for (int n = 0; n < 2; ++n) acc[a][b][m][n] = (f32x4){0.f, 0.f, 0.f, 0.f};
    bf16x8 At[4][2], B0[2][2], B1[2][2];
    v8i32 At8[4], B08[2], B18[2];
    unsigned curA[2][2], nxtA[2][2];
    if constexpr (Sched::LDSLIST) { if (wid == 0) S.dma_list(cur, (unsigned)__builtin_amdgcn_readfirstlane((int)(unsigned)(size_t)S.ltile), lane);
        asm volatile("s_waitcnt vmcnt(0)" ::: "memory"); PG8_BAR; }
    PG8_AOFFS(curA, cur);
    const char* cB = (const char*)Bbase + S.boff(cur);
    PG8_STAGEB(PG8_SB(0, 0), cB); PG8_STAGEB(PG8_SB(0, 1), cB + hstep); PG8_STAGEA(PG8_SA(0, 0), 0, curA[0]); PG8_STAGEA(PG8_SA(0, 1), 0, curA[1]);
    if (wr == 1) PG8_BAR;
    PG8_WAIT_V(2); PG8_BAR;
    PG8_STAGEB(PG8_SB(1, 0), cB + kstep); PG8_STAGEA(PG8_SA(1, 0), kstep, curA[0]); PG8_STAGEB(PG8_SB(1, 1), cB + hstep + kstep);
    PG8_WAIT_V(6); PG8_BAR;
    for (;;) {
        if constexpr (Epi::META) E.prefetch(cur, S, tid);
        const bool has_next = S.next(ui + 1, nxt); nxt.par = (ui + 1) & 1;
        const char* nB = cB;
        if (has_next) { nB = (const char*)Bbase + S.boff(nxt);
            if constexpr (Sched::LDSLIST) { if (wid == 0) S.dma_list(nxt, (unsigned)__builtin_amdgcn_readfirstlane((int)(unsigned)(size_t)S.ltile), lane); }
            else PG8_AOFFS(nxtA, nxt); }
        else {
#pragma unroll
            for (int h = 0; h < 2; ++h)
#pragma unroll
                for (int i = 0; i < 2; ++i) nxtA[h][i] = curA[h][i];
        }
#pragma unroll 1
        for (int t = 0; t < nt; t += 2) {
            const bool last = (t == nt - 2);
            if constexpr (Sched::LDSLIST) { if (last && has_next) PG8_AOFFS(nxtA, nxt); }
            const size_t k1 = (size_t)(t + 1) * kstep, k2 = last ? 0 : (size_t)(t + 2) * kstep, k3 = k2 + kstep;
            const char* b2 = last ? nB : cB + (size_t)(t + 2) * kstep; const char* b3 = b2 + kstep;
            PG8_LDB(B0, 0, 0); if (!HN || !cur.hn) PG8_LDB(B1, 0, 1); PG8_SCHED; PG8_LDA(At, 0, 0); PG8_STAGEA(PG8_SA(1, 1), k1, curA[1]);
            PG8_WAIT_V(8); PG8_WAIT_L(0); PG8_BAR; PG8_MMA(0, 0, At, B0); if (!HN || !cur.hn) PG8_MMA(0, 1, At, B1); PG8_BAR; PG8_SCHED;
            PG8_LDA(At, 0, 1); PG8_STAGEB(PG8_SB(0, 0), b2); PG8_STAGEB(PG8_SB(0, 1), b2 + hstep); PG8_STAGEA2(PG8_SA(0, 0), k2, 0);
            PG8_WAIT_V(8); PG8_WAIT_L(0); PG8_BAR; PG8_MMA(1, 0, At, B0); if (!HN || !cur.hn) PG8_MMA(1, 1, At, B1); PG8_BAR; PG8_SCHED;
            PG8_LDB(B0, 1, 0); if (!HN || !cur.hn) PG8_LDB(B1, 1, 1); PG8_SCHED; PG8_LDA(At, 1, 0); PG8_STAGEA2(PG8_SA(0, 1), k2, 1);
            PG8_WAIT_V(8); PG8_WAIT_L(0); PG8_BAR; PG8_MMA(0, 0, At, B0); if (!HN || !cur.hn) PG8_MMA(0, 1, At, B1); PG8_BAR; PG8_SCHED;
            PG8_LDA(At, 1, 1); PG8_STAGEB(PG8_SB(1, 0), b3); PG8_STAGEB(PG8_SB(1, 1), b3 + hstep); PG8_STAGEA2(PG8_SA(1, 0), k3, 0);
            PG8_WAIT_V(8); PG8_WAIT_L(0); PG8_BAR; PG8_MMA(1, 0, At, B0); if (!HN || !cur.hn) PG8_MMA(1, 1, At, B1); PG8_BAR; PG8_SCHED;
        }
        if (wr == 0) PG8_BAR;
        if constexpr (F8) asm volatile("s_nop 15\n\ts_nop 15" ::: "memory");
        E(acc, cur, wr, wc, fr, fq, S);
        if (!has_next) break;
#pragma unroll
        for (int a = 0; a < 2; ++a)
#pragma unroll
            for (int b = 0; b < 2; ++b)
#pragma unroll
                for (int m = 0; m < 4; ++m)
#pragma unroll
                    for (int n = 0; n < 2; ++n) acc[a][b][m][n] = (f32x4){0.f, 0.f, 0.f, 0.f};
        cur = nxt; cB = nB; ++ui;
#pragma unroll
        for (int h = 0; h < 2; ++h)
#pragma unroll
            for (int i = 0; i < 2; ++i) curA[h][i] = nxtA[h][i];
        if (wr == 1) PG8_BAR;
    }
    PG8_WAIT_V(0);
    PG8_BAR;
#undef PG8_SA
#undef PG8_SB
#undef PG8_STAGEA
#undef PG8_STAGEA2
#undef PG8_STAGEB
#undef PG8_LDA
#undef PG8_LDB
#undef PG8_MMA
#undef PG8_CAT
#undef PG8_WAIT_V
#undef PG8_WAIT_L
#undef PG8_BAR
#undef PG8_SCHED
#undef PG8_AOFFS
}
}
using pg8::Unit;

struct DenseSched {
    static constexpr bool LDSLIST = false;
    int nN, nTot, G, c, kb;
    __device__ void init(int nN_, int G_, int c_, int kb_ = 2048) { nN = nN_; nTot = NPANEL * nN_; G = G_; c = c_; kb = kb_; }
    __device__ __forceinline__ bool next(int i, Unit& u) const {
        const int L = i * G + c; if (L >= nTot) return false;
        pg8::static_tile(L, NPANEL, nN, u.pm, u.pn); u.e = 0; u.lt = 0; u.hn = 0; return true;
    }
    __device__ __forceinline__ int arow(const Unit& u, int r) const { return panel_row0(u.pm) + r; }
    __device__ __forceinline__ int orow(const Unit& u, int r) const { return panel_row0(u.pm) + r; }
    __device__ __forceinline__ size_t boff(const Unit& u) const { return (size_t)u.pn * 256 * kb; }
};
template <bool GATHER> struct MoeSchedT {
    static constexpr bool LDSLIST = GATHER;
    const LAS int* tstart;
    const LAS int* cnt;
    const int* list;
    const float* listw;
    int nN, G, c, K; size_t wbase;
    const LAS int* ltile;
    __device__ __forceinline__ bool next(int i, Unit& u) const {
        const int cx = (G & 7) ? c : (c & 7) * (G >> 3) + (c >> 3);
        const int L = i * G + cx, ntot = tstart[16] * nN;
        const int R0 = (ntot / G) * G, left = ntot - R0; const bool split = left > 0 && 2 * left <= G;
        int Lu = L, hn = 0, hsel = 0;
        if (split && L >= R0) { const int j = L - R0; if (j >= 2 * left) return false; Lu = R0 + (j >> 1); hn = 1; hsel = j & 1; }
        else if (L >= ntot) return false;
        const int tl = Lu / nN; u.pn = 2 * (Lu - tl * nN) + hsel; u.hn = hn; u.pm = tl; int e = 0;
#pragma unroll
        for (int j = 1; j < 16; ++j) e += (tl >= tstart[j]) ? 1 : 0;
        u.e = e; u.lt = tl - tstart[e]; return true;
    }
    __device__ __forceinline__ void dma_list(const Unit& u, unsigned lds_dst, int lane) const { lds_dma16((const char*)(list + (size_t)u.e * LISTCAP + (size_t)u.lt * 256) + lane * 16, lds_dst); }
    __device__ __forceinline__ void dma_listw(const Unit& u, unsigned lds_dst, int lane) const { lds_dma16((const char*)(listw + (size_t)u.e * LISTCAP + (size_t)u.lt * 256) + lane * 16, lds_dst); }
    __device__ __forceinline__ bool valid(const Unit& u, int r) const { return u.lt * 256 + r < cnt[u.e]; }
    __device__ __forceinline__ int arow(const Unit& u, int r) const {
        if (!GATHER) return u.pm * 256 + r;
        return ltile[valid(u, r) ? r : 0] >> 1; }
    __device__ __forceinline__ size_t boff(const Unit& u) const { return wbase + ((size_t)u.e * 1024 + (size_t)u.pn * 128) * K; }
};

struct EpiBf16 {
    static constexpr bool PERM = true, META = false;
    bf16_t* O; int ldc, ncols; int sc_lo, sc_hi; float sc; unsigned* kn; int kn_lo;
    template <class Sched> __device__ __forceinline__ void operator()(const f32x4 (&acc)[2][2][4][2], const Unit& u, int wr, int wc, int fr, int fq, const Sched& S) const {
        const float s = (u.pn >= sc_lo && u.pn < sc_hi) ? sc : 1.f;
        if (kn && (u.pn == kn_lo || u.pn == kn_lo + 1)) {
#pragma unroll
            for (int bj = 0; bj < 2; ++bj) { float mxs = 0.f;
#pragma unroll
                for (int ai = 0; ai < 2; ++ai)
#pragma unroll
                    for (int m = 0; m < 4; ++m) { const f32x4 v0 = acc[ai][bj][m][0], v1 = acc[ai][bj][m][1];
                        float ss = v0[0] * v0[0] + v0[1] * v0[1] + v0[2] * v0[2] + v0[3] * v0[3] + v1[0] * v1[0] + v1[1] * v1[1] + v1[2] * v1[2] + v1[3] * v1[3];
                        ss += __shfl_xor(ss, 16); ss += __shfl_xor(ss, 32); mxs = fmaxf(mxs, ss); }
                mxs = fmaxf(mxs, __shfl_xor(mxs, 1)); mxs = fmaxf(mxs, __shfl_xor(mxs, 2)); mxs = fmaxf(mxs, __shfl_xor(mxs, 4)); mxs = fmaxf(mxs, __shfl_xor(mxs, 8));
                if (fr == 0 && fq == 0) atomicMax(kn + ((u.pm >> 5) * 8 + (u.pn - kn_lo) * 4 + bj * 2 + (wc >> 1)) * 2 + (wc & 1), __float_as_uint(mxs)); } }
#pragma unroll
        for (int ai = 0; ai < 2; ++ai)
#pragma unroll
            for (int m = 0; m < 4; ++m) { const int orow = S.orow(u, ai * 128 + wr * 64 + m * 16 + fr);
#pragma unroll
                for (int bj = 0; bj < 2; ++bj) { const int col = u.pn * 256 + bj * 128 + wc * 32 + 8 * fq;
                    const f32x4 v0 = acc[ai][bj][m][0] * s, v1 = acc[ai][bj][m][1] * s;
                    u32x4 w; w.x = cvt_pk_bf16(v0[0], v0[1]); w.y = cvt_pk_bf16(v0[2], v0[3]); w.z = cvt_pk_bf16(v1[0], v1[1]); w.w = cvt_pk_bf16(v1[2], v1[3]);
                    if (orow >= 0 && col < ncols) *(u32x4*)(O + (size_t)orow * ldc + col) = w; } }
    }
};
struct EpiResBf16 {
    static constexpr bool PERM = true, META = false;
    const bf16_t* Hb; bf16_t* T;
    template <class Sched> __device__ __forceinline__ void operator()(const f32x4 (&acc)[2][2][4][2], const Unit& u, int wr, int wc, int fr, int fq, const Sched& S) const {
        u32x4 h[2][4][2];
#pragma unroll
        for (int ai = 0; ai < 2; ++ai)
#pragma unroll
            for (int m = 0; m < 4; ++m) { const size_t orow = (size_t)S.orow(u, ai * 128 + wr * 64 + m * 16 + fr);
#pragma unroll
                for (int bj = 0; bj < 2; ++bj) h[ai][m][bj] = *(const u32x4*)(Hb + orow * D + u.pn * 256 + bj * 128 + wc * 32 + 8 * fq); }
        __builtin_amdgcn_sched_barrier(0);
#pragma unroll
        for (int ai = 0; ai < 2; ++ai)
#pragma unroll
            for (int m = 0; m < 4; ++m) { const size_t orow = (size_t)S.orow(u, ai * 128 + wr * 64 + m * 16 + fr);
#pragma unroll
                for (int bj = 0; bj < 2; ++bj) { const int col = u.pn * 256 + bj * 128 + wc * 32 + 8 * fq;
                    const u32x4 hh = h[ai][m][bj]; const f32x4 v0 = acc[ai][bj][m][0], v1 = acc[ai][bj][m][1];
                    u32x4 w; w.x = cvt_pk_bf16(bflo(hh.x) * ALPHA + v0[0], bfhi(hh.x) * ALPHA + v0[1]); w.y = cvt_pk_bf16(bflo(hh.y) * ALPHA + v0[2], bfhi(hh.y) * ALPHA + v0[3]);
                    w.z = cvt_pk_bf16(bflo(hh.z) * ALPHA + v1[0], bfhi(hh.z) * ALPHA + v1[1]); w.w = cvt_pk_bf16(bflo(hh.w) * ALPHA + v1[2], bfhi(hh.w) * ALPHA + v1[3]);
                    *(u32x4*)(T + orow * D + col) = w; } }
    }
};
template <int MODE> __device__ __forceinline__ void meta_gemm(const bf16_t* Hb, const bf16_t* Res, const bf16_t* Bt, int N, bf16_t* O, int ldo, int sc_lo, int sc_hi, float sc, int wg, int nwg, const int tid_, unsigned* knm = nullptr) {
    const int lane = tid_ & 63, wave = __builtin_amdgcn_readfirstlane(tid_ >> 6), tok = lane & 15, kq = lane >> 4;
    for (int tile = wg * 8 + wave; tile < N / 16; tile += nwg * 8) {
        const bf16_t* wp = Bt + (size_t)(tile * 16 + tok) * 1024 + kq * 8; const bf16_t* hp = Hb + (size_t)tok * D + kq * 8;
        f32x4 acc = (f32x4){0.f, 0.f, 0.f, 0.f};
#pragma unroll 16
        for (int k = 0; k < 32; ++k) { const bf16x8 a = *(const bf16x8*)(wp + k * 32), bb = *(const bf16x8*)(hp + k * 32); acc = __builtin_amdgcn_mfma_f32_16x16x32_bf16(a, bb, acc, 0, 0, 0); }
        const int n = tile * 16 + 4 * kq;
        if (MODE == 0 && knm && tile >= 64 && tile < 96) {
            float ss = acc[0] * acc[0] + acc[1] * acc[1] + acc[2] * acc[2] + acc[3] * acc[3]; ss += __shfl_xor(ss, 16); ss += __shfl_xor(ss, 32);
            ss = fmaxf(ss, __shfl_xor(ss, 1)); ss = fmaxf(ss, __shfl_xor(ss, 2)); ss = fmaxf(ss, __shfl_xor(ss, 4)); ss = fmaxf(ss, __shfl_xor(ss, 8));
            if (lane == 0) atomicMax(knm + (tile - 64), __float_as_uint(ss)); }
        if (MODE == 0) { const float f = (n >= sc_lo && n < sc_hi) ? sc : 1.f; u32x2 w; w.x = cvt_pk_bf16(acc[0] * f, acc[1] * f); w.y = cvt_pk_bf16(acc[2] * f, acc[3] * f);
#pragma unroll
            for (int b = 0; b < NB; ++b) *(u32x2*)(O + (size_t)(b * LB + tok) * ldo + n) = w; }
        else { const u32x2 h = *(const u32x2*)(Res + (size_t)tok * D + n); u32x2 w; w.x = cvt_pk_bf16(bflo(h.x) * ALPHA + acc[0], bfhi(h.x) * ALPHA + acc[1]); w.y = cvt_pk_bf16(bflo(h.y) * ALPHA + acc[2], bfhi(h.y) * ALPHA + acc[3]);
#pragma unroll
            for (int b = 0; b < NB; ++b) *(u32x2*)(O + (size_t)(b * LB + tok) * ldo + n) = w; }
    }
}
struct EpiSiluMul {
    static constexpr bool PERM = true, META = false;
    unsigned char* ACT;
    template <class Sched> __device__ __forceinline__ void operator()(const f32x4 (&acc)[2][2][4][2], const Unit& u, int wr, int wc, int fr, int fq, const Sched& S) const {
#pragma unroll
        for (int ai = 0; ai < 2; ++ai)
#pragma unroll
            for (int m = 0; m < 4; ++m) { const size_t arow = (size_t)u.pm * 256 + ai * 128 + wr * 64 + m * 16 + fr;
#pragma unroll
                for (int bj = 0; bj < 2; ++bj) { if (bj == 1 && u.hn) continue; const int col = u.pn * 64 + bj * 64 + wc * 16 + 4 * fq;
                    const f32x4 g = acc[ai][bj][m][0], up = acc[ai][bj][m][1]; float a[4];
#pragma unroll
                    for (int i = 0; i < 4; ++i) a[i] = g[i] * __builtin_amdgcn_rcpf(1.f + __builtin_amdgcn_exp2f(g[i] * -1.44269504f)) * (up[i] * F8_ASCALE);
                    *(unsigned*)(ACT + arow * DEXP + col) = pk4_fp8(a[0], a[1], a[2], a[3]); } }
    }
};
struct EpiScatter {
    static constexpr bool PERM = true, META = true;
    unsigned char* YK; LAS int* ms; LAS float* mw;
    template <class Sched> __device__ __forceinline__ void prefetch(const Unit& u, const Sched& S, int tid) const {
        if (__builtin_amdgcn_readfirstlane(tid >> 6) == 0) { S.dma_list(u, (unsigned)__builtin_amdgcn_readfirstlane((int)(unsigned)(size_t)(ms + u.par * 256)), tid & 63);
            S.dma_listw(u, (unsigned)__builtin_amdgcn_readfirstlane((int)(unsigned)(size_t)(mw + u.par * 256)), tid & 63); } }
    template <class Sched> __device__ __forceinline__ void operator()(const f32x4 (&acc)[2][2][4][2], const Unit& u, int wr, int wc, int fr, int fq, const Sched& S) const {
        int sl[2][4]; float w8[2][4];
#pragma unroll
        for (int ai = 0; ai < 2; ++ai)
#pragma unroll
            for (int m = 0; m < 4; ++m) { const int rt = u.par * 256 + ai * 128 + wr * 64 + m * 16 + fr; sl[ai][m] = ms[rt]; w8[ai][m] = mw[rt] * F8_YSCALE; }
        const int nvalid = S.cnt[u.e] - u.lt * 256;
#pragma unroll
        for (int ai = 0; ai < 2; ++ai)
#pragma unroll
            for (int m = 0; m < 4; ++m) { const int rl = ai * 128 + wr * 64 + m * 16 + fr; const bool ok = rl < nvalid; const int s_ = ok ? sl[ai][m] : 0;
                unsigned char* yrow = YK + ((size_t)(s_ & 1) * M1 + (size_t)(s_ >> 1)) * D + u.pn * 128 + wc * 32 + 8 * fq;
#pragma unroll
                for (int bj = 0; bj < 2; ++bj) {
                    const f32x4 v0 = acc[ai][bj][m][0] * w8[ai][m], v1 = acc[ai][bj][m][1] * w8[ai][m];
                    u32x2 w; w.x = pk4_fp8(v0[0], v0[1], v0[2], v0[3]); w.y = pk4_fp8(v1[0], v1[1], v1[2], v1[3]);
                    if (ok && !(bj == 1 && u.hn)) *(u32x2*)(yrow + bj * 128) = w; } }
    }
};

template <int MODE> __device__ __forceinline__ int wrow_map(int n) { return MODE == 0 ? n : (8 * (n >> 2) + (n & 3) + (MODE == 2 ? 4 : 0)); }
template <int MODE> __device__ __forceinline__ void transpose_item_f8(const float* W, int srcpitch, int K, int N, unsigned char* WT, int dpitch, LAS float* scr, int item, int lane) {
    const int nblk = (N + 31) / 32, kb = item / nblk, nb = item % nblk, k0 = 64 * kb, n0 = 32 * nb;
    { float tmp[32];
#pragma unroll
        for (int i = 0; i < 32; ++i) { const int kk = 2 * i + (lane >> 5), n = n0 + (lane & 31); tmp[i] = n < N ? W[(size_t)(k0 + kk) * srcpitch + n] : 0.f; }
#pragma unroll
        for (int i = 0; i < 32; ++i) scr[(2 * i + (lane >> 5)) * 33 + (lane & 31)] = tmp[i] * F8_WSCALE; }
    asm volatile("s_waitcnt lgkmcnt(0)" ::: "memory");
#pragma unroll
    for (int j = 0; j < 2; ++j) { const int slot = lane + 64 * j, nl = slot >> 2, c = slot & 3; const LAS float* sp = scr + (16 * c) * 33 + nl;
        u32x4 o; o.x = pk4_fp8(sp[0 * 33], sp[1 * 33], sp[2 * 33], sp[3 * 33]); o.y = pk4_fp8(sp[4 * 33], sp[5 * 33], sp[6 * 33], sp[7 * 33]);
        o.z = pk4_fp8(sp[8 * 33], sp[9 * 33], sp[10 * 33], sp[11 * 33]); o.w = pk4_fp8(sp[12 * 33], sp[13 * 33], sp[14 * 33], sp[15 * 33]);
        if (n0 + nl < N) *(u32x4*)(WT + (size_t)wrow_map<MODE>(n0 + nl) * dpitch + k0 + 16 * c) = o; }
    asm volatile("s_waitcnt lgkmcnt(0)" ::: "memory");
}
template <int MODE> __device__ __forceinline__ void transpose_item(const float* W, int srcpitch, int K, int N, bf16_t* WT, int dpitch, int dcol0, LAS float* scr, int item, int lane) {
    const int nblk = (N + 31) / 32, kb = item / nblk, nb = item % nblk, k0 = 64 * kb, n0 = 32 * nb;
    { float tmp[32];
#pragma unroll
        for (int i = 0; i < 32; ++i) { const int kk = 2 * i + (lane >> 5), n = n0 + (lane & 31); tmp[i] = n < N ? W[(size_t)(k0 + kk) * srcpitch + n] : 0.f; }
#pragma unroll
        for (int i = 0; i < 32; ++i) scr[(2 * i + (lane >> 5)) * 33 + (lane & 31)] = tmp[i]; }
    asm volatile("s_waitcnt lgkmcnt(0)" ::: "memory");
    const int c = lane & 7;
#pragma unroll
    for (int j = 0; j < 4; ++j) { const int nl = (lane >> 3) + 8 * j; const LAS float* s = scr + (8 * c) * 33 + nl;
        u32x4 o; o.x = pk2(s[0 * 33], s[1 * 33]); o.y = pk2(s[2 * 33], s[3 * 33]); o.z = pk2(s[4 * 33], s[5 * 33]); o.w = pk2(s[6 * 33], s[7 * 33]);
        if (n0 + nl < N) *(u32x4*)(WT + (size_t)wrow_map<MODE>(n0 + nl) * dpitch + dcol0 + k0 + 8 * c) = o; }
    asm volatile("s_waitcnt lgkmcnt(0)" ::: "memory");
}
constexpr int PI_IN0 = 16 * 64, PI_OUT0 = 8 * 32, PI_OUT08 = 8 * 32, PI_IN1 = 16 * 96, PI_IN18 = 16 * 96, PI_OUT18 = 16 * 32, PI_G = 32 * 256, PI_U = 32 * 256, PI_D = 32 * 256;
constexpr int PREP_EARLY = PI_IN0, PREP_NITEMS = PI_IN0 + PI_OUT0 + PI_OUT08 + PI_IN1 + PI_IN18 + PI_OUT18 + PI_G + PI_U + PI_D;
__device__ __forceinline__ void prep_items(const Ptrs& P, LAS unsigned char* lds, const int it_lo, const int it_hi, const int gw, const int NGW, const int lane, const int wave) {
    LAS float* scr = (LAS float*)(lds + wave * 16384);
    bf16_t* Win0 = (bf16_t*)(P.ws + W_IN0); bf16_t* Wout0 = (bf16_t*)(P.ws + W_OUT0); bf16_t* Win1 = (bf16_t*)(P.ws + W_IN1);
    unsigned char* Wgu = P.ws + W_GU; unsigned char* Wdn = P.ws + W_DN;
    struct ItemD { const float* W; unsigned char* dst; int srcpitch, N, nblk, dpitch, dcol, mode, f8; };
    auto decode = [&](int it, ItemD& d, int& r) {
        r = it;
        if (r < PI_IN0) { d = ItemD{P.even_w_in, (unsigned char*)Win0, EVEN_IN, EVEN_IN, 64, 2048, 0, 0, 0}; return; } r -= PI_IN0;
        if (r < PI_OUT0) { d = ItemD{P.even_w_out + (size_t)512 * 1024, (unsigned char*)Wout0, 1024, 1024, 32, 2048, 1024, 0, 0}; return; } r -= PI_OUT0;
        if (r < PI_OUT08) { d = ItemD{P.even_w_out + (size_t)512 * 1024, P.ws + W_OUT08, 1024, 1024, 32, 1024, 512, 0, 1}; return; } r -= PI_OUT08;
        if (r < PI_IN1) { d = ItemD{P.odd_w_in, (unsigned char*)Win1, ODD_IN, ODD_N, 96, 2048, 0, 0, 0}; return; } r -= PI_IN1;
        if (r < PI_IN18) { d = ItemD{P.odd_w_in, P.ws + W_IN18, ODD_IN, ODD_N, 96, 1024, 0, 0, 1}; return; } r -= PI_IN18;
        if (r < PI_OUT18) { d = ItemD{P.odd_w_out, P.ws + W_OUT18, 1024, 1024, 32, 1024, 0, 0, 1}; return; } r -= PI_OUT18;
        if (r < PI_G) { const int le = r >> 8; r &= 255; d = ItemD{P.moe_w_gate + (size_t)le * 1024 * 512, Wgu + (size_t)le * 1024 * 1024, 512, 512, 16, 1024, 0, 1, 1}; return; } r -= PI_G;
        if (r < PI_U) { const int le = r >> 8; r &= 255; d = ItemD{P.moe_w_up + (size_t)le * 1024 * 512, Wgu + (size_t)le * 1024 * 1024, 512, 512, 16, 1024, 0, 2, 1}; return; } r -= PI_U;
        { const int le = r >> 8; r &= 255; d = ItemD{P.moe_w_down + (size_t)le * 512 * 1024, Wdn + (size_t)le * 1024 * 512, 1024, 1024, 32, 512, 0, 0, 1}; } };
#define PREP_LOAD(d, r, tmp) do { const int kb_ = (r) / (d).nblk, nb_ = (r) % (d).nblk; \
        _Pragma("unroll") for (int i = 0; i < 8; ++i) { const int kk = 8 * i + (lane >> 3), n = 32 * nb_ + 4 * (lane & 7); tmp[i] = *(const f32x4*)((d).W + (size_t)(64 * kb_ + kk) * (d).srcpitch + n); } } while (0)
#define PREP_STORE(d, r, tmp) do { const int kb_ = (r) / (d).nblk, nb_ = (r) % (d).nblk, k0_ = 64 * kb_, n0_ = 32 * nb_; const float sc_ = (d).f8 ? F8_WSCALE : 1.f; \
        _Pragma("unroll") for (int i = 0; i < 8; ++i) { LAS float* wp_ = scr + (8 * i + (lane >> 3)) * 33 + 4 * (lane & 7); wp_[0] = tmp[i][0] * sc_; wp_[1] = tmp[i][1] * sc_; wp_[2] = tmp[i][2] * sc_; wp_[3] = tmp[i][3] * sc_; } \
        asm volatile("s_waitcnt lgkmcnt(0)" ::: "memory"); \
        if ((d).f8) { _Pragma("unroll") for (int j = 0; j < 2; ++j) { const int slot = lane + 64 * j, nl = slot >> 2, c = slot & 3; const LAS float* sp = scr + (16 * c) * 33 + nl; \
                u32x4 o; o.x = pk4_fp8(sp[0 * 33], sp[1 * 33], sp[2 * 33], sp[3 * 33]); o.y = pk4_fp8(sp[4 * 33], sp[5 * 33], sp[6 * 33], sp[7 * 33]); \
                o.z = pk4_fp8(sp[8 * 33], sp[9 * 33], sp[10 * 33], sp[11 * 33]); o.w = pk4_fp8(sp[12 * 33], sp[13 * 33], sp[14 * 33], sp[15 * 33]); \
                const int n = n0_ + nl, rown = (d).mode == 0 ? n : (8 * (n >> 2) + (n & 3) + ((d).mode == 2 ? 4 : 0)); \
                if (n < (d).N) *(u32x4*)((d).dst + (size_t)rown * (d).dpitch + (d).dcol + k0_ + 16 * c) = o; } } \
        else { const int c = lane & 7; \
            _Pragma("unroll") for (int j = 0; j < 4; ++j) { const int nl = (lane >> 3) + 8 * j; const LAS float* sp = scr + (8 * c) * 33 + nl; \
                u32x4 o; o.x = pk2(sp[0 * 33], sp[1 * 33]); o.y = pk2(sp[2 * 33], sp[3 * 33]); o.z = pk2(sp[4 * 33], sp[5 * 33]); o.w = pk2(sp[6 * 33], sp[7 * 33]); \
                if (n0_ + nl < (d).N) *(u32x4*)((d).dst + (size_t)(n0_ + nl) * (d).dpitch + (d).dcol + (size_t)(k0_ + 8 * c) * 2) = o; } } \
        asm volatile("s_waitcnt lgkmcnt(0)" ::: "memory"); } while (0)
#define PREP_TRY(idx, d, r, tmp, ok) do { ok = (idx) < it_hi; decode(ok ? (idx) : it_lo, d, r); PREP_LOAD(d, r, tmp); } while (0)
    { ItemD dA, dB, dC; int rA = 0, rB = 0, rC = 0; f32x4 tA[8], tB[8], tC[8]; bool okA, okB, okC;
        int it = it_lo + gw;
        PREP_TRY(it, dA, rA, tA, okA); PREP_TRY(it + NGW, dB, rB, tB, okB);
        while (okA) {
            PREP_TRY(it + 2 * NGW, dC, rC, tC, okC);
            PREP_STORE(dA, rA, tA);
            if (!okB) break;
            PREP_TRY(it + 3 * NGW, dA, rA, tA, okA);
            PREP_STORE(dB, rB, tB);
            if (!okC) break;
            PREP_TRY(it + 4 * NGW, dB, rB, tB, okB);
            PREP_STORE(dC, rC, tC);
            it += 3 * NGW; } }
#undef PREP_TRY
#undef PREP_LOAD
#undef PREP_STORE
}
__device__ __forceinline__ void prep_fold(const Ptrs& P, const int gw, const int NGW, const int lane) {
    bf16_t* Wout0 = (bf16_t*)(P.ws + W_OUT0);
    for (int it = gw; it < 128 * 16; it += NGW) {
        const int cp0 = (it >> 4) * 4, n = (it & 15) * 64 + lane, g = cp0 >> 7, c0 = cp0 & 127;
        const float* pw = P.pool_w + ((size_t)g * 128 + c0) * 128; const float* ps = P.pool_scale + g * 128; const float* wo = P.even_w_out + (size_t)(g * 128) * 1024 + n;
        float a[4] = {0.f, 0.f, 0.f, 0.f}; float wv[128];
#pragma unroll
        for (int d = 0; d < 128; ++d) wv[d] = wo[(size_t)d * 1024];
        __builtin_amdgcn_sched_barrier(0);
#pragma unroll
        for (int d = 0; d < 128; ++d) { const float w = ps[d] * wv[d];
#pragma unroll
            for (int j = 0; j < 4; ++j) a[j] += pw[j * 128 + d] * w; }
#pragma unroll
        for (int j = 0; j < 4; ++j) { Wout0[(size_t)n * 1024 + cp0 + j] = (bf16_t)f2bf(a[j]); }
        *(unsigned*)(P.ws + W_OUT08 + (size_t)n * 1024 + cp0) = pk4_fp8(a[0] * F8_WSCALE, a[1] * F8_WSCALE, a[2] * F8_WSCALE, a[3] * F8_WSCALE);
    }
}
__device__ __forceinline__ void stage_prep(const Ptrs& P, LAS unsigned char* lds, int wg, int nwg) {
    const int tid = tid_opaque(P), lane = tid & 63, wave = __builtin_amdgcn_readfirstlane(tid >> 6);
    const int gw = wg * 8 + wave, NGW = nwg * 8;
    prep_items(P, lds, 0, nwg == 256 ? PREP_EARLY : PREP_NITEMS, gw, NGW, lane, wave);
    if (nwg != 256) prep_fold(P, gw, NGW, lane);
    bf16_t* Hb = (bf16_t*)(P.ws + WS_HB);
    for (int row0 = gw * 4; row0 < M1; row0 += NGW * 4) { f32x4 v[4][4];
#pragma unroll
        for (int q = 0; q < 4; ++q) { const f32x4* xr = (const f32x4*)h0_ptr(P, row0 + q) + lane;
#pragma unroll
            for (int j = 0; j < 4; ++j) v[q][j] = xr[64 * j]; }
#pragma unroll
        for (int q = 0; q < 4; ++q) { unsigned long long* o8 = (unsigned long long*)(Hb + (size_t)(row0 + q) * D) + lane;
#pragma unroll
            for (int j = 0; j < 4; ++j) o8[64 * j] = (unsigned long long)pk2(v[q][j].x, v[q][j].y) | ((unsigned long long)pk2(v[q][j].z, v[q][j].w) << 32); } }
    if (wg == 0 && tid == 0) { float s1 = 0.f, s2 = 0.f; for (int i = 0; i < 64; ++i) { s1 += P.lq1[i] * P.lk1[i]; s2 += P.lq2[i] * P.lk2[i]; }
        ((float*)(P.ws + WS_MISC))[0] = __expf(s1) - __expf(s2) + LAMBDA_INIT; }
}

template <int W> __device__ __forceinline__ void pool_block(const bf16_t* Z, unsigned char* A28, bf16_t* A2m, int row0, int p0, int col) {
    u32x4 v[W + 15];
#pragma unroll
    for (int k = 0; k < W + 15; ++k) v[k] = (p0 - (W - 1) + k >= 0) ? *(const u32x4*)(Z + (size_t)(row0 - (W - 1) + k) * EVEN_IN + col) : (u32x4){0u, 0u, 0u, 0u};
    float s[8];
#pragma unroll
    for (int i = 0; i < 8; ++i) s[i] = 0.f;
#pragma unroll
    for (int k = 0; k < W - 1; ++k) { s[0] += bflo(v[k].x); s[1] += bfhi(v[k].x); s[2] += bflo(v[k].y); s[3] += bfhi(v[k].y); s[4] += bflo(v[k].z); s[5] += bfhi(v[k].z); s[6] += bflo(v[k].w); s[7] += bfhi(v[k].w); }
#pragma unroll
    for (int r = 0; r < 16; ++r) { const u32x4 in = v[W - 1 + r];
        s[0] += bflo(in.x); s[1] += bfhi(in.x); s[2] += bflo(in.y); s[3] += bfhi(in.y); s[4] += bflo(in.z); s[5] += bfhi(in.z); s[6] += bflo(in.w); s[7] += bfhi(in.w);
        const int p = p0 + r; const float inv = 1.f / (float)((p + 1) < W ? (p + 1) : W);
        const float dv[8] = {s[0] * inv - bflo(in.x), s[1] * inv - bfhi(in.x), s[2] * inv - bflo(in.y), s[3] * inv - bfhi(in.y), s[4] * inv - bflo(in.z), s[5] * inv - bfhi(in.z), s[6] * inv - bflo(in.w), s[7] * inv - bfhi(in.w)};
        const int row = row0 + r;
        if (p < NMETA) { u32x4 o; o.x = pk2(dv[0], dv[1]); o.y = pk2(dv[2], dv[3]); o.z = pk2(dv[4], dv[5]); o.w = pk2(dv[6], dv[7]); *(u32x4*)(A2m + (size_t)((row / LB) * NMETA + p) * D + col) = o; }
        else { u32x2 o; o.x = pk4_fp8(dv[0] * F8_ASCALE, dv[1] * F8_ASCALE, dv[2] * F8_ASCALE, dv[3] * F8_ASCALE); o.y = pk4_fp8(dv[4] * F8_ASCALE, dv[5] * F8_ASCALE, dv[6] * F8_ASCALE, dv[7] * F8_ASCALE); *(u32x2*)(A28 + (size_t)row * D + col) = o; }
        const u32x4 out = v[r];
        s[0] -= bflo(out.x); s[1] -= bfhi(out.x); s[2] -= bflo(out.y); s[3] -= bfhi(out.y); s[4] -= bflo(out.z); s[5] -= bfhi(out.z); s[6] -= bflo(out.w); s[7] -= bfhi(out.w); }
}
__device__ __forceinline__ void stage_pool(const Ptrs& P, int wg, int nwg) {
    const bf16_t* Z = (const bf16_t*)(P.ws + WS_Z); unsigned char* A28 = P.ws + WS_A2; bf16_t* A2m = (bf16_t*)(P.ws + WS_A2M);
    const int tid_ = tid_opaque(P), lane = tid_ & 63; const int gwv = __builtin_amdgcn_readfirstlane(wg * 8 + (tid_ >> 6)), NGW = nwg * 8;
    for (int it = gwv; it < (M1 / 64) * 4; it += NGW) { const int gi = it & 3, blk = (it >> 2) * 4 + (lane >> 4), row0 = blk * 16, p0 = row0 % LB, col = gi * 128 + (lane & 15) * 8;
        if (gi == 0) pool_block<2>(Z, A28, A2m, row0, p0, col); else if (gi == 1) pool_block<4>(Z, A28, A2m, row0, p0, col);
        else if (gi == 2) pool_block<8>(Z, A28, A2m, row0, p0, col); else pool_block<16>(Z, A28, A2m, row0, p0, col); }
}

__device__ __forceinline__ void route16(const float (&lg)[16], const float* bias, int& e0, int& e1, float& w0, float& w1) {
    float mx = lg[0];
#pragma unroll
    for (int e = 1; e < 16; ++e) mx = fmaxf(mx, lg[e]);
    float p[16], sum = 0.f;
#pragma unroll
    for (int e = 0; e < 16; ++e) { p[e] = __builtin_amdgcn_exp2f((lg[e] - mx) * 1.44269504f); sum += p[e]; }
    const float inv = 1.f / sum; float sel[16];
#pragma unroll
    for (int e = 0; e < 16; ++e) { p[e] *= inv; sel[e] = p[e] + bias[e]; }
    int gbest = 0; float gsb = -3.0e38f; int bi0 = 0, bi1 = 1; float bp0 = 0.f, bp1 = 0.f;
#pragma unroll
    for (int g = 0; g < 4; ++g) {
        int i0 = 0; float m0 = sel[4 * g];
#pragma unroll
        for (int i = 1; i < 4; ++i) if (sel[4 * g + i] > m0) { m0 = sel[4 * g + i]; i0 = i; }
        int i1 = (i0 == 0) ? 1 : 0; float m1 = (i0 == 0) ? sel[4 * g + 1] : sel[4 * g];
#pragma unroll
        for (int i = 1; i < 4; ++i) if (i != i0 && i != ((i0 == 0) ? 1 : 0) && sel[4 * g + i] > m1) { m1 = sel[4 * g + i]; i1 = i; }
        const float gs = m0 + m1;
        float q0 = 0.f, q1 = 0.f;
#pragma unroll
        for (int i = 0; i < 4; ++i) { q0 = (i == i0) ? p[4 * g + i] : q0; q1 = (i == i1) ? p[4 * g + i] : q1; }
        if (gs > gsb) { gsb = gs; gbest = g; bi0 = i0; bi1 = i1; bp0 = q0; bp1 = q1; }
    }
    e0 = gbest * 4 + bi0; e1 = gbest * 4 + bi1; const float ws = 1.f / (bp0 + bp1); w0 = bp0 * ws; w1 = bp1 * ws;
}

constexpr int LN_WROW = 80, LN_LGS = 1024 * LN_WROW, LN_CNT = LN_LGS + 8 * 256, LN_ENT = LN_CNT + 128, LN_GB = 90112;
template <int MODE> __device__ __forceinline__ void stage_ln(const Ptrs& P, LAS unsigned char* lds, int wg, int nwg) {
    constexpr int LAYER = MODE & 1; constexpr bool MIX = MODE < 2, MATV = MODE != 3, ROUTE = MODE < 2;
    const int tid = tid_opaque(P), lane = tid & 63, wave = __builtin_amdgcn_readfirstlane(tid >> 6);
    constexpr int O_TL = 0, TLP = 2064, O_PD = 66560, O_ST = 99328, O_SE = 99584, O_CE = 99648;
    constexpr int O_GB = ROUTE ? 100352 : LN_GB, O_LGS = ROUTE ? 108544 : LN_LGS, O_CNT = ROUTE ? 110592 : LN_CNT, O_ENT = ROUTE ? 110720 : LN_ENT;
    LAS float* lgs = (LAS float*)(lds + O_LGS) + wave * 64; LAS int* lcnt = (LAS int*)(lds + O_CNT); LAS int* lbase = lcnt + 16; LAS int* ent = (LAS int*)(lds + O_ENT); LAS float* entw = (LAS float*)(lds + O_ENT + 2048);
    int R = (((M1 + nwg - 1) / nwg) + 3) & ~3, r0 = wg * R, r1 = (r0 + R) < M1 ? (r0 + R) : M1;
    if ((MODE == 1 || MODE == 3) && nwg == 256) { R = 128; r0 = (wg >> 6) * LB + NMETA + (wg & 63) * 128; r1 = r0 + 128; }
    if (MODE == 2) { const float* src = MODE == 2 ? P.odd_w_in + ODD_N : P.router_w; const int stride = MODE == 2 ? ODD_IN : 16;
        for (int i = tid; i < 4096; i += 512) { const int cc = i >> 2, q4 = i & 3; const int lrow = (cc >> 9) * 512 + (cc & 7) * 64 + ((cc & 511) >> 3);
            *(LAS f32x4*)(lds + lrow * LN_WROW + q4 * 16) = *(const f32x4*)(src + (size_t)cc * stride + q4 * 4); } }
    if (ROUTE) { if (tid < 16) lcnt[tid] = 0; for (int i = tid; i < 2 * R; i += 512) ent[i] = -1; }
    { const float* gb_ = (tid < 256 ? (MIX ? P.ln_mix_g : P.ln_ffn_g) : (MIX ? P.ln_mix_b : P.ln_ffn_b)) + LAYER * D; const int i_ = tid & 255, hf_ = i_ >> 7, q_ = (i_ >> 6) & 1, ln_ = i_ & 63;
        ((LAS f32x4*)(lds + O_GB))[tid] = *(const f32x4*)(gb_ + hf_ * 512 + ln_ * 8 + q_ * 4); }
    bf16x8 bw[8];
    if (ROUTE) { const float* gp_ = P.ln_mix_g + LAYER * D; const float* bp_ = P.ln_mix_b + LAYER * D;
        const int n_ = lane & 31, kh_ = lane >> 5, e_ = n_ & 15; const bool lo_ = n_ >= 16;
#pragma unroll
        for (int ks = 0; ks < 8; ++ks) { unsigned hw[8];
#pragma unroll
            for (int j = 0; j < 8; ++j) { const int k_ = 128 * wave + 16 * ks + 8 * kh_ + j; const float wv = gp_[k_] * P.router_w[k_ * 16 + e_]; const unsigned hb_ = cvt_pk_bf16(wv, 0.f) & 0xffffu;
                const float res_ = wv - __uint_as_float(hb_ << 16); hw[j] = lo_ ? (cvt_pk_bf16(res_, 0.f) & 0xffffu) : hb_; }
            const u32x4 pk_ = (u32x4){hw[0] | (hw[1] << 16), hw[2] | (hw[3] << 16), hw[4] | (hw[5] << 16), hw[6] | (hw[7] << 16)}; bw[ks] = __builtin_bit_cast(bf16x8, pk_); }
        { const int e2_ = tid & 15, part_ = tid >> 4; float s_ = 0.f, c_ = 0.f;
            for (int k_ = part_ * 32; k_ < part_ * 32 + 32; ++k_) { const float wr_ = P.router_w[k_ * 16 + e2_]; s_ += gp_[k_] * wr_; c_ += bp_[k_] * wr_; }
            ((LAS float*)(lds + O_PD))[part_ * 16 + e2_] = s_; ((LAS float*)(lds + O_PD))[512 + part_ * 16 + e2_] = c_; }
        __syncthreads();
        if (tid < 32) { const int e2_ = tid & 15; const int which_ = tid >> 4; float a_ = 0.f; for (int p_ = 0; p_ < 32; ++p_) a_ += ((LAS float*)(lds + O_PD))[which_ * 512 + p_ * 16 + e2_]; ((LAS float*)(lds + (which_ ? O_CE : O_SE)))[e2_] = a_; } }
    __syncthreads();
    bf16_t* Hb = (bf16_t*)(P.ws + WS_HB); const bf16_t* T = (const bf16_t*)(P.ws + WS_T); const unsigned char* YK = P.ws + WS_YK; float* RW = (float*)(P.ws + WS_RW); float* GLR = (float*)(P.ws + WS_GLR);
    u32x4 raw[4][2], ry[4][2];
#define LN_LDRAW(q0n) do { _Pragma("unroll") for (int j = 0; j < 4; ++j) { const int rr_ = (q0n) + j, rw_ = rr_ < r1 ? rr_ : r1 - 1; \
        _Pragma("unroll") for (int hf = 0; hf < 2; ++hf) { const size_t off_ = (size_t)rw_ * D + hf * 512 + lane * 8; \
            if (MIX) raw[j][hf] = *(const u32x4*)(T + off_); \
            else { raw[j][hf] = *(const u32x4*)(Hb + off_); const u32x2 y0_ = *(const u32x2*)(YK + off_), y1_ = *(const u32x2*)(YK + (size_t)M1 * D + off_); ry[j][hf] = (u32x4){y0_.x, y0_.y, y1_.x, y1_.y}; } } } } while (0)
    const int qend = ROUTE ? r0 + 32 * ((r1 - r0 + 31) / 32) : r1;
    if (ROUTE || r0 + 4 * wave < r1) LN_LDRAW(r0 + 4 * wave);
    for (int q0 = r0 + 4 * wave; q0 < qend; q0 += 32) {
        float x[4][16]; bool act[4]; int rows[4];
#pragma unroll
        for (int j = 0; j < 4; ++j) { const int rr = q0 + j; rows[j] = rr < r1 ? rr : r1 - 1; const int p = rows[j] % LB; act[j] = rr < r1 && !((MODE == 1 || MODE == 3) && p < NMETA); }
#pragma unroll
        for (int j = 0; j < 4; ++j)
#pragma unroll
            for (int hf = 0; hf < 2; ++hf) {
                if (MIX) { const u32x4 t = raw[j][hf];
                    x[j][hf * 8 + 0] = bflo(t.x); x[j][hf * 8 + 1] = bfhi(t.x); x[j][hf * 8 + 2] = bflo(t.y); x[j][hf * 8 + 3] = bfhi(t.y); x[j][hf * 8 + 4] = bflo(t.z); x[j][hf * 8 + 5] = bfhi(t.z); x[j][hf * 8 + 6] = bflo(t.w); x[j][hf * 8 + 7] = bfhi(t.w); }
                else { const u32x4 h = raw[j][hf], yy = ry[j][hf];
                    float a0[4], a1[4], b0[4], b1[4]; fp8x4_to_f32(yy.x, a0); fp8x4_to_f32(yy.y, a1); fp8x4_to_f32(yy.z, b0); fp8x4_to_f32(yy.w, b1);
                    constexpr float ys = 1.f / F8_YSCALE;
                    x[j][hf * 8 + 0] = bflo(h.x) * ALPHA + (a0[0] + b0[0]) * ys; x[j][hf * 8 + 1] = bfhi(h.x) * ALPHA + (a0[1] + b0[1]) * ys;
                    x[j][hf * 8 + 2] = bflo(h.y) * ALPHA + (a0[2] + b0[2]) * ys; x[j][hf * 8 + 3] = bfhi(h.y) * ALPHA + (a0[3] + b0[3]) * ys;
                    x[j][hf * 8 + 4] = bflo(h.z) * ALPHA + (a1[0] + b1[0]) * ys; x[j][hf * 8 + 5] = bfhi(h.z) * ALPHA + (a1[1] + b1[1]) * ys;
                    x[j][hf * 8 + 6] = bflo(h.w) * ALPHA + (a1[2] + b1[2]) * ys; x[j][hf * 8 + 7] = bfhi(h.w) * ALPHA + (a1[3] + b1[3]) * ys; } }
        if (ROUTE) {
#pragma unroll
            for (int j = 0; j < 4; ++j)
#pragma unroll
                for (int hf = 0; hf < 2; ++hf) *(LAS u32x4*)(lds + O_TL + (4 * wave + j) * TLP + hf * 1024 + lane * 16) = raw[j][hf]; }
        __builtin_amdgcn_sched_barrier(0);
        if (ROUTE || q0 + 32 < r1) LN_LDRAW(q0 + 32);
        float mean[4], rstd[4];
#pragma unroll
        for (int j = 0; j < 4; ++j) { float sm = 0.f;
#pragma unroll
            for (int i = 0; i < 16; ++i) sm += x[j][i];
            mean[j] = sm; }
        wave_sum4(mean);
#pragma unroll
        for (int j = 0; j < 4; ++j) { mean[j] *= (1.f / D); float s2 = 0.f;
#pragma unroll
            for (int i = 0; i < 16; ++i) { x[j][i] -= mean[j]; s2 += x[j][i] * x[j][i]; }
            rstd[j] = s2; }
        wave_sum4(rstd);
#pragma unroll
        for (int j = 0; j < 4; ++j) rstd[j] = __builtin_amdgcn_rsqf(rstd[j] * (1.f / D) + LN_EPS);
        {
#pragma unroll
            for (int hf = 0; hf < 2; ++hf)
#pragma unroll
                for (int q = 0; q < 2; ++q) { const f32x4 g4 = ((const LAS f32x4*)(lds + O_GB))[(hf * 2 + q) * 64 + lane], b4 = ((const LAS f32x4*)(lds + O_GB))[256 + (hf * 2 + q) * 64 + lane];
#pragma unroll
                    for (int e = 0; e < 4; ++e)
#pragma unroll
                        for (int j = 0; j < 4; ++j) x[j][hf * 8 + q * 4 + e] = x[j][hf * 8 + q * 4 + e] * rstd[j] * g4[e] + b4[e]; } }
#pragma unroll
        for (int j = 0; j < 4; ++j) {
            if (act[j]) {
                if (MODE != 3) {
#pragma unroll
                    for (int hf = 0; hf < 2; ++hf) { u32x4 w; w.x = pk2(x[j][hf * 8], x[j][hf * 8 + 1]); w.y = pk2(x[j][hf * 8 + 2], x[j][hf * 8 + 3]); w.z = pk2(x[j][hf * 8 + 4], x[j][hf * 8 + 5]); w.w = pk2(x[j][hf * 8 + 6], x[j][hf * 8 + 7]);
                        *(u32x4*)(Hb + (size_t)rows[j] * D + hf * 512 + lane * 8) = w;
                        if (ROUTE || MODE == 2) { u32x2 w8; w8.x = pk4_fp8(x[j][hf * 8] * F8_HSCALE, x[j][hf * 8 + 1] * F8_HSCALE, x[j][hf * 8 + 2] * F8_HSCALE, x[j][hf * 8 + 3] * F8_HSCALE);
                            w8.y = pk4_fp8(x[j][hf * 8 + 4] * F8_HSCALE, x[j][hf * 8 + 5] * F8_HSCALE, x[j][hf * 8 + 6] * F8_HSCALE, x[j][hf * 8 + 7] * F8_HSCALE);
                            *(u32x2*)(P.ws + WS_HB8 + (size_t)rows[j] * D + hf * 512 + lane * 8) = w8; } } }
                else { const int b = rows[j] / LB, p = rows[j] - b * LB; float* orow = P.out + ((size_t)b * SEQ + (p - NMETA)) * D;
#pragma unroll
                    for (int hf = 0; hf < 2; ++hf)
#pragma unroll
                        for (int q = 0; q < 2; ++q) *(f32x4*)(orow + hf * 512 + lane * 8 + q * 4) = (f32x4){x[j][hf * 8 + q * 4], x[j][hf * 8 + q * 4 + 1], x[j][hf * 8 + q * 4 + 2], x[j][hf * 8 + q * 4 + 3]}; } } }
        if (ROUTE) {
            asm volatile("s_waitcnt lgkmcnt(0)\n\ts_barrier" ::: "memory");
            f32x16 dacc = f32x16{};
            { const LAS unsigned char* ap_ = lds + O_TL + (lane & 31) * TLP + (128 * wave + 8 * (lane >> 5)) * 2;
#pragma unroll
                for (int ks = 0; ks < 8; ++ks) { const bf16x8 a_ = *(const LAS bf16x8*)(ap_ + ks * 32); dacc = __builtin_amdgcn_mfma_f32_32x32x16_bf16(a_, bw[ks], dacc, 0, 0, 0); } }
            { LAS float* pd_ = (LAS float*)(lds + O_PD) + wave * 1024 + (lane & 31);
#pragma unroll
                for (int r = 0; r < 16; ++r) pd_[(((r & 3) + 8 * (r >> 2)) + 4 * (lane >> 5)) * 32] = dacc[r]; }
            if (lane == 0) {
#pragma unroll
                for (int j = 0; j < 4; ++j) { ((LAS float*)(lds + O_ST))[(4 * wave + j) * 2] = mean[j]; ((LAS float*)(lds + O_ST))[(4 * wave + j) * 2 + 1] = rstd[j]; } }
            asm volatile("s_waitcnt lgkmcnt(0)\n\ts_barrier" ::: "memory");
            { const int rw_ = 4 * wave + (lane >> 4), e_ = lane & 15; const LAS float* pd_ = (const LAS float*)(lds + O_PD) + rw_ * 32 + e_; float pre = 0.f;
#pragma unroll
                for (int w_ = 0; w_ < 8; ++w_) pre += pd_[w_ * 1024] + pd_[w_ * 1024 + 16];
                const float mr_ = ((const LAS float*)(lds + O_ST))[rw_ * 2], rs_ = ((const LAS float*)(lds + O_ST))[rw_ * 2 + 1];
                lgs[lane] = rs_ * (pre - mr_ * ((const LAS float*)(lds + O_SE))[e_]) + ((const LAS float*)(lds + O_CE))[e_]; }
            asm volatile("s_waitcnt lgkmcnt(0)" ::: "memory");
            { const int j = lane >> 4; float lg[16];
#pragma unroll
                for (int e4 = 0; e4 < 4; ++e4) { const f32x4 t4 = *(const LAS f32x4*)(lgs + j * 16 + e4 * 4); lg[e4 * 4] = t4.x; lg[e4 * 4 + 1] = t4.y; lg[e4 * 4 + 2] = t4.z; lg[e4 * 4 + 3] = t4.w; }
                int e0, e1; float w0, w1; route16(lg, P.router_bias, e0, e1, w0, w1);
                bool a_ = false;
#pragma unroll
                for (int jj = 0; jj < 4; ++jj) a_ = (jj == j) ? act[jj] : a_;
                if (a_ && (lane & 15) == 0) { const int row = q0 + j; const int li0 = atomicAdd((int*)&lcnt[e0], 1), li1 = atomicAdd((int*)&lcnt[e1], 1);
                    ent[2 * (row - r0)] = e0 | (li0 << 8); ent[2 * (row - r0) + 1] = e1 | (li1 << 8); entw[2 * (row - r0)] = w0; entw[2 * (row - r0) + 1] = w1; }
                asm volatile("s_waitcnt lgkmcnt(0)" ::: "memory"); }
        }
        if (MODE == 2) {
            float fin[2];
#define LN_DPP(v_, ctrl_) __builtin_bit_cast(float, __builtin_amdgcn_update_dpp(0, __builtin_bit_cast(int, (v_)), (ctrl_), 0xf, 0xf, false))
#pragma unroll
            for (int h8 = 0; h8 < 2; ++h8) {
                f32x2 v2[16];
#pragma unroll
                for (int i = 0; i < 16; ++i) v2[i] = (f32x2){0.f, 0.f};
#pragma unroll
                for (int hf = 0; hf < 2; ++hf)
#pragma unroll
                    for (int i = 0; i < 8; ++i) { const LAS f32x4* wp = (const LAS f32x4*)(lds + (hf * 512 + i * 64 + lane) * LN_WROW + h8 * 32); const f32x4 wa = wp[0], wb = wp[1];
                        const f32x2 w0 = (f32x2){wa.x, wa.y}, w1 = (f32x2){wa.z, wa.w}, w2 = (f32x2){wb.x, wb.y}, w3 = (f32x2){wb.z, wb.w};
#pragma unroll
                        for (int j = 0; j < 4; ++j) { const float hv = x[j][hf * 8 + i]; const f32x2 h2 = (f32x2){hv, hv};
                            v2[j * 4] = __builtin_elementwise_fma(h2, w0, v2[j * 4]); v2[j * 4 + 1] = __builtin_elementwise_fma(h2, w1, v2[j * 4 + 1]);
                            v2[j * 4 + 2] = __builtin_elementwise_fma(h2, w2, v2[j * 4 + 2]); v2[j * 4 + 3] = __builtin_elementwise_fma(h2, w3, v2[j * 4 + 3]); } }
                float v[32];
#pragma unroll
                for (int i = 0; i < 16; ++i) { v[2 * i] = v2[i].x; v[2 * i + 1] = v2[i].y; }
#pragma unroll
                for (int i = 0; i < 16; ++i) { const auto r = __builtin_amdgcn_permlane32_swap(__float_as_uint(v[i]), __float_as_uint(v[i + 16]), false, false); const unsigned r0 = r[0], r1 = r[1];
                    v[i] = __uint_as_float(r0) + __uint_as_float(r1); }
#pragma unroll
                for (int i = 0; i < 8; ++i) { const auto r = __builtin_amdgcn_permlane16_swap(__float_as_uint(v[i]), __float_as_uint(v[i + 8]), false, false); const unsigned r0 = r[0], r1 = r[1];
                    v[i] = __uint_as_float(r0) + __uint_as_float(r1); }
                const bool b3 = (lane & 8) != 0, b2 = (lane & 4) != 0, b1 = (lane & 2) != 0;
#pragma unroll
                for (int i = 0; i < 4; ++i) { const float keep = b3 ? v[i + 4] : v[i], send = b3 ? v[i] : v[i + 4]; v[i] = keep + LN_DPP(send, 0x128); }
#pragma unroll
                for (int i = 0; i < 2; ++i) { const float keep = b2 ? v[i + 2] : v[i], send = b2 ? v[i] : v[i + 2]; v[i] = keep + LN_DPP(send, 0x141); }
                { const float keep = b1 ? v[1] : v[0], send = b1 ? v[0] : v[1]; v[0] = keep + LN_DPP(send, 0x1b); }
                v[0] += LN_DPP(v[0], 0xb1);
                fin[h8] = v[0];
                __builtin_amdgcn_sched_barrier(0);
            }
#undef LN_DPP
            const int oute = (lane & 1) * 8 + ((lane >> 1) & 7); const float outv = (lane & 1) ? fin[1] : fin[0];
            if (MODE != 2) { lgs[(lane >> 4) * 16 + oute] = outv; asm volatile("s_waitcnt lgkmcnt(0)" ::: "memory"); }
            if (MODE == 2) { const int j = lane >> 4; bool a_ = false;
#pragma unroll
                for (int jj = 0; jj < 4; ++jj) a_ = (jj == j) ? act[jj] : a_;
                if (a_) GLR[(size_t)(q0 + j) * 16 + oute] = outv; }
            else {
                const int j = lane >> 4; float lg[16];
#pragma unroll
                for (int e4 = 0; e4 < 4; ++e4) { const f32x4 t4 = *(const LAS f32x4*)(lgs + j * 16 + e4 * 4); lg[e4 * 4] = t4.x; lg[e4 * 4 + 1] = t4.y; lg[e4 * 4 + 2] = t4.z; lg[e4 * 4 + 3] = t4.w; }
                int e0, e1; float w0, w1; route16(lg, P.router_bias, e0, e1, w0, w1);
                bool a_ = false;
#pragma unroll
                for (int jj = 0; jj < 4; ++jj) a_ = (jj == j) ? act[jj] : a_;
                if (a_ && (lane & 15) == 0) { const int row = q0 + j; const int li0 = atomicAdd((int*)&lcnt[e0], 1), li1 = atomicAdd((int*)&lcnt[e1], 1);
                    ent[2 * (row - r0)] = e0 | (li0 << 8); ent[2 * (row - r0) + 1] = e1 | (li1 << 8); entw[2 * (row - r0)] = w0; entw[2 * (row - r0) + 1] = w1; }
                asm volatile("s_waitcnt lgkmcnt(0)" ::: "memory");
            }
        }
    }
    if (ROUTE) {
        __syncthreads();
        unsigned* gcnt = (unsigned*)(P.ws + WS_CTL) + CW_CNT + 64 * LAYER;
        if (tid < 16) lbase[tid] = (int)atomicAdd(gcnt + tid, (unsigned)lcnt[tid]);
        __syncthreads();
        int* list = (int*)(P.ws + WS_LIST); float* listw = (float*)(P.ws + WS_LISTW);
        for (int i = tid; i < 2 * (r1 - r0); i += 512) { const int en = ent[i]; if (en >= 0) { const int e = en & 0xff, li = en >> 8; const size_t at = (size_t)e * LISTCAP + lbase[e] + li; list[at] = (r0 + (i >> 1)) * 2 + (i & 1); listw[at] = entw[i]; } }
    }
    __syncthreads();
}

__device__ __forceinline__ void attn_naive_item(const Ptrs& P, int row, int h, LAS float* qs, int lane) {
    const bf16_t* Z = (const bf16_t*)(P.ws + WS_Z); bf16_t* A2m = (bf16_t*)(P.ws + WS_A2M);
    const int b = row / LB, p = row - b * LB, rowb = b * LB;
    const bf16_t* zq = Z + (size_t)row * EVEN_IN + 512 + h * 128;
    qs[lane] = bf2f(zq[lane]); qs[64 + lane] = bf2f(zq[64 + lane]);
    asm volatile("s_waitcnt lgkmcnt(0)" ::: "memory");
    const float slope2 = exp2f(-2.f * (float)(h + 1)) * LOG2E;
    float m0 = -INFINITY, m1 = -INFINITY, l0 = 0.f, l1 = 0.f, o00 = 0.f, o01 = 0.f, o10 = 0.f, o11 = 0.f;
    for (int j0 = 0; j0 <= p; j0 += 64) {
        const int j = j0 + lane; const bool valid = j <= p; float s0 = -INFINITY, s1 = -INFINITY;
        if (valid) { const u32x4* kr = (const u32x4*)(Z + (size_t)(rowb + j) * EVEN_IN + 1024 + h * 128); float d0 = 0.f, d1 = 0.f;
#pragma unroll
            for (int c = 0; c < 8; ++c) { const u32x4 kv = kr[c]; const LAS float* q = qs + 8 * c;
                d0 += q[0] * bflo(kv.x) + q[1] * bfhi(kv.x) + q[2] * bflo(kv.y) + q[3] * bfhi(kv.y) + q[4] * bflo(kv.z) + q[5] * bfhi(kv.z) + q[6] * bflo(kv.w) + q[7] * bfhi(kv.w); }
#pragma unroll
            for (int c = 8; c < 16; ++c) { const u32x4 kv = kr[c]; const LAS float* q = qs + 8 * c;
                d1 += q[0] * bflo(kv.x) + q[1] * bfhi(kv.x) + q[2] * bflo(kv.y) + q[3] * bfhi(kv.y) + q[4] * bflo(kv.z) + q[5] * bfhi(kv.z) + q[6] * bflo(kv.w) + q[7] * bfhi(kv.w); }
            const float bias = -slope2 * (float)(p - j); s0 = d0 + bias; s1 = d1 + bias; }
        const float mn0 = fmaxf(m0, wave_max(s0)), mn1 = fmaxf(m1, wave_max(s1));
        const float f0 = exp2f(m0 - mn0), f1 = exp2f(m1 - mn1);
        const float p0 = valid ? exp2f(s0 - mn0) : 0.f, p1 = valid ? exp2f(s1 - mn1) : 0.f;
        l0 = l0 * f0 + wave_sum(p0); l1 = l1 * f1 + wave_sum(p1); o00 *= f0; o01 *= f0; o10 *= f1; o11 *= f1; m0 = mn0; m1 = mn1;
        const int nk = (p - j0 + 1) < 64 ? (p - j0 + 1) : 64;
        const bf16_t* vr = Z + (size_t)(rowb + j0) * EVEN_IN + 1536 + h * 128 + lane;
        for (int jj = 0; jj < nk; ++jj) { const float a0 = __shfl(p0, jj), a1 = __shfl(p1, jj); const float v0 = bf2f(vr[(size_t)jj * EVEN_IN]), v1 = bf2f(vr[(size_t)jj * EVEN_IN + 64]);
            o00 += a0 * v0; o01 += a0 * v1; o10 += a1 * v0; o11 += a1 * v1; }
    }
    const float lam = ((const float*)(P.ws + WS_MISC))[0];
    const float a0 = o00 / l0 - lam * o10 / l1, a1 = o01 / l0 - lam * o11 / l1;
    const float r = 1.f / sqrtf(wave_sum(a0 * a0 + a1 * a1) * (1.f / 128.f) + RMS_EPS);
    bf16_t* o = A2m + (size_t)(b * NMETA + p) * D + 512 + h * 128;
    o[lane] = (bf16_t)f2bf(a0 * r * P.subln[lane] * (1.f - LAMBDA_INIT)); o[64 + lane] = (bf16_t)f2bf(a1 * r * P.subln[64 + lane] * (1.f - LAMBDA_INIT));
}

namespace att {
typedef short s16x4 __attribute__((ext_vector_type(4)));
typedef short v4i16_t __attribute__((ext_vector_type(4)));
constexpr int KSLOT = 8192, VSLOT = 16384, NBUF = 2;
constexpr int LDS_K = 0, LDS_V = NBUF * KSLOT, LDS_WS = LDS_V + NBUF * VSLOT, LDS_OST = LDS_WS + 2048, LDS_TOTAL = LDS_OST + 8 * 8192;
static_assert(LDS_TOTAL <= 131072, "attention LDS");
constexpr float THR = 8.f;
__device__ __forceinline__ int crow(int r, int hi) { return (r & 3) + 8 * (r >> 2) + 4 * hi; }
__device__ __forceinline__ float swapmax(float v) { auto rr = __builtin_amdgcn_permlane32_swap(__float_as_uint(v), __float_as_uint(v), false, false); return fmaxf(__uint_as_float(rr[0]), __uint_as_float(rr[1])); }
__device__ __forceinline__ float swapsum(float v) { auto rr = __builtin_amdgcn_permlane32_swap(__float_as_uint(v), __float_as_uint(v), false, false); return __uint_as_float(rr[0]) + __uint_as_float(rr[1]); }
#define VTR_A(dst, base, off) asm volatile("ds_read_b64_tr_b16 %0, %1 offset:%2" : "=v"(dst) : "v"(base), "n"(off))
#define VTR_WAIT(n, a, b) asm volatile("s_waitcnt lgkmcnt(%2)" : "+v"(a), "+v"(b) : "n"(n))
__device__ __forceinline__ s16x4 vtr(const LAS unsigned char* p) { return __builtin_bit_cast(s16x4, __builtin_amdgcn_ds_read_tr16_b64_v4i16((LAS v4i16_t*)p)); }

__device__ __forceinline__ void glds16(const void* gsrc, unsigned lds_dst) { unsigned keep;
    asm volatile("s_mov_b32 %0, m0\n\ts_mov_b32 m0, %2\n\ts_nop 0\n\tglobal_load_lds_dwordx4 %1, off\n\ts_mov_b32 m0, %0" : "=&s"(keep) : "v"(gsrc), "s"(lds_dst) : "memory"); }
#define ATT_WAITBAR() asm volatile("s_waitcnt vmcnt(0) lgkmcnt(0)\n\ts_barrier" ::: "memory")
#define ATT_WAITBAR_N(n) asm volatile("s_waitcnt vmcnt(" #n ") lgkmcnt(0)\n\ts_barrier" ::: "memory")
constexpr int PD = 3, K4 = PD + 1, V3 = PD + 2;
constexpr int L2_K = 0, L2_V = K4 * KSLOT, L2_WS = L2_V + V3 * VSLOT, L2_TOTAL = L2_WS + 2048, L2_OST = 0;
static_assert(L2_TOTAL + 128 <= 131072 && 8 * 8192 <= L2_WS, "attention v2 LDS");
__device__ __forceinline__ unsigned short bfr(float f) { return (unsigned short)f2bf(f); }
__device__ __forceinline__ void attn_unit(const Ptrs& P, LAS unsigned char* lds, int b, int vh, int qb) {
    const int tid = tid_opaque(P), lane = tid & 63, r32 = lane & 31, hi = lane >> 5; const int wid = __builtin_amdgcn_readfirstlane(tid >> 6);
    const bf16_t* Z = (const bf16_t*)(P.ws + WS_Z); bf16_t* Ob = (bf16_t*)(P.ws + WS_OA);
    const int rowb = b * LB, hd = vh >> 1;
    const int qrow0 = rowb + NMETA + 256 * qb + 32 * wid;
    const bf16_t* Kc = Z + 1024 + vh * 64; const bf16_t* Vc = Z + 1536 + hd * 128;
    const float slope2 = __uint_as_float(__builtin_amdgcn_readfirstlane(__float_as_uint(exp2f(-2.f * (float)(hd + 1)) * LOG2E)));
    LAS float* wsf = (LAS float*)(lds + L2_WS) + wid * 64;
    bf16x8 qr[4];
    { const bf16_t* qp = Z + (size_t)(qrow0 + r32) * EVEN_IN + 512 + vh * 64 + hi * 8;
#pragma unroll
        for (int ks = 0; ks < 4; ++ks) qr[ks] = *(const bf16x8*)(qp + ks * 16); }
#define ATT_KROW0(i) (((i) >= NR) ? rowb : rowb + NMETA + 64 * (4 * qb + 3 - (i)))
#define ATT_PK0(i) (((i) >= NR) ? 0 : NMETA + 64 * (4 * qb + 3 - (i)))
#define ATT_DMA(i) do { const int kr0_ = ATT_KROW0(i); const int ks_ = (i) % K4, vs_ = (i) % V3; \
        glds16(Kc + (size_t)(kr0_ + krow_) * EVEN_IN + kchk_ * 8, (unsigned)__builtin_amdgcn_readfirstlane((int)(lds0 + L2_K + ks_ * KSLOT + wid * 1024))); \
        _Pragma("unroll") for (int i_ = 0; i_ < 2; ++i_) { const int pc_ = wid * 2 + i_, db_ = pc_ >> 2, rg_ = pc_ & 3; \
            glds16(Vc + (size_t)(kr0_ + 16 * rg_ + (lane >> 2)) * EVEN_IN + db_ * 32 + (lane & 3) * 8, (unsigned)__builtin_amdgcn_readfirstlane((int)(lds0 + L2_V + vs_ * VSLOT + pc_ * 1024))); } } while (0)
    const unsigned lds0 = (unsigned)(size_t)lds;
    const int krow_ = 8 * wid + (lane >> 3), kchk_ = (lane & 7) ^ ((krow_ >> 1) & 7);
    int koff[4];
#pragma unroll
    for (int ks = 0; ks < 4; ++ks) koff[ks] = r32 * 128 + (((2 * ks + hi) ^ ((r32 >> 1) & 7)) << 4);
    int NR = 1 << 30, NT;
    ATT_DMA(0); ATT_DMA(1); ATT_DMA(2);
    { float qs = 0.f;
#pragma unroll
        for (int ks = 0; ks < 4; ++ks) { const u32x4 w = __builtin_bit_cast(u32x4, qr[ks]);
#pragma unroll
            for (int j = 0; j < 4; ++j) { const float a_ = bflo(w[j]), b_ = bfhi(w[j]); qs += a_ * a_ + b_ * b_; } }
        qs = swapsum(qs);
#pragma unroll
        for (int o_ = 1; o_ < 32; o_ <<= 1) qs = fmaxf(qs, __shfl_xor(qs, o_));
        if (lane == 0) wsf[0] = qs;
        ATT_WAITBAR();
        float q2 = 0.f;
#pragma unroll
        for (int w_ = 0; w_ < 8; ++w_) q2 = fmaxf(q2, ((LAS float*)(lds + L2_WS))[w_ * 64]);
        const unsigned* kn = (const unsigned*)(P.ws + WS_CTL) + CW_KN;
        const int kl_ = lane < 6 ? lane : 0; const unsigned kw_ = __hip_atomic_load(kn + (kl_ < 2 ? (b * 8 + vh) * 2 + kl_ : 64 + vh * 4 + (kl_ - 2)), __ATOMIC_RELAXED, __HIP_MEMORY_SCOPE_AGENT);
        const float k2r = __uint_as_float(__builtin_amdgcn_readlane(kw_, 0)) + __uint_as_float(__builtin_amdgcn_readlane(kw_, 1));
        const float k2m = __uint_as_float(__builtin_amdgcn_readlane(kw_, 2)) + __uint_as_float(__builtin_amdgcn_readlane(kw_, 3)) + __uint_as_float(__builtin_amdgcn_readlane(kw_, 4)) + __uint_as_float(__builtin_amdgcn_readlane(kw_, 5));
        const float QK = sqrtf(q2 * fmaxf(k2r, k2m) * 1.02f) * 1.01f + 1.f;
        const float dist = (151.f + 2.f * QK) / slope2;
        int tskip = (int)floorf(((float)(256 * qb - 63) - dist) * (1.f / 64.f)); tskip = tskip < -1 ? -1 : tskip;
        NR = 4 * qb + 3 - tskip; const bool hasm = (float)(NMETA + 256 * qb - 15) <= dist;
        NR = __builtin_amdgcn_readfirstlane(NR); NT = NR + (__builtin_amdgcn_readfirstlane((int)hasm) ? 1 : 0); }
    const int qrel = 32 * wid + r32, pq = NMETA + 256 * qb + qrel;
    float l = 0.f, cin = 0.f;
#define ATT_SETC() do { } while (0)
    f32x16 o[4];
#pragma unroll
    for (int d = 0; d < 4; ++d) o[d] = f32x16{};
    u32x4 pw[4];
    f32x16 p0, p1;
    const LAS unsigned char* vpl = lds + L2_V + ((lane >> 4) & 1) * 32 + (lane & 3) * 8 + (4 * hi + ((lane & 15) >> 2)) * 64;
#define ATT_QK(i) do { bf16x8 kf_[8];     \
        { const LAS unsigned char* kb_ = lds + L2_K + ((i) % K4) * KSLOT; \
          _Pragma("unroll") for (int ks = 0; ks < 4; ++ks) { kf_[2 * ks] = *(const LAS bf16x8*)(kb_ + koff[ks]); kf_[2 * ks + 1] = *(const LAS bf16x8*)(kb_ + koff[ks] + 4096); } } \
        __builtin_amdgcn_sched_barrier(0); \
        { const float cl_ = slope2 * (float)(ATT_PK0(i) + 4 * hi - pq) + cin, s32_ = 32.f * slope2; \
          _Pragma("unroll") for (int r = 0; r < 16; ++r) { p0[r] = fmaf(slope2, (float)((r & 3) + 8 * (r >> 2)), cl_); p1[r] = p0[r] + s32_; } } \
        _Pragma("unroll") for (int ks = 0; ks < 4; ++ks) { \
            p0 = __builtin_amdgcn_mfma_f32_32x32x16_bf16(kf_[2 * ks], qr[ks], p0, 0, 0, 0); p1 = __builtin_amdgcn_mfma_f32_32x32x16_bf16(kf_[2 * ks + 1], qr[ks], p1, 0, 0, 0); } \
        if ((i) < 4 || (i) >= NR) { const int lim_ = (((i) >= NR) ? 15 : qrel - 64 * (3 - (i))) - 4 * hi;     \
            _Pragma("unroll") for (int r = 0; r < 16; ++r) { const int kv = (r & 3) + 8 * (r >> 2); if (kv > lim_) p0[r] = -INFINITY; if (kv + 32 > lim_) p1[r] = -INFINITY; } } } while (0)
#define ATT_PV(vslot) do { const LAS unsigned char* vp_ = vpl + (vslot) * VSLOT; \
        _Pragma("unroll") for (int s2_ = 0; s2_ < 4; ++s2_) { s16x4 vq_[8]; \
            _Pragma("unroll") for (int d = 0; d < 4; ++d) { vq_[2 * d] = vtr(vp_ + d * 4096 + s2_ * 1024); vq_[2 * d + 1] = vtr(vp_ + d * 4096 + s2_ * 1024 + 512); } \
            _Pragma("unroll") for (int d = 0; d < 4; ++d) { const bf16x8 vf = (bf16x8){vq_[2 * d][0], vq_[2 * d][1], vq_[2 * d][2], vq_[2 * d][3], vq_[2 * d + 1][0], vq_[2 * d + 1][1], vq_[2 * d + 1][2], vq_[2 * d + 1][3]}; \
                o[d] = __builtin_amdgcn_mfma_f32_32x32x16_bf16(__builtin_bit_cast(bf16x8, pw[s2_]), vf, o[d], 0, 0, 0); } } } while (0)
#define ATT_ROWMAX(mx) do { float a_ = fmaxf(p0[0], p1[0]); _Pragma("unroll") for (int r = 1; r < 16; ++r) a_ = fmaxf(a_, fmaxf(p0[r], p1[r])); mx = swapmax(a_); } while (0)
#define ATT_IMAX(im) do { int a_ = __float_as_int(p0[0]); _Pragma("unroll") for (int r = 1; r < 16; ++r) { const int b_ = __float_as_int(p0[r]); a_ = a_ > b_ ? a_ : b_; } \
        _Pragma("unroll") for (int r = 0; r < 16; ++r) { const int b_ = __float_as_int(p1[r]); a_ = a_ > b_ ? a_ : b_; } im = a_; } while (0)
#define ATT_EXP_PACK() do { float sacc = 0.f; \
        _Pragma("unroll") for (int r = 0; r < 16; ++r) { p0[r] = __builtin_amdgcn_exp2f(p0[r]); p1[r] = __builtin_amdgcn_exp2f(p1[r]); sacc += p0[r] + p1[r]; } \
        l += sacc; \
        _Pragma("unroll") for (int j = 0; j < 4; ++j) { pw[0][j] = cvt_pk_bf16(p0[2 * j], p0[2 * j + 1]); pw[1][j] = cvt_pk_bf16(p0[8 + 2 * j], p0[8 + 2 * j + 1]); \
            pw[2][j] = cvt_pk_bf16(p1[2 * j], p1[2 * j + 1]); pw[3][j] = cvt_pk_bf16(p1[8 + 2 * j], p1[8 + 2 * j + 1]); } } while (0)
    f32x16 q0, q1;
    ATT_WAITBAR_N(6);
    ATT_QK(0);
    { float mx; ATT_ROWMAX(mx); const float d0 = fmaxf(mx, -256.f); cin -= d0;
#pragma unroll
        for (int r = 0; r < 16; ++r) { p0[r] = __builtin_amdgcn_exp2f(p0[r] - d0); p1[r] = __builtin_amdgcn_exp2f(p1[r] - d0); } }
#define ATT_PACK4(O0, O1, g) do { const int b_ = (((g) >> 1) * 8 + ((g) & 1) * 4) & 15; \
        if ((g) < 4) { pw[(g) >> 1][2 * ((g) & 1)] = cvt_pk_bf16(O0[b_], O0[b_ + 1]); pw[(g) >> 1][2 * ((g) & 1) + 1] = cvt_pk_bf16(O0[b_ + 2], O0[b_ + 3]); sacc += (O0[b_] + O0[b_ + 1]) + (O0[b_ + 2] + O0[b_ + 3]); } \
        else { pw[(g) >> 1][2 * ((g) & 1)] = cvt_pk_bf16(O1[b_], O1[b_ + 1]); pw[(g) >> 1][2 * ((g) & 1) + 1] = cvt_pk_bf16(O1[b_ + 2], O1[b_ + 3]); sacc += (O1[b_] + O1[b_ + 1]) + (O1[b_ + 2] + O1[b_ + 3]); } \
        asm volatile("" : "+v"(pw[(g) >> 1][2 * ((g) & 1)]), "+v"(pw[(g) >> 1][2 * ((g) & 1) + 1]), "+v"(sacc)); } while (0)
#define ATT_STEP(i, N0, N1, O0, O1) do { \
        { bf16x8 kf_[8]; float sacc = 0.f; \
          { const LAS unsigned char* kb_ = lds + L2_K + ((i) % K4) * KSLOT; \
            _Pragma("unroll") for (int ks = 0; ks < 4; ++ks) { kf_[2 * ks] = *(const LAS bf16x8*)(kb_ + koff[ks]); kf_[2 * ks + 1] = *(const LAS bf16x8*)(kb_ + koff[ks] + 4096); } } \
          __builtin_amdgcn_sched_barrier(0); \
          { const float cl_ = slope2 * (float)(ATT_PK0(i) + 4 * hi - pq) + cin, s32_ = 32.f * slope2; \
            _Pragma("unroll") for (int r = 0; r < 16; ++r) { N0[r] = fmaf(slope2, (float)((r & 3) + 8 * (r >> 2)), cl_); N1[r] = N0[r] + s32_; } } \
          _Pragma("unroll") for (int ks = 0; ks < 4; ++ks) { \
              N0 = __builtin_amdgcn_mfma_f32_32x32x16_bf16(kf_[2 * ks], qr[ks], N0, 0, 0, 0); ATT_PACK4(O0, O1, 2 * ks); __builtin_amdgcn_sched_barrier(0); \
              N1 = __builtin_amdgcn_mfma_f32_32x32x16_bf16(kf_[2 * ks + 1], qr[ks], N1, 0, 0, 0); ATT_PACK4(O0, O1, 2 * ks + 1); __builtin_amdgcn_sched_barrier(0); } \
          l += sacc; \
          if ((i) < 4 || (i) >= NR) { const int lim_ = (((i) >= NR) ? 15 : qrel - 64 * (3 - (i))) - 4 * hi; \
              _Pragma("unroll") for (int r = 0; r < 16; ++r) { const int kv = (r & 3) + 8 * (r >> 2); if (kv > lim_) N0[r] = -INFINITY; if (kv + 32 > lim_) N1[r] = -INFINITY; } } } \
        unsigned vp_ = (unsigned)(size_t)vpl + (unsigned)((((i) - 1) % V3) * VSLOT); asm volatile("" : "+v"(vp_)); \
        s16x4 vq[2][8]; \
        _Pragma("unroll") for (int d = 0; d < 4; ++d) { VTR_A(vq[0][2 * d], vp_, d * 4096); VTR_A(vq[0][2 * d + 1], vp_, d * 4096 + 512); } \
        __builtin_amdgcn_sched_barrier(0); \
        int imx; { int a_ = __float_as_int(N0[0]); _Pragma("unroll") for (int r = 1; r < 16; ++r) { const int b_ = __float_as_int(N0[r]); a_ = a_ > b_ ? a_ : b_; } \
            _Pragma("unroll") for (int r = 0; r < 16; ++r) { const int b_ = __float_as_int(N1[r]); a_ = a_ > b_ ? a_ : b_; } imx = a_; } \
        if (__any(imx > __builtin_bit_cast(int, THR))) { \
            float mx; { float a_ = fmaxf(N0[0], N1[0]); _Pragma("unroll") for (int r = 1; r < 16; ++r) a_ = fmaxf(a_, fmaxf(N0[r], N1[r])); mx = swapmax(a_); } \
            const float dl = ceilf(fmaxf(mx, 0.f)), f = __builtin_amdgcn_exp2f(-dl); cin -= dl; l *= f; \
            if (hi == 0) wsf[r32] = f; \
            asm volatile("s_waitcnt lgkmcnt(0)" ::: "memory"); \
            _Pragma("unroll") for (int r = 0; r < 16; ++r) { const float fr_ = wsf[crow(r, hi)]; N0[r] -= dl; N1[r] -= dl; \
                _Pragma("unroll") for (int d = 0; d < 4; ++d) o[d][r] *= fr_; } \
            const unsigned du = (unsigned)dl; \
            _Pragma("unroll") for (int s2_ = 0; s2_ < 4; ++s2_) _Pragma("unroll") for (int j = 0; j < 4; ++j) { const unsigned w = pw[s2_][j]; unsigned lo = w & 0xffffu, hh = w >> 16; \
                    lo = (((lo >> 7) & 0xffu) > du) ? lo - (du << 7) : 0u; hh = (((hh >> 7) & 0xffu) > du) ? hh - (du << 7) : 0u; pw[s2_][j] = lo | (hh << 16); } \
        } \
        _Pragma("unroll") for (int s2_ = 0; s2_ < 4; ++s2_) { \
            if (s2_ < 3) { _Pragma("unroll") for (int d = 0; d < 4; ++d) { VTR_A(vq[(s2_ + 1) & 1][2 * d], vp_, d * 4096 + (s2_ + 1) * 1024); VTR_A(vq[(s2_ + 1) & 1][2 * d + 1], vp_, d * 4096 + (s2_ + 1) * 1024 + 512); } } \
            __builtin_amdgcn_sched_barrier(0); \
            _Pragma("unroll") for (int d = 0; d < 4; ++d) { VTR_WAIT((s2_ < 3 ? 8 : 0) + 6 - 2 * d, vq[s2_ & 1][2 * d], vq[s2_ & 1][2 * d + 1]); \
                const s16x4 lo = vq[s2_ & 1][2 * d], h4 = vq[s2_ & 1][2 * d + 1]; \
                const bf16x8 vf = (bf16x8){lo[0], lo[1], lo[2], lo[3], h4[0], h4[1], h4[2], h4[3]}; \
                o[d] = __builtin_amdgcn_mfma_f32_32x32x16_bf16(__builtin_bit_cast(bf16x8, pw[s2_]), vf, o[d], 0, 0, 0); \
                const int e_ = s2_ * 4 + d; \
                if (e_ < 8) { float x0_ = __builtin_amdgcn_exp2f(N0[2 * e_]), x1_ = __builtin_amdgcn_exp2f(N0[2 * e_ + 1]); asm volatile("" : "+v"(x0_), "+v"(x1_)); N0[2 * e_] = x0_; N0[2 * e_ + 1] = x1_; }     \
                else { float x0_ = __builtin_amdgcn_exp2f(N1[(2 * e_) & 15]), x1_ = __builtin_amdgcn_exp2f(N1[(2 * e_ + 1) & 15]); asm volatile("" : "+v"(x0_), "+v"(x1_)); N1[(2 * e_) & 15] = x0_; N1[(2 * e_ + 1) & 15] = x1_; } } \
            __builtin_amdgcn_sched_barrier(0); } } while (0)
    { int i = 1;
        for (; i + 1 < NT; i += 2) { ATT_WAITBAR_N(0); if (i + 2 < NT) ATT_DMA(i + 2); if (i + 3 < NT) ATT_DMA(i + 3);
            ATT_STEP(i, q0, q1, p0, p1); ATT_STEP(i + 1, p0, p1, q0, q1); }
        if (i < NT) { ATT_WAITBAR_N(0); ATT_STEP(i, q0, q1, p0, p1); float sacc = 0.f;
#pragma unroll
            for (int g = 0; g < 8; ++g) ATT_PACK4(q0, q1, g);
            l += sacc; }
        else { float sacc = 0.f;
#pragma unroll
            for (int g = 0; g < 8; ++g) ATT_PACK4(p0, p1, g);
            l += sacc; } }
#undef ATT_STEP
#undef ATT_PACK4
    ATT_PV((NT - 1) % V3);
    l = swapsum(l);
    if (hi == 0) wsf[32 + r32] = l;
    ATT_WAITBAR();
    LAS bf16_t* stg = (LAS bf16_t*)(lds + L2_OST + wid * 8192);
    int lane_e = lane; asm volatile("" : "+v"(lane_e));
    const int r32e = lane_e & 31, hie = lane_e >> 5;
#pragma unroll
    for (int r = 0; r < 16; ++r) { const int orow = crow(r, hie); const float rl = 1.f / wsf[32 + orow];
#pragma unroll
        for (int d = 0; d < 4; ++d) stg[orow * 128 + d * 32 + r32e] = (bf16_t)f2bf(o[d][r] * rl); }
    asm volatile("s_waitcnt lgkmcnt(0)" ::: "memory");
#pragma unroll
    for (int i = 0; i < 8; ++i) { const int row = i * 4 + (lane_e >> 4), ch = lane_e & 15; const u32x4 v = *(const LAS u32x4*)(stg + row * 128 + ch * 8);
        *(u32x4*)(Ob + (size_t)(qrow0 + row) * D + vh * 128 + ch * 8) = v; }
    ATT_WAITBAR();
#undef ATT_DMA
#undef ATT_KROW0
#undef ATT_PK0
#undef ATT_QK
#undef ATT_PV
#undef ATT_ROWMAX
#undef ATT_IMAX
#undef ATT_EXP_PACK
#undef ATT_SETC
}
}

__device__ __forceinline__ void stage_attn(const Ptrs& P, LAS unsigned char* lds, int wg, int nwg, int flags) {
    const int tid_ = tid_opaque(P); const int lane = tid_ & 63, wave = __builtin_amdgcn_readfirstlane(tid_ >> 6);
    if (!(flags & 2)) { LAS float* qs = (LAS float*)(lds) + wave * 128;
        for (int it = wg * 8 + wave; it < NB * NMETA * 4; it += nwg * 8) { const int rr = it >> 2; attn_naive_item(P, (rr >> 4) * LB + (rr & 15), it & 3, qs, lane); }
        }
    __syncthreads();
    if (nwg == 256 && wg >= 192 && !(flags & 2)) { prep_items(P, lds, PREP_EARLY, PREP_NITEMS, (wg - 192) * 8 + wave, 64 * 8, lane, wave); prep_fold(P, (wg - 192) * 8 + wave, 64 * 8, lane); __syncthreads(); }
    if (flags & 1) return;
    unsigned* qhead = (unsigned*)(P.ws + WS_CTL) + CW_AQ; LAS int* qslot = (LAS int*)(lds + att::L2_TOTAL + 64);
    for (;;) {
        if (tid_ == 0) qslot[0] = (int)atomicAdd(qhead, 1u);
        __syncthreads();
        const int L = __builtin_amdgcn_readfirstlane(qslot[0]);
        __syncthreads();
        if (L >= 1024) break;
        int b, vh, qb;
        if (L < 512) { qb = 31 - (L >> 4); b = (L >> 2) & 3; vh = 4 + (L & 3); }
        else { const int j = L & 255; qb = 31 - (j >> 3); b = (j >> 1) & 3; vh = (L < 768 ? 2 : 0) + (j & 1); }
        att::attn_unit(P, lds, b, vh, qb); }
}
__device__ __forceinline__ void stage_combine(const Ptrs& P, int wg, int nwg) {
    const int tid_ = tid_opaque(P); const int lane = tid_ & 63, wave = __builtin_amdgcn_readfirstlane(tid_ >> 6); const bf16_t* Ob = (const bf16_t*)(P.ws + WS_OA); unsigned char* A28 = P.ws + WS_A2;
    const float lam = ((const float*)(P.ws + WS_MISC))[0]; const int h = lane >> 4, c = (lane & 15) * 8;
    float sw[8];
#pragma unroll
    for (int j = 0; j < 8; ++j) sw[j] = P.subln[c + j] * (1.f - LAMBDA_INIT);
    for (int rr0 = (wg * 8 + wave) * 4; rr0 < NB * SEQ; rr0 += nwg * 8 * 4) {
        u32x4 av[4], bv[4];
#pragma unroll
        for (int q = 0; q < 4; ++q) { const int rr = rr0 + q, row = (rr >> 13) * LB + NMETA + (rr & 8191);
            av[q] = *(const u32x4*)(Ob + (size_t)row * D + (2 * h) * 128 + c); bv[q] = *(const u32x4*)(Ob + (size_t)row * D + (2 * h + 1) * 128 + c); }
#pragma unroll
        for (int q = 0; q < 4; ++q) { const int rr = rr0 + q, row = (rr >> 13) * LB + NMETA + (rr & 8191); const u32x4 a = av[q], bb = bv[q];
            float v[8]; v[0] = bflo(a.x) - lam * bflo(bb.x); v[1] = bfhi(a.x) - lam * bfhi(bb.x); v[2] = bflo(a.y) - lam * bflo(bb.y); v[3] = bfhi(a.y) - lam * bfhi(bb.y);
            v[4] = bflo(a.z) - lam * bflo(bb.z); v[5] = bfhi(a.z) - lam * bfhi(bb.z); v[6] = bflo(a.w) - lam * bflo(bb.w); v[7] = bfhi(a.w) - lam * bfhi(bb.w);
            float ss = 0.f;
#pragma unroll
            for (int j = 0; j < 8; ++j) ss += v[j] * v[j];
            ss += __shfl_xor(ss, 1); ss += __shfl_xor(ss, 2); ss += __shfl_xor(ss, 4); ss += __shfl_xor(ss, 8);
            const float r = __builtin_amdgcn_rsqf(ss * (1.f / 128.f) + RMS_EPS);
            const float rr_ = r * F8_ASCALE; u32x2 o; o.x = pk4_fp8(v[0] * rr_ * sw[0], v[1] * rr_ * sw[1], v[2] * rr_ * sw[2], v[3] * rr_ * sw[3]); o.y = pk4_fp8(v[4] * rr_ * sw[4], v[5] * rr_ * sw[5], v[6] * rr_ * sw[6], v[7] * rr_ * sw[7]);
            *(u32x2*)(A28 + (size_t)row * D + 512 + h * 128 + c) = o; } }
}

namespace gla {
 using att::s16x4; using att::vtr; using att::crow;
constexpr int LQD = 0, LKD = 16384, LKW = 32768, LP = 49152, LV = 58368, LOS = 91136, LEB = 124928, LHN = LEB + 1024, LGL = LHN + 1024, LEND = LGL + 4096;
static_assert(LEND <= 131072, "gla LDS");
constexpr int PST = 144, OST = 528;
constexpr size_t U_BYTES = (size_t)128 * 256 * 4;
__device__ __forceinline__ float* u_slot(const Ptrs& P, int bh, int seg) { return (float*)(P.ws + WS_OA + ((size_t)bh * 16 + seg) * U_BYTES); }
__device__ __forceinline__ float* a_slot(const Ptrs& P, int bh, int seg) { return (float*)(P.ws + WS_OA + (size_t)256 * U_BYTES) + ((size_t)bh * 16 + seg) * 128; }
__device__ __forceinline__ float* eb_slot(const Ptrs& P, int b, int cidx) { return (float*)(P.ws + WS_OA + (size_t)256 * U_BYTES + 262144) + ((size_t)b * 129 + cidx) * 512; }

constexpr int PRE_W2 = 0, PRE_TOT = 32768;
__device__ __forceinline__ void pre_chunk(const Ptrs& P, LAS unsigned char* lds, int tid, int r0, int nrows, float* eb, const float (&gb)[8]) {
    const int lane = tid & 63; const int w = __builtin_amdgcn_readfirstlane(tid >> 6);
    bf16_t* Z = (bf16_t*)(P.ws + WS_Z); const float* GLR = (const float*)(P.ws + WS_GLR); LAS float* gl = (LAS float*)(lds + LGL);
    const LAS f32x4* w2l = (const LAS f32x4*)(lds + PRE_W2); LAS f32x4* totl = (LAS f32x4*)(lds + PRE_TOT);
    const int nact = nrows >> 3; const bool act = w < nact;
    bf16_t* zr = Z + (size_t)(r0 + 8 * w) * ODD_N + 8 * lane;
#define PRE_BAR() asm volatile("s_waitcnt lgkmcnt(0)\n\ts_barrier" ::: "memory")
    u32x4 qv[8], kv[8];
    const f32x4 glr = ((const f32x4*)(GLR + (size_t)r0 * 16))[tid & 255];
    __builtin_amdgcn_sched_barrier(0);
#pragma unroll
    for (int t = 0; t < 8; ++t) { qv[t] = *(const u32x4*)(zr + (size_t)t * ODD_N); kv[t] = *(const u32x4*)(zr + (size_t)t * ODD_N + 512); }
    __builtin_amdgcn_sched_barrier(0);
    ((LAS f32x4*)gl)[tid & 255] = glr;
    PRE_BAR();
    float cum[8][8];
    if (act) {
        f32x2 c2[8][4];
#pragma unroll
        for (int t = 0; t < 8; ++t)
#pragma unroll
            for (int cp = 0; cp < 4; ++cp) c2[t][cp] = (f32x2){gb[2 * cp], gb[2 * cp + 1]};
#pragma unroll
        for (int j4 = 0; j4 < 4; ++j4) { f32x4 glv[8];
#pragma unroll
            for (int t = 0; t < 8; ++t) glv[t] = ((const LAS f32x4*)gl)[(8 * w + t) * 4 + j4];
#pragma unroll
            for (int jj = 0; jj < 4; ++jj) { const f32x4 wa = w2l[((4 * j4 + jj) * 2 + 0) * 64 + lane], wb = w2l[((4 * j4 + jj) * 2 + 1) * 64 + lane];
#pragma unroll
                for (int t = 0; t < 8; ++t) { const float sg = glv[t][jj]; const f32x2 s2 = (f32x2){sg, sg};
                    c2[t][0] = __builtin_elementwise_fma(s2, (f32x2){wa[0], wa[1]}, c2[t][0]); c2[t][1] = __builtin_elementwise_fma(s2, (f32x2){wa[2], wa[3]}, c2[t][1]);
                    c2[t][2] = __builtin_elementwise_fma(s2, (f32x2){wb[0], wb[1]}, c2[t][2]); c2[t][3] = __builtin_elementwise_fma(s2, (f32x2){wb[2], wb[3]}, c2[t][3]); } } }
#pragma unroll
        for (int t = 0; t < 8; ++t)
#pragma unroll
            for (int cp = 0; cp < 4; ++cp) { cum[t][2 * cp] = c2[t][cp].x; cum[t][2 * cp + 1] = c2[t][cp].y; }
#pragma unroll
        for (int ch = 0; ch < 8; ++ch) { float run = 0.f;
#pragma unroll
            for (int t = 0; t < 8; ++t) { const float g = cum[t][ch]; run += (fminf(g, 0.f) - 0.69314718f * __builtin_amdgcn_logf(1.f + __builtin_amdgcn_exp2f(fabsf(g) * -1.44269504f))) * (1.f / 16.f); cum[t][ch] = run; } }
        totl[(w * 2 + 0) * 64 + lane] = (f32x4){cum[7][0], cum[7][1], cum[7][2], cum[7][3]}; totl[(w * 2 + 1) * 64 + lane] = (f32x4){cum[7][4], cum[7][5], cum[7][6], cum[7][7]};
    }
    PRE_BAR();
    if (act) {
        float off[8];
#pragma unroll
        for (int ch = 0; ch < 8; ++ch) off[ch] = 0.f;
        for (int pw_ = 0; pw_ < w; ++pw_) { const f32x4 a = totl[(pw_ * 2 + 0) * 64 + lane], b = totl[(pw_ * 2 + 1) * 64 + lane];
            off[0] += a[0]; off[1] += a[1]; off[2] += a[2]; off[3] += a[3]; off[4] += b[0]; off[5] += b[1]; off[6] += b[2]; off[7] += b[3]; }
#pragma unroll
        for (int t = 0; t < 8; ++t) { float e[8], ie[8];
#pragma unroll
            for (int ch = 0; ch < 8; ++ch) { e[ch] = __builtin_amdgcn_exp2f((off[ch] + cum[t][ch]) * 1.44269504f); ie[ch] = __builtin_amdgcn_rcpf(e[ch]); }
            const u32x4 q = qv[t], k = kv[t]; u32x4 qo, ko;
            qo.x = cvt_pk_bf16(bflo(q.x) * e[0], bfhi(q.x) * e[1]); qo.y = cvt_pk_bf16(bflo(q.y) * e[2], bfhi(q.y) * e[3]); qo.z = cvt_pk_bf16(bflo(q.z) * e[4], bfhi(q.z) * e[5]); qo.w = cvt_pk_bf16(bflo(q.w) * e[6], bfhi(q.w) * e[7]);
            ko.x = cvt_pk_bf16(bflo(k.x) * ie[0], bfhi(k.x) * ie[1]); ko.y = cvt_pk_bf16(bflo(k.y) * ie[2], bfhi(k.y) * ie[3]); ko.z = cvt_pk_bf16(bflo(k.z) * ie[4], bfhi(k.z) * ie[5]); ko.w = cvt_pk_bf16(bflo(k.w) * ie[6], bfhi(k.w) * ie[7]);
            *(u32x4*)(zr + (size_t)t * ODD_N) = qo; *(u32x4*)(zr + (size_t)t * ODD_N + 512) = ko; }
        if (w == nact - 1) {
            *(f32x4*)(eb + 8 * lane) = (f32x4){__expf(off[0] + cum[7][0]), __expf(off[1] + cum[7][1]), __expf(off[2] + cum[7][2]), __expf(off[3] + cum[7][3])};
            *(f32x4*)(eb + 8 * lane + 4) = (f32x4){__expf(off[4] + cum[7][4]), __expf(off[5] + cum[7][5]), __expf(off[6] + cum[7][6]), __expf(off[7] + cum[7][7])}; }
    }
    PRE_BAR();
#undef PRE_BAR
}
__device__ __forceinline__ void stage_pre(const Ptrs& P, LAS unsigned char* lds, int wg, int nwg) {
    const int tid = tid_opaque(P); const int lane = tid & 63;
    for (int idx = tid; idx < 2048; idx += 512) { const int j = idx >> 7, hf = (idx >> 6) & 1, ln = idx & 63; ((LAS f32x4*)(lds + PRE_W2))[idx] = *(const f32x4*)(P.gate_w2 + j * 512 + 8 * ln + 4 * hf); }
    float gb[8];
    { const f32x4 a = *(const f32x4*)(P.gate_b + 8 * lane), b = *(const f32x4*)(P.gate_b + 8 * lane + 4); gb[0] = a[0]; gb[1] = a[1]; gb[2] = a[2]; gb[3] = a[3]; gb[4] = b[0]; gb[5] = b[1]; gb[6] = b[2]; gb[7] = b[3]; }
    __syncthreads();
    for (int it = wg; it < NB * 128; it += nwg) { const int b = it >> 7, j = it & 127, rowb = b * LB;
        if (j == 0) pre_chunk(P, lds, tid, rowb, NMETA, eb_slot(P, b, 0), gb);
        pre_chunk(P, lds, tid, rowb + NMETA + 64 * j, 64, eb_slot(P, b, j + 1), gb); }
}

__device__ __forceinline__ void segment_state(const Ptrs& P, LAS unsigned char* lds, int bh, int seg) {
    const int tid = tid_opaque(P), lane = tid & 63, r32 = lane & 31, hi = lane >> 5; const int wid = __builtin_amdgcn_readfirstlane(tid >> 6);
    const int b = bh >> 2, h = bh & 3, rowb = b * LB;
    const bf16_t* Z = (const bf16_t*)(P.ws + WS_Z);
    constexpr int BUF = 49152, BV = 0, BKW = 32768, BEB = 98304;
    const unsigned lds0 = (unsigned)(size_t)lds;
    f32x16 S[4];
#pragma unroll
    for (int cb = 0; cb < 4; ++cb) S[cb] = f32x16{};
    const int nch = 8 + (seg == 0 ? 1 : 0);
    const LAS unsigned char* trb = lds + ((lane >> 4) & 1) * 32 + (lane & 3) * 8 + (8 * hi + ((lane & 15) >> 2)) * 64;
#define GS_R0(ch) ((seg == 0 && (ch) == 0) ? rowb : rowb + NMETA + 64 * (seg * 8 + (ch) - (seg == 0 ? 1 : 0)))
#define GS_ISSUE(ch) do { const int r0_ = GS_R0(ch), bo_ = ((ch) & 1) * BUF; \
        _Pragma("unroll") for (int i_ = 0; i_ < 4; ++i_) { const int pc = wid * 4 + i_, db = pc >> 2, rg = pc & 3; \
            att::glds16(Z + (size_t)(r0_ + 16 * rg + (lane >> 2)) * ODD_N + 1024 + h * 256 + db * 32 + (lane & 3) * 8, (unsigned)__builtin_amdgcn_readfirstlane((int)(lds0 + bo_ + BV + pc * 1024))); } \
        _Pragma("unroll") for (int i_ = 0; i_ < 2; ++i_) { const int pc = wid * 2 + i_, cb = pc >> 2, rg = pc & 3; \
            att::glds16(Z + (size_t)(r0_ + 16 * rg + (lane >> 2)) * ODD_N + 512 + h * 128 + cb * 32 + (lane & 3) * 8, (unsigned)__builtin_amdgcn_readfirstlane((int)(lds0 + bo_ + BKW + pc * 1024))); } \
        if (wid == 0) { const int cidx_ = (seg == 0 && (ch) == 0) ? 0 : seg * 8 + (ch) - (seg == 0 ? 1 : 0) + 1; \
            att::glds16(eb_slot(P, b, cidx_) + h * 128 + lane * 4, (unsigned)__builtin_amdgcn_readfirstlane((int)(lds0 + BEB + ((ch) & 1) * 1024))); } } while (0)
    GS_ISSUE(0); GS_ISSUE(1);
    float aprod = 1.f;
    for (int ch = 0; ch < nch; ++ch) {
        const int bo = (ch & 1) * BUF; const bool metac = (seg == 0 && ch == 0);
        if (ch + 1 < nch) { if (wid == 0) asm volatile("s_waitcnt vmcnt(7) lgkmcnt(0)\n\ts_barrier" ::: "memory"); else asm volatile("s_waitcnt vmcnt(6) lgkmcnt(0)\n\ts_barrier" ::: "memory"); }
        else asm volatile("s_waitcnt vmcnt(0) lgkmcnt(0)\n\ts_barrier" ::: "memory");
        const LAS float* eB = (const LAS float*)(lds + BEB + (ch & 1) * 1024);
        if (tid < 128) aprod *= eB[tid];
        const int nks = metac ? 1 : 4;
        bf16x8 vf[4];
#pragma unroll
        for (int ks = 0; ks < 4; ++ks) { const s16x4 lo = vtr(trb + bo + BV + (wid * 4 + ks) * 1024), h4 = vtr(trb + bo + BV + (wid * 4 + ks) * 1024 + 256); vf[ks] = (bf16x8){lo[0], lo[1], lo[2], lo[3], h4[0], h4[1], h4[2], h4[3]}; }
#pragma unroll
        for (int cb = 0; cb < 4; ++cb) {
#pragma unroll
            for (int ks = 0; ks < 4; ++ks) if (ks < nks) { const s16x4 lo = vtr(trb + bo + BKW + (cb * 4 + ks) * 1024), h4 = vtr(trb + bo + BKW + (cb * 4 + ks) * 1024 + 256);
                const bf16x8 kf = (bf16x8){lo[0], lo[1], lo[2], lo[3], h4[0], h4[1], h4[2], h4[3]};
                S[cb] = __builtin_amdgcn_mfma_f32_32x32x16_bf16(kf, vf[ks], S[cb], 0, 0, 0); }
#pragma unroll
            for (int g = 0; g < 4; ++g) { const f32x4 e4 = *(const LAS f32x4*)(eB + 32 * cb + 8 * g + 4 * hi); S[cb][4 * g] *= e4.x; S[cb][4 * g + 1] *= e4.y; S[cb][4 * g + 2] *= e4.z; S[cb][4 * g + 3] *= e4.w; } }
        asm volatile("s_waitcnt lgkmcnt(0)\n\ts_barrier" ::: "memory");
        if (ch + 2 < nch) GS_ISSUE(ch + 2);
    }
#undef GS_ISSUE
#undef GS_R0
    float* u = u_slot(P, bh, seg);
#pragma unroll
    for (int cb = 0; cb < 4; ++cb)
#pragma unroll
        for (int r = 0; r < 16; ++r) u[(size_t)(32 * cb + crow(r, hi)) * 256 + 32 * wid + r32] = S[cb][r];
    if (tid < 128) a_slot(P, bh, seg)[tid] = aprod;
    asm volatile("s_waitcnt vmcnt(0) lgkmcnt(0)\n\ts_barrier" ::: "memory");
}
__device__ __forceinline__ void segment_out(const Ptrs& P, LAS unsigned char* lds, int bh, int seg) {
    const int tid = tid_opaque(P), lane = tid & 63, r32 = lane & 31, hi = lane >> 5; const int wid = __builtin_amdgcn_readfirstlane(tid >> 6);
    const int b = bh >> 2, h = bh & 3, rowb = b * LB;
    const bf16_t* Z = (const bf16_t*)(P.ws + WS_Z); unsigned char* A28 = P.ws + WS_A2;
    LAS float* eB = (LAS float*)(lds + LEB); LAS float* hnl = (LAS float*)(lds + LHN);
    if (tid < 256) hnl[tid] = P.head_norm[tid];
    f32x16 S[4];
    if (seg > 0) { const float* u = u_slot(P, bh, seg - 1);
#pragma unroll
        for (int cb = 0; cb < 4; ++cb)
#pragma unroll
            for (int r = 0; r < 16; ++r) S[cb][r] = u[(size_t)(32 * cb + crow(r, hi)) * 256 + 32 * wid + r32]; }
    else {
#pragma unroll
        for (int cb = 0; cb < 4; ++cb) S[cb] = f32x16{}; }
    const int nch = 8 + (seg == 0 ? 1 : 0);
    const unsigned lds0 = (unsigned)(size_t)lds;
    const LAS unsigned char* trb = lds + ((lane >> 4) & 1) * 32 + (lane & 3) * 8 + (8 * hi + ((lane & 15) >> 2)) * 64;
#define GO_META(ch) (seg == 0 && (ch) == 0)
#define GO_R0(ch) (GO_META(ch) ? rowb : rowb + NMETA + 64 * (seg * 8 + (ch) - (seg == 0 ? 1 : 0)))
#define GO_CIDX(ch) (GO_META(ch) ? 0 : seg * 8 + (ch) - (seg == 0 ? 1 : 0) + 1)
#define GO_ISSUE_A(ch) do { const int r0_ = GO_R0(ch); \
        _Pragma("unroll") for (int i_ = 0; i_ < 4; ++i_) { const int pc = wid * 4 + i_, db = pc >> 2, rg = pc & 3; \
            att::glds16(Z + (size_t)(r0_ + 16 * rg + (lane >> 2)) * ODD_N + 1024 + h * 256 + db * 32 + (lane & 3) * 8, (unsigned)__builtin_amdgcn_readfirstlane((int)(lds0 + LV + pc * 1024))); } \
        if (!GO_META(ch)) { _Pragma("unroll") for (int i_ = 0; i_ < 2; ++i_) { const int chk = wid * 2 + i_; \
            att::glds16(Z + (size_t)(r0_ + lane) * ODD_N + h * 128 + chk * 8, (unsigned)__builtin_amdgcn_readfirstlane((int)(lds0 + LQD + chk * 1024))); \
            att::glds16(Z + (size_t)(r0_ + lane) * ODD_N + 512 + h * 128 + chk * 8, (unsigned)__builtin_amdgcn_readfirstlane((int)(lds0 + LKD + chk * 1024))); } } } while (0)
#define GO_ISSUE_B(ch) do { const int r0_ = GO_R0(ch); \
        _Pragma("unroll") for (int i_ = 0; i_ < 2; ++i_) { const int pc = wid * 2 + i_, cb = pc >> 2, rg = pc & 3; \
            att::glds16(Z + (size_t)(r0_ + 16 * rg + (lane >> 2)) * ODD_N + 512 + h * 128 + cb * 32 + (lane & 3) * 8, (unsigned)__builtin_amdgcn_readfirstlane((int)(lds0 + LKW + pc * 1024))); } \
        if (wid == 0) att::glds16(eb_slot(P, b, GO_CIDX(ch)) + h * 128 + lane * 4, (unsigned)__builtin_amdgcn_readfirstlane((int)(lds0 + LEB))); } while (0)
    GO_ISSUE_A(0); GO_ISSUE_B(0);
    for (int ch = 0; ch < nch; ++ch) {
        const bool outc = !GO_META(ch); const int r0 = GO_R0(ch);
        asm volatile("s_waitcnt vmcnt(0) lgkmcnt(0)\n\ts_barrier" ::: "memory");
        u32x4 rgv[4];
        if (outc) { const u32x4* rgp = (const u32x4*)(Z + (size_t)(r0 + (tid >> 3)) * ODD_N + 2048 + h * 256 + (tid & 7) * 32);
#pragma unroll
            for (int q = 0; q < 4; ++q) rgv[q] = rgp[q]; }
        f32x16 o[2];
        if (outc) {
            if (wid < 4) { const int sb = wid & 1, tb = wid >> 1; f32x16 x = f32x16{};
                if (!(sb == 1 && tb == 0)) {
#pragma unroll
                    for (int ks = 0; ks < 8; ++ks) { const bf16x8 a = *(const LAS bf16x8*)(lds + LKD + (2 * ks + hi) * 1024 + (32 * sb + r32) * 16), bq = *(const LAS bf16x8*)(lds + LQD + (2 * ks + hi) * 1024 + (32 * tb + r32) * 16);
                        x = __builtin_amdgcn_mfma_f32_32x32x16_bf16(a, bq, x, 0, 0, 0); }
                    if (sb == tb) {
#pragma unroll
                        for (int r = 0; r < 16; ++r) if (crow(r, hi) > r32) x[r] = 0.f; }
                }
#pragma unroll
                for (int g = 0; g < 4; ++g) { u32x2 w; w.x = cvt_pk_bf16(x[4 * g], x[4 * g + 1]); w.y = cvt_pk_bf16(x[4 * g + 2], x[4 * g + 3]);
                    *(LAS u32x2*)(lds + LP + (32 * tb + r32) * PST + (32 * sb + 8 * g + 4 * hi) * 2) = w; } }
            o[0] = f32x16{}; o[1] = f32x16{};
#pragma unroll
            for (int cb = 0; cb < 4; ++cb)
#pragma unroll
                for (int s2 = 0; s2 < 2; ++s2) { u32x4 sw;
#pragma unroll
                    for (int j = 0; j < 4; ++j) sw[j] = cvt_pk_bf16(S[cb][8 * s2 + 2 * j], S[cb][8 * s2 + 2 * j + 1]);
                    const int kst = 2 * cb + s2;
#pragma unroll
                    for (int tb = 0; tb < 2; ++tb) { const LAS unsigned char* ap = lds + LQD + (2 * kst) * 1024 + (32 * tb + r32) * 16 + 8 * hi;
                        const u32x2 a0 = *(const LAS u32x2*)ap, a1 = *(const LAS u32x2*)(ap + 1024); const u32x4 a = (u32x4){a0.x, a0.y, a1.x, a1.y};
                        o[tb] = __builtin_amdgcn_mfma_f32_32x32x16_bf16(__builtin_bit_cast(bf16x8, a), __builtin_bit_cast(bf16x8, sw), o[tb], 0, 0, 0); } }
        }
        const int nks = outc ? 4 : 1;
        bf16x8 vf[4];
#pragma unroll
        for (int ks = 0; ks < 4; ++ks) { const s16x4 lo = vtr(trb + LV + (wid * 4 + ks) * 1024), h4 = vtr(trb + LV + (wid * 4 + ks) * 1024 + 256); vf[ks] = (bf16x8){lo[0], lo[1], lo[2], lo[3], h4[0], h4[1], h4[2], h4[3]}; }
        asm volatile("s_waitcnt lgkmcnt(0)\n\ts_barrier" ::: "memory");
        if (outc) asm volatile("" :: "v"(rgv[0]), "v"(rgv[1]), "v"(rgv[2]), "v"(rgv[3]));
        if (ch + 1 < nch) GO_ISSUE_A(ch + 1);
        if (outc) {
#pragma unroll
            for (int ks = 0; ks < 4; ++ks)
#pragma unroll
                for (int tb = 0; tb < 2; ++tb) { const bf16x8 a = *(const LAS bf16x8*)(lds + LP + (32 * tb + r32) * PST + (16 * ks + 8 * hi) * 2);
                    o[tb] = __builtin_amdgcn_mfma_f32_32x32x16_bf16(a, vf[ks], o[tb], 0, 0, 0); }
#pragma unroll
            for (int tb = 0; tb < 2; ++tb)
#pragma unroll
                for (int r = 0; r < 16; ++r) *(LAS bf16_t*)(lds + LOS + (32 * tb + crow(r, hi)) * OST + (32 * wid + r32) * 2) = (bf16_t)f2bf(o[tb][r]);
        }
#pragma unroll
        for (int cb = 0; cb < 4; ++cb) {
#pragma unroll
            for (int ks = 0; ks < 4; ++ks) if (ks < nks) { const s16x4 lo = vtr(trb + LKW + (cb * 4 + ks) * 1024), h4 = vtr(trb + LKW + (cb * 4 + ks) * 1024 + 256);
                const bf16x8 kf = (bf16x8){lo[0], lo[1], lo[2], lo[3], h4[0], h4[1], h4[2], h4[3]};
                S[cb] = __builtin_amdgcn_mfma_f32_32x32x16_bf16(kf, vf[ks], S[cb], 0, 0, 0); }
#pragma unroll
            for (int g = 0; g < 4; ++g) { const f32x4 e4 = *(const LAS f32x4*)(eB + 32 * cb + 8 * g + 4 * hi); S[cb][4 * g] *= e4.x; S[cb][4 * g + 1] *= e4.y; S[cb][4 * g + 2] *= e4.z; S[cb][4 * g + 3] *= e4.w; } }
        asm volatile("s_waitcnt lgkmcnt(0)\n\ts_barrier" ::: "memory");
        if (ch + 1 < nch) GO_ISSUE_B(ch + 1);
        if (outc) {
            const int t = tid >> 3, j8 = tid & 7; const size_t row = (size_t)(r0 + t);
            float ss = 0.f;
#pragma unroll
            for (int q = 0; q < 4; ++q) { const u32x4 a = *(const LAS u32x4*)(lds + LOS + t * OST + j8 * 64 + q * 16);
                const float v0 = bflo(a.x), v1 = bfhi(a.x), v2 = bflo(a.y), v3 = bfhi(a.y), v4 = bflo(a.z), v5 = bfhi(a.z), v6 = bflo(a.w), v7 = bfhi(a.w);
                ss += v0 * v0 + v1 * v1 + v2 * v2 + v3 * v3 + v4 * v4 + v5 * v5 + v6 * v6 + v7 * v7; }
            ss += __shfl_xor(ss, 1); ss += __shfl_xor(ss, 2); ss += __shfl_xor(ss, 4);
            const float rn = __builtin_amdgcn_rsqf(ss * (1.f / 256.f) + RMS_EPS);
            u32x2* dst = (u32x2*)(A28 + row * D + h * 256 + j8 * 32);
#pragma unroll
            for (int q = 0; q < 4; ++q) { const u32x4 a = *(const LAS u32x4*)(lds + LOS + t * OST + j8 * 64 + q * 16);
                const float v[8] = {bflo(a.x), bfhi(a.x), bflo(a.y), bfhi(a.y), bflo(a.z), bfhi(a.z), bflo(a.w), bfhi(a.w)};
                const u32x4 g4 = rgv[q]; const float gv[8] = {bflo(g4.x), bfhi(g4.x), bflo(g4.y), bfhi(g4.y), bflo(g4.z), bfhi(g4.z), bflo(g4.w), bfhi(g4.w)}; float y[8];
#pragma unroll
                for (int e = 0; e < 8; ++e) y[e] = v[e] * (rn * F8_ASCALE) * hnl[j8 * 32 + 8 * q + e] * (gv[e] * __builtin_amdgcn_rcpf(1.f + __builtin_amdgcn_exp2f(gv[e] * -1.44269504f)));
                u32x2 w; w.x = pk4_fp8(y[0], y[1], y[2], y[3]); w.y = pk4_fp8(y[4], y[5], y[6], y[7]); dst[q] = w;
                __builtin_amdgcn_sched_barrier(0); }
        }
    }
    asm volatile("s_waitcnt vmcnt(0) lgkmcnt(0)\n\ts_barrier" ::: "memory");
#undef GO_META
#undef GO_R0
#undef GO_CIDX
#undef GO_ISSUE_A
#undef GO_ISSUE_B
}
template <bool OUT> __device__ __forceinline__ void segment(const Ptrs& P, LAS unsigned char* lds, int bh, int seg) {
    const int tid = tid_opaque(P), lane = tid & 63, r32 = lane & 31, hi = lane >> 5; const int wid = __builtin_amdgcn_readfirstlane(tid >> 6);
    const int b = bh >> 2, h = bh & 3, rowb = b * LB;
    const bf16_t* Z = (const bf16_t*)(P.ws + WS_Z); unsigned char* A28 = P.ws + WS_A2;
    LAS float* eB = (LAS float*)(lds + LEB); LAS float* hnl = (LAS float*)(lds + LHN);
    if (OUT && tid < 256) hnl[tid] = P.head_norm[tid];
    f32x16 S[4];
    if (OUT && seg > 0) { const float* u = u_slot(P, bh, seg - 1);
#pragma unroll
        for (int cb = 0; cb < 4; ++cb)
#pragma unroll
            for (int r = 0; r < 16; ++r) S[cb][r] = u[(size_t)(32 * cb + crow(r, hi)) * 256 + 32 * wid + r32]; }
    else {
#pragma unroll
        for (int cb = 0; cb < 4; ++cb) S[cb] = f32x16{}; }
    float aprod = 1.f;
    const int nch = 8 + (seg == 0 ? 1 : 0);
    const LAS unsigned char* trb = lds + ((lane >> 4) & 1) * 32 + (lane & 3) * 8 + (8 * hi + ((lane & 15) >> 2)) * 64;
    for (int ch = 0; ch < nch; ++ch) {
        const bool metac = (seg == 0 && ch == 0);
        const int cj = seg * 8 + ch - (seg == 0 ? 1 : 0);
        const int r0 = metac ? rowb : rowb + NMETA + 64 * cj;
        const float* ebg = eb_slot(P, b, metac ? 0 : cj + 1) + h * 128;
#pragma unroll
        for (int i_ = 0; i_ < 4; ++i_) { const int pc = wid * 4 + i_, db = pc >> 2, rg = pc & 3;
            __builtin_amdgcn_global_load_lds((const unsigned*)(Z + (size_t)(r0 + 16 * rg + (lane >> 2)) * ODD_N + 1024 + h * 256 + db * 32 + (lane & 3) * 8), (LAS unsigned*)(lds + LV + pc * 1024), 16, 0, 0); }
#pragma unroll
        for (int i_ = 0; i_ < 2; ++i_) { const int pc = wid * 2 + i_, cb = pc >> 2, rg = pc & 3;
            __builtin_amdgcn_global_load_lds((const unsigned*)(Z + (size_t)(r0 + 16 * rg + (lane >> 2)) * ODD_N + 512 + h * 128 + cb * 32 + (lane & 3) * 8), (LAS unsigned*)(lds + LKW + pc * 1024), 16, 0, 0); }
        const bool outc = OUT && !metac;
        u32x4 rgv[4];
        if (outc) { const u32x4* rgp = (const u32x4*)(Z + (size_t)(r0 + (tid >> 3)) * ODD_N + 2048 + h * 256 + (tid & 7) * 32);
#pragma unroll
            for (int q = 0; q < 4; ++q) rgv[q] = rgp[q]; }
        if (outc) {
#pragma unroll
            for (int i_ = 0; i_ < 2; ++i_) { const int chk = wid * 2 + i_;
                __builtin_amdgcn_global_load_lds((const unsigned*)(Z + (size_t)(r0 + lane) * ODD_N + h * 128 + chk * 8), (LAS unsigned*)(lds + LQD + chk * 1024), 16, 0, 0);
                __builtin_amdgcn_global_load_lds((const unsigned*)(Z + (size_t)(r0 + lane) * ODD_N + 512 + h * 128 + chk * 8), (LAS unsigned*)(lds + LKD + chk * 1024), 16, 0, 0); } }
        if (tid < 128) { const float e = ebg[tid]; eB[tid] = e; aprod *= e; }
        __syncthreads();
        f32x16 o[2];
        if (outc) {
            if (wid < 4) { const int sb = wid & 1, tb = wid >> 1; f32x16 x = f32x16{};
                if (!(sb == 1 && tb == 0)) {
#pragma unroll
                    for (int ks = 0; ks < 8; ++ks) { const bf16x8 a = *(const LAS bf16x8*)(lds + LKD + (2 * ks + hi) * 1024 + (32 * sb + r32) * 16), bq = *(const LAS bf16x8*)(lds + LQD + (2 * ks + hi) * 1024 + (32 * tb + r32) * 16);
                        x = __builtin_amdgcn_mfma_f32_32x32x16_bf16(a, bq, x, 0, 0, 0); }
                    if (sb == tb) {
#pragma unroll
                        for (int r = 0; r < 16; ++r) if (crow(r, hi) > r32) x[r] = 0.f; }
                }
#pragma unroll
                for (int g = 0; g < 4; ++g) { u32x2 w; w.x = cvt_pk_bf16(x[4 * g], x[4 * g + 1]); w.y = cvt_pk_bf16(x[4 * g + 2], x[4 * g + 3]);
                    *(LAS u32x2*)(lds + LP + (32 * tb + r32) * PST + (32 * sb + 8 * g + 4 * hi) * 2) = w; } }
            o[0] = f32x16{}; o[1] = f32x16{};
#pragma unroll
            for (int cb = 0; cb < 4; ++cb)
#pragma unroll
                for (int s2 = 0; s2 < 2; ++s2) { u32x4 sw;
#pragma unroll
                    for (int j = 0; j < 4; ++j) sw[j] = cvt_pk_bf16(S[cb][8 * s2 + 2 * j], S[cb][8 * s2 + 2 * j + 1]);
                    const int kst = 2 * cb + s2;
#pragma unroll
                    for (int tb = 0; tb < 2; ++tb) { const LAS unsigned char* ap = lds + LQD + (2 * kst) * 1024 + (32 * tb + r32) * 16 + 8 * hi;
                        const u32x2 a0 = *(const LAS u32x2*)ap, a1 = *(const LAS u32x2*)(ap + 1024); const u32x4 a = (u32x4){a0.x, a0.y, a1.x, a1.y};
                        o[tb] = __builtin_amdgcn_mfma_f32_32x32x16_bf16(__builtin_bit_cast(bf16x8, a), __builtin_bit_cast(bf16x8, sw), o[tb], 0, 0, 0); } }
            __syncthreads();
        }
        const int nks = metac ? 1 : 4;
        bf16x8 vf[4];
#pragma unroll
        for (int ks = 0; ks < 4; ++ks) { const s16x4 lo = vtr(trb + LV + (wid * 4 + ks) * 1024), h4 = vtr(trb + LV + (wid * 4 + ks) * 1024 + 256); vf[ks] = (bf16x8){lo[0], lo[1], lo[2], lo[3], h4[0], h4[1], h4[2], h4[3]}; }
        if (outc) {
#pragma unroll
            for (int ks = 0; ks < 4; ++ks)
#pragma unroll
                for (int tb = 0; tb < 2; ++tb) { const bf16x8 a = *(const LAS bf16x8*)(lds + LP + (32 * tb + r32) * PST + (16 * ks + 8 * hi) * 2);
                    o[tb] = __builtin_amdgcn_mfma_f32_32x32x16_bf16(a, vf[ks], o[tb], 0, 0, 0); }
#pragma unroll
            for (int tb = 0; tb < 2; ++tb)
#pragma unroll
                for (int r = 0; r < 16; ++r) *(LAS bf16_t*)(lds + LOS + (32 * tb + crow(r, hi)) * OST + (32 * wid + r32) * 2) = (bf16_t)f2bf(o[tb][r]);
        }
#pragma unroll
        for (int cb = 0; cb < 4; ++cb) {
#pragma unroll
            for (int ks = 0; ks < 4; ++ks) if (ks < nks) { const s16x4 lo = vtr(trb + LKW + (cb * 4 + ks) * 1024), h4 = vtr(trb + LKW + (cb * 4 + ks) * 1024 + 256);
                const bf16x8 kf = (bf16x8){lo[0], lo[1], lo[2], lo[3], h4[0], h4[1], h4[2], h4[3]};
                S[cb] = __builtin_amdgcn_mfma_f32_32x32x16_bf16(kf, vf[ks], S[cb], 0, 0, 0); }
#pragma unroll
            for (int g = 0; g < 4; ++g) { const f32x4 e4 = *(const LAS f32x4*)(eB + 32 * cb + 8 * g + 4 * hi); S[cb][4 * g] *= e4.x; S[cb][4 * g + 1] *= e4.y; S[cb][4 * g + 2] *= e4.z; S[cb][4 * g + 3] *= e4.w; } }
        __syncthreads();
        if (outc) {
            const int t = tid >> 3, j8 = tid & 7; const size_t row = (size_t)(r0 + t);
            float ss = 0.f;
#pragma unroll
            for (int q = 0; q < 4; ++q) { const u32x4 a = *(const LAS u32x4*)(lds + LOS + t * OST + j8 * 64 + q * 16);
                const float v0 = bflo(a.x), v1 = bfhi(a.x), v2 = bflo(a.y), v3 = bfhi(a.y), v4 = bflo(a.z), v5 = bfhi(a.z), v6 = bflo(a.w), v7 = bfhi(a.w);
                ss += v0 * v0 + v1 * v1 + v2 * v2 + v3 * v3 + v4 * v4 + v5 * v5 + v6 * v6 + v7 * v7; }
            ss += __shfl_xor(ss, 1); ss += __shfl_xor(ss, 2); ss += __shfl_xor(ss, 4);
            const float rn = __builtin_amdgcn_rsqf(ss * (1.f / 256.f) + RMS_EPS);
            u32x2* dst = (u32x2*)(A28 + row * D + h * 256 + j8 * 32);
#pragma unroll
            for (int q = 0; q < 4; ++q) { const u32x4 a = *(const LAS u32x4*)(lds + LOS + t * OST + j8 * 64 + q * 16);
                const float v[8] = {bflo(a.x), bfhi(a.x), bflo(a.y), bfhi(a.y), bflo(a.z), bfhi(a.z), bflo(a.w), bfhi(a.w)};
                const u32x4 g4 = rgv[q]; const float gv[8] = {bflo(g4.x), bfhi(g4.x), bflo(g4.y), bfhi(g4.y), bflo(g4.z), bfhi(g4.z), bflo(g4.w), bfhi(g4.w)}; float y[8];
#pragma unroll
                for (int e = 0; e < 8; ++e) y[e] = v[e] * (rn * F8_ASCALE) * hnl[j8 * 32 + 8 * q + e] * (gv[e] * __builtin_amdgcn_rcpf(1.f + __builtin_amdgcn_exp2f(gv[e] * -1.44269504f)));
                u32x2 w; w.x = pk4_fp8(y[0], y[1], y[2], y[3]); w.y = pk4_fp8(y[4], y[5], y[6], y[7]); dst[q] = w;
                __builtin_amdgcn_sched_barrier(0); }
        }
    }
    if (!OUT) { float* u = u_slot(P, bh, seg);
#pragma unroll
        for (int cb = 0; cb < 4; ++cb)
#pragma unroll
            for (int r = 0; r < 16; ++r) u[(size_t)(32 * cb + crow(r, hi)) * 256 + 32 * wid + r32] = S[cb][r];
        if (tid < 128) a_slot(P, bh, seg)[tid] = aprod; }
    __syncthreads();
}
}
template <bool OUT> __device__ __forceinline__ void stage_gla_seg(const Ptrs& P, LAS unsigned char* lds, int wg, int nwg) {
    for (int u = wg; u < 256; u += nwg) { if constexpr (OUT) gla::segment_out(P, lds, u >> 4, u & 15); else gla::segment_state(P, lds, u >> 4, u & 15); }
}
__device__ __forceinline__ void stage_gla_scan(const Ptrs& P, int wg, int nwg) {
    const int tid_ = tid_opaque(P);
    for (int idx = wg * 512 + tid_; idx < 16 * 32768; idx += nwg * 512) { const int bh = idx >> 15, e = idx & 32767, cch = e >> 8;
        float uv[15], av[15];
#pragma unroll
        for (int sg = 0; sg < 15; ++sg) { uv[sg] = gla::u_slot(P, bh, sg)[e]; av[sg] = gla::a_slot(P, bh, sg)[cch]; }
        float Sv = 0.f;
#pragma unroll
        for (int sg = 0; sg < 15; ++sg) { Sv = av[sg] * Sv + uv[sg]; gla::u_slot(P, bh, sg)[e] = Sv; } }
}

#define XB_TMO      128
#define XB_XCNT(j)  (256  + 64 * (j))
#define XB_XSUB(j)  (1280 + 64 * (j))
#define XB_XGEN(j)  (2304 + 64 * (j))
#define XB_TOP      3328
#define XB_TOPGEN   3392
#define XCD_BAR_WORDS 3456
#define XB_SPIN_CAP (1u << 18)
__device__ __forceinline__ unsigned xb_ld(unsigned* p)              { return __hip_atomic_load(p, __ATOMIC_RELAXED, __HIP_MEMORY_SCOPE_AGENT); }
__device__ __forceinline__ unsigned xb_add(unsigned* p, unsigned v) { return __hip_atomic_fetch_add(p, v, __ATOMIC_RELAXED, __HIP_MEMORY_SCOPE_AGENT); }
__device__ __forceinline__ unsigned xb_xcc_id() { return (unsigned)__builtin_amdgcn_s_getreg((3 << 11) | 20) & 0xFu; }
#define XB_SPIN(cond, bar) do { unsigned _sp = 0; while (cond) { __builtin_amdgcn_s_sleep(1); \
    if ((++_sp & 255u) == 0u) { if (xb_ld(&(bar)[XB_TMO])) break; if (_sp > XB_SPIN_CAP) { atomicAdd(&(bar)[XB_TMO], 1u); break; } } } } while (0)
struct XcdBarrier { unsigned* bar; unsigned x; volatile LAS unsigned* st; };
__device__ __forceinline__ XcdBarrier xcd_barrier_post(unsigned* bar, volatile LAS unsigned* st, const bool t0) {
    XcdBarrier b; b.bar = bar; b.x = xb_xcc_id(); b.st = st;
    if (t0) (void)xb_add(&bar[XB_XCNT(b.x)], 1u);
    return b;
}
__device__ __forceinline__ void xcd_barrier_complete(unsigned* bar, unsigned x, unsigned& nloc, unsigned& nx) {
    const unsigned G = gridDim.x * gridDim.y * gridDim.z;
    unsigned sum, cnt, mine, sp = 0u;
    for (;;) {
        sum = 0u; cnt = 0u; mine = 0u;
#pragma unroll
        for (unsigned j = 0; j < 16; ++j) { const unsigned c = xb_ld(&bar[XB_XCNT(j)]); sum += c; cnt += (c > 0u) ? 1u : 0u; mine = (j == x) ? c : mine; }
        if (sum == G) break;
        __builtin_amdgcn_s_sleep(1);
        if ((++sp & 255u) == 0u) { if (xb_ld(&bar[XB_TMO])) break; if (sp > XB_SPIN_CAP) { atomicAdd(&bar[XB_TMO], 1u); break; } }
    }
    nloc = mine > 0u ? mine : 1u; nx = cnt > 0u ? cnt : 1u;
}
__device__ __forceinline__ void xcd_barrier(const XcdBarrier& b, const bool t0) {
    asm volatile("s_waitcnt vmcnt(0)" ::: "memory");
    __syncthreads();
    if (t0) {
        unsigned* bar = b.bar;
        __builtin_amdgcn_s_waitcnt(0);
        unsigned nloc = b.st[0], nx = b.st[1];
        if (nloc == 0u) { xcd_barrier_complete(bar, b.x, nloc, nx); b.st[0] = nloc; b.st[1] = nx; }
        const unsigned old = xb_add(&bar[XB_XSUB(b.x)], 1u);
        const unsigned gen = old / nloc;
        if (old + 1u == (gen + 1u) * nloc) {
            __builtin_amdgcn_fence(__ATOMIC_RELEASE, "agent");
            asm volatile("s_waitcnt vmcnt(0)" ::: "memory");
            const unsigned og = xb_add(&bar[XB_TOP], 1u);
            const unsigned tg = og / nx;
            if (og + 1u == (tg + 1u) * nx) xb_add(&bar[XB_TOPGEN], 1u);
            else XB_SPIN(xb_ld(&bar[XB_TOPGEN]) == tg, bar);
            __builtin_amdgcn_fence(__ATOMIC_ACQUIRE, "agent");
            xb_add(&bar[XB_XGEN(b.x)], 1u);
            asm volatile("s_waitcnt vmcnt(0)" ::: "memory");
        } else {
            XB_SPIN(xb_ld(&bar[XB_XGEN(b.x)]) == gen, bar);
            __builtin_amdgcn_fence(__ATOMIC_ACQUIRE, "agent");
            asm volatile("s_waitcnt vmcnt(0)" ::: "memory");
        }
    }
    __syncthreads();
}

constexpr int LDS_BYTES = 147456;
constexpr int LDS_CTL = 131072;
constexpr int CW_BAR = 4096;
enum GemmKind { G_IN0 = 0, G_OUT0, G_GU0, G_DN0, G_IN1, G_OUT1, G_GU1, G_DN1 };
__device__ __forceinline__ void moe_setup(const Ptrs& P, int layer, LAS int* tstart, LAS int* cnt, const int tid) {
    if (tid < 64) { const unsigned* g = (const unsigned*)(P.ws + WS_CTL) + CW_CNT + 64 * layer;
        const int c = tid < 16 ? (int)__hip_atomic_load(g + tid, __ATOMIC_RELAXED, __HIP_MEMORY_SCOPE_AGENT) : 0; const int tiles = (c + 255) >> 8; int incl = tiles;
#pragma unroll
        for (int d = 1; d < 16; d <<= 1) { const int o = __shfl_up(incl, d); if (tid >= d) incl += o; }
        if (tid < 16) { cnt[tid] = c; tstart[tid] = incl - tiles; }
        if (tid == 15) tstart[16] = incl; }
    __syncthreads();
}
template <int KIND> __device__ __forceinline__ void stage_gemm(const Ptrs& P, LAS unsigned char* lds, int wg, int nwg) {
    const int tid = tid_opaque(P);
    LAS unsigned char* ring = lds; LAS int* tstart = (LAS int*)(lds + LDS_CTL + 256); LAS int* cnt = (LAS int*)(lds + LDS_CTL + 384);
    const bf16_t* Hb = (const bf16_t*)(P.ws + WS_HB); bf16_t* Z = (bf16_t*)(P.ws + WS_Z); const unsigned char* A28 = P.ws + WS_A2; const bf16_t* A2m = (const bf16_t*)(P.ws + WS_A2M); bf16_t* T = (bf16_t*)(P.ws + WS_T);
    unsigned char* ACT = P.ws + WS_ACT; unsigned char* YK = P.ws + WS_YK;
    if constexpr (KIND == G_IN0) { meta_gemm<0>(Hb, Hb, (const bf16_t*)(P.ws + W_IN0), EVEN_IN, Z, EVEN_IN, 512, 1024, QSCALE0, wg, nwg, tid, (unsigned*)(P.ws + WS_CTL) + CW_KN + 64);
        DenseSched S; S.init(EVEN_IN / 256, nwg, wg); EpiBf16 E{Z, EVEN_IN, EVEN_IN, 2, 4, QSCALE0, (unsigned*)(P.ws + WS_CTL) + CW_KN, 4};
        pg8::gemm_phase(ring, Hb, P.ws + W_IN0, 2048, 2048, S, E, tid); }
    else if constexpr (KIND == G_OUT0) { meta_gemm<1>(A2m, Hb, (const bf16_t*)(P.ws + W_OUT0), 1024, T, D, 0, 0, 1.f, wg, nwg, tid);
        DenseSched S; S.init(4, nwg, wg, 1024); EpiResBf16 E{Hb, T};
        pg8::gemm_phase<EpiResBf16, DenseSched, true>(ring, A28, P.ws + W_OUT08, 1024, 1024, S, E, tid, F8_ASC, F8_WSC); }
    else if constexpr (KIND == G_IN1) { meta_gemm<0>(Hb, Hb, (const bf16_t*)(P.ws + W_IN1), ODD_N, Z, ODD_N, 0, 512, QSCALE1, wg, nwg, tid);
        DenseSched S; S.init(ODD_N / 256, nwg, wg, 1024); EpiBf16 E{Z, ODD_N, ODD_N, 0, 2, QSCALE1, nullptr, 0};
        pg8::gemm_phase<EpiBf16, DenseSched, true>(ring, P.ws + WS_HB8, P.ws + W_IN18, 1024, 1024, S, E, tid, F8_HSC, F8_WSC); }
    else if constexpr (KIND == G_OUT1) { DenseSched S; S.init(4, nwg, wg, 1024); EpiResBf16 E{Hb, T};
        pg8::gemm_phase<EpiResBf16, DenseSched, true>(ring, A28, P.ws + W_OUT18, 1024, 1024, S, E, tid, F8_ASC, F8_WSC); }
    else if constexpr (KIND == G_GU0 || KIND == G_GU1) { constexpr int layer = KIND == G_GU0 ? 0 : 1; moe_setup(P, layer, tstart, cnt, tid);
        MoeSchedT<true> S{tstart, cnt, (const int*)(P.ws + WS_LIST), (const float*)(P.ws + WS_LISTW), 4, nwg, wg, 1024, (size_t)layer * 16 * 1024 * 1024, (const LAS int*)(lds + LDS_CTL + 1024)}; EpiSiluMul E{ACT};
        pg8::gemm_phase<EpiSiluMul, MoeSchedT<true>, true, true>(ring, P.ws + WS_HB8, P.ws + W_GU, 1024, 1024, S, E, tid, F8_HSC, F8_WSC); }
    else { constexpr int layer = KIND == G_DN0 ? 0 : 1; moe_setup(P, layer, tstart, cnt, tid);
        MoeSchedT<false> S{tstart, cnt, (const int*)(P.ws + WS_LIST), (const float*)(P.ws + WS_LISTW), 4, nwg, wg, 512, (size_t)layer * 16 * 1024 * 512, nullptr}; EpiScatter E{YK, (LAS int*)(lds + LDS_CTL + 1024), (LAS float*)(lds + LDS_CTL + 3072)};
        pg8::gemm_phase<EpiScatter, MoeSchedT<false>, true, true>(ring, ACT, P.ws + W_DN, 512, 512, S, E, tid, F8_ASC, F8_WSC); }
}

constexpr int NPHASE = 19;
struct Args { Ptrs P; int lo, hi, flags, pad; };
__global__ void __launch_bounds__(512, 2) mega(Args a) {
    extern __shared__ __attribute__((aligned(16))) unsigned char lds_[];
    LAS unsigned char* lds = (LAS unsigned char*)lds_;
    const Ptrs& P = a.P;
    const int wg = blockIdx.x, nwg = gridDim.x, lo = a.lo, hi = a.hi;
    for (int u = threadIdx.x; u < (LDS_BYTES - LDS_CTL) / 4; u += 512) ((LAS unsigned*)(lds + LDS_CTL))[u] = 0u;
    __syncthreads();
    if ((threadIdx.x & 63) == 0) ((volatile LAS int*)(lds + LDS_WIDTAB))[hw_wave_key()] = (int)(threadIdx.x >> 6);
    __syncthreads();
    XcdBarrier bar; bar.bar = (unsigned*)(P.ws + WS_CTL) + CW_BAR; bar.x = 0; bar.st = nullptr;
    const bool multi = (hi - lo) > 1;
    if (multi) bar = xcd_barrier_post((unsigned*)(P.ws + WS_CTL) + CW_BAR, (volatile LAS unsigned*)(lds + LDS_CTL) + 8, tid_opaque(P) == 0);
#define IN(k) (lo <= (k) && (k) < hi)
#define SEAM(k) do { if (IN(k) && IN((k) + 1)) xcd_barrier(bar, tid_opaque(P) == 0); } while (0)
#define RUN(k, ...) do { if (IN(k)) { __VA_ARGS__; } SEAM(k); } while (0)
    RUN(0, stage_prep(P, lds, wg, nwg));
    RUN(1, stage_gemm<G_IN0>(P, lds, wg, nwg));
    RUN(2, if (!(a.flags & 2)) stage_pool(P, wg, nwg); stage_attn(P, lds, wg, nwg, a.flags));
    RUN(3, stage_combine(P, wg, nwg));
    RUN(4, stage_gemm<G_OUT0>(P, lds, wg, nwg));
    RUN(5, stage_ln<0>(P, lds, wg, nwg));
    RUN(6, stage_gemm<G_GU0>(P, lds, wg, nwg));
    RUN(7, stage_gemm<G_DN0>(P, lds, wg, nwg));
    RUN(8, stage_ln<2>(P, lds, wg, nwg));
    RUN(9, stage_gemm<G_IN1>(P, lds, wg, nwg));
    RUN(10, gla::stage_pre(P, lds, wg, nwg));
    RUN(11, stage_gla_seg<false>(P, lds, wg, nwg));
    RUN(12, stage_gla_scan(P, wg, nwg));
    RUN(13, stage_gla_seg<true>(P, lds, wg, nwg));
    RUN(14, stage_gemm<G_OUT1>(P, lds, wg, nwg));
    RUN(15, stage_ln<1>(P, lds, wg, nwg));
    RUN(16, stage_gemm<G_GU1>(P, lds, wg, nwg));
    RUN(17, stage_gemm<G_DN1>(P, lds, wg, nwg));
    RUN(18, stage_ln<3>(P, lds, wg, nwg));
#undef RUN
#undef IN
#undef SEAM
}

#ifndef MK_MULTI
#define MK_MULTI 0
#endif
extern "C" void kernel_launch(void* const* d_in, const int* in_sizes, int n_in, void* d_out, int out_size, void* d_ws, size_t ws_size, hipStream_t stream) {
    static int grid = 0;
    if (grid == 0) {
        if (n_in != 25 || ws_size < WS_END || out_size != NB * SEQ * D) { fprintf(stderr, "kernel_launch: bad args n_in %d ws %zu (need %zu) out %d\n", n_in, ws_size, (size_t)WS_END, out_size); grid = -1; return; }
        int dev = 0, cus = 0, per_cu = 0;
        if (hipGetDevice(&dev) != hipSuccess || hipDeviceGetAttribute(&cus, hipDeviceAttributeMultiprocessorCount, dev) != hipSuccess) { grid = -1; return; }
        if (hipFuncSetAttribute((const void*)mega, hipFuncAttributeMaxDynamicSharedMemorySize, LDS_BYTES) != hipSuccess) { fprintf(stderr, "kernel_launch: hipFuncSetAttribute failed\n"); grid = -1; return; }
        if (hipOccupancyMaxActiveBlocksPerMultiprocessor(&per_cu, (const void*)mega, 512, LDS_BYTES) != hipSuccess || per_cu < 1) { fprintf(stderr, "kernel_launch: occupancy query says %d blocks/CU\n", per_cu); (void)hipGetLastError(); grid = -1; return; }
        grid = cus;
    }
    if (grid < 0) return;
    (void)hipMemsetAsync((char*)d_ws + WS_CTL, 0, CTL_BYTES, stream);
    Args a{};
    const float** pp = (const float**)&a.P;
    for (int i = 0; i < 25; ++i) pp[i] = (const float*)d_in[i];
    a.P.out = (float*)d_out; a.P.ws = (unsigned char*)d_ws;
#if MK_MULTI
    for (int k = 0; k < NPHASE; ++k) { a.lo = k; a.hi = k + 1; for (int r = 0; r < 1 + (int)((PROBE_DUP >> k) & 1u); ++r) { a.flags = r ? PROBE_FLAGS : 0; hipLaunchKernelGGL(mega, dim3(grid), dim3(512), LDS_BYTES, stream, a); } }
#else
    a.lo = 0; a.hi = NPHASE; hipLaunchKernelGGL(mega, dim3(grid), dim3(512), LDS_BYTES, stream, a);
#endif
}
```

```cpp
#include <hip/hip_runtime.h>
#include <cstdio>
#include <cstdint>

#ifndef PROBE_FLAGS
#define PROBE_FLAGS 0
#endif
#ifndef PROBE_DUP
#define PROBE_DUP 0u
#endif
#define GAS __attribute__((address_space(1)))
#define LAS __attribute__((address_space(3)))
typedef unsigned short bf16_t;
typedef short bf16x8 __attribute__((ext_vector_type(8)));
typedef float f32x4 __attribute__((ext_vector_type(4)));
typedef float f32x2 __attribute__((ext_vector_type(2)));
typedef float f32x16 __attribute__((ext_vector_type(16)));
typedef unsigned u32x4 __attribute__((ext_vector_type(4)));
typedef unsigned u32x2 __attribute__((ext_vector_type(2)));

constexpr int D = 1024, NB = 4, SEQ = 8192, NMETA = 16;
constexpr int LB = SEQ + NMETA;
constexpr int M1 = NB * LB;
constexpr int NPANEL = NB * SEQ / 256;
constexpr int EVEN_IN = 2048, ODD_IN = 3088, ODD_N = 3072;
#define Z1AT(row, col) (((size_t)((col) >> 8) * M1 + (size_t)(row)) * 256 + (size_t)((col) & 255))
constexpr int NEXP = 16, DEXP = 512;
constexpr float ALPHA = 1.41421356237f;
constexpr float LN_EPS = 1e-5f, RMS_EPS = 1e-6f;
constexpr float LOG2E = 1.4426950408889634f;
constexpr float QSCALE0 = 0.125f * LOG2E;
constexpr float QSCALE1 = 0.08838834764831845f;
constexpr float LAMBDA_INIT = 0.2f;

constexpr size_t MiB = 1u << 20;
constexpr size_t WS_CTL = 0;
constexpr size_t CTL_BYTES = 1 * MiB;
constexpr size_t CTL_ZERO = 32768;
constexpr size_t WS_MISC = 1 * MiB;
constexpr size_t WS_RW = 2 * MiB;
constexpr size_t WS_LIST = 3 * MiB;
constexpr size_t WS_GLR = 5 * MiB + 262144;
constexpr size_t WS_W = 8 * MiB;
constexpr size_t W_IN0 = WS_W;
constexpr size_t W_OUT0 = W_IN0 + (size_t)2048 * 1024 * 2;
constexpr size_t W_IN1 = W_OUT0 + (size_t)1024 * 1024 * 2;
constexpr size_t W_IN18 = W_IN1 + (size_t)ODD_N * 1024 * 2;
constexpr size_t W_OUT1 = W_IN18 + (size_t)ODD_N * 1024;
constexpr size_t W_IN08 = W_OUT1;
constexpr size_t W_OUT08 = W_OUT1 + (size_t)1024 * 1024 * 2;
constexpr size_t W_OUT18 = W_OUT08 + (size_t)1024 * 1024;
constexpr size_t W_GU = W_OUT18 + (size_t)1024 * 1024;
constexpr size_t W_DN = W_GU + (size_t)2 * 16 * 1024 * 1024;
constexpr size_t W_END = W_DN + (size_t)2 * 16 * 1024 * 512;
constexpr size_t WS_HB = 76 * MiB;
constexpr size_t WS_HB8 = WS_HB + (size_t)M1 * 1024 * 2;
constexpr size_t WS_Z = WS_HB8 + (size_t)M1 * 1024 + 524288;
constexpr size_t WS_T = WS_Z;
constexpr size_t WS_YK = WS_Z;
constexpr size_t WS_OA = WS_Z + (size_t)M1 * ODD_N * 2;
constexpr size_t WS_A2 = WS_OA + (size_t)M1 * 1024 * 2;
constexpr size_t WS_A2M = WS_MISC + 65536;
constexpr size_t WS_ACT = WS_OA;
constexpr size_t WS_LISTW = WS_A2 + (size_t)M1 * 1024;
constexpr size_t WS_END = WS_LISTW + (size_t)16 * M1 * 4;
static_assert(W_END <= WS_HB, "weights fit");
static_assert(WS_END <= (size_t)512 * MiB, "workspace fits 512 MiB");
static_assert(WS_LIST + (size_t)16 * M1 * 4 <= WS_GLR && WS_GLR + (size_t)M1 * 64 <= WS_W, "small buffers");
constexpr float F8_YSCALE = 32.f;
constexpr float F8_WSCALE = 32.f, F8_HSCALE = 4.f, F8_ASCALE = 4.f;
constexpr int F8_WSC = 0x7a7a7a7a, F8_HSC = 0x7d7d7d7d, F8_ASC = 0x7d7d7d7d;
constexpr int CW_CNT = 64;
constexpr int LISTCAP = M1;
constexpr int CW_KN = 256;
constexpr int CW_AQ = 512;

__device__ __forceinline__ float bf2f(unsigned short b) { return __builtin_bit_cast(float, (unsigned)b << 16); }
__device__ __forceinline__ float bflo(unsigned w) { return __builtin_bit_cast(float, w << 16); }
__device__ __forceinline__ float bfhi(unsigned w) { return __builtin_bit_cast(float, w & 0xffff0000u); }
typedef __bf16 bf16x2_t __attribute__((ext_vector_type(2)));
__device__ __forceinline__ unsigned cvt_pk_bf16(float lo, float hi) { const f32x2 v = {lo, hi}; const bf16x2_t b = __builtin_convertvector(v, bf16x2_t); return __builtin_bit_cast(unsigned, b); }
__device__ __forceinline__ unsigned pk2(float lo, float hi) { return cvt_pk_bf16(lo, hi); }
__device__ __forceinline__ unsigned f2bf(float f) { return cvt_pk_bf16(f, 0.f) & 0xffffu; }
__device__ __forceinline__ unsigned pk4_fp8(float a, float b, float c, float d) {
    a = fminf(fmaxf(a, -448.f), 448.f); b = fminf(fmaxf(b, -448.f), 448.f); c = fminf(fmaxf(c, -448.f), 448.f); d = fminf(fmaxf(d, -448.f), 448.f);
    int w = 0; w = __builtin_amdgcn_cvt_pk_fp8_f32(a, b, w, false); w = __builtin_amdgcn_cvt_pk_fp8_f32(c, d, w, true); return (unsigned)w; }
__device__ __forceinline__ void fp8x4_to_f32(unsigned w, float (&o)[4]) { const f32x2 a = __builtin_amdgcn_cvt_pk_f32_fp8((int)w, false), b = __builtin_amdgcn_cvt_pk_f32_fp8((int)w, true); o[0] = a.x; o[1] = a.y; o[2] = b.x; o[3] = b.y; }
__device__ __forceinline__ void lds_dma16(const void* gsrc, unsigned lds_dst) { unsigned keep;
    asm volatile("s_mov_b32 %0, m0\n\ts_mov_b32 m0, %2\n\ts_nop 0\n\tglobal_load_lds_dwordx4 %1, off\n\ts_mov_b32 m0, %0" : "=&s"(keep) : "v"(gsrc), "s"(lds_dst) : "memory"); }
__device__ __forceinline__ void wave_sum4(float (&v)[4]) {
    const auto r02 = __builtin_amdgcn_permlane32_swap(__float_as_uint(v[0]), __float_as_uint(v[2]), false, false); const unsigned x0 = r02[0], x1 = r02[1];
    const auto r13 = __builtin_amdgcn_permlane32_swap(__float_as_uint(v[1]), __float_as_uint(v[3]), false, false); const unsigned y0 = r13[0], y1 = r13[1];
    const float a0 = __uint_as_float(x0) + __uint_as_float(x1), a1 = __uint_as_float(y0) + __uint_as_float(y1);
    const auto rb = __builtin_amdgcn_permlane16_swap(__float_as_uint(a0), __float_as_uint(a1), false, false); const unsigned z0 = rb[0], z1 = rb[1];
    float b = __uint_as_float(z0) + __uint_as_float(z1);
#define WS4_DPP(x_, c_) __builtin_bit_cast(float, __builtin_amdgcn_update_dpp(0, __builtin_bit_cast(int, (x_)), (c_), 0xf, 0xf, false))
    b += WS4_DPP(b, 0x128); b += WS4_DPP(b, 0x141); b += WS4_DPP(b, 0x1b); b += WS4_DPP(b, 0xb1);
#undef WS4_DPP
    const int bi = __builtin_bit_cast(int, b);
    v[0] = __builtin_bit_cast(float, __builtin_amdgcn_readlane(bi, 0)); v[1] = __builtin_bit_cast(float, __builtin_amdgcn_readlane(bi, 16));
    v[2] = __builtin_bit_cast(float, __builtin_amdgcn_readlane(bi, 32)); v[3] = __builtin_bit_cast(float, __builtin_amdgcn_readlane(bi, 48));
}
__device__ __forceinline__ float wave_sum(float v) {
#pragma unroll
    for (int o = 1; o < 64; o <<= 1) v += __shfl_xor(v, o);
    return v;
}
__device__ __forceinline__ float wave_max(float v) {
#pragma unroll
    for (int o = 1; o < 64; o <<= 1) v = fmaxf(v, __shfl_xor(v, o));
    return v;
}
struct Ptrs {
    const float *x, *meta, *even_w_in, *pool_w, *pool_scale, *lq1, *lk1, *lq2, *lk2, *subln, *even_w_out, *odd_w_in, *gate_w2, *gate_b, *head_norm, *odd_w_out,
        *ln_mix_g, *ln_mix_b, *ln_ffn_g, *ln_ffn_b, *router_w, *router_bias, *moe_w_gate, *moe_w_up, *moe_w_down;
    float* out; unsigned char* ws;
};
constexpr int LDS_WIDTAB = 131072 + 512;
extern __shared__ __attribute__((aligned(16))) unsigned char lds_dyn_alias_[];
__device__ __forceinline__ unsigned hw_wave_key() { return (unsigned)__builtin_amdgcn_s_getreg((5 << 11) | 4) & 0x3fu; }
__device__ __forceinline__ int tid_opaque(const Ptrs&) {
    unsigned z = 0u; asm volatile("" : "+v"(z));
    const int lane = (int)__builtin_amdgcn_mbcnt_hi(~0u, __builtin_amdgcn_mbcnt_lo(~0u, z));
    const int wid = __builtin_amdgcn_readfirstlane(((const volatile LAS int*)((LAS unsigned char*)lds_dyn_alias_ + LDS_WIDTAB))[hw_wave_key()]);
    return wid * 64 + lane;
}
__device__ __forceinline__ int panel_row0(int pm) { return (pm >> 5) * LB + NMETA + (pm & 31) * 256; }
__device__ __forceinline__ const float* h0_ptr(const Ptrs& P, int row) { const int b = row / LB, p = row - b * LB; return p < NMETA ? P.meta + (size_t)p * D : P.x + ((size_t)b * SEQ + (p - NMETA)) * D; }

namespace pg8 {
constexpr int BM = 256, BK = 64, HALF = 128, HTB = HALF * BK * 2, STAGE_BYTES = 8 * HTB, NXCD = 8, WGM = 8;
__host__ __device__ __forceinline__ int lds_byte(int r, int c) { const int st = (r >> 4) * 2 + (c >> 5), rr = r & 15, cc = c & 31, ob = rr * 64 + cc * 2; return st * 1024 + (ob ^ (((ob >> 9) & 1) << 5)); }
__host__ __device__ __forceinline__ void stage_rc(int b, int& R, int& C) { const int st = b / 1024, sb = b % 1024, swz = sb ^ (((sb >> 9) & 1) << 5); R = (st >> 1) * 16 + swz / 64; C = (st & 1) * 32 + (swz % 64) / 2; }
__host__ __device__ __forceinline__ int perm32(int rho) { const int n = rho >> 4, i = rho & 15; return 8 * (i >> 2) + 4 * n + (i & 3); }
struct Unit { int pm, pn, e, lt, hn, par; };

__device__ __forceinline__ void static_tile(int L, int nM, int nN, int& pm, int& pn) {
    const int nwg = nM * nN; int wgid = L;
    { const int q = nwg / NXCD, r = nwg % NXCD, xcd = wgid % NXCD, off = wgid / NXCD; wgid = (xcd < r ? xcd * (q + 1) : r * (q + 1) + (xcd - r) * q) + off; }
    const int nig = WGM * nN, gid = wgid / nig, fm = gid * WGM, gsz = (nM - fm) < WGM ? (nM - fm) : WGM;
    pm = fm + ((wgid % nig) % gsz); pn = (wgid % nig) / gsz;
}

typedef int v8i32 __attribute__((ext_vector_type(8)));
template <class Epi, class Sched, bool F8 = false, bool HN = false>
__device__ __forceinline__ void gemm_phase(LAS unsigned char* lds, const void* Abase, const void* Bbase, const int KA, const int KB_, const Sched& S, const Epi& E, const int tid, const int sclA = 0x7f7f7f7f, const int sclB = 0x7f7f7f7f) {
    const int wid = __builtin_amdgcn_readfirstlane(tid >> 6), lane = tid & 63, wr = wid >> 2, wc = wid & 3, fr = lane & 15, fq = lane >> 4;
    const int nt = KA / 128;
    unsigned voffB[2];
#pragma unroll
    for (int i = 0; i < 2; ++i) { int R, C; stage_rc(tid * 16 + i * 8192, R, C); const int Rb = Epi::PERM ? ((R & ~31) + perm32(R & 31)) : R;
        voffB[i] = (unsigned)(Rb * KB_ + C * 2); }
    const size_t kstep = (size_t)(BK * 2);
    const size_t hstep = (size_t)HALF * KB_;
    const unsigned ldsw = (unsigned)wid * 1024u;
    const int aoff = lds_byte(wr * 64 + fr, fq * 8), boff = lds_byte(wc * 32 + fr, fq * 8);
#define PG8_SA(b, h) (((b) * 2 + (h)) * HTB)
#define PG8_SB(b, h) ((4 + (b) * 2 + (h)) * HTB)
#define PG8_STAGEB(bufoff, gbase) do { _Pragma("unroll") for (int _i = 0; _i < 2; ++_i) \
        __builtin_amdgcn_global_load_lds((const unsigned*)((const char*)(gbase) + voffB[_i]), (LAS unsigned*)(lds + (bufoff) + ldsw + _i * 8192), 16, 0, 0); } while (0)
#define PG8_STAGEA(bufoff, kbyte, off2) do { _Pragma("unroll") for (int _i = 0; _i < 2; ++_i) \
        __builtin_amdgcn_global_load_lds((const unsigned*)((const char*)Abase + (kbyte) + (off2)[_i]), (LAS unsigned*)(lds + (bufoff) + ldsw + _i * 8192), 16, 0, 0); } while (0)
#define PG8_STAGEA2(bufoff, kbyte, h) do { _Pragma("unroll") for (int _i = 0; _i < 2; ++_i) \
        __builtin_amdgcn_global_load_lds((const unsigned*)((const char*)Abase + (kbyte) + (last ? nxtA[h][_i] : curA[h][_i])), (LAS unsigned*)(lds + (bufoff) + ldsw + _i * 8192), 16, 0, 0); } while (0)
#define PG8_CAT(x0, x1) __builtin_shufflevector(x0, x1, 0, 1, 2, 3, 4, 5, 6, 7)
#define PG8_LDA(dst, b, h) do { _Pragma("unroll") for (int m = 0; m < 4; ++m) { \
        if constexpr (F8) dst##8[m] = __builtin_bit_cast(v8i32, PG8_CAT(*(const LAS u32x4*)(lds + PG8_SA(b, h) + aoff + m * 2048), *(const LAS u32x4*)(lds + PG8_SA(b, h) + aoff + m * 2048 + 1024))); \
        else { _Pragma("unroll") for (int k = 0; k < 2; ++k) dst[m][k] = *(const LAS bf16x8*)(lds + PG8_SA(b, h) + aoff + m * 2048 + k * 1024); } } } while (0)
#define PG8_LDB(dst, b, h) do { _Pragma("unroll") for (int n = 0; n < 2; ++n) { \
        if constexpr (F8) dst##8[n] = __builtin_bit_cast(v8i32, PG8_CAT(*(const LAS u32x4*)(lds + PG8_SB(b, h) + boff + n * 2048), *(const LAS u32x4*)(lds + PG8_SB(b, h) + boff + n * 2048 + 1024))); \
        else { _Pragma("unroll") for (int k = 0; k < 2; ++k) dst[n][k] = *(const LAS bf16x8*)(lds + PG8_SB(b, h) + boff + n * 2048 + k * 1024); } } } while (0)
#define PG8_MMA(ai, bj, At, Bt) do { __builtin_amdgcn_s_setprio(1); _Pragma("unroll") for (int m = 0; m < 4; ++m) _Pragma("unroll") for (int n = 0; n < 2; ++n) { \
        if constexpr (F8) asm volatile("v_mfma_scale_f32_16x16x128_f8f6f4 %0, %1, %2, %0, %3, %4 op_sel_hi:[0,0,0]" : "+v"(acc[ai][bj][m][n]) : "v"(Bt##8[n]), "v"(At##8[m]), "v"(sclB), "v"(sclA));     \
        else { _Pragma("unroll") for (int k = 0; k < 2; ++k) acc[ai][bj][m][n] = __builtin_amdgcn_mfma_f32_16x16x32_bf16(Bt[n][k], At[m][k], acc[ai][bj][m][n], 0, 0, 0); } } __builtin_amdgcn_s_setprio(0); } while (0)
#define PG8_WAIT_V(n) asm volatile("s_waitcnt vmcnt(" #n ")" ::: "memory")
#define PG8_WAIT_L(n) asm volatile("s_waitcnt lgkmcnt(" #n ")" ::: "memory")
#define PG8_BAR __builtin_amdgcn_s_barrier()
#define PG8_SCHED __builtin_amdgcn_sched_barrier(0)
#define PG8_AOFFS(dst, u) do { int tl_ = tid; asm volatile("" : "+v"(tl_));     \
        _Pragma("unroll") for (int _i = 0; _i < 2; ++_i) { int R_, C_; stage_rc(tl_ * 16 + _i * 8192, R_, C_); \
            _Pragma("unroll") for (int _h = 0; _h < 2; ++_h) dst[_h][_i] = (unsigned)S.arow(u, 128 * _h + R_) * (unsigned)KA + (unsigned)C_ * 2u; } } while (0)
    Unit cur, nxt; int ui = 0;
    if (!S.next(0, cur)) return;
    cur.par = 0;
    f32x4 acc[2][2][4][2];
#pragma unroll
    for (int a = 0; a < 2; ++a)
#pragma unroll
        for (int b = 0; b < 2; ++b)
#pragma unroll
            for (int m = 0; m < 4; ++m)
#pragma unroll
                for (int n = 0; n < 2; ++n) acc[a][b][m][n] = (f32x4){0.f, 0.f, 0.f, 0.f};
    bf16x8 At[4][2], B0[2][2], B1[2][2];
    v8i32 At8[4], B08[2], B18[2];
    unsigned curA[2][2], nxtA[2][2];
    if constexpr (Sched::LDSLIST) { if (wid == 0) S.dma_list(cur, (unsigned)__builtin_amdgcn_readfirstlane((int)(unsigned)(size_t)S.ltile), lane);
        asm volatile("s_waitcnt vmcnt(0)" ::: "memory"); PG8_BAR; }
    PG8_AOFFS(curA, cur);
    const char* cB = (const char*)Bbase + S.boff(cur);
    PG8_STAGEB(PG8_SB(0, 0), cB); PG8_STAGEB(PG8_SB(0, 1), cB + hstep); PG8_STAGEA(PG8_SA(0, 0), 0, curA[0]); PG8_STAGEA(PG8_SA(0, 1), 0, curA[1]);
    if (wr == 1) PG8_BAR;
    PG8_WAIT_V(2); PG8_BAR;
    PG8_STAGEB(PG8_SB(1, 0), cB + kstep); PG8_STAGEA(PG8_SA(1, 0), kstep, curA[0]); PG8_STAGEB(PG8_SB(1, 1), cB + hstep + kstep);
    PG8_WAIT_V(6); PG8_BAR;
    for (;;) {
        if constexpr (Epi::META) E.prefetch(cur, S, tid);
        const bool has_next = S.next(ui + 1, nxt); nxt.par = (ui + 1) & 1;
        const char* nB = cB;
        if (has_next) { nB = (const char*)Bbase + S.boff(nxt);
            if constexpr (Sched::LDSLIST) { if (wid == 0) S.dma_list(nxt, (unsigned)__builtin_amdgcn_readfirstlane((int)(unsigned)(size_t)S.ltile), lane); }
            else PG8_AOFFS(nxtA, nxt); }
        else {
#pragma unroll
            for (int h = 0; h < 2; ++h)
#pragma unroll
                for (int i = 0; i < 2; ++i) nxtA[h][i] = curA[h][i];
        }
#pragma unroll 1
        for (int t = 0; t < nt; t += 2) {
            const bool last = (t == nt - 2);
            if constexpr (Sched::LDSLIST) { if (last && has_next) PG8_AOFFS(nxtA, nxt); }
            const size_t k1 = (size_t)(t + 1) * kstep, k2 = last ? 0 : (size_t)(t + 2) * kstep, k3 = k2 + kstep;
            const char* b2 = last ? nB : cB + (size_t)(t + 2) * kstep; const char* b3 = b2 + kstep;
            PG8_LDB(B0, 0, 0); if (!HN || !cur.hn) PG8_LDB(B1, 0, 1); PG8_SCHED; PG8_LDA(At, 0, 0); PG8_STAGEA(PG8_SA(1, 1), k1, curA[1]);
            PG8_WAIT_V(8); PG8_WAIT_L(0); PG8_BAR; PG8_MMA(0, 0, At, B0); if (!HN || !cur.hn) PG8_MMA(0, 1, At, B1); PG8_BAR; PG8_SCHED;
            PG8_LDA(At, 0, 1); PG8_STAGEB(PG8_SB(0, 0), b2); PG8_STAGEB(PG8_SB(0, 1), b2 + hstep); PG8_STAGEA2(PG8_SA(0, 0), k2, 0);
            PG8_WAIT_V(8); PG8_WAIT_L(0); PG8_BAR; PG8_MMA(1, 0, At, B0); if (!HN || !cur.hn) PG8_MMA(1, 1, At, B1); PG8_BAR; PG8_SCHED;
            PG8_LDB(B0, 1, 0); if (!HN || !cur.hn) PG8_LDB(B1, 1, 1); PG8_SCHED; PG8_LDA(At, 1, 0); PG8_STAGEA2(PG8_SA(0, 1), k2, 1);
            PG8_WAIT_V(8); PG8_WAIT_L(0); PG8_BAR; PG8_MMA(0, 0, At, B0); if (!HN || !cur.hn) PG8_MMA(0, 1, At, B1); PG8_BAR; PG8_SCHED;
            PG8_LDA(At, 1, 1); PG8_STAGEB(PG8_SB(1, 0), b3); PG8_STAGEB(PG8_SB(1, 1), b3 + hstep); PG8_STAGEA2(PG8_SA(1, 0), k3, 0);
            PG8_WAIT_V(8); PG8_WAIT_L(0); PG8_BAR; PG8_MMA(1, 0, At, B0); if (!HN || !cur.hn) PG8_MMA(1, 1, At, B1); PG8_BAR; PG8_SCHED;
        }
        if (wr == 0) PG8_BAR;
        if constexpr (F8) asm volatile("s_nop 15\n\ts_nop 15" ::: "memory");
        E(acc, cur, wr, wc, fr, fq, S);
        if (!has_next) break;
#pragma unroll
        for (int a = 0; a < 2; ++a)
#pragma unroll
            for (int b = 0; b < 2; ++b)
#pragma unroll
                for (int m = 0; m < 4; ++m)
#pragma unroll
                    for (int n = 0; n < 2; ++n) acc[a][b][m][n] = (f32x4){0.f, 0.f, 0.f, 0.f};
        cur = nxt; cB = nB; ++ui;
#pragma unroll
        for (int h = 0; h < 2; ++h)
#pragma unroll
            for (int i = 0; i < 2; ++i) curA[h][i] = nxtA[h][i];
        if (wr == 1) PG8_BAR;
    }
    PG8_WAIT_V(0);
    PG8_BAR;
#undef PG8_SA
#undef PG8_SB
#undef PG8_STAGEA
#undef PG8_STAGEA2
#undef PG8_STAGEB
#undef PG8_LDA
#undef PG8_LDB
#undef PG8_MMA
#undef PG8_CAT
#undef PG8_WAIT_V
#undef PG8_WAIT_L
#undef PG8_BAR
#undef PG8_SCHED
#undef PG8_AOFFS
}
}
using pg8::Unit;

struct DenseSched {
    static constexpr bool LDSLIST = false;
    int nN, nTot, G, c, kb;
    __device__ void init(int nN_, int G_, int c_, int kb_ = 2048) { nN = nN_; nTot = NPANEL * nN_; G = G_; c = c_; kb = kb_; }
    __device__ __forceinline__ bool next(int i, Unit& u) const {
        const int L = i * G + c; if (L >= nTot) return false;
        pg8::static_tile(L, NPANEL, nN, u.pm, u.pn); u.e = 0; u.lt = 0; u.hn = 0; return true;
    }
    __device__ __forceinline__ int arow(const Unit& u, int r) const { return panel_row0(u.pm) + r; }
    __device__ __forceinline__ int orow(const Unit& u, int r) const { return panel_row0(u.pm) + r; }
    __device__ __forceinline__ size_t boff(const Unit& u) const { return (size_t)u.pn * 256 * kb; }
};
template <bool GATHER> struct MoeSchedT {
    static constexpr bool LDSLIST = GATHER;
    const LAS int* tstart;
    const LAS int* cnt;
    const int* list;
    const float* listw;
    int nN, G, c, K; size_t wbase;
    const LAS int* ltile;
    __device__ __forceinline__ bool next(int i, Unit& u) const {
        const int cx = (G & 7) ? c : (c & 7) * (G >> 3) + (c >> 3);
        const int L = i * G + cx, ntot = tstart[16] * nN;
        const int R0 = (ntot / G) * G, left = ntot - R0; const bool split = left > 0 && 2 * left <= G;
        int Lu = L, hn = 0, hsel = 0;
        if (split && L >= R0) { const int j = L - R0; if (j >= 2 * left) return false; Lu = R0 + (j >> 1); hn = 1; hsel = j & 1; }
        else if (L >= ntot) return false;
        const int tl = Lu / nN; u.pn = 2 * (Lu - tl * nN) + hsel; u.hn = hn; u.pm = tl; int e = 0;
#pragma unroll
        for (int j = 1; j < 16; ++j) e += (tl >= tstart[j]) ? 1 : 0;
        u.e = e; u.lt = tl - tstart[e]; return true;
    }
    __device__ __forceinline__ void dma_list(const Unit& u, unsigned lds_dst, int lane) const { lds_dma16((const char*)(list + (size_t)u.e * LISTCAP + (size_t)u.lt * 256) + lane * 16, lds_dst); }
    __device__ __forceinline__ void dma_listw(const Unit& u, unsigned lds_dst, int lane) const { lds_dma16((const char*)(listw + (size_t)u.e * LISTCAP + (size_t)u.lt * 256) + lane * 16, lds_dst); }
    __device__ __forceinline__ bool valid(const Unit& u, int r) const { return u.lt * 256 + r < cnt[u.e]; }
    __device__ __forceinline__ int arow(const Unit& u, int r) const {
        if (!GATHER) return u.pm * 256 + r;
        return ltile[valid(u, r) ? r : 0] >> 1; }
    __device__ __forceinline__ size_t boff(const Unit& u) const { return wbase + ((size_t)u.e * 1024 + (size_t)u.pn * 128) * K; }
};

struct EpiBf16 {
    static constexpr bool PERM = true, META = false;
    bf16_t* O; int ldc, ncols; int sc_lo, sc_hi; float sc; unsigned* kn; int kn_lo; int tmaj = 0;
    template <class Sched> __device__ __forceinline__ void operator()(const f32x4 (&acc)[2][2][4][2], const Unit& u, int wr, int wc, int fr, int fq, const Sched& S) const {
        const float s = (u.pn >= sc_lo && u.pn < sc_hi) ? sc : 1.f;
        if (kn && (u.pn == kn_lo || u.pn == kn_lo + 1)) {
#pragma unroll
            for (int bj = 0; bj < 2; ++bj) { float mxs = 0.f;
#pragma unroll
                for (int ai = 0; ai < 2; ++ai)
#pragma unroll
                    for (int m = 0; m < 4; ++m) { const f32x4 v0 = acc[ai][bj][m][0], v1 = acc[ai][bj][m][1];
                        float ss = v0[0] * v0[0] + v0[1] * v0[1] + v0[2] * v0[2] + v0[3] * v0[3] + v1[0] * v1[0] + v1[1] * v1[1] + v1[2] * v1[2] + v1[3] * v1[3];
                        ss += __shfl_xor(ss, 16); ss += __shfl_xor(ss, 32); mxs = fmaxf(mxs, ss); }
                mxs = fmaxf(mxs, __shfl_xor(mxs, 1)); mxs = fmaxf(mxs, __shfl_xor(mxs, 2)); mxs = fmaxf(mxs, __shfl_xor(mxs, 4)); mxs = fmaxf(mxs, __shfl_xor(mxs, 8));
                if (fr == 0 && fq == 0) atomicMax(kn + ((u.pm >> 5) * 8 + (u.pn - kn_lo) * 4 + bj * 2 + (wc >> 1)) * 2 + (wc & 1), __float_as_uint(mxs)); } }
        if (tmaj && (u.pn + 1) * 256 <= ncols) {
            bf16_t* Ot = O + Z1AT(0, u.pn * 256);
            const unsigned c0 = (unsigned)(wc * 32 + 8 * fq);
            if (s == 1.f) {
#pragma unroll
                for (int ai = 0; ai < 2; ++ai)
#pragma unroll
                    for (int m = 0; m < 4; ++m) { const unsigned ro = (unsigned)S.orow(u, ai * 128 + wr * 64 + m * 16 + fr) * 256u + c0;
#pragma unroll
                        for (int bj = 0; bj < 2; ++bj) { const f32x4 v0 = acc[ai][bj][m][0], v1 = acc[ai][bj][m][1];
                            u32x4 w; w.x = cvt_pk_bf16(v0[0], v0[1]); w.y = cvt_pk_bf16(v0[2], v0[3]); w.z = cvt_pk_bf16(v1[0], v1[1]); w.w = cvt_pk_bf16(v1[2], v1[3]);
                            *(u32x4*)(Ot + (ro + (unsigned)bj * 128u)) = w; } } }
            else {
#pragma unroll
                for (int ai = 0; ai < 2; ++ai)
#pragma unroll
                    for (int m = 0; m < 4; ++m) { const unsigned ro = (unsigned)S.orow(u, ai * 128 + wr * 64 + m * 16 + fr) * 256u + c0;
#pragma unroll
                        for (int bj = 0; bj < 2; ++bj) { const f32x4 v0 = acc[ai][bj][m][0] * s, v1 = acc[ai][bj][m][1] * s;
                            u32x4 w; w.x = cvt_pk_bf16(v0[0], v0[1]); w.y = cvt_pk_bf16(v0[2], v0[3]); w.z = cvt_pk_bf16(v1[0], v1[1]); w.w = cvt_pk_bf16(v1[2], v1[3]);
                            *(u32x4*)(Ot + (ro + (unsigned)bj * 128u)) = w; } } }
            return; }
#pragma unroll
        for (int ai = 0; ai < 2; ++ai)
#pragma unroll
            for (int m = 0; m < 4; ++m) { const int orow = S.orow(u, ai * 128 + wr * 64 + m * 16 + fr);
#pragma unroll
                for (int bj = 0; bj < 2; ++bj) { const int col = u.pn * 256 + bj * 128 + wc * 32 + 8 * fq;
                    const f32x4 v0 = acc[ai][bj][m][0] * s, v1 = acc[ai][bj][m][1] * s;
                    u32x4 w; w.x = cvt_pk_bf16(v0[0], v0[1]); w.y = cvt_pk_bf16(v0[2], v0[3]); w.z = cvt_pk_bf16(v1[0], v1[1]); w.w = cvt_pk_bf16(v1[2], v1[3]);
                    if (orow >= 0 && col < ncols) *(u32x4*)(O + (tmaj ? Z1AT(orow, col) : (size_t)orow * ldc + col)) = w; } }
    }
};
struct EpiResBf16 {
    static constexpr bool PERM = true, META = false;
    const bf16_t* Hb; bf16_t* T;
    template <class Sched> __device__ __forceinline__ void operator()(const f32x4 (&acc)[2][2][4][2], const Unit& u, int wr, int wc, int fr, int fq, const Sched& S) const {
        u32x4 h[2][4][2];
#pragma unroll
        for (int ai = 0; ai < 2; ++ai)
#pragma unroll
            for (int m = 0; m < 4; ++m) { const size_t orow = (size_t)S.orow(u, ai * 128 + wr * 64 + m * 16 + fr);
#pragma unroll
                for (int bj = 0; bj < 2; ++bj) h[ai][m][bj] = *(const u32x4*)(Hb + orow * D + u.pn * 256 + bj * 128 + wc * 32 + 8 * fq); }
        __builtin_amdgcn_sched_barrier(0);
#pragma unroll
        for (int ai = 0; ai < 2; ++ai)
#pragma unroll
            for (int m = 0; m < 4; ++m) { const size_t orow = (size_t)S.orow(u, ai * 128 + wr * 64 + m * 16 + fr);
#pragma unroll
                for (int bj = 0; bj < 2; ++bj) { const int col = u.pn * 256 + bj * 128 + wc * 32 + 8 * fq;
                    const u32x4 hh = h[ai][m][bj]; const f32x4 v0 = acc[ai][bj][m][0], v1 = acc[ai][bj][m][1];
                    u32x4 w; w.x = cvt_pk_bf16(bflo(hh.x) * ALPHA + v0[0], bfhi(hh.x) * ALPHA + v0[1]); w.y = cvt_pk_bf16(bflo(hh.y) * ALPHA + v0[2], bfhi(hh.y) * ALPHA + v0[3]);
                    w.z = cvt_pk_bf16(bflo(hh.z) * ALPHA + v1[0], bfhi(hh.z) * ALPHA + v1[1]); w.w = cvt_pk_bf16(bflo(hh.w) * ALPHA + v1[2], bfhi(hh.w) * ALPHA + v1[3]);
                    *(u32x4*)(T + orow * D + col) = w; } }
    }
};
template <int MODE> __device__ __forceinline__ void meta_gemm(LAS unsigned char* mlds, const bf16_t* Hb, const bf16_t* Res, const bf16_t* Bt, int N, bf16_t* O, int ldo, int sc_lo, int sc_hi, float sc, int wg, int nwg, const int tid_, unsigned* knm = nullptr) {
    const int lane = tid_ & 63, wave = __builtin_amdgcn_readfirstlane(tid_ >> 6), tok = lane & 15, kq = lane >> 4;
    for (int tile = wg; tile < N / 16; tile += nwg) {
        const bf16_t* wp = Bt + (size_t)(tile * 16 + tok) * 1024 + kq * 8 + wave * 128; const bf16_t* hp = Hb + (size_t)tok * D + kq * 8 + wave * 128;
        f32x4 acc = (f32x4){0.f, 0.f, 0.f, 0.f};
#pragma unroll
        for (int k = 0; k < 4; ++k) { const bf16x8 a = *(const bf16x8*)(wp + k * 32), bb = *(const bf16x8*)(hp + k * 32); acc = __builtin_amdgcn_mfma_f32_16x16x32_bf16(a, bb, acc, 0, 0, 0); }
        LAS f32x4* red = (LAS f32x4*)mlds;
        red[wave * 64 + lane] = acc;
        __syncthreads();
        if (wave == 0) {
#pragma unroll
            for (int w_ = 1; w_ < 8; ++w_) { const f32x4 o_ = red[w_ * 64 + lane]; acc[0] += o_[0]; acc[1] += o_[1]; acc[2] += o_[2]; acc[3] += o_[3]; } }
        __syncthreads();
        if (wave != 0) continue;
        const int n = tile * 16 + 4 * kq;
        if (MODE == 0 && knm && tile >= 64 && tile < 96) {
            float ss = acc[0] * acc[0] + acc[1] * acc[1] + acc[2] * acc[2] + acc[3] * acc[3]; ss += __shfl_xor(ss, 16); ss += __shfl_xor(ss, 32);
            ss = fmaxf(ss, __shfl_xor(ss, 1)); ss = fmaxf(ss, __shfl_xor(ss, 2)); ss = fmaxf(ss, __shfl_xor(ss, 4)); ss = fmaxf(ss, __shfl_xor(ss, 8));
            if (lane == 0) atomicMax(knm + (tile - 64), __float_as_uint(ss)); }
        if (MODE == 0) { const float f = (n >= sc_lo && n < sc_hi) ? sc : 1.f; u32x2 w; w.x = cvt_pk_bf16(acc[0] * f, acc[1] * f); w.y = cvt_pk_bf16(acc[2] * f, acc[3] * f);
#pragma unroll
            for (int b = 0; b < NB; ++b) *(u32x2*)(O + (ldo ? (size_t)(b * LB + tok) * ldo + n : Z1AT(b * LB + tok, n))) = w; }
        else { const u32x2 h = *(const u32x2*)(Res + (size_t)tok * D + n); u32x2 w; w.x = cvt_pk_bf16(bflo(h.x) * ALPHA + acc[0], bfhi(h.x) * ALPHA + acc[1]); w.y = cvt_pk_bf16(bflo(h.y) * ALPHA + acc[2], bfhi(h.y) * ALPHA + acc[3]);
#pragma unroll
            for (int b = 0; b < NB; ++b) *(u32x2*)(O + (size_t)(b * LB + tok) * ldo + n) = w; }
    }
}
struct EpiSiluMul {
    static constexpr bool PERM = true, META = false;
    unsigned char* ACT;
    template <class Sched> __device__ __forceinline__ void operator()(const f32x4 (&acc)[2][2][4][2], const Unit& u, int wr, int wc, int fr, int fq, const Sched& S) const {
#pragma unroll
        for (int ai = 0; ai < 2; ++ai)
#pragma unroll
            for (int m = 0; m < 4; ++m) { const size_t arow = (size_t)u.pm * 256 + ai * 128 + wr * 64 + m * 16 + fr;
#pragma unroll
                for (int bj = 0; bj < 2; ++bj) { if (bj == 1 && u.hn) continue; const int col = u.pn * 64 + bj * 64 + wc * 16 + 4 * fq;
                    const f32x4 g = acc[ai][bj][m][0], up = acc[ai][bj][m][1]; float a[4];
#pragma unroll
                    for (int i = 0; i < 4; ++i) a[i] = g[i] * __builtin_amdgcn_rcpf(1.f + __builtin_amdgcn_exp2f(g[i] * -1.44269504f)) * (up[i] * F8_ASCALE);
                    *(unsigned*)(ACT + arow * DEXP + col) = pk4_fp8(a[0], a[1], a[2], a[3]); } }
    }
};
struct EpiScatter {
    static constexpr bool PERM = true, META = true;
    unsigned char* YK; LAS int* ms; LAS float* mw;
    template <class Sched> __device__ __forceinline__ void prefetch(const Unit& u, const Sched& S, int tid) const {
        if (__builtin_amdgcn_readfirstlane(tid >> 6) == 0) { S.dma_list(u, (unsigned)__builtin_amdgcn_readfirstlane((int)(unsigned)(size_t)(ms + u.par * 256)), tid & 63);
            S.dma_listw(u, (unsigned)__builtin_amdgcn_readfirstlane((int)(unsigned)(size_t)(mw + u.par * 256)), tid & 63); } }
    template <class Sched> __device__ __forceinline__ void operator()(const f32x4 (&acc)[2][2][4][2], const Unit& u, int wr, int wc, int fr, int fq, const Sched& S) const {
        int sl[2][4]; float w8[2][4];
#pragma unroll
        for (int ai = 0; ai < 2; ++ai)
#pragma unroll
            for (int m = 0; m < 4; ++m) { const int rt = u.par * 256 + ai * 128 + wr * 64 + m * 16 + fr; sl[ai][m] = ms[rt]; w8[ai][m] = mw[rt] * F8_YSCALE; }
        const int nvalid = S.cnt[u.e] - u.lt * 256;
#pragma unroll
        for (int ai = 0; ai < 2; ++ai)
#pragma unroll
            for (int m = 0; m < 4; ++m) { const int rl = ai * 128 + wr * 64 + m * 16 + fr; const bool ok = rl < nvalid; const int s_ = ok ? sl[ai][m] : 0;
                unsigned char* yrow = YK + ((size_t)(s_ & 1) * M1 + (size_t)(s_ >> 1)) * D + u.pn * 128 + wc * 32 + 8 * fq;
#pragma unroll
                for (int bj = 0; bj < 2; ++bj) {
                    const f32x4 v0 = acc[ai][bj][m][0] * w8[ai][m], v1 = acc[ai][bj][m][1] * w8[ai][m];
                    u32x2 w; w.x = pk4_fp8(v0[0], v0[1], v0[2], v0[3]); w.y = pk4_fp8(v1[0], v1[1], v1[2], v1[3]);
                    if (ok && !(bj == 1 && u.hn)) *(u32x2*)(yrow + bj * 128) = w; } }
    }
};

template <int MODE> __device__ __forceinline__ int wrow_map(int n) { return MODE == 0 ? n : (8 * (n >> 2) + (n & 3) + (MODE == 2 ? 4 : 0)); }
template <int MODE> __device__ __forceinline__ void transpose_item_f8(const float* W, int srcpitch, int K, int N, unsigned char* WT, int dpitch, LAS float* scr, int item, int lane) {
    const int nblk = (N + 31) / 32, kb = item / nblk, nb = item % nblk, k0 = 64 * kb, n0 = 32 * nb;
    { float tmp[32];
#pragma unroll
        for (int i = 0; i < 32; ++i) { const int kk = 2 * i + (lane >> 5), n = n0 + (lane & 31); tmp[i] = n < N ? W[(size_t)(k0 + kk) * srcpitch + n] : 0.f; }
#pragma unroll
        for (int i = 0; i < 32; ++i) scr[(2 * i + (lane >> 5)) * 33 + (lane & 31)] = tmp[i] * F8_WSCALE; }
    asm volatile("s_waitcnt lgkmcnt(0)" ::: "memory");
#pragma unroll
    for (int j = 0; j < 2; ++j) { const int slot = lane + 64 * j, nl = slot >> 2, c = slot & 3; const LAS float* sp = scr + (16 * c) * 33 + nl;
        u32x4 o; o.x = pk4_fp8(sp[0 * 33], sp[1 * 33], sp[2 * 33], sp[3 * 33]); o.y = pk4_fp8(sp[4 * 33], sp[5 * 33], sp[6 * 33], sp[7 * 33]);
        o.z = pk4_fp8(sp[8 * 33], sp[9 * 33], sp[10 * 33], sp[11 * 33]); o.w = pk4_fp8(sp[12 * 33], sp[13 * 33], sp[14 * 33], sp[15 * 33]);
        if (n0 + nl < N) *(u32x4*)(WT + (size_t)wrow_map<MODE>(n0 + nl) * dpitch + k0 + 16 * c) = o; }
    asm volatile("s_waitcnt lgkmcnt(0)" ::: "memory");
}
template <int MODE> __device__ __forceinline__ void transpose_item(const float* W, int srcpitch, int K, int N, bf16_t* WT, int dpitch, int dcol0, LAS float* scr, int item, int lane) {
    const int nblk = (N + 31) / 32, kb = item / nblk, nb = item % nblk, k0 = 64 * kb, n0 = 32 * nb;
    { float tmp[32];
#pragma unroll
        for (int i = 0; i < 32; ++i) { const int kk = 2 * i + (lane >> 5), n = n0 + (lane & 31); tmp[i] = n < N ? W[(size_t)(k0 + kk) * srcpitch + n] : 0.f; }
#pragma unroll
        for (int i = 0; i < 32; ++i) scr[(2 * i + (lane >> 5)) * 33 + (lane & 31)] = tmp[i]; }
    asm volatile("s_waitcnt lgkmcnt(0)" ::: "memory");
    const int c = lane & 7;
#pragma unroll
    for (int j = 0; j < 4; ++j) { const int nl = (lane >> 3) + 8 * j; const LAS float* s = scr + (8 * c) * 33 + nl;
        u32x4 o; o.x = pk2(s[0 * 33], s[1 * 33]); o.y = pk2(s[2 * 33], s[3 * 33]); o.z = pk2(s[4 * 33], s[5 * 33]); o.w = pk2(s[6 * 33], s[7 * 33]);
        if (n0 + nl < N) *(u32x4*)(WT + (size_t)wrow_map<MODE>(n0 + nl) * dpitch + dcol0 + k0 + 8 * c) = o; }
    asm volatile("s_waitcnt lgkmcnt(0)" ::: "memory");
}
constexpr int PI_IN0 = 16 * 64, PI_IN08 = 16 * 64, PI_OUT0 = 8 * 32, PI_OUT08 = 8 * 32, PI_IN1 = 16 * 96, PI_IN18 = 16 * 96, PI_OUT18 = 16 * 32, PI_G = 32 * 256, PI_U = 32 * 256, PI_D = 32 * 256;
constexpr int PREP_EARLY = PI_IN0 + PI_IN08, PREP_NITEMS = PI_IN0 + PI_IN08 + PI_OUT0 + PI_OUT08 + PI_IN1 + PI_IN18 + PI_OUT18 + PI_G + PI_U + PI_D;
__device__ __forceinline__ void prep_items(const Ptrs& P, LAS unsigned char* lds, const int it_lo, const int it_hi, const int gw, const int NGW, const int lane, const int wave) {
    LAS float* scr = (LAS float*)(lds + wave * 16384);
    bf16_t* Win0 = (bf16_t*)(P.ws + W_IN0); bf16_t* Wout0 = (bf16_t*)(P.ws + W_OUT0); bf16_t* Win1 = (bf16_t*)(P.ws + W_IN1);
    unsigned char* Wgu = P.ws + W_GU; unsigned char* Wdn = P.ws + W_DN;
    struct ItemD { const float* W; unsigned char* dst; int srcpitch, N, nblk, dpitch, dcol, mode, f8; };
    auto decode = [&](int it, ItemD& d, int& r) {
        r = it;
        if (r < PI_IN0) { d = ItemD{P.even_w_in, (unsigned char*)Win0, EVEN_IN, EVEN_IN, 64, 2048, 0, 0, 0}; return; } r -= PI_IN0;
        if (r < PI_IN08) { d = ItemD{P.even_w_in, P.ws + W_IN08, EVEN_IN, EVEN_IN, 64, 1024, 0, 0, 1}; return; } r -= PI_IN08;
        if (r < PI_OUT0) { d = ItemD{P.even_w_out + (size_t)512 * 1024, (unsigned char*)Wout0, 1024, 1024, 32, 2048, 1024, 0, 0}; return; } r -= PI_OUT0;
        if (r < PI_OUT08) { d = ItemD{P.even_w_out + (size_t)512 * 1024, P.ws + W_OUT08, 1024, 1024, 32, 1024, 512, 0, 1}; return; } r -= PI_OUT08;
        if (r < PI_IN1) { d = ItemD{P.odd_w_in, (unsigned char*)Win1, ODD_IN, ODD_N, 96, 2048, 0, 0, 0}; return; } r -= PI_IN1;
        if (r < PI_IN18) { d = ItemD{P.odd_w_in, P.ws + W_IN18, ODD_IN, ODD_N, 96, 1024, 0, 0, 1}; return; } r -= PI_IN18;
        if (r < PI_OUT18) { d = ItemD{P.odd_w_out, P.ws + W_OUT18, 1024, 1024, 32, 1024, 0, 0, 1}; return; } r -= PI_OUT18;
        if (r < PI_G) { const int le = r >> 8; r &= 255; d = ItemD{P.moe_w_gate + (size_t)le * 1024 * 512, Wgu + (size_t)le * 1024 * 1024, 512, 512, 16, 1024, 0, 1, 1}; return; } r -= PI_G;
        if (r < PI_U) { const int le = r >> 8; r &= 255; d = ItemD{P.moe_w_up + (size_t)le * 1024 * 512, Wgu + (size_t)le * 1024 * 1024, 512, 512, 16, 1024, 0, 2, 1}; return; } r -= PI_U;
        { const int le = r >> 8; r &= 255; d = ItemD{P.moe_w_down + (size_t)le * 512 * 1024, Wdn + (size_t)le * 1024 * 512, 1024, 1024, 32, 512, 0, 0, 1}; } };
#define PREP_LOAD(d, r, tmp) do { const int kb_ = (r) / (d).nblk, nb_ = (r) % (d).nblk; \
        _Pragma("unroll") for (int i = 0; i < 8; ++i) { const int kk = 8 * i + (lane >> 3), n = 32 * nb_ + 4 * (lane & 7); tmp[i] = *(const f32x4*)((d).W + (size_t)(64 * kb_ + kk) * (d).srcpitch + n); } } while (0)
#define PREP_STORE(d, r, tmp) do { const int kb_ = (r) / (d).nblk, nb_ = (r) % (d).nblk, k0_ = 64 * kb_, n0_ = 32 * nb_; const float sc_ = (d).f8 ? F8_WSCALE : 1.f; \
        _Pragma("unroll") for (int i = 0; i < 8; ++i) { LAS float* wp_ = scr + (8 * i + (lane >> 3)) * 33 + 4 * (lane & 7); wp_[0] = tmp[i][0] * sc_; wp_[1] = tmp[i][1] * sc_; wp_[2] = tmp[i][2] * sc_; wp_[3] = tmp[i][3] * sc_; } \
        asm volatile("s_waitcnt lgkmcnt(0)" ::: "memory"); \
        if ((d).f8) { _Pragma("unroll") for (int j = 0; j < 2; ++j) { const int slot = lane + 64 * j, nl = slot >> 2, c = slot & 3; const LAS float* sp = scr + (16 * c) * 33 + nl; \
                u32x4 o; o.x = pk4_fp8(sp[0 * 33], sp[1 * 33], sp[2 * 33], sp[3 * 33]); o.y = pk4_fp8(sp[4 * 33], sp[5 * 33], sp[6 * 33], sp[7 * 33]); \
                o.z = pk4_fp8(sp[8 * 33], sp[9 * 33], sp[10 * 33], sp[11 * 33]); o.w = pk4_fp8(sp[12 * 33], sp[13 * 33], sp[14 * 33], sp[15 * 33]); \
                const int n = n0_ + nl, rown = (d).mode == 0 ? n : (8 * (n >> 2) + (n & 3) + ((d).mode == 2 ? 4 : 0)); \
                if (n < (d).N) *(u32x4*)((d).dst + (size_t)rown * (d).dpitch + (d).dcol + k0_ + 16 * c) = o; } } \
        else { const int c = lane & 7; \
            _Pragma("unroll") for (int j = 0; j < 4; ++j) { const int nl = (lane >> 3) + 8 * j; const LAS float* sp = scr + (8 * c) * 33 + nl; \
                u32x4 o; o.x = pk2(sp[0 * 33], sp[1 * 33]); o.y = pk2(sp[2 * 33], sp[3 * 33]); o.z = pk2(sp[4 * 33], sp[5 * 33]); o.w = pk2(sp[6 * 33], sp[7 * 33]); \
                if (n0_ + nl < (d).N) *(u32x4*)((d).dst + (size_t)(n0_ + nl) * (d).dpitch + (d).dcol + (size_t)(k0_ + 8 * c) * 2) = o; } } \
        asm volatile("s_waitcnt lgkmcnt(0)" ::: "memory"); } while (0)
#define PREP_TRY(idx, d, r, tmp, ok) do { ok = (idx) < it_hi; decode(ok ? (idx) : it_lo, d, r); PREP_LOAD(d, r, tmp); } while (0)
    { ItemD dA, dB, dC; int rA = 0, rB = 0, rC = 0; f32x4 tA[8], tB[8], tC[8]; bool okA, okB, okC;
        int it = it_lo + gw;
        PREP_TRY(it, dA, rA, tA, okA); PREP_TRY(it + NGW, dB, rB, tB, okB);
        while (okA) {
            PREP_TRY(it + 2 * NGW, dC, rC, tC, okC);
            PREP_STORE(dA, rA, tA);
            if (!okB) break;
            PREP_TRY(it + 3 * NGW, dA, rA, tA, okA);
            PREP_STORE(dB, rB, tB);
            if (!okC) break;
            PREP_TRY(it + 4 * NGW, dB, rB, tB, okB);
            PREP_STORE(dC, rC, tC);
            it += 3 * NGW; } }
#undef PREP_TRY
#undef PREP_LOAD
#undef PREP_STORE
}
__device__ __forceinline__ void prep_fold(const Ptrs& P, const int gw, const int NGW, const int lane) {
    bf16_t* Wout0 = (bf16_t*)(P.ws + W_OUT0);
    for (int it = gw; it < 128 * 16; it += NGW) {
        const int cp0 = (it >> 4) * 4, n = (it & 15) * 64 + lane, g = cp0 >> 7, c0 = cp0 & 127;
        const float* pw = P.pool_w + ((size_t)g * 128 + c0) * 128; const float* ps = P.pool_scale + g * 128; const float* wo = P.even_w_out + (size_t)(g * 128) * 1024 + n;
        float a[4] = {0.f, 0.f, 0.f, 0.f}; float wv[64];
        float cf[4][2]; { const float ps0 = ps[lane], ps1 = ps[lane + 64];
#pragma unroll
            for (int j = 0; j < 4; ++j) { cf[j][0] = pw[j * 128 + lane] * ps0; cf[j][1] = pw[j * 128 + 64 + lane] * ps1; } }
#pragma unroll
        for (int hf = 0; hf < 2; ++hf) {
#pragma unroll
            for (int d = 0; d < 64; ++d) wv[d] = wo[(size_t)(hf * 64 + d) * 1024];
            __builtin_amdgcn_sched_barrier(0);
#pragma unroll
            for (int d = 0; d < 64; ++d) {
#pragma unroll
                for (int j = 0; j < 4; ++j) a[j] += __uint_as_float(__builtin_amdgcn_readlane(__float_as_uint(cf[j][hf]), d)) * wv[d]; }
            __builtin_amdgcn_sched_barrier(0); }
#pragma unroll
        for (int j = 0; j < 4; ++j) { Wout0[(size_t)n * 1024 + cp0 + j] = (bf16_t)f2bf(a[j]); }
        *(unsigned*)(P.ws + W_OUT08 + (size_t)n * 1024 + cp0) = pk4_fp8(a[0] * F8_WSCALE, a[1] * F8_WSCALE, a[2] * F8_WSCALE, a[3] * F8_WSCALE);
    }
}
__device__ __forceinline__ void stage_prep(const Ptrs& P, LAS unsigned char* lds, int wg, int nwg) {
    const int tid = tid_opaque(P), lane = tid & 63, wave = __builtin_amdgcn_readfirstlane(tid >> 6);
    const int gw = wg * 8 + wave, NGW = nwg * 8;
    if (wg == 0 && wave == 0) { const float s1 = wave_sum(P.lq1[lane] * P.lk1[lane]), s2 = wave_sum(P.lq2[lane] * P.lk2[lane]);
        if (lane == 0) ((float*)(P.ws + WS_MISC))[0] = __expf(s1) - __expf(s2) + LAMBDA_INIT; }
    prep_items(P, lds, 0, nwg == 256 ? PREP_EARLY : PREP_NITEMS, gw, NGW, lane, wave);
    if (nwg != 256) prep_fold(P, gw, NGW, lane);
    bf16_t* Hb = (bf16_t*)(P.ws + WS_HB);
    for (int row0 = gw * 4; row0 < M1; row0 += NGW * 4) { f32x4 v[4][4];
#pragma unroll
        for (int q = 0; q < 4; ++q) { const f32x4* xr = (const f32x4*)h0_ptr(P, row0 + q) + lane;
#pragma unroll
            for (int j = 0; j < 4; ++j) v[q][j] = xr[64 * j]; }
#pragma unroll
        for (int q = 0; q < 4; ++q) { unsigned long long* o8 = (unsigned long long*)(Hb + (size_t)(row0 + q) * D) + lane;
#pragma unroll
            for (int j = 0; j < 4; ++j) o8[64 * j] = (unsigned long long)pk2(v[q][j].x, v[q][j].y) | ((unsigned long long)pk2(v[q][j].z, v[q][j].w) << 32);
            unsigned* o4 = (unsigned*)(P.ws + WS_HB8 + (size_t)(row0 + q) * D) + lane;
#pragma unroll
            for (int j = 0; j < 4; ++j) o4[64 * j] = pk4_fp8(v[q][j].x * F8_HSCALE, v[q][j].y * F8_HSCALE, v[q][j].z * F8_HSCALE, v[q][j].w * F8_HSCALE); } }
}

template <int W> __device__ __forceinline__ void pool_block(const bf16_t* Z, unsigned char* A28, bf16_t* A2m, int row0, int p0, int col) {
    u32x4 v[W + 15];
#pragma unroll
    for (int k = 0; k < W + 15; ++k) v[k] = (p0 - (W - 1) + k >= 0) ? *(const u32x4*)(Z + Z1AT(row0 - (W - 1) + k, col)) : (u32x4){0u, 0u, 0u, 0u};
    float s[8];
#pragma unroll
    for (int i = 0; i < 8; ++i) s[i] = 0.f;
#pragma unroll
    for (int k = 0; k < W - 1; ++k) { s[0] += bflo(v[k].x); s[1] += bfhi(v[k].x); s[2] += bflo(v[k].y); s[3] += bfhi(v[k].y); s[4] += bflo(v[k].z); s[5] += bfhi(v[k].z); s[6] += bflo(v[k].w); s[7] += bfhi(v[k].w); }
#pragma unroll
    for (int r = 0; r < 16; ++r) { const u32x4 in = v[W - 1 + r];
        s[0] += bflo(in.x); s[1] += bfhi(in.x); s[2] += bflo(in.y); s[3] += bfhi(in.y); s[4] += bflo(in.z); s[5] += bfhi(in.z); s[6] += bflo(in.w); s[7] += bfhi(in.w);
        const int p = p0 + r; const float inv = 1.f / (float)((p + 1) < W ? (p + 1) : W);
        const float dv[8] = {s[0] * inv - bflo(in.x), s[1] * inv - bfhi(in.x), s[2] * inv - bflo(in.y), s[3] * inv - bfhi(in.y), s[4] * inv - bflo(in.z), s[5] * inv - bfhi(in.z), s[6] * inv - bflo(in.w), s[7] * inv - bfhi(in.w)};
        const int row = row0 + r;
        if (p < NMETA) { u32x4 o; o.x = pk2(dv[0], dv[1]); o.y = pk2(dv[2], dv[3]); o.z = pk2(dv[4], dv[5]); o.w = pk2(dv[6], dv[7]); *(u32x4*)(A2m + (size_t)((row / LB) * NMETA + p) * D + col) = o; }
        else { u32x2 o; o.x = pk4_fp8(dv[0] * F8_ASCALE, dv[1] * F8_ASCALE, dv[2] * F8_ASCALE, dv[3] * F8_ASCALE); o.y = pk4_fp8(dv[4] * F8_ASCALE, dv[5] * F8_ASCALE, dv[6] * F8_ASCALE, dv[7] * F8_ASCALE); *(u32x2*)(A28 + (size_t)row * D + col) = o; }
        const u32x4 out = v[r];
        s[0] -= bflo(out.x); s[1] -= bfhi(out.x); s[2] -= bflo(out.y); s[3] -= bfhi(out.y); s[4] -= bflo(out.z); s[5] -= bfhi(out.z); s[6] -= bflo(out.w); s[7] -= bfhi(out.w); }
}
__device__ __forceinline__ void stage_pool(const Ptrs& P, int wg, int nwg) {
    const bf16_t* Z = (const bf16_t*)(P.ws + WS_Z); unsigned char* A28 = P.ws + WS_A2; bf16_t* A2m = (bf16_t*)(P.ws + WS_A2M);
    const int tid_ = tid_opaque(P), lane = tid_ & 63; const int gwv = __builtin_amdgcn_readfirstlane(wg * 8 + (tid_ >> 6)), NGW = nwg * 8;
    for (int it = gwv; it < (M1 / 64) * 4; it += NGW) { const int gi = it & 3, blk = (it >> 2) * 4 + (lane >> 4), row0 = blk * 16, p0 = row0 % LB, col = gi * 128 + (lane & 15) * 8;
        if (gi == 0) pool_block<2>(Z, A28, A2m, row0, p0, col); else if (gi == 1) pool_block<4>(Z, A28, A2m, row0, p0, col);
        else if (gi == 2) pool_block<8>(Z, A28, A2m, row0, p0, col); else pool_block<16>(Z, A28, A2m, row0, p0, col); }
}

template <class BP> __device__ __forceinline__ void route16(const float (&lg)[16], BP bias, int& e0, int& e1, float& w0, float& w1) {
    float mx = lg[0];
#pragma unroll
    for (int e = 1; e < 16; ++e) mx = fmaxf(mx, lg[e]);
    float p[16], sum = 0.f;
#pragma unroll
    for (int e = 0; e < 16; ++e) { p[e] = __builtin_amdgcn_exp2f((lg[e] - mx) * 1.44269504f); sum += p[e]; }
    const float inv = 1.f / sum; float sel[16];
#pragma unroll
    for (int e = 0; e < 16; ++e) { p[e] *= inv; sel[e] = p[e] + bias[e]; }
    int gbest = 0; float gsb = -3.0e38f; int bi0 = 0, bi1 = 1; float bp0 = 0.f, bp1 = 0.f;
#pragma unroll
    for (int g = 0; g < 4; ++g) {
        int i0 = 0; float m0 = sel[4 * g];
#pragma unroll
        for (int i = 1; i < 4; ++i) if (sel[4 * g + i] > m0) { m0 = sel[4 * g + i]; i0 = i; }
        int i1 = (i0 == 0) ? 1 : 0; float m1 = (i0 == 0) ? sel[4 * g + 1] : sel[4 * g];
#pragma unroll
        for (int i = 1; i < 4; ++i) if (i != i0 && i != ((i0 == 0) ? 1 : 0) && sel[4 * g + i] > m1) { m1 = sel[4 * g + i]; i1 = i; }
        const float gs = m0 + m1;
        float q0 = 0.f, q1 = 0.f;
#pragma unroll
        for (int i = 0; i < 4; ++i) { q0 = (i == i0) ? p[4 * g + i] : q0; q1 = (i == i1) ? p[4 * g + i] : q1; }
        if (gs > gsb) { gsb = gs; gbest = g; bi0 = i0; bi1 = i1; bp0 = q0; bp1 = q1; }
    }
    e0 = gbest * 4 + bi0; e1 = gbest * 4 + bi1; const float ws = 1.f / (bp0 + bp1); w0 = bp0 * ws; w1 = bp1 * ws;
}

constexpr int LN_WROW = 80, LN_LGS = 1024 * LN_WROW, LN_CNT = LN_LGS + 8 * 256, LN_ENT = LN_CNT + 128, LN_GB = 90112;
template <int MODE> __device__ __forceinline__ void stage_ln(const Ptrs& P, LAS unsigned char* lds, int wg, int nwg) {
    constexpr int LAYER = MODE & 1; constexpr bool MIX = MODE < 2, MATV = MODE != 3, ROUTE = MODE < 2;
    const int tid = tid_opaque(P), lane = tid & 63, wave = __builtin_amdgcn_readfirstlane(tid >> 6);
    constexpr int O_TL = 0, TLP = 2064, O_PD = 66560, O_ST = 99328, O_SE = 99584, O_CE = 99648, O_RB = 99712;
    constexpr int O_GB = ROUTE ? 100352 : LN_GB, O_LGS = ROUTE ? 108544 : LN_LGS, O_CNT = ROUTE ? 110592 : LN_CNT, O_ENT = ROUTE ? 110720 : LN_ENT;
    LAS float* lgs = (LAS float*)(lds + O_LGS) + wave * 64; LAS int* lcnt = (LAS int*)(lds + O_CNT); LAS int* lbase = lcnt + 16; LAS int* ent = (LAS int*)(lds + O_ENT); LAS float* entw = (LAS float*)(lds + O_ENT + 2048);
    int R = (((M1 + nwg - 1) / nwg) + 3) & ~3, r0 = wg * R, r1 = (r0 + R) < M1 ? (r0 + R) : M1;
    if ((MODE == 1 || MODE == 3) && nwg == 256) { R = 128; r0 = (wg >> 6) * LB + NMETA + (wg & 63) * 128; r1 = r0 + 128; }
    if (MODE == 2) { const float* src = MODE == 2 ? P.odd_w_in + ODD_N : P.router_w; const int stride = MODE == 2 ? ODD_IN : 16;
        f32x4 st_[8];
#pragma unroll
        for (int it = 0; it < 8; ++it) { const int i = tid + it * 512, cc = i >> 2, q4 = i & 3; st_[it] = *(const f32x4*)(src + (size_t)cc * stride + q4 * 4); }
#pragma unroll
        for (int it = 0; it < 8; ++it) { const int i = tid + it * 512, cc = i >> 2, q4 = i & 3; const int lrow = (cc >> 9) * 512 + (cc & 7) * 64 + ((cc & 511) >> 3);
            *(LAS f32x4*)(lds + lrow * LN_WROW + q4 * 16) = st_[it]; } }
    if (ROUTE) { if (tid < 16) lcnt[tid] = 0; for (int i = tid; i < 2 * R; i += 512) ent[i] = -1; }
    { const float* gb_ = (tid < 256 ? (MIX ? P.ln_mix_g : P.ln_ffn_g) : (MIX ? P.ln_mix_b : P.ln_ffn_b)) + LAYER * D; const int i_ = tid & 255, hf_ = i_ >> 7, q_ = (i_ >> 6) & 1, ln_ = i_ & 63;
        ((LAS f32x4*)(lds + O_GB))[tid] = *(const f32x4*)(gb_ + hf_ * 512 + ln_ * 8 + q_ * 4); }
    bf16_t* Hb = (bf16_t*)(P.ws + WS_HB); const bf16_t* T = (const bf16_t*)(P.ws + WS_T); const unsigned char* YK = P.ws + WS_YK; float* RW = (float*)(P.ws + WS_RW); float* GLR = (float*)(P.ws + WS_GLR);
    u32x4 raw[4][2], ry[4][2];
#define LN_LDRAW(q0n) do { _Pragma("unroll") for (int j = 0; j < 4; ++j) { const int rr_ = (q0n) + j, rw_ = rr_ < r1 ? rr_ : r1 - 1; \
        _Pragma("unroll") for (int hf = 0; hf < 2; ++hf) { const size_t off_ = (size_t)rw_ * D + hf * 512 + lane * 8; \
            if (MIX) raw[j][hf] = *(const u32x4*)(T + off_); \
            else { raw[j][hf] = *(const u32x4*)(Hb + off_); const u32x2 y0_ = *(const u32x2*)(YK + off_), y1_ = *(const u32x2*)(YK + (size_t)M1 * D + off_); ry[j][hf] = (u32x4){y0_.x, y0_.y, y1_.x, y1_.y}; } } } } while (0)
    const int qend = ROUTE ? r0 + 32 * ((r1 - r0 + 31) / 32) : r1;
    if (ROUTE || r0 + 4 * wave < r1) LN_LDRAW(r0 + 4 * wave);
    bf16x8 bw[8];
    if (ROUTE) { const float* gp_ = P.ln_mix_g + LAYER * D; const float* bp_ = P.ln_mix_b + LAYER * D;
        const int n_ = lane & 31, kh_ = lane >> 5, e_ = n_ & 15; const bool lo_ = n_ >= 16;
#pragma unroll
        for (int ks = 0; ks < 8; ++ks) { unsigned hw[8];
#pragma unroll
            for (int j = 0; j < 8; ++j) { const int k_ = 128 * wave + 16 * ks + 8 * kh_ + j; const float wv = gp_[k_] * P.router_w[k_ * 16 + e_]; const unsigned hb_ = cvt_pk_bf16(wv, 0.f) & 0xffffu;
                const float res_ = wv - __uint_as_float(hb_ << 16); hw[j] = lo_ ? (cvt_pk_bf16(res_, 0.f) & 0xffffu) : hb_; }
            const u32x4 pk_ = (u32x4){hw[0] | (hw[1] << 16), hw[2] | (hw[3] << 16), hw[4] | (hw[5] << 16), hw[6] | (hw[7] << 16)}; bw[ks] = __builtin_bit_cast(bf16x8, pk_); }
        if (tid >= 64 && tid < 80) ((LAS float*)(lds + O_RB))[tid - 64] = P.router_bias[tid - 64];
        { const int e2_ = tid & 15, part_ = tid >> 4; float s_ = 0.f, c_ = 0.f;
            for (int k_ = part_ * 32; k_ < part_ * 32 + 32; ++k_) { const float wr_ = P.router_w[k_ * 16 + e2_]; s_ += gp_[k_] * wr_; c_ += bp_[k_] * wr_; }
            ((LAS float*)(lds + O_PD))[part_ * 16 + e2_] = s_; ((LAS float*)(lds + O_PD))[512 + part_ * 16 + e2_] = c_; }
        __syncthreads();
        if (tid < 32) { const int e2_ = tid & 15; const int which_ = tid >> 4; float a_ = 0.f; for (int p_ = 0; p_ < 32; ++p_) a_ += ((LAS float*)(lds + O_PD))[which_ * 512 + p_ * 16 + e2_]; ((LAS float*)(lds + (which_ ? O_CE : O_SE)))[e2_] = a_; } }
    __syncthreads();
    for (int q0 = r0 + 4 * wave; q0 < qend; q0 += 32) {
        float x[4][16]; bool act[4]; int rows[4];
#pragma unroll
        for (int j = 0; j < 4; ++j) { const int rr = q0 + j; rows[j] = rr < r1 ? rr : r1 - 1; const int p = rows[j] % LB; act[j] = rr < r1 && !((MODE == 1 || MODE == 3) && p < NMETA); }
#pragma unroll
        for (int j = 0; j < 4; ++j)
#pragma unroll
            for (int hf = 0; hf < 2; ++hf) {
                if (MIX) { const u32x4 t = raw[j][hf];
                    x[j][hf * 8 + 0] = bflo(t.x); x[j][hf * 8 + 1] = bfhi(t.x); x[j][hf * 8 + 2] = bflo(t.y); x[j][hf * 8 + 3] = bfhi(t.y); x[j][hf * 8 + 4] = bflo(t.z); x[j][hf * 8 + 5] = bfhi(t.z); x[j][hf * 8 + 6] = bflo(t.w); x[j][hf * 8 + 7] = bfhi(t.w); }
                else { const u32x4 h = raw[j][hf], yy = ry[j][hf];
                    float a0[4], a1[4], b0[4], b1[4]; fp8x4_to_f32(yy.x, a0); fp8x4_to_f32(yy.y, a1); fp8x4_to_f32(yy.z, b0); fp8x4_to_f32(yy.w, b1);
                    constexpr float ys = 1.f / F8_YSCALE;
                    x[j][hf * 8 + 0] = bflo(h.x) * ALPHA + (a0[0] + b0[0]) * ys; x[j][hf * 8 + 1] = bfhi(h.x) * ALPHA + (a0[1] + b0[1]) * ys;
                    x[j][hf * 8 + 2] = bflo(h.y) * ALPHA + (a0[2] + b0[2]) * ys; x[j][hf * 8 + 3] = bfhi(h.y) * ALPHA + (a0[3] + b0[3]) * ys;
                    x[j][hf * 8 + 4] = bflo(h.z) * ALPHA + (a1[0] + b1[0]) * ys; x[j][hf * 8 + 5] = bfhi(h.z) * ALPHA + (a1[1] + b1[1]) * ys;
                    x[j][hf * 8 + 6] = bflo(h.w) * ALPHA + (a1[2] + b1[2]) * ys; x[j][hf * 8 + 7] = bfhi(h.w) * ALPHA + (a1[3] + b1[3]) * ys; } }
        if (ROUTE) {
#pragma unroll
            for (int j = 0; j < 4; ++j)
#pragma unroll
                for (int hf = 0; hf < 2; ++hf) *(LAS u32x4*)(lds + O_TL + (4 * wave + j) * TLP + hf * 1024 + lane * 16) = raw[j][hf]; }
        __builtin_amdgcn_sched_barrier(0);
        if (ROUTE || q0 + 32 < r1) LN_LDRAW(q0 + 32);
        float mean[4], rstd[4];
#pragma unroll
        for (int j = 0; j < 4; ++j) { float sm = 0.f;
#pragma unroll
            for (int i = 0; i < 16; ++i) sm += x[j][i];
            mean[j] = sm; }
        wave_sum4(mean);
#pragma unroll
        for (int j = 0; j < 4; ++j) { mean[j] *= (1.f / D); float s2 = 0.f;
#pragma unroll
            for (int i = 0; i < 16; ++i) { x[j][i] -= mean[j]; s2 += x[j][i] * x[j][i]; }
            rstd[j] = s2; }
        wave_sum4(rstd);
#pragma unroll
        for (int j = 0; j < 4; ++j) rstd[j] = __builtin_amdgcn_rsqf(rstd[j] * (1.f / D) + LN_EPS);
        {
#pragma unroll
            for (int hf = 0; hf < 2; ++hf)
#pragma unroll
                for (int q = 0; q < 2; ++q) { const f32x4 g4 = ((const LAS f32x4*)(lds + O_GB))[(hf * 2 + q) * 64 + lane], b4 = ((const LAS f32x4*)(lds + O_GB))[256 + (hf * 2 + q) * 64 + lane];
#pragma unroll
                    for (int e = 0; e < 4; ++e)
#pragma unroll
                        for (int j = 0; j < 4; ++j) x[j][hf * 8 + q * 4 + e] = x[j][hf * 8 + q * 4 + e] * rstd[j] * g4[e] + b4[e]; } }
#pragma unroll
        for (int j = 0; j < 4; ++j) {
            if (ROUTE || act[j]) {
                if (MODE != 3) {
#pragma unroll
                    for (int hf = 0; hf < 2; ++hf) { u32x4 w; w.x = pk2(x[j][hf * 8], x[j][hf * 8 + 1]); w.y = pk2(x[j][hf * 8 + 2], x[j][hf * 8 + 3]); w.z = pk2(x[j][hf * 8 + 4], x[j][hf * 8 + 5]); w.w = pk2(x[j][hf * 8 + 6], x[j][hf * 8 + 7]);
                        *(u32x4*)(Hb + (size_t)rows[j] * D + hf * 512 + lane * 8) = w;
                        if (ROUTE || MODE == 2) { u32x2 w8; w8.x = pk4_fp8(x[j][hf * 8] * F8_HSCALE, x[j][hf * 8 + 1] * F8_HSCALE, x[j][hf * 8 + 2] * F8_HSCALE, x[j][hf * 8 + 3] * F8_HSCALE);
                            w8.y = pk4_fp8(x[j][hf * 8 + 4] * F8_HSCALE, x[j][hf * 8 + 5] * F8_HSCALE, x[j][hf * 8 + 6] * F8_HSCALE, x[j][hf * 8 + 7] * F8_HSCALE);
                            *(u32x2*)(P.ws + WS_HB8 + (size_t)rows[j] * D + hf * 512 + lane * 8) = w8; } } }
                else { const int b = rows[j] / LB, p = rows[j] - b * LB; float* orow = P.out + ((size_t)b * SEQ + (p - NMETA)) * D;
#pragma unroll
                    for (int hf = 0; hf < 2; ++hf)
#pragma unroll
                        for (int q = 0; q < 2; ++q) *(f32x4*)(orow + hf * 512 + lane * 8 + q * 4) = (f32x4){x[j][hf * 8 + q * 4], x[j][hf * 8 + q * 4 + 1], x[j][hf * 8 + q * 4 + 2], x[j][hf * 8 + q * 4 + 3]}; } } }
        if (ROUTE) {
            asm volatile("s_waitcnt lgkmcnt(0)\n\ts_barrier" ::: "memory");
            f32x16 dacc = f32x16{};
            { const LAS unsigned char* ap_ = lds + O_TL + (lane & 31) * TLP + (128 * wave + 8 * (lane >> 5)) * 2;
#pragma unroll
                for (int ks = 0; ks < 8; ++ks) { const bf16x8 a_ = *(const LAS bf16x8*)(ap_ + ks * 32); dacc = __builtin_amdgcn_mfma_f32_32x32x16_bf16(a_, bw[ks], dacc, 0, 0, 0); } }
            { LAS float* pd_ = (LAS float*)(lds + O_PD) + wave * 1024 + (lane & 31);
#pragma unroll
                for (int r = 0; r < 16; ++r) pd_[(((r & 3) + 8 * (r >> 2)) + 4 * (lane >> 5)) * 32] = dacc[r]; }
            if (lane == 0) {
#pragma unroll
                for (int j = 0; j < 4; ++j) { ((LAS float*)(lds + O_ST))[(4 * wave + j) * 2] = mean[j]; ((LAS float*)(lds + O_ST))[(4 * wave + j) * 2 + 1] = rstd[j]; } }
            asm volatile("s_waitcnt lgkmcnt(0)\n\ts_barrier" ::: "memory");
            { const int rw_ = 4 * wave + (lane >> 4), e_ = lane & 15; const LAS float* pd_ = (const LAS float*)(lds + O_PD) + rw_ * 32 + e_; float pre = 0.f;
#pragma unroll
                for (int w_ = 0; w_ < 8; ++w_) pre += pd_[w_ * 1024] + pd_[w_ * 1024 + 16];
                const float mr_ = ((const LAS float*)(lds + O_ST))[rw_ * 2], rs_ = ((const LAS float*)(lds + O_ST))[rw_ * 2 + 1];
                lgs[lane] = rs_ * (pre - mr_ * ((const LAS float*)(lds + O_SE))[e_]) + ((const LAS float*)(lds + O_CE))[e_]; }
            asm volatile("s_waitcnt lgkmcnt(0)" ::: "memory");
            { const int j = lane >> 4; float lg[16];
#pragma unroll
                for (int e4 = 0; e4 < 4; ++e4) { const f32x4 t4 = *(const LAS f32x4*)(lgs + j * 16 + e4 * 4); lg[e4 * 4] = t4.x; lg[e4 * 4 + 1] = t4.y; lg[e4 * 4 + 2] = t4.z; lg[e4 * 4 + 3] = t4.w; }
                int e0, e1; float w0, w1; route16(lg, (const LAS float*)(lds + O_RB), e0, e1, w0, w1);
                bool a_ = false;
#pragma unroll
                for (int jj = 0; jj < 4; ++jj) a_ = (jj == j) ? act[jj] : a_;
                if (a_ && (lane & 15) == 0) { const int row = q0 + j; const int li0 = atomicAdd((int*)&lcnt[e0], 1), li1 = atomicAdd((int*)&lcnt[e1], 1);
                    ent[2 * (row - r0)] = e0 | (li0 << 8); ent[2 * (row - r0) + 1] = e1 | (li1 << 8); entw[2 * (row - r0)] = w0; entw[2 * (row - r0) + 1] = w1; }
                asm volatile("s_waitcnt lgkmcnt(0)" ::: "memory"); }
        }
        if (MODE == 2) {
            float fin[2];
#define LN_DPP(v_, ctrl_) __builtin_bit_cast(float, __builtin_amdgcn_update_dpp(0, __builtin_bit_cast(int, (v_)), (ctrl_), 0xf, 0xf, false))
#pragma unroll
            for (int h8 = 0; h8 < 2; ++h8) {
                f32x2 v2[16];
#pragma unroll
                for (int i = 0; i < 16; ++i) v2[i] = (f32x2){0.f, 0.f};
#pragma unroll
                for (int hf = 0; hf < 2; ++hf)
#pragma unroll
                    for (int i = 0; i < 8; ++i) { const LAS f32x4* wp = (const LAS f32x4*)(lds + (hf * 512 + i * 64 + lane) * LN_WROW + h8 * 32); const f32x4 wa = wp[0], wb = wp[1];
                        const f32x2 w0 = (f32x2){wa.x, wa.y}, w1 = (f32x2){wa.z, wa.w}, w2 = (f32x2){wb.x, wb.y}, w3 = (f32x2){wb.z, wb.w};
#pragma unroll
                        for (int j = 0; j < 4; ++j) { const float hv = x[j][hf * 8 + i]; const f32x2 h2 = (f32x2){hv, hv};
                            v2[j * 4] = __builtin_elementwise_fma(h2, w0, v2[j * 4]); v2[j * 4 + 1] = __builtin_elementwise_fma(h2, w1, v2[j * 4 + 1]);
                            v2[j * 4 + 2] = __builtin_elementwise_fma(h2, w2, v2[j * 4 + 2]); v2[j * 4 + 3] = __builtin_elementwise_fma(h2, w3, v2[j * 4 + 3]); } }
                float v[32];
#pragma unroll
                for (int i = 0; i < 16; ++i) { v[2 * i] = v2[i].x; v[2 * i + 1] = v2[i].y; }
#pragma unroll
                for (int i = 0; i < 16; ++i) { const auto r = __builtin_amdgcn_permlane32_swap(__float_as_uint(v[i]), __float_as_uint(v[i + 16]), false, false); const unsigned r0 = r[0], r1 = r[1];
                    v[i] = __uint_as_float(r0) + __uint_as_float(r1); }
#pragma unroll
                for (int i = 0; i < 8; ++i) { const auto r = __builtin_amdgcn_permlane16_swap(__float_as_uint(v[i]), __float_as_uint(v[i + 8]), false, false); const unsigned r0 = r[0], r1 = r[1];
                    v[i] = __uint_as_float(r0) + __uint_as_float(r1); }
                const bool b3 = (lane & 8) != 0, b2 = (lane & 4) != 0, b1 = (lane & 2) != 0;
#pragma unroll
                for (int i = 0; i < 4; ++i) { const float keep = b3 ? v[i + 4] : v[i], send = b3 ? v[i] : v[i + 4]; v[i] = keep + LN_DPP(send, 0x128); }
#pragma unroll
                for (int i = 0; i < 2; ++i) { const float keep = b2 ? v[i + 2] : v[i], send = b2 ? v[i] : v[i + 2]; v[i] = keep + LN_DPP(send, 0x141); }
                { const float keep = b1 ? v[1] : v[0], send = b1 ? v[0] : v[1]; v[0] = keep + LN_DPP(send, 0x1b); }
                v[0] += LN_DPP(v[0], 0xb1);
                fin[h8] = v[0];
                __builtin_amdgcn_sched_barrier(0);
            }
#undef LN_DPP
            const int oute = (lane & 1) * 8 + ((lane >> 1) & 7); const float outv = (lane & 1) ? fin[1] : fin[0];
            if (MODE != 2) { lgs[(lane >> 4) * 16 + oute] = outv; asm volatile("s_waitcnt lgkmcnt(0)" ::: "memory"); }
            if (MODE == 2) { const int j = lane >> 4; bool a_ = false;
#pragma unroll
                for (int jj = 0; jj < 4; ++jj) a_ = (jj == j) ? act[jj] : a_;
                if (a_) GLR[(size_t)(q0 + j) * 16 + oute] = outv; }
            else {
                const int j = lane >> 4; float lg[16];
#pragma unroll
                for (int e4 = 0; e4 < 4; ++e4) { const f32x4 t4 = *(const LAS f32x4*)(lgs + j * 16 + e4 * 4); lg[e4 * 4] = t4.x; lg[e4 * 4 + 1] = t4.y; lg[e4 * 4 + 2] = t4.z; lg[e4 * 4 + 3] = t4.w; }
                int e0, e1; float w0, w1; route16(lg, P.router_bias, e0, e1, w0, w1);
                bool a_ = false;
#pragma unroll
                for (int jj = 0; jj < 4; ++jj) a_ = (jj == j) ? act[jj] : a_;
                if (a_ && (lane & 15) == 0) { const int row = q0 + j; const int li0 = atomicAdd((int*)&lcnt[e0], 1), li1 = atomicAdd((int*)&lcnt[e1], 1);
                    ent[2 * (row - r0)] = e0 | (li0 << 8); ent[2 * (row - r0) + 1] = e1 | (li1 << 8); entw[2 * (row - r0)] = w0; entw[2 * (row - r0) + 1] = w1; }
                asm volatile("s_waitcnt lgkmcnt(0)" ::: "memory");
            }
        }
    }
    if (ROUTE) {
        __syncthreads();
        unsigned* gcnt = (unsigned*)(P.ws + WS_CTL) + CW_CNT + 64 * LAYER;
        if (tid < 16) lbase[tid] = (int)atomicAdd(gcnt + tid, (unsigned)lcnt[tid]);
        __syncthreads();
        int* list = (int*)(P.ws + WS_LIST); float* listw = (float*)(P.ws + WS_LISTW);
        for (int i = tid; i < 2 * (r1 - r0); i += 512) { const int en = ent[i]; if (en >= 0) { const int e = en & 0xff, li = en >> 8; const size_t at = (size_t)e * LISTCAP + lbase[e] + li; list[at] = (r0 + (i >> 1)) * 2 + (i & 1); listw[at] = entw[i]; } }
    }
    __syncthreads();
}

__device__ __forceinline__ void attn_naive_item(const Ptrs& P, int row, int h, LAS float* qs, int lane) {
    const bf16_t* Z = (const bf16_t*)(P.ws + WS_Z); bf16_t* A2m = (bf16_t*)(P.ws + WS_A2M);
    const int b = row / LB, p = row - b * LB, rowb = b * LB;
    const bf16_t* zq = Z + Z1AT(row, 512 + h * 128);
    qs[lane] = bf2f(zq[lane]); qs[64 + lane] = bf2f(zq[64 + lane]);
    asm volatile("s_waitcnt lgkmcnt(0)" ::: "memory");
    const float slope2 = exp2f(-2.f * (float)(h + 1)) * LOG2E;
    float m0 = -INFINITY, m1 = -INFINITY, l0 = 0.f, l1 = 0.f, o00 = 0.f, o01 = 0.f, o10 = 0.f, o11 = 0.f;
    for (int j0 = 0; j0 <= p; j0 += 64) {
        const int j = j0 + lane; const bool valid = j <= p; float s0 = -INFINITY, s1 = -INFINITY;
        if (valid) { const u32x4* kr = (const u32x4*)(Z + Z1AT(rowb + j, 1024 + h * 128)); float d0 = 0.f, d1 = 0.f;
#pragma unroll
            for (int c = 0; c < 8; ++c) { const u32x4 kv = kr[c]; const LAS float* q = qs + 8 * c;
                d0 += q[0] * bflo(kv.x) + q[1] * bfhi(kv.x) + q[2] * bflo(kv.y) + q[3] * bfhi(kv.y) + q[4] * bflo(kv.z) + q[5] * bfhi(kv.z) + q[6] * bflo(kv.w) + q[7] * bfhi(kv.w); }
#pragma unroll
            for (int c = 8; c < 16; ++c) { const u32x4 kv = kr[c]; const LAS float* q = qs + 8 * c;
                d1 += q[0] * bflo(kv.x) + q[1] * bfhi(kv.x) + q[2] * bflo(kv.y) + q[3] * bfhi(kv.y) + q[4] * bflo(kv.z) + q[5] * bfhi(kv.z) + q[6] * bflo(kv.w) + q[7] * bfhi(kv.w); }
            const float bias = -slope2 * (float)(p - j); s0 = d0 + bias; s1 = d1 + bias; }
        const float mn0 = fmaxf(m0, wave_max(s0)), mn1 = fmaxf(m1, wave_max(s1));
        const float f0 = exp2f(m0 - mn0), f1 = exp2f(m1 - mn1);
        const float p0 = valid ? exp2f(s0 - mn0) : 0.f, p1 = valid ? exp2f(s1 - mn1) : 0.f;
        l0 = l0 * f0 + wave_sum(p0); l1 = l1 * f1 + wave_sum(p1); o00 *= f0; o01 *= f0; o10 *= f1; o11 *= f1; m0 = mn0; m1 = mn1;
        const int nk = (p - j0 + 1) < 64 ? (p - j0 + 1) : 64;
        const bf16_t* vr = Z + Z1AT(rowb + j0, 1536 + h * 128 + lane);
        for (int jj = 0; jj < nk; ++jj) { const float a0 = __shfl(p0, jj), a1 = __shfl(p1, jj); const float v0 = bf2f(vr[(size_t)jj * 256]), v1 = bf2f(vr[(size_t)jj * 256 + 64]);
            o00 += a0 * v0; o01 += a0 * v1; o10 += a1 * v0; o11 += a1 * v1; }
    }
    const float lam = ((const float*)(P.ws + WS_MISC))[0];
    const float a0 = o00 / l0 - lam * o10 / l1, a1 = o01 / l0 - lam * o11 / l1;
    const float r = 1.f / sqrtf(wave_sum(a0 * a0 + a1 * a1) * (1.f / 128.f) + RMS_EPS);
    bf16_t* o = A2m + (size_t)(b * NMETA + p) * D + 512 + h * 128;
    o[lane] = (bf16_t)f2bf(a0 * r * P.subln[lane] * (1.f - LAMBDA_INIT)); o[64 + lane] = (bf16_t)f2bf(a1 * r * P.subln[64 + lane] * (1.f - LAMBDA_INIT));
}

namespace att {
typedef short s16x4 __attribute__((ext_vector_type(4)));
typedef short v4i16_t __attribute__((ext_vector_type(4)));
constexpr int KSLOT = 8192, VSLOT = 16384, NBUF = 2;
constexpr int LDS_K = 0, LDS_V = NBUF * KSLOT, LDS_WS = LDS_V + NBUF * VSLOT, LDS_OST = LDS_WS + 2048, LDS_TOTAL = LDS_OST + 8 * 8192;
static_assert(LDS_TOTAL <= 131072, "attention LDS");
constexpr float THR = 8.f;
__device__ __forceinline__ int crow(int r, int hi) { return (r & 3) + 8 * (r >> 2) + 4 * hi; }
__device__ __forceinline__ float swapmax(float v) { auto rr = __builtin_amdgcn_permlane32_swap(__float_as_uint(v), __float_as_uint(v), false, false); return fmaxf(__uint_as_float(rr[0]), __uint_as_float(rr[1])); }
__device__ __forceinline__ float swapsum(float v) { auto rr = __builtin_amdgcn_permlane32_swap(__float_as_uint(v), __float_as_uint(v), false, false); return __uint_as_float(rr[0]) + __uint_as_float(rr[1]); }
#define VTR_A(dst, base, off) asm volatile("ds_read_b64_tr_b16 %0, %1 offset:%2" : "=v"(dst) : "v"(base), "n"(off))
#define VTR_WAIT(n, a, b) asm volatile("s_waitcnt lgkmcnt(%2)" : "+v"(a), "+v"(b) : "n"(n))
__device__ __forceinline__ s16x4 vtr(const LAS unsigned char* p) { return __builtin_bit_cast(s16x4, __builtin_amdgcn_ds_read_tr16_b64_v4i16((LAS v4i16_t*)p)); }

__device__ __forceinline__ void glds16(const void* gsrc, unsigned lds_dst) { unsigned keep;
    asm volatile("s_mov_b32 %0, m0\n\ts_mov_b32 m0, %2\n\ts_nop 0\n\tglobal_load_lds_dwordx4 %1, off\n\ts_mov_b32 m0, %0" : "=&s"(keep) : "v"(gsrc), "s"(lds_dst) : "memory"); }
#define ATT_WAITBAR() asm volatile("s_waitcnt vmcnt(0) lgkmcnt(0)\n\ts_barrier" ::: "memory")
#define ATT_WAITBAR_N(n) asm volatile("s_waitcnt vmcnt(" #n ") lgkmcnt(0)\n\ts_barrier" ::: "memory")
constexpr int PD = 3, K4 = PD + 1, V3 = PD + 2;
constexpr int L2_K = 0, L2_V = K4 * KSLOT, L2_WS = L2_V + V3 * VSLOT, L2_TOTAL = L2_WS + 2048, L2_OST = 0;
static_assert(L2_TOTAL + 128 <= 131072 && 8 * 8192 <= L2_WS, "attention v2 LDS");
__device__ __forceinline__ unsigned short bfr(float f) { return (unsigned short)f2bf(f); }
__device__ __forceinline__ void attn_unit(const Ptrs& P, LAS unsigned char* lds, int b, int vh, int qb) {
    const int tid = tid_opaque(P), lane = tid & 63, r32 = lane & 31, hi = lane >> 5; const int wid = __builtin_amdgcn_readfirstlane(tid >> 6);
    const bf16_t* Z = (const bf16_t*)(P.ws + WS_Z); bf16_t* Ob = (bf16_t*)(P.ws + WS_OA);
    const int rowb = b * LB, hd = vh >> 1;
    const int qrow0 = rowb + NMETA + 256 * qb + 32 * wid;
    const bf16_t* Kc = Z + (size_t)(4 + (vh >> 2)) * M1 * 256 + (vh & 3) * 64; const bf16_t* Vc = Z + (size_t)(6 + (hd >> 1)) * M1 * 256 + (hd & 1) * 128;
    const float slope2 = __uint_as_float(__builtin_amdgcn_readfirstlane(__float_as_uint(exp2f(-2.f * (float)(hd + 1)) * LOG2E)));
    LAS float* wsf = (LAS float*)(lds + L2_WS) + wid * 64;
    bf16x8 qr[4];
    { const bf16_t* qp = Z + Z1AT(qrow0 + r32, 512 + vh * 64 + hi * 8);
#pragma unroll
        for (int ks = 0; ks < 4; ++ks) qr[ks] = *(const bf16x8*)(qp + ks * 16); }
#define ATT_KROW0(i) (((i) >= NR) ? rowb : rowb + NMETA + 64 * (4 * qb + 3 - (i)))
#define ATT_PK0(i) (((i) >= NR) ? 0 : NMETA + 64 * (4 * qb + 3 - (i)))
#define ATT_DMA(i) do { const int kr0_ = ATT_KROW0(i); const int ks_ = (i) % K4, vs_ = (i) % V3; \
        glds16(Kc + (unsigned)(kr0_ + krow_) * 256u + kchk_ * 8, (unsigned)__builtin_amdgcn_readfirstlane((int)(lds0 + L2_K + ks_ * KSLOT + wid * 1024))); \
        _Pragma("unroll") for (int i_ = 0; i_ < 2; ++i_) { const int pc_ = wid * 2 + i_, db_ = pc_ >> 2, rg_ = pc_ & 3; \
            glds16(Vc + (unsigned)(kr0_ + 16 * rg_ + (lane >> 2)) * 256u + db_ * 32 + (lane & 3) * 8, (unsigned)__builtin_amdgcn_readfirstlane((int)(lds0 + L2_V + vs_ * VSLOT + pc_ * 1024))); } } while (0)
    const unsigned lds0 = (unsigned)(size_t)lds;
    const int krow_ = 8 * wid + (lane >> 3), kchk_ = (lane & 7) ^ ((krow_ >> 1) & 7);
    int koff[4];
#pragma unroll
    for (int ks = 0; ks < 4; ++ks) koff[ks] = r32 * 128 + (((2 * ks + hi) ^ ((r32 >> 1) & 7)) << 4);
    int NR = 1 << 30, NT;
    ATT_DMA(0); ATT_DMA(1); ATT_DMA(2);
    const unsigned* kn = (const unsigned*)(P.ws + WS_CTL) + CW_KN;
    const int kl_ = lane < 6 ? lane : 0; const unsigned kw_ = __hip_atomic_load(kn + (kl_ < 2 ? (b * 8 + vh) * 2 + kl_ : 64 + vh * 4 + (kl_ - 2)), __ATOMIC_RELAXED, __HIP_MEMORY_SCOPE_AGENT);
    { float qs = 0.f;
#pragma unroll
        for (int ks = 0; ks < 4; ++ks) { const u32x4 w = __builtin_bit_cast(u32x4, qr[ks]);
#pragma unroll
            for (int j = 0; j < 4; ++j) { const float a_ = bflo(w[j]), b_ = bfhi(w[j]); qs += a_ * a_ + b_ * b_; } }
        qs = swapsum(qs);
#pragma unroll
        for (int o_ = 1; o_ < 32; o_ <<= 1) qs = fmaxf(qs, __shfl_xor(qs, o_));
        if (lane == 0) wsf[0] = qs;
        ATT_WAITBAR();
        float q2 = 0.f;
#pragma unroll
        for (int w_ = 0; w_ < 8; ++w_) q2 = fmaxf(q2, ((LAS float*)(lds + L2_WS))[w_ * 64]);
        const float k2r = __uint_as_float(__builtin_amdgcn_readlane(kw_, 0)) + __uint_as_float(__builtin_amdgcn_readlane(kw_, 1));
        const float k2m = __uint_as_float(__builtin_amdgcn_readlane(kw_, 2)) + __uint_as_float(__builtin_amdgcn_readlane(kw_, 3)) + __uint_as_float(__builtin_amdgcn_readlane(kw_, 4)) + __uint_as_float(__builtin_amdgcn_readlane(kw_, 5));
        const float QK = sqrtf(q2 * fmaxf(k2r, k2m) * 1.02f) * 1.01f + 1.f;
        const float dist = (151.f + 2.f * QK) / slope2;
        int tskip = (int)floorf(((float)(256 * qb - 63) - dist) * (1.f / 64.f)); tskip = tskip < -1 ? -1 : tskip;
        NR = 4 * qb + 3 - tskip; const bool hasm = (float)(NMETA + 256 * qb - 15) <= dist;
        NR = __builtin_amdgcn_readfirstlane(NR); NT = NR + (__builtin_amdgcn_readfirstlane((int)hasm) ? 1 : 0); }
    const int qrel = 32 * wid + r32, pq = NMETA + 256 * qb + qrel;
    float l = 0.f, cin = 0.f;
#define ATT_SETC() do { } while (0)
    f32x16 o[4];
#pragma unroll
    for (int d = 0; d < 4; ++d) o[d] = f32x16{};
    u32x4 pw[4];
    f32x16 p0, p1;
    const LAS unsigned char* vpl = lds + L2_V + ((lane >> 4) & 1) * 32 + (lane & 3) * 8 + (4 * hi + ((lane & 15) >> 2)) * 64;
#define ATT_QK(i) do { bf16x8 kf_[8];     \
        { const LAS unsigned char* kb_ = lds + L2_K + ((i) % K4) * KSLOT; \
          _Pragma("unroll") for (int ks = 0; ks < 4; ++ks) { kf_[2 * ks] = *(const LAS bf16x8*)(kb_ + koff[ks]); kf_[2 * ks + 1] = *(const LAS bf16x8*)(kb_ + koff[ks] + 4096); } } \
        __builtin_amdgcn_sched_barrier(0); \
        { const float cl_ = slope2 * (float)(ATT_PK0(i) + 4 * hi - pq) + cin, s32_ = 32.f * slope2; \
          _Pragma("unroll") for (int r = 0; r < 16; ++r) { p0[r] = fmaf(slope2, (float)((r & 3) + 8 * (r >> 2)), cl_); p1[r] = p0[r] + s32_; } } \
        _Pragma("unroll") for (int ks = 0; ks < 4; ++ks) { \
            p0 = __builtin_amdgcn_mfma_f32_32x32x16_bf16(kf_[2 * ks], qr[ks], p0, 0, 0, 0); p1 = __builtin_amdgcn_mfma_f32_32x32x16_bf16(kf_[2 * ks + 1], qr[ks], p1, 0, 0, 0); } \
        if ((i) < 4 || (i) >= NR) { const int lim_ = (((i) >= NR) ? 15 : qrel - 64 * (3 - (i))) - 4 * hi;     \
            _Pragma("unroll") for (int r = 0; r < 16; ++r) { const int kv = (r & 3) + 8 * (r >> 2); if (kv > lim_) p0[r] = -INFINITY; if (kv + 32 > lim_) p1[r] = -INFINITY; } } } while (0)
#define ATT_PV(vslot) do { const LAS unsigned char* vp_ = vpl + (vslot) * VSLOT; \
        _Pragma("unroll") for (int s2_ = 0; s2_ < 4; ++s2_) { s16x4 vq_[8]; \
            _Pragma("unroll") for (int d = 0; d < 4; ++d) { vq_[2 * d] = vtr(vp_ + d * 4096 + s2_ * 1024); vq_[2 * d + 1] = vtr(vp_ + d * 4096 + s2_ * 1024 + 512); } \
            _Pragma("unroll") for (int d = 0; d < 4; ++d) { const bf16x8 vf = (bf16x8){vq_[2 * d][0], vq_[2 * d][1], vq_[2 * d][2], vq_[2 * d][3], vq_[2 * d + 1][0], vq_[2 * d + 1][1], vq_[2 * d + 1][2], vq_[2 * d + 1][3]}; \
                o[d] = __builtin_amdgcn_mfma_f32_32x32x16_bf16(__builtin_bit_cast(bf16x8, pw[s2_]), vf, o[d], 0, 0, 0); } } } while (0)
#define ATT_ROWMAX(mx) do { float a_ = fmaxf(p0[0], p1[0]); _Pragma("unroll") for (int r = 1; r < 16; ++r) a_ = fmaxf(a_, fmaxf(p0[r], p1[r])); mx = swapmax(a_); } while (0)
#define ATT_IMAX(im) do { int a_ = __float_as_int(p0[0]); _Pragma("unroll") for (int r = 1; r < 16; ++r) { const int b_ = __float_as_int(p0[r]); a_ = a_ > b_ ? a_ : b_; } \
        _Pragma("unroll") for (int r = 0; r < 16; ++r) { const int b_ = __float_as_int(p1[r]); a_ = a_ > b_ ? a_ : b_; } im = a_; } while (0)
#define ATT_EXP_PACK() do { float sacc = 0.f; \
        _Pragma("unroll") for (int r = 0; r < 16; ++r) { p0[r] = __builtin_amdgcn_exp2f(p0[r]); p1[r] = __builtin_amdgcn_exp2f(p1[r]); sacc += p0[r] + p1[r]; } \
        l += sacc; \
        _Pragma("unroll") for (int j = 0; j < 4; ++j) { pw[0][j] = cvt_pk_bf16(p0[2 * j], p0[2 * j + 1]); pw[1][j] = cvt_pk_bf16(p0[8 + 2 * j], p0[8 + 2 * j + 1]); \
            pw[2][j] = cvt_pk_bf16(p1[2 * j], p1[2 * j + 1]); pw[3][j] = cvt_pk_bf16(p1[8 + 2 * j], p1[8 + 2 * j + 1]); } } while (0)
    f32x16 q0, q1;
    ATT_WAITBAR_N(6);
    ATT_QK(0);
    { float mx; ATT_ROWMAX(mx); const float d0 = fmaxf(mx, -256.f); cin -= d0;
#pragma unroll
        for (int r = 0; r < 16; ++r) { p0[r] = __builtin_amdgcn_exp2f(p0[r] - d0); p1[r] = __builtin_amdgcn_exp2f(p1[r] - d0); } }
#define ATT_PACK4(O0, O1, g) do { const int b_ = (((g) >> 1) * 8 + ((g) & 1) * 4) & 15; \
        if ((g) < 4) { pw[(g) >> 1][2 * ((g) & 1)] = cvt_pk_bf16(O0[b_], O0[b_ + 1]); pw[(g) >> 1][2 * ((g) & 1) + 1] = cvt_pk_bf16(O0[b_ + 2], O0[b_ + 3]); sacc += (O0[b_] + O0[b_ + 1]) + (O0[b_ + 2] + O0[b_ + 3]); } \
        else { pw[(g) >> 1][2 * ((g) & 1)] = cvt_pk_bf16(O1[b_], O1[b_ + 1]); pw[(g) >> 1][2 * ((g) & 1) + 1] = cvt_pk_bf16(O1[b_ + 2], O1[b_ + 3]); sacc += (O1[b_] + O1[b_ + 1]) + (O1[b_ + 2] + O1[b_ + 3]); } \
        asm volatile("" : "+v"(pw[(g) >> 1][2 * ((g) & 1)]), "+v"(pw[(g) >> 1][2 * ((g) & 1) + 1]), "+v"(sacc)); } while (0)
#define ATT_STEP(i, N0, N1, O0, O1) do { \
        { bf16x8 kf_[8]; float sacc = 0.f; \
          { const LAS unsigned char* kb_ = lds + L2_K + ((i) % K4) * KSLOT; \
            _Pragma("unroll") for (int ks = 0; ks < 4; ++ks) { kf_[2 * ks] = *(const LAS bf16x8*)(kb_ + koff[ks]); kf_[2 * ks + 1] = *(const LAS bf16x8*)(kb_ + koff[ks] + 4096); } } \
          __builtin_amdgcn_sched_barrier(0); \
          { const float cl_ = slope2 * (float)(ATT_PK0(i) + 4 * hi - pq) + cin, s32_ = 32.f * slope2; \
            _Pragma("unroll") for (int r = 0; r < 16; ++r) { N0[r] = fmaf(slope2, (float)((r & 3) + 8 * (r >> 2)), cl_); N1[r] = N0[r] + s32_; } } \
          _Pragma("unroll") for (int ks = 0; ks < 4; ++ks) { \
              N0 = __builtin_amdgcn_mfma_f32_32x32x16_bf16(kf_[2 * ks], qr[ks], N0, 0, 0, 0); ATT_PACK4(O0, O1, 2 * ks); __builtin_amdgcn_sched_barrier(0); \
              N1 = __builtin_amdgcn_mfma_f32_32x32x16_bf16(kf_[2 * ks + 1], qr[ks], N1, 0, 0, 0); ATT_PACK4(O0, O1, 2 * ks + 1); __builtin_amdgcn_sched_barrier(0); } \
          l += sacc; \
          if ((i) < 4 || (i) >= NR) { const int lim_ = (((i) >= NR) ? 15 : qrel - 64 * (3 - (i))) - 4 * hi; \
              _Pragma("unroll") for (int r = 0; r < 16; ++r) { const int kv = (r & 3) + 8 * (r >> 2); if (kv > lim_) N0[r] = -INFINITY; if (kv + 32 > lim_) N1[r] = -INFINITY; } } } \
        unsigned vp_ = (unsigned)(size_t)vpl + (unsigned)((((i) - 1) % V3) * VSLOT); asm volatile("" : "+v"(vp_)); \
        s16x4 vq[2][8]; \
        _Pragma("unroll") for (int d = 0; d < 4; ++d) { VTR_A(vq[0][2 * d], vp_, d * 4096); VTR_A(vq[0][2 * d + 1], vp_, d * 4096 + 512); } \
        __builtin_amdgcn_sched_barrier(0); \
        int imx; { int a_ = __float_as_int(N0[0]); _Pragma("unroll") for (int r = 1; r < 16; ++r) { const int b_ = __float_as_int(N0[r]); a_ = a_ > b_ ? a_ : b_; } \
            _Pragma("unroll") for (int r = 0; r < 16; ++r) { const int b_ = __float_as_int(N1[r]); a_ = a_ > b_ ? a_ : b_; } imx = a_; } \
        if (__any(imx > __builtin_bit_cast(int, THR))) { \
            float mx; { float a_ = fmaxf(N0[0], N1[0]); _Pragma("unroll") for (int r = 1; r < 16; ++r) a_ = fmaxf(a_, fmaxf(N0[r], N1[r])); mx = swapmax(a_); } \
            const float dl = ceilf(fmaxf(mx, 0.f)), f = __builtin_amdgcn_exp2f(-dl); cin -= dl; l *= f; \
            if (hi == 0) wsf[r32] = f; \
            asm volatile("s_waitcnt lgkmcnt(0)" ::: "memory"); \
            _Pragma("unroll") for (int r = 0; r < 16; ++r) { const float fr_ = wsf[crow(r, hi)]; N0[r] -= dl; N1[r] -= dl; \
                _Pragma("unroll") for (int d = 0; d < 4; ++d) o[d][r] *= fr_; } \
            const unsigned du = (unsigned)dl; \
            _Pragma("unroll") for (int s2_ = 0; s2_ < 4; ++s2_) _Pragma("unroll") for (int j = 0; j < 4; ++j) { const unsigned w = pw[s2_][j]; unsigned lo = w & 0xffffu, hh = w >> 16; \
                    lo = (((lo >> 7) & 0xffu) > du) ? lo - (du << 7) : 0u; hh = (((hh >> 7) & 0xffu) > du) ? hh - (du << 7) : 0u; pw[s2_][j] = lo | (hh << 16); } \
        } \
        _Pragma("unroll") for (int s2_ = 0; s2_ < 4; ++s2_) { \
            if (s2_ < 3) { _Pragma("unroll") for (int d = 0; d < 4; ++d) { VTR_A(vq[(s2_ + 1) & 1][2 * d], vp_, d * 4096 + (s2_ + 1) * 1024); VTR_A(vq[(s2_ + 1) & 1][2 * d + 1], vp_, d * 4096 + (s2_ + 1) * 1024 + 512); } } \
            __builtin_amdgcn_sched_barrier(0); \
            _Pragma("unroll") for (int d = 0; d < 4; ++d) { VTR_WAIT((s2_ < 3 ? 8 : 0) + 6 - 2 * d, vq[s2_ & 1][2 * d], vq[s2_ & 1][2 * d + 1]); \
                const s16x4 lo = vq[s2_ & 1][2 * d], h4 = vq[s2_ & 1][2 * d + 1]; \
                const bf16x8 vf = (bf16x8){lo[0], lo[1], lo[2], lo[3], h4[0], h4[1], h4[2], h4[3]}; \
                o[d] = __builtin_amdgcn_mfma_f32_32x32x16_bf16(__builtin_bit_cast(bf16x8, pw[s2_]), vf, o[d], 0, 0, 0); \
                const int e_ = s2_ * 4 + d; \
                if (e_ < 8) { float x0_ = __builtin_amdgcn_exp2f(N0[2 * e_]), x1_ = __builtin_amdgcn_exp2f(N0[2 * e_ + 1]); asm volatile("" : "+v"(x0_), "+v"(x1_)); N0[2 * e_] = x0_; N0[2 * e_ + 1] = x1_; }     \
                else { float x0_ = __builtin_amdgcn_exp2f(N1[(2 * e_) & 15]), x1_ = __builtin_amdgcn_exp2f(N1[(2 * e_ + 1) & 15]); asm volatile("" : "+v"(x0_), "+v"(x1_)); N1[(2 * e_) & 15] = x0_; N1[(2 * e_ + 1) & 15] = x1_; } } \
            __builtin_amdgcn_sched_barrier(0); } } while (0)
    { int i = 1;
        for (; i + 1 < NT; i += 2) { ATT_WAITBAR_N(0); if (i + 2 < NT) ATT_DMA(i + 2); if (i + 3 < NT) ATT_DMA(i + 3);
            ATT_STEP(i, q0, q1, p0, p1); ATT_STEP(i + 1, p0, p1, q0, q1); }
        if (i < NT) { ATT_WAITBAR_N(0); ATT_STEP(i, q0, q1, p0, p1); float sacc = 0.f;
#pragma unroll
            for (int g = 0; g < 8; ++g) ATT_PACK4(q0, q1, g);
            l += sacc; }
        else { float sacc = 0.f;
#pragma unroll
            for (int g = 0; g < 8; ++g) ATT_PACK4(p0, p1, g);
            l += sacc; } }
#undef ATT_STEP
#undef ATT_PACK4
    ATT_PV((NT - 1) % V3);
    l = swapsum(l);
    if (hi == 0) wsf[32 + r32] = l;
    ATT_WAITBAR();
    LAS bf16_t* stg = (LAS bf16_t*)(lds + L2_OST + wid * 8192);
    int lane_e = lane; asm volatile("" : "+v"(lane_e));
    const int r32e = lane_e & 31, hie = lane_e >> 5;
#pragma unroll
    for (int r = 0; r < 16; ++r) { const int orow = crow(r, hie); const float rl = 1.f / wsf[32 + orow];
#pragma unroll
        for (int d = 0; d < 4; ++d) stg[orow * 128 + d * 32 + r32e] = (bf16_t)f2bf(o[d][r] * rl); }
    asm volatile("s_waitcnt lgkmcnt(0)" ::: "memory");
#pragma unroll
    for (int i = 0; i < 8; ++i) { const int row = i * 4 + (lane_e >> 4), ch = lane_e & 15; const u32x4 v = *(const LAS u32x4*)(stg + row * 128 + ch * 8);
        *(u32x4*)(Ob + (size_t)(qrow0 + row) * D + vh * 128 + ch * 8) = v; }
    asm volatile("s_waitcnt lgkmcnt(0)\n\ts_barrier" ::: "memory");
#undef ATT_DMA
#undef ATT_KROW0
#undef ATT_PK0
#undef ATT_QK
#undef ATT_PV
#undef ATT_ROWMAX
#undef ATT_IMAX
#undef ATT_EXP_PACK
#undef ATT_SETC
}
}

__device__ __forceinline__ void stage_attn(const Ptrs& P, LAS unsigned char* lds, int wg, int nwg, int flags) {
    const int tid_ = tid_opaque(P); const int lane = tid_ & 63, wave = __builtin_amdgcn_readfirstlane(tid_ >> 6);
    if (!(flags & 2)) { LAS float* qs = (LAS float*)(lds) + wave * 128;
        for (int it = wg * 8 + wave; it < NB * NMETA * 4; it += nwg * 8) { const int rr = it >> 2; attn_naive_item(P, (rr >> 4) * LB + (rr & 15), it & 3, qs, lane); }
        }
    __syncthreads();
    if (nwg == 256 && wg >= 192 && !(flags & 2)) { prep_items(P, lds, PREP_EARLY, PREP_NITEMS, (wg - 192) * 8 + wave, 64 * 8, lane, wave); prep_fold(P, (wg - 192) * 8 + wave, 64 * 8, lane); __syncthreads(); }
    if (flags & 1) return;
    unsigned* qhead = (unsigned*)(P.ws + WS_CTL) + CW_AQ; LAS int* qslot = (LAS int*)(lds + att::L2_TOTAL + 64);
    for (;;) {
        if (tid_ == 0) qslot[0] = (int)atomicAdd(qhead, 1u);
        __syncthreads();
        const int L = __builtin_amdgcn_readfirstlane(qslot[0]);
        __syncthreads();
        if (L >= 1024) break;
        int b, vh, qb;
        if (L < 512) { qb = 31 - (L >> 4); b = (L >> 2) & 3; vh = 4 + (L & 3); }
        else { const int j = L & 255; qb = 31 - (j >> 3); b = (j >> 1) & 3; vh = (L < 768 ? 2 : 0) + (j & 1); }
        att::attn_unit(P, lds, b, vh, qb); }
}
__device__ __forceinline__ void stage_combine(const Ptrs& P, int wg, int nwg) {
    const int tid_ = tid_opaque(P); const int lane = tid_ & 63, wave = __builtin_amdgcn_readfirstlane(tid_ >> 6); const bf16_t* Ob = (const bf16_t*)(P.ws + WS_OA); unsigned char* A28 = P.ws + WS_A2;
    const float lam = ((const float*)(P.ws + WS_MISC))[0]; const int h = lane >> 4, c = (lane & 15) * 8;
    float sw[8];
#pragma unroll
    for (int j = 0; j < 8; ++j) sw[j] = P.subln[c + j] * (1.f - LAMBDA_INIT);
    for (int rr0 = (wg * 8 + wave) * 4; rr0 < NB * SEQ; rr0 += nwg * 8 * 4) {
        u32x4 av[4], bv[4];
#pragma unroll
        for (int q = 0; q < 4; ++q) { const int rr = rr0 + q, row = (rr >> 13) * LB + NMETA + (rr & 8191);
            av[q] = *(const u32x4*)(Ob + (size_t)row * D + (2 * h) * 128 + c); bv[q] = *(const u32x4*)(Ob + (size_t)row * D + (2 * h + 1) * 128 + c); }
#pragma unroll
        for (int q = 0; q < 4; ++q) { const int rr = rr0 + q, row = (rr >> 13) * LB + NMETA + (rr & 8191); const u32x4 a = av[q], bb = bv[q];
            float v[8]; v[0] = bflo(a.x) - lam * bflo(bb.x); v[1] = bfhi(a.x) - lam * bfhi(bb.x); v[2] = bflo(a.y) - lam * bflo(bb.y); v[3] = bfhi(a.y) - lam * bfhi(bb.y);
            v[4] = bflo(a.z) - lam * bflo(bb.z); v[5] = bfhi(a.z) - lam * bfhi(bb.z); v[6] = bflo(a.w) - lam * bflo(bb.w); v[7] = bfhi(a.w) - lam * bfhi(bb.w);
            float ss = 0.f;
#pragma unroll
            for (int j = 0; j < 8; ++j) ss += v[j] * v[j];
            ss += __shfl_xor(ss, 1); ss += __shfl_xor(ss, 2); ss += __shfl_xor(ss, 4); ss += __shfl_xor(ss, 8);
            const float r = __builtin_amdgcn_rsqf(ss * (1.f / 128.f) + RMS_EPS);
            const float rr_ = r * F8_ASCALE; u32x2 o; o.x = pk4_fp8(v[0] * rr_ * sw[0], v[1] * rr_ * sw[1], v[2] * rr_ * sw[2], v[3] * rr_ * sw[3]); o.y = pk4_fp8(v[4] * rr_ * sw[4], v[5] * rr_ * sw[5], v[6] * rr_ * sw[6], v[7] * rr_ * sw[7]);
            *(u32x2*)(A28 + (size_t)row * D + 512 + h * 128 + c) = o; } }
}

namespace gla {
 using att::s16x4; using att::vtr; using att::crow;
constexpr int LQD = 0, LKD = 16384, LKW = 32768, LP = 49152, LV = 58368, LOS = 91136, LEB = 124928, LHN = LEB + 1024, LGL = LHN + 1024, LEND = LGL + 4096;
static_assert(LEND <= 131072, "gla LDS");
constexpr int PST = 144, OST = 528;
constexpr size_t U_BYTES = (size_t)128 * 256 * 4;
__device__ __forceinline__ float* u_slot(const Ptrs& P, int bh, int seg) { return (float*)(P.ws + WS_OA + ((size_t)bh * 16 + seg) * U_BYTES); }
__device__ __forceinline__ float* a_slot(const Ptrs& P, int bh, int seg) { return (float*)(P.ws + WS_OA + (size_t)256 * U_BYTES) + ((size_t)bh * 16 + seg) * 128; }
__device__ __forceinline__ float* eb_slot(const Ptrs& P, int b, int cidx) { return (float*)(P.ws + WS_OA + (size_t)256 * U_BYTES + 262144) + ((size_t)b * 129 + cidx) * 512; }

constexpr int PRE_W2 = 0, PRE_TOT = 32768;
__device__ __forceinline__ void pre_chunk(const Ptrs& P, LAS unsigned char* lds, int tid, int r0, int nrows, float* eb, const float (&gb)[8]) {
    const int lane = tid & 63; const int w = __builtin_amdgcn_readfirstlane(tid >> 6);
    bf16_t* Z = (bf16_t*)(P.ws + WS_Z); const float* GLR = (const float*)(P.ws + WS_GLR); LAS float* gl = (LAS float*)(lds + LGL);
    const LAS f32x4* w2l = (const LAS f32x4*)(lds + PRE_W2); LAS f32x4* totl = (LAS f32x4*)(lds + PRE_TOT);
    const int nact = nrows >> 3; const bool act = w < nact;
    bf16_t* zq = Z + Z1AT(r0 + 8 * w, 8 * lane); bf16_t* zk = Z + Z1AT(r0 + 8 * w, 512 + 8 * lane);
#define PRE_BAR() asm volatile("s_waitcnt lgkmcnt(0)\n\ts_barrier" ::: "memory")
    u32x4 qv[8], kv[8];
    const f32x4 glr = ((const f32x4*)(GLR + (size_t)r0 * 16))[tid & 255];
    __builtin_amdgcn_sched_barrier(0);
#pragma unroll
    for (int t = 0; t < 8; ++t) { qv[t] = *(const u32x4*)(zq + t * 256); kv[t] = *(const u32x4*)(zk + t * 256); }
    __builtin_amdgcn_sched_barrier(0);
    ((LAS f32x4*)gl)[tid & 255] = glr;
    PRE_BAR();
    float cum[8][8];
    if (act) {
        f32x2 c2[8][4];
#pragma unroll
        for (int t = 0; t < 8; ++t)
#pragma unroll
            for (int cp = 0; cp < 4; ++cp) c2[t][cp] = (f32x2){gb[2 * cp], gb[2 * cp + 1]};
#pragma unroll
        for (int j4 = 0; j4 < 4; ++j4) { f32x4 glv[8];
#pragma unroll
            for (int t = 0; t < 8; ++t) glv[t] = ((const LAS f32x4*)gl)[(8 * w + t) * 4 + j4];
#pragma unroll
            for (int jj = 0; jj < 4; ++jj) { const f32x4 wa = w2l[((4 * j4 + jj) * 2 + 0) * 64 + lane], wb = w2l[((4 * j4 + jj) * 2 + 1) * 64 + lane];
#pragma unroll
                for (int t = 0; t < 8; ++t) { const float sg = glv[t][jj]; const f32x2 s2 = (f32x2){sg, sg};
                    c2[t][0] = __builtin_elementwise_fma(s2, (f32x2){wa[0], wa[1]}, c2[t][0]); c2[t][1] = __builtin_elementwise_fma(s2, (f32x2){wa[2], wa[3]}, c2[t][1]);
                    c2[t][2] = __builtin_elementwise_fma(s2, (f32x2){wb[0], wb[1]}, c2[t][2]); c2[t][3] = __builtin_elementwise_fma(s2, (f32x2){wb[2], wb[3]}, c2[t][3]); } } }
#pragma unroll
        for (int t = 0; t < 8; ++t)
#pragma unroll
            for (int cp = 0; cp < 4; ++cp) { cum[t][2 * cp] = c2[t][cp].x; cum[t][2 * cp + 1] = c2[t][cp].y; }
#pragma unroll
        for (int ch = 0; ch < 8; ++ch) { float run = 0.f;
#pragma unroll
            for (int t = 0; t < 8; ++t) { const float g = cum[t][ch]; run += (fminf(g, 0.f) - 0.69314718f * __builtin_amdgcn_logf(1.f + __builtin_amdgcn_exp2f(fabsf(g) * -1.44269504f))) * (1.f / 16.f); cum[t][ch] = run; } }
        totl[(w * 2 + 0) * 64 + lane] = (f32x4){cum[7][0], cum[7][1], cum[7][2], cum[7][3]}; totl[(w * 2 + 1) * 64 + lane] = (f32x4){cum[7][4], cum[7][5], cum[7][6], cum[7][7]};
    }
    PRE_BAR();
    if (act) {
        float off[8];
#pragma unroll
        for (int ch = 0; ch < 8; ++ch) off[ch] = 0.f;
        for (int pw_ = 0; pw_ < w; ++pw_) { const f32x4 a = totl[(pw_ * 2 + 0) * 64 + lane], b = totl[(pw_ * 2 + 1) * 64 + lane];
            off[0] += a[0]; off[1] += a[1]; off[2] += a[2]; off[3] += a[3]; off[4] += b[0]; off[5] += b[1]; off[6] += b[2]; off[7] += b[3]; }
#pragma unroll
        for (int t = 0; t < 8; ++t) { float e[8], ie[8];
#pragma unroll
            for (int ch = 0; ch < 8; ++ch) { e[ch] = __builtin_amdgcn_exp2f((off[ch] + cum[t][ch]) * 1.44269504f); ie[ch] = __builtin_amdgcn_rcpf(e[ch]); }
            const u32x4 q = qv[t], k = kv[t]; u32x4 qo, ko;
            qo.x = cvt_pk_bf16(bflo(q.x) * e[0], bfhi(q.x) * e[1]); qo.y = cvt_pk_bf16(bflo(q.y) * e[2], bfhi(q.y) * e[3]); qo.z = cvt_pk_bf16(bflo(q.z) * e[4], bfhi(q.z) * e[5]); qo.w = cvt_pk_bf16(bflo(q.w) * e[6], bfhi(q.w) * e[7]);
            ko.x = cvt_pk_bf16(bflo(k.x) * ie[0], bfhi(k.x) * ie[1]); ko.y = cvt_pk_bf16(bflo(k.y) * ie[2], bfhi(k.y) * ie[3]); ko.z = cvt_pk_bf16(bflo(k.z) * ie[4], bfhi(k.z) * ie[5]); ko.w = cvt_pk_bf16(bflo(k.w) * ie[6], bfhi(k.w) * ie[7]);
            *(u32x4*)(zq + t * 256) = qo; *(u32x4*)(zk + t * 256) = ko; }
        if (w == nact - 1) {
            *(f32x4*)(eb + 8 * lane) = (f32x4){__expf(off[0] + cum[7][0]), __expf(off[1] + cum[7][1]), __expf(off[2] + cum[7][2]), __expf(off[3] + cum[7][3])};
            *(f32x4*)(eb + 8 * lane + 4) = (f32x4){__expf(off[4] + cum[7][4]), __expf(off[5] + cum[7][5]), __expf(off[6] + cum[7][6]), __expf(off[7] + cum[7][7])}; }
    }
    PRE_BAR();
#undef PRE_BAR
}
__device__ __forceinline__ void stage_pre(const Ptrs& P, LAS unsigned char* lds, int wg, int nwg) {
    const int tid = tid_opaque(P); const int lane = tid & 63;
    { f32x4 st_[4];
#pragma unroll
        for (int it = 0; it < 4; ++it) { const int idx = tid + it * 512, j = idx >> 7, hf = (idx >> 6) & 1, ln = idx & 63; st_[it] = *(const f32x4*)(P.gate_w2 + j * 512 + 8 * ln + 4 * hf); }
#pragma unroll
        for (int it = 0; it < 4; ++it) ((LAS f32x4*)(lds + PRE_W2))[tid + it * 512] = st_[it]; }
    float gb[8];
    { const f32x4 a = *(const f32x4*)(P.gate_b + 8 * lane), b = *(const f32x4*)(P.gate_b + 8 * lane + 4); gb[0] = a[0]; gb[1] = a[1]; gb[2] = a[2]; gb[3] = a[3]; gb[4] = b[0]; gb[5] = b[1]; gb[6] = b[2]; gb[7] = b[3]; }
    __syncthreads();
    for (int it = wg; it < NB * 128; it += nwg) { const int b = it >> 7, j = it & 127, rowb = b * LB;
        if (j == 0) pre_chunk(P, lds, tid, rowb, NMETA, eb_slot(P, b, 0), gb);
        pre_chunk(P, lds, tid, rowb + NMETA + 64 * j, 64, eb_slot(P, b, j + 1), gb); }
}

__device__ __forceinline__ void segment_state(const Ptrs& P, LAS unsigned char* lds, int bh, int seg) {
    const int tid = tid_opaque(P), lane = tid & 63, r32 = lane & 31, hi = lane >> 5; const int wid = __builtin_amdgcn_readfirstlane(tid >> 6);
    const int b = bh >> 2, h = bh & 3, rowb = b * LB;
    const bf16_t* Z = (const bf16_t*)(P.ws + WS_Z);
    const bf16_t* Zk = Z + (size_t)(2 + (h >> 1)) * M1 * 256 + (h & 1) * 128; const bf16_t* Zv = Z + (size_t)(4 + h) * M1 * 256;
    constexpr int BUF = 49152, BV = 0, BKW = 32768, BEB = 98304;
    const unsigned lds0 = (unsigned)(size_t)lds;
    f32x16 S[4];
#pragma unroll
    for (int cb = 0; cb < 4; ++cb) S[cb] = f32x16{};
    const int nch = 8 + (seg == 0 ? 1 : 0);
    const LAS unsigned char* trb = lds + ((lane >> 4) & 1) * 32 + (lane & 3) * 8 + (8 * hi + ((lane & 15) >> 2)) * 64;
#define GS_R0(ch) ((seg == 0 && (ch) == 0) ? rowb : rowb + NMETA + 64 * (seg * 8 + (ch) - (seg == 0 ? 1 : 0)))
#define GS_ISSUE(ch) do { const int r0_ = GS_R0(ch), bo_ = ((ch) & 1) * BUF; \
        _Pragma("unroll") for (int i_ = 0; i_ < 4; ++i_) { const int pc = wid * 4 + i_, db = pc >> 2, rg = pc & 3; \
            att::glds16(Zv + (unsigned)(r0_ + 16 * rg + (lane >> 2)) * 256u + db * 32 + (lane & 3) * 8, (unsigned)__builtin_amdgcn_readfirstlane((int)(lds0 + bo_ + BV + pc * 1024))); } \
        _Pragma("unroll") for (int i_ = 0; i_ < 2; ++i_) { const int pc = wid * 2 + i_, cb = pc >> 2, rg = pc & 3; \
            att::glds16(Zk + (unsigned)(r0_ + 16 * rg + (lane >> 2)) * 256u + cb * 32 + (lane & 3) * 8, (unsigned)__builtin_amdgcn_readfirstlane((int)(lds0 + bo_ + BKW + pc * 1024))); } \
        if (wid == 0) { const int cidx_ = (seg == 0 && (ch) == 0) ? 0 : seg * 8 + (ch) - (seg == 0 ? 1 : 0) + 1; \
            att::glds16(eb_slot(P, b, cidx_) + h * 128 + lane * 4, (unsigned)__builtin_amdgcn_readfirstlane((int)(lds0 + BEB + ((ch) & 1) * 1024))); } } while (0)
    GS_ISSUE(0); GS_ISSUE(1);
    float aprod = 1.f;
    for (int ch = 0; ch < nch; ++ch) {
        const int bo = (ch & 1) * BUF; const bool metac = (seg == 0 && ch == 0);
        if (ch + 1 < nch) { if (wid == 0) asm volatile("s_waitcnt vmcnt(7) lgkmcnt(0)\n\ts_barrier" ::: "memory"); else asm volatile("s_waitcnt vmcnt(6) lgkmcnt(0)\n\ts_barrier" ::: "memory"); }
        else asm volatile("s_waitcnt vmcnt(0) lgkmcnt(0)\n\ts_barrier" ::: "memory");
        const LAS float* eB = (const LAS float*)(lds + BEB + (ch & 1) * 1024);
        if (tid < 128) aprod *= eB[tid];
        const int nks = metac ? 1 : 4;
        bf16x8 vf[4];
#pragma unroll
        for (int ks = 0; ks < 4; ++ks) { const s16x4 lo = vtr(trb + bo + BV + (wid * 4 + ks) * 1024), h4 = vtr(trb + bo + BV + (wid * 4 + ks) * 1024 + 256); vf[ks] = (bf16x8){lo[0], lo[1], lo[2], lo[3], h4[0], h4[1], h4[2], h4[3]}; }
#pragma unroll
        for (int cb = 0; cb < 4; ++cb) {
#pragma unroll
            for (int ks = 0; ks < 4; ++ks) if (ks < nks) { const s16x4 lo = vtr(trb + bo + BKW + (cb * 4 + ks) * 1024), h4 = vtr(trb + bo + BKW + (cb * 4 + ks) * 1024 + 256);
                const bf16x8 kf = (bf16x8){lo[0], lo[1], lo[2], lo[3], h4[0], h4[1], h4[2], h4[3]};
                S[cb] = __builtin_amdgcn_mfma_f32_32x32x16_bf16(kf, vf[ks], S[cb], 0, 0, 0); }
#pragma unroll
            for (int g = 0; g < 4; ++g) { const f32x4 e4 = *(const LAS f32x4*)(eB + 32 * cb + 8 * g + 4 * hi); S[cb][4 * g] *= e4.x; S[cb][4 * g + 1] *= e4.y; S[cb][4 * g + 2] *= e4.z; S[cb][4 * g + 3] *= e4.w; } }
        asm volatile("s_waitcnt lgkmcnt(0)\n\ts_barrier" ::: "memory");
        if (ch + 2 < nch) GS_ISSUE(ch + 2);
    }
#undef GS_ISSUE
#undef GS_R0
    float* u = u_slot(P, bh, seg);
#pragma unroll
    for (int cb = 0; cb < 4; ++cb)
#pragma unroll
        for (int r = 0; r < 16; ++r) u[(size_t)(32 * cb + crow(r, hi)) * 256 + 32 * wid + r32] = S[cb][r];
    if (tid < 128) a_slot(P, bh, seg)[tid] = aprod;
    asm volatile("s_waitcnt vmcnt(0) lgkmcnt(0)\n\ts_barrier" ::: "memory");
}
__device__ __forceinline__ void segment_out(const Ptrs& P, LAS unsigned char* lds, int bh, int seg) {
    const int tid = tid_opaque(P), lane = tid & 63, r32 = lane & 31, hi = lane >> 5; const int wid = __builtin_amdgcn_readfirstlane(tid >> 6);
    const int b = bh >> 2, h = bh & 3, rowb = b * LB;
    const bf16_t* Z = (const bf16_t*)(P.ws + WS_Z); unsigned char* A28 = P.ws + WS_A2;
    const bf16_t* Zq = Z + (size_t)(h >> 1) * M1 * 256 + (h & 1) * 128; const bf16_t* Zk = Z + (size_t)(2 + (h >> 1)) * M1 * 256 + (h & 1) * 128; const bf16_t* Zv = Z + (size_t)(4 + h) * M1 * 256; const bf16_t* Zg = Z + (size_t)(8 + h) * M1 * 256;
    LAS float* eB = (LAS float*)(lds + LEB); LAS float* hnl = (LAS float*)(lds + LHN);
    if (tid < 256) hnl[tid] = P.head_norm[tid];
    f32x16 S[4];
    if (seg > 0) { const float* u = u_slot(P, bh, seg - 1);
#pragma unroll
        for (int cb = 0; cb < 4; ++cb)
#pragma unroll
            for (int r = 0; r < 16; ++r) S[cb][r] = u[(size_t)(32 * cb + crow(r, hi)) * 256 + 32 * wid + r32]; }
    else {
#pragma unroll
        for (int cb = 0; cb < 4; ++cb) S[cb] = f32x16{}; }
    const int nch = 8 + (seg == 0 ? 1 : 0);
    const unsigned lds0 = (unsigned)(size_t)lds;
    const LAS unsigned char* trb = lds + ((lane >> 4) & 1) * 32 + (lane & 3) * 8 + (8 * hi + ((lane & 15) >> 2)) * 64;
#define GO_META(ch) (seg == 0 && (ch) == 0)
#define GO_R0(ch) (GO_META(ch) ? rowb : rowb + NMETA + 64 * (seg * 8 + (ch) - (seg == 0 ? 1 : 0)))
#define GO_CIDX(ch) (GO_META(ch) ? 0 : seg * 8 + (ch) - (seg == 0 ? 1 : 0) + 1)
#define GO_ISSUE_A(ch) do { const int r0_ = GO_R0(ch); \
        _Pragma("unroll") for (int i_ = 0; i_ < 4; ++i_) { const int pc = wid * 4 + i_, db = pc >> 2, rg = pc & 3; \
            att::glds16(Zv + (unsigned)(r0_ + 16 * rg + (lane >> 2)) * 256u + db * 32 + (lane & 3) * 8, (unsigned)__builtin_amdgcn_readfirstlane((int)(lds0 + LV + pc * 1024))); } \
        if (!GO_META(ch)) { _Pragma("unroll") for (int i_ = 0; i_ < 2; ++i_) { const int chk = wid * 2 + i_; \
            att::glds16(Zq + (unsigned)(r0_ + lane) * 256u + chk * 8, (unsigned)__builtin_amdgcn_readfirstlane((int)(lds0 + LQD + chk * 1024))); \
            att::glds16(Zk + (unsigned)(r0_ + lane) * 256u + chk * 8, (unsigned)__builtin_amdgcn_readfirstlane((int)(lds0 + LKD + chk * 1024))); } } } while (0)
#define GO_ISSUE_B(ch) do { const int r0_ = GO_R0(ch); \
        _Pragma("unroll") for (int i_ = 0; i_ < 2; ++i_) { const int pc = wid * 2 + i_, cb = pc >> 2, rg = pc & 3; \
            att::glds16(Zk + (unsigned)(r0_ + 16 * rg + (lane >> 2)) * 256u + cb * 32 + (lane & 3) * 8, (unsigned)__builtin_amdgcn_readfirstlane((int)(lds0 + LKW + pc * 1024))); } \
        if (wid == 0) att::glds16(eb_slot(P, b, GO_CIDX(ch)) + h * 128 + lane * 4, (unsigned)__builtin_amdgcn_readfirstlane((int)(lds0 + LEB))); } while (0)
    GO_ISSUE_A(0); GO_ISSUE_B(0);
    for (int ch = 0; ch < nch; ++ch) {
        const bool outc = !GO_META(ch); const int r0 = GO_R0(ch);
        if (ch > 0 && !GO_META(ch - 1)) asm volatile("s_waitcnt vmcnt(2) lgkmcnt(0)\n\ts_barrier" ::: "memory");
        else asm volatile("s_waitcnt vmcnt(0) lgkmcnt(0)\n\ts_barrier" ::: "memory");
        u32x4 rgv[4];
        if (outc) { const unsigned rgo_ = ((unsigned)(r0 + (tid >> 3)) * 256u + (tid & 7) * 32) * 2u;
#pragma unroll
            for (int q = 0; q < 4; ++q) rgv[q] = *(const u32x4*)((const unsigned char*)Zg + rgo_ + q * 16); }
        f32x16 o[2];
        if (outc) {
            if (wid < 4) { const int sb = wid & 1, tb = wid >> 1; f32x16 x = f32x16{};
                if (!(sb == 1 && tb == 0)) {
#pragma unroll
                    for (int ks = 0; ks < 8; ++ks) { const bf16x8 a = *(const LAS bf16x8*)(lds + LKD + (2 * ks + hi) * 1024 + (32 * sb + r32) * 16), bq = *(const LAS bf16x8*)(lds + LQD + (2 * ks + hi) * 1024 + (32 * tb + r32) * 16);
                        x = __builtin_amdgcn_mfma_f32_32x32x16_bf16(a, bq, x, 0, 0, 0); }
                    if (sb == tb) {
#pragma unroll
                        for (int r = 0; r < 16; ++r) if (crow(r, hi) > r32) x[r] = 0.f; }
                }
#pragma unroll
                for (int g = 0; g < 4; ++g) { u32x2 w; w.x = cvt_pk_bf16(x[4 * g], x[4 * g + 1]); w.y = cvt_pk_bf16(x[4 * g + 2], x[4 * g + 3]);
                    *(LAS u32x2*)(lds + LP + (32 * tb + r32) * PST + (32 * sb + 8 * g + 4 * hi) * 2) = w; } }
            o[0] = f32x16{}; o[1] = f32x16{};
#pragma unroll
            for (int cb = 0; cb < 4; ++cb)
#pragma unroll
                for (int s2 = 0; s2 < 2; ++s2) { u32x4 sw;
#pragma unroll
                    for (int j = 0; j < 4; ++j) sw[j] = cvt_pk_bf16(S[cb][8 * s2 + 2 * j], S[cb][8 * s2 + 2 * j + 1]);
                    const int kst = 2 * cb + s2;
#pragma unroll
                    for (int tb = 0; tb < 2; ++tb) { const LAS unsigned char* ap = lds + LQD + (2 * kst) * 1024 + (32 * tb + r32) * 16 + 8 * hi;
                        const u32x2 a0 = *(const LAS u32x2*)ap, a1 = *(const LAS u32x2*)(ap + 1024); const u32x4 a = (u32x4){a0.x, a0.y, a1.x, a1.y};
                        o[tb] = __builtin_amdgcn_mfma_f32_32x32x16_bf16(__builtin_bit_cast(bf16x8, a), __builtin_bit_cast(bf16x8, sw), o[tb], 0, 0, 0); } }
        }
        const int nks = outc ? 4 : 1;
        bf16x8 vf[4];
#pragma unroll
        for (int ks = 0; ks < 4; ++ks) { const s16x4 lo = vtr(trb + LV + (wid * 4 + ks) * 1024), h4 = vtr(trb + LV + (wid * 4 + ks) * 1024 + 256); vf[ks] = (bf16x8){lo[0], lo[1], lo[2], lo[3], h4[0], h4[1], h4[2], h4[3]}; }
        asm volatile("s_waitcnt lgkmcnt(0)\n\ts_barrier" ::: "memory");
        if (outc) asm volatile("" :: "v"(rgv[0]), "v"(rgv[1]), "v"(rgv[2]), "v"(rgv[3]));
        if (ch + 1 < nch) GO_ISSUE_A(ch + 1);
        if (outc) {
#pragma unroll
            for (int ks = 0; ks < 4; ++ks)
#pragma unroll
                for (int tb = 0; tb < 2; ++tb) { const bf16x8 a = *(const LAS bf16x8*)(lds + LP + (32 * tb + r32) * PST + (16 * ks + 8 * hi) * 2);
                    o[tb] = __builtin_amdgcn_mfma_f32_32x32x16_bf16(a, vf[ks], o[tb], 0, 0, 0); }
#pragma unroll
            for (int tb = 0; tb < 2; ++tb)
#pragma unroll
                for (int r = 0; r < 16; ++r) *(LAS bf16_t*)(lds + LOS + (32 * tb + crow(r, hi)) * OST + (32 * wid + r32) * 2) = (bf16_t)f2bf(o[tb][r]);
        }
#pragma unroll
        for (int cb = 0; cb < 4; ++cb) {
#pragma unroll
            for (int ks = 0; ks < 4; ++ks) if (ks < nks) { const s16x4 lo = vtr(trb + LKW + (cb * 4 + ks) * 1024), h4 = vtr(trb + LKW + (cb * 4 + ks) * 1024 + 256);
                const bf16x8 kf = (bf16x8){lo[0], lo[1], lo[2], lo[3], h4[0], h4[1], h4[2], h4[3]};
                S[cb] = __builtin_amdgcn_mfma_f32_32x32x16_bf16(kf, vf[ks], S[cb], 0, 0, 0); }
#pragma unroll
            for (int g = 0; g < 4; ++g) { const f32x4 e4 = *(const LAS f32x4*)(eB + 32 * cb + 8 * g + 4 * hi); S[cb][4 * g] *= e4.x; S[cb][4 * g + 1] *= e4.y; S[cb][4 * g + 2] *= e4.z; S[cb][4 * g + 3] *= e4.w; } }
        asm volatile("s_waitcnt lgkmcnt(0)\n\ts_barrier" ::: "memory");
        if (ch + 1 < nch) GO_ISSUE_B(ch + 1);
        if (outc) {
            const int t = tid >> 3, j8 = tid & 7; const size_t row = (size_t)(r0 + t);
            float ss = 0.f;
#pragma unroll
            for (int q = 0; q < 4; ++q) { const u32x4 a = *(const LAS u32x4*)(lds + LOS + t * OST + j8 * 64 + q * 16);
                const float v0 = bflo(a.x), v1 = bfhi(a.x), v2 = bflo(a.y), v3 = bfhi(a.y), v4 = bflo(a.z), v5 = bfhi(a.z), v6 = bflo(a.w), v7 = bfhi(a.w);
                ss += v0 * v0 + v1 * v1 + v2 * v2 + v3 * v3 + v4 * v4 + v5 * v5 + v6 * v6 + v7 * v7; }
            ss += __shfl_xor(ss, 1); ss += __shfl_xor(ss, 2); ss += __shfl_xor(ss, 4);
            const float rn = __builtin_amdgcn_rsqf(ss * (1.f / 256.f) + RMS_EPS);
            u32x2* dst = (u32x2*)(A28 + row * D + h * 256 + j8 * 32);
#pragma unroll
            for (int q = 0; q < 4; ++q) { const u32x4 a = *(const LAS u32x4*)(lds + LOS + t * OST + j8 * 64 + q * 16);
                const float v[8] = {bflo(a.x), bfhi(a.x), bflo(a.y), bfhi(a.y), bflo(a.z), bfhi(a.z), bflo(a.w), bfhi(a.w)};
                const u32x4 g4 = rgv[q]; const float gv[8] = {bflo(g4.x), bfhi(g4.x), bflo(g4.y), bfhi(g4.y), bflo(g4.z), bfhi(g4.z), bflo(g4.w), bfhi(g4.w)}; float y[8];
#pragma unroll
                for (int e = 0; e < 8; ++e) y[e] = v[e] * (rn * F8_ASCALE) * hnl[j8 * 32 + 8 * q + e] * (gv[e] * __builtin_amdgcn_rcpf(1.f + __builtin_amdgcn_exp2f(gv[e] * -1.44269504f)));
                u32x2 w; w.x = pk4_fp8(y[0], y[1], y[2], y[3]); w.y = pk4_fp8(y[4], y[5], y[6], y[7]); dst[q] = w;
                __builtin_amdgcn_sched_barrier(0); }
        }
    }
    asm volatile("s_waitcnt vmcnt(0) lgkmcnt(0)\n\ts_barrier" ::: "memory");
#undef GO_META
#undef GO_R0
#undef GO_CIDX
#undef GO_ISSUE_A
#undef GO_ISSUE_B
}
template <bool OUT> __device__ __forceinline__ void segment(const Ptrs& P, LAS unsigned char* lds, int bh, int seg) {
    const int tid = tid_opaque(P), lane = tid & 63, r32 = lane & 31, hi = lane >> 5; const int wid = __builtin_amdgcn_readfirstlane(tid >> 6);
    const int b = bh >> 2, h = bh & 3, rowb = b * LB;
    const bf16_t* Z = (const bf16_t*)(P.ws + WS_Z); unsigned char* A28 = P.ws + WS_A2;
    LAS float* eB = (LAS float*)(lds + LEB); LAS float* hnl = (LAS float*)(lds + LHN);
    if (OUT && tid < 256) hnl[tid] = P.head_norm[tid];
    f32x16 S[4];
    if (OUT && seg > 0) { const float* u = u_slot(P, bh, seg - 1);
#pragma unroll
        for (int cb = 0; cb < 4; ++cb)
#pragma unroll
            for (int r = 0; r < 16; ++r) S[cb][r] = u[(size_t)(32 * cb + crow(r, hi)) * 256 + 32 * wid + r32]; }
    else {
#pragma unroll
        for (int cb = 0; cb < 4; ++cb) S[cb] = f32x16{}; }
    float aprod = 1.f;
    const int nch = 8 + (seg == 0 ? 1 : 0);
    const LAS unsigned char* trb = lds + ((lane >> 4) & 1) * 32 + (lane & 3) * 8 + (8 * hi + ((lane & 15) >> 2)) * 64;
    for (int ch = 0; ch < nch; ++ch) {
        const bool metac = (seg == 0 && ch == 0);
        const int cj = seg * 8 + ch - (seg == 0 ? 1 : 0);
        const int r0 = metac ? rowb : rowb + NMETA + 64 * cj;
        const float* ebg = eb_slot(P, b, metac ? 0 : cj + 1) + h * 128;
#pragma unroll
        for (int i_ = 0; i_ < 4; ++i_) { const int pc = wid * 4 + i_, db = pc >> 2, rg = pc & 3;
            __builtin_amdgcn_global_load_lds((const unsigned*)(Z + (size_t)(r0 + 16 * rg + (lane >> 2)) * ODD_N + 1024 + h * 256 + db * 32 + (lane & 3) * 8), (LAS unsigned*)(lds + LV + pc * 1024), 16, 0, 0); }
#pragma unroll
        for (int i_ = 0; i_ < 2; ++i_) { const int pc = wid * 2 + i_, cb = pc >> 2, rg = pc & 3;
            __builtin_amdgcn_global_load_lds((const unsigned*)(Z + (size_t)(r0 + 16 * rg + (lane >> 2)) * ODD_N + 512 + h * 128 + cb * 32 + (lane & 3) * 8), (LAS unsigned*)(lds + LKW + pc * 1024), 16, 0, 0); }
        const bool outc = OUT && !metac;
        u32x4 rgv[4];
        if (outc) { const u32x4* rgp = (const u32x4*)(Z + Z1AT(r0 + (tid >> 3), 2048 + h * 256 + (tid & 7) * 32));
#pragma unroll
            for (int q = 0; q < 4; ++q) rgv[q] = rgp[q]; }
        if (outc) {
#pragma unroll
            for (int i_ = 0; i_ < 2; ++i_) { const int chk = wid * 2 + i_;
                __builtin_amdgcn_global_load_lds((const unsigned*)(Z + (size_t)(r0 + lane) * ODD_N + h * 128 + chk * 8), (LAS unsigned*)(lds + LQD + chk * 1024), 16, 0, 0);
                __builtin_amdgcn_global_load_lds((const unsigned*)(Z + (size_t)(r0 + lane) * ODD_N + 512 + h * 128 + chk * 8), (LAS unsigned*)(lds + LKD + chk * 1024), 16, 0, 0); } }
        if (tid < 128) { const float e = ebg[tid]; eB[tid] = e; aprod *= e; }
        __syncthreads();
        f32x16 o[2];
        if (outc) {
            if (wid < 4) { const int sb = wid & 1, tb = wid >> 1; f32x16 x = f32x16{};
                if (!(sb == 1 && tb == 0)) {
#pragma unroll
                    for (int ks = 0; ks < 8; ++ks) { const bf16x8 a = *(const LAS bf16x8*)(lds + LKD + (2 * ks + hi) * 1024 + (32 * sb + r32) * 16), bq = *(const LAS bf16x8*)(lds + LQD + (2 * ks + hi) * 1024 + (32 * tb + r32) * 16);
                        x = __builtin_amdgcn_mfma_f32_32x32x16_bf16(a, bq, x, 0, 0, 0); }
                    if (sb == tb) {
#pragma unroll
                        for (int r = 0; r < 16; ++r) if (crow(r, hi) > r32) x[r] = 0.f; }
                }
#pragma unroll
                for (int g = 0; g < 4; ++g) { u32x2 w; w.x = cvt_pk_bf16(x[4 * g], x[4 * g + 1]); w.y = cvt_pk_bf16(x[4 * g + 2], x[4 * g + 3]);
                    *(LAS u32x2*)(lds + LP + (32 * tb + r32) * PST + (32 * sb + 8 * g + 4 * hi) * 2) = w; } }
            o[0] = f32x16{}; o[1] = f32x16{};
#pragma unroll
            for (int cb = 0; cb < 4; ++cb)
#pragma unroll
                for (int s2 = 0; s2 < 2; ++s2) { u32x4 sw;
#pragma unroll
                    for (int j = 0; j < 4; ++j) sw[j] = cvt_pk_bf16(S[cb][8 * s2 + 2 * j], S[cb][8 * s2 + 2 * j + 1]);
                    const int kst = 2 * cb + s2;
#pragma unroll
                    for (int tb = 0; tb < 2; ++tb) { const LAS unsigned char* ap = lds + LQD + (2 * kst) * 1024 + (32 * tb + r32) * 16 + 8 * hi;
                        const u32x2 a0 = *(const LAS u32x2*)ap, a1 = *(const LAS u32x2*)(ap + 1024); const u32x4 a = (u32x4){a0.x, a0.y, a1.x, a1.y};
                        o[tb] = __builtin_amdgcn_mfma_f32_32x32x16_bf16(__builtin_bit_cast(bf16x8, a), __builtin_bit_cast(bf16x8, sw), o[tb], 0, 0, 0); } }
            __syncthreads();
        }
        const int nks = metac ? 1 : 4;
        bf16x8 vf[4];
#pragma unroll
        for (int ks = 0; ks < 4; ++ks) { const s16x4 lo = vtr(trb + LV + (wid * 4 + ks) * 1024), h4 = vtr(trb + LV + (wid * 4 + ks) * 1024 + 256); vf[ks] = (bf16x8){lo[0], lo[1], lo[2], lo[3], h4[0], h4[1], h4[2], h4[3]}; }
        if (outc) {
#pragma unroll
            for (int ks = 0; ks < 4; ++ks)
#pragma unroll
                for (int tb = 0; tb < 2; ++tb) { const bf16x8 a = *(const LAS bf16x8*)(lds + LP + (32 * tb + r32) * PST + (16 * ks + 8 * hi) * 2);
                    o[tb] = __builtin_amdgcn_mfma_f32_32x32x16_bf16(a, vf[ks], o[tb], 0, 0, 0); }
#pragma unroll
            for (int tb = 0; tb < 2; ++tb)
#pragma unroll
                for (int r = 0; r < 16; ++r) *(LAS bf16_t*)(lds + LOS + (32 * tb + crow(r, hi)) * OST + (32 * wid + r32) * 2) = (bf16_t)f2bf(o[tb][r]);
        }
#pragma unroll
        for (int cb = 0; cb < 4; ++cb) {
#pragma unroll
            for (int ks = 0; ks < 4; ++ks) if (ks < nks) { const s16x4 lo = vtr(trb + LKW + (cb * 4 + ks) * 1024), h4 = vtr(trb + LKW + (cb * 4 + ks) * 1024 + 256);
                const bf16x8 kf = (bf16x8){lo[0], lo[1], lo[2], lo[3], h4[0], h4[1], h4[2], h4[3]};
                S[cb] = __builtin_amdgcn_mfma_f32_32x32x16_bf16(kf, vf[ks], S[cb], 0, 0, 0); }
#pragma unroll
            for (int g = 0; g < 4; ++g) { const f32x4 e4 = *(const LAS f32x4*)(eB + 32 * cb + 8 * g + 4 * hi); S[cb][4 * g] *= e4.x; S[cb][4 * g + 1] *= e4.y; S[cb][4 * g + 2] *= e4.z; S[cb][4 * g + 3] *= e4.w; } }
        __syncthreads();
        if (outc) {
            const int t = tid >> 3, j8 = tid & 7; const size_t row = (size_t)(r0 + t);
            float ss = 0.f;
#pragma unroll
            for (int q = 0; q < 4; ++q) { const u32x4 a = *(const LAS u32x4*)(lds + LOS + t * OST + j8 * 64 + q * 16);
                const float v0 = bflo(a.x), v1 = bfhi(a.x), v2 = bflo(a.y), v3 = bfhi(a.y), v4 = bflo(a.z), v5 = bfhi(a.z), v6 = bflo(a.w), v7 = bfhi(a.w);
                ss += v0 * v0 + v1 * v1 + v2 * v2 + v3 * v3 + v4 * v4 + v5 * v5 + v6 * v6 + v7 * v7; }
            ss += __shfl_xor(ss, 1); ss += __shfl_xor(ss, 2); ss += __shfl_xor(ss, 4);
            const float rn = __builtin_amdgcn_rsqf(ss * (1.f / 256.f) + RMS_EPS);
            u32x2* dst = (u32x2*)(A28 + row * D + h * 256 + j8 * 32);
#pragma unroll
            for (int q = 0; q < 4; ++q) { const u32x4 a = *(const LAS u32x4*)(lds + LOS + t * OST + j8 * 64 + q * 16);
                const float v[8] = {bflo(a.x), bfhi(a.x), bflo(a.y), bfhi(a.y), bflo(a.z), bfhi(a.z), bflo(a.w), bfhi(a.w)};
                const u32x4 g4 = rgv[q]; const float gv[8] = {bflo(g4.x), bfhi(g4.x), bflo(g4.y), bfhi(g4.y), bflo(g4.z), bfhi(g4.z), bflo(g4.w), bfhi(g4.w)}; float y[8];
#pragma unroll
                for (int e = 0; e < 8; ++e) y[e] = v[e] * (rn * F8_ASCALE) * hnl[j8 * 32 + 8 * q + e] * (gv[e] * __builtin_amdgcn_rcpf(1.f + __builtin_amdgcn_exp2f(gv[e] * -1.44269504f)));
                u32x2 w; w.x = pk4_fp8(y[0], y[1], y[2], y[3]); w.y = pk4_fp8(y[4], y[5], y[6], y[7]); dst[q] = w;
                __builtin_amdgcn_sched_barrier(0); }
        }
    }
    if (!OUT) { float* u = u_slot(P, bh, seg);
#pragma unroll
        for (int cb = 0; cb < 4; ++cb)
#pragma unroll
            for (int r = 0; r < 16; ++r) u[(size_t)(32 * cb + crow(r, hi)) * 256 + 32 * wid + r32] = S[cb][r];
        if (tid < 128) a_slot(P, bh, seg)[tid] = aprod; }
    __syncthreads();
}
}
template <bool OUT> __device__ __forceinline__ void stage_gla_seg(const Ptrs& P, LAS unsigned char* lds, int wg, int nwg) {
    for (int u = wg; u < 256; u += nwg) { if constexpr (OUT) gla::segment_out(P, lds, u >> 4, u & 15); else gla::segment_state(P, lds, u >> 4, u & 15); }
}
__device__ __forceinline__ void stage_gla_scan(const Ptrs& P, int wg, int nwg) {
    const int tid_ = tid_opaque(P);
    for (int idx = wg * 512 + tid_; idx < 16 * 32768; idx += nwg * 512) { const int bh = idx >> 15, e = idx & 32767, cch = e >> 8;
        float uv[15], av[15];
#pragma unroll
        for (int sg = 0; sg < 15; ++sg) { uv[sg] = gla::u_slot(P, bh, sg)[e]; av[sg] = gla::a_slot(P, bh, sg)[cch]; }
        float Sv = 0.f;
#pragma unroll
        for (int sg = 0; sg < 15; ++sg) { Sv = av[sg] * Sv + uv[sg]; gla::u_slot(P, bh, sg)[e] = Sv; } }
}

#define XB_TMO      128
#define XB_XCNT(j)  (256  + 64 * (j))
#define XB_XSUB(j)  (1280 + 64 * (j))
#define XB_XGEN(j)  (2304 + 64 * (j))
#define XB_TOP      3328
#define XB_TOPGEN   3392
#define XCD_BAR_WORDS 3456
#define XB_SPIN_CAP (1u << 18)
__device__ __forceinline__ unsigned xb_ld(unsigned* p)              { return __hip_atomic_load(p, __ATOMIC_RELAXED, __HIP_MEMORY_SCOPE_AGENT); }
__device__ __forceinline__ unsigned xb_add(unsigned* p, unsigned v) { return __hip_atomic_fetch_add(p, v, __ATOMIC_RELAXED, __HIP_MEMORY_SCOPE_AGENT); }
__device__ __forceinline__ unsigned xb_xcc_id() { return (unsigned)__builtin_amdgcn_s_getreg((3 << 11) | 20) & 0xFu; }
#define XB_SPIN(cond, bar) do { unsigned _sp = 0; while (cond) { __builtin_amdgcn_s_sleep(1); \
    if ((++_sp & 255u) == 0u) { if (xb_ld(&(bar)[XB_TMO])) break; if (_sp > XB_SPIN_CAP) { atomicAdd(&(bar)[XB_TMO], 1u); break; } } } } while (0)
struct XcdBarrier { unsigned* bar; unsigned x; volatile LAS unsigned* st; };
__device__ __forceinline__ XcdBarrier xcd_barrier_post(unsigned* bar, volatile LAS unsigned* st, const bool t0) {
    XcdBarrier b; b.bar = bar; b.x = xb_xcc_id(); b.st = st;
    if (t0) (void)xb_add(&bar[XB_XCNT(b.x)], 1u);
    return b;
}
__device__ __forceinline__ void xcd_barrier_complete(unsigned* bar, unsigned x, unsigned& nloc, unsigned& nx) {
    const unsigned G = gridDim.x * gridDim.y * gridDim.z;
    unsigned sum, cnt, mine, sp = 0u;
    for (;;) {
        sum = 0u; cnt = 0u; mine = 0u;
#pragma unroll
        for (unsigned j = 0; j < 16; ++j) { const unsigned c = xb_ld(&bar[XB_XCNT(j)]); sum += c; cnt += (c > 0u) ? 1u : 0u; mine = (j == x) ? c : mine; }
        if (sum == G) break;
        __builtin_amdgcn_s_sleep(1);
        if ((++sp & 255u) == 0u) { if (xb_ld(&bar[XB_TMO])) break; if (sp > XB_SPIN_CAP) { atomicAdd(&bar[XB_TMO], 1u); break; } }
    }
    nloc = mine > 0u ? mine : 1u; nx = cnt > 0u ? cnt : 1u;
}
__device__ __forceinline__ void xcd_barrier(const XcdBarrier& b, const bool t0) {
    asm volatile("s_waitcnt vmcnt(0)" ::: "memory");
    __syncthreads();
    if (t0) {
        unsigned* bar = b.bar;
        __builtin_amdgcn_s_waitcnt(0);
        unsigned nloc = b.st[0], nx = b.st[1];
        if (nloc == 0u) { xcd_barrier_complete(bar, b.x, nloc, nx); b.st[0] = nloc; b.st[1] = nx; }
        const unsigned old = xb_add(&bar[XB_XSUB(b.x)], 1u);
        const unsigned gen = old / nloc;
        if (old + 1u == (gen + 1u) * nloc) {
            __builtin_amdgcn_fence(__ATOMIC_RELEASE, "agent");
            asm volatile("s_waitcnt vmcnt(0)" ::: "memory");
            const unsigned og = xb_add(&bar[XB_TOP], 1u);
            const unsigned tg = og / nx;
            if (og + 1u == (tg + 1u) * nx) xb_add(&bar[XB_TOPGEN], 1u);
            else XB_SPIN(xb_ld(&bar[XB_TOPGEN]) == tg, bar);
            __builtin_amdgcn_fence(__ATOMIC_ACQUIRE, "agent");
            xb_add(&bar[XB_XGEN(b.x)], 1u);
            asm volatile("s_waitcnt vmcnt(0)" ::: "memory");
        } else {
            XB_SPIN(xb_ld(&bar[XB_XGEN(b.x)]) == gen, bar);
            __builtin_amdgcn_fence(__ATOMIC_ACQUIRE, "agent");
            asm volatile("s_waitcnt vmcnt(0)" ::: "memory");
        }
    }
    __syncthreads();
}

constexpr int LDS_BYTES = 147456;
constexpr int LDS_CTL = 131072;
constexpr int CW_BAR = 4096;
enum GemmKind { G_IN0 = 0, G_OUT0, G_GU0, G_DN0, G_IN1, G_OUT1, G_GU1, G_DN1 };
__device__ __forceinline__ void moe_setup(const Ptrs& P, int layer, LAS int* tstart, LAS int* cnt, const int tid) {
    if (tid < 64) { const unsigned* g = (const unsigned*)(P.ws + WS_CTL) + CW_CNT + 64 * layer;
        const int c = tid < 16 ? (int)__hip_atomic_load(g + tid, __ATOMIC_RELAXED, __HIP_MEMORY_SCOPE_AGENT) : 0; const int tiles = (c + 255) >> 8; int incl = tiles;
#pragma unroll
        for (int d = 1; d < 16; d <<= 1) { const int o = __shfl_up(incl, d); if (tid >= d) incl += o; }
        if (tid < 16) { cnt[tid] = c; tstart[tid] = incl - tiles; }
        if (tid == 15) tstart[16] = incl; }
    __syncthreads();
}
template <int KIND> __device__ __forceinline__ void stage_gemm(const Ptrs& P, LAS unsigned char* lds, int wg, int nwg) {
    const int tid = tid_opaque(P);
    LAS unsigned char* ring = lds; LAS int* tstart = (LAS int*)(lds + LDS_CTL + 256); LAS int* cnt = (LAS int*)(lds + LDS_CTL + 384);
    const bf16_t* Hb = (const bf16_t*)(P.ws + WS_HB); bf16_t* Z = (bf16_t*)(P.ws + WS_Z); const unsigned char* A28 = P.ws + WS_A2; const bf16_t* A2m = (const bf16_t*)(P.ws + WS_A2M); bf16_t* T = (bf16_t*)(P.ws + WS_T);
    unsigned char* ACT = P.ws + WS_ACT; unsigned char* YK = P.ws + WS_YK;
    if constexpr (KIND == G_IN0) { meta_gemm<0>(lds, Hb, Hb, (const bf16_t*)(P.ws + W_IN0), EVEN_IN, Z, 0, 512, 1024, QSCALE0, wg, nwg, tid, (unsigned*)(P.ws + WS_CTL) + CW_KN + 64);
        DenseSched S; S.init(EVEN_IN / 256, nwg, wg, 1024); EpiBf16 E{Z, EVEN_IN, EVEN_IN, 2, 4, QSCALE0, (unsigned*)(P.ws + WS_CTL) + CW_KN, 4, 1};
        pg8::gemm_phase<EpiBf16, DenseSched, true>(ring, P.ws + WS_HB8, P.ws + W_IN08, 1024, 1024, S, E, tid, F8_HSC, F8_WSC); }
    else if constexpr (KIND == G_OUT0) { meta_gemm<1>(lds, A2m, Hb, (const bf16_t*)(P.ws + W_OUT0), 1024, T, D, 0, 0, 1.f, wg, nwg, tid);
        DenseSched S; S.init(4, nwg, wg, 1024); EpiResBf16 E{Hb, T};
        pg8::gemm_phase<EpiResBf16, DenseSched, true>(ring, A28, P.ws + W_OUT08, 1024, 1024, S, E, tid, F8_ASC, F8_WSC); }
    else if constexpr (KIND == G_IN1) { meta_gemm<0>(lds, Hb, Hb, (const bf16_t*)(P.ws + W_IN1), ODD_N, Z, 0, 0, 512, QSCALE1, wg, nwg, tid);
        DenseSched S; S.init(ODD_N / 256, nwg, wg, 1024); EpiBf16 E{Z, ODD_N, ODD_N, 0, 2, QSCALE1, nullptr, 0, 1};
        pg8::gemm_phase<EpiBf16, DenseSched, true>(ring, P.ws + WS_HB8, P.ws + W_IN18, 1024, 1024, S, E, tid, F8_HSC, F8_WSC); }
    else if constexpr (KIND == G_OUT1) { DenseSched S; S.init(4, nwg, wg, 1024); EpiResBf16 E{Hb, T};
        pg8::gemm_phase<EpiResBf16, DenseSched, true>(ring, A28, P.ws + W_OUT18, 1024, 1024, S, E, tid, F8_ASC, F8_WSC); }
    else if constexpr (KIND == G_GU0 || KIND == G_GU1) { constexpr int layer = KIND == G_GU0 ? 0 : 1; moe_setup(P, layer, tstart, cnt, tid);
        MoeSchedT<true> S{tstart, cnt, (const int*)(P.ws + WS_LIST), (const float*)(P.ws + WS_LISTW), 4, nwg, wg, 1024, (size_t)layer * 16 * 1024 * 1024, (const LAS int*)(lds + LDS_CTL + 1024)}; EpiSiluMul E{ACT};
        pg8::gemm_phase<EpiSiluMul, MoeSchedT<true>, true, true>(ring, P.ws + WS_HB8, P.ws + W_GU, 1024, 1024, S, E, tid, F8_HSC, F8_WSC); }
    else { constexpr int layer = KIND == G_DN0 ? 0 : 1; moe_setup(P, layer, tstart, cnt, tid);
        MoeSchedT<false> S{tstart, cnt, (const int*)(P.ws + WS_LIST), (const float*)(P.ws + WS_LISTW), 4, nwg, wg, 512, (size_t)layer * 16 * 1024 * 512, nullptr}; EpiScatter E{YK, (LAS int*)(lds + LDS_CTL + 1024), (LAS float*)(lds + LDS_CTL + 3072)};
        pg8::gemm_phase<EpiScatter, MoeSchedT<false>, true, true>(ring, ACT, P.ws + W_DN, 512, 512, S, E, tid, F8_ASC, F8_WSC); }
}

constexpr int NPHASE = 19;
struct Args { Ptrs P; int lo, hi, flags, pad; };
__global__ void __launch_bounds__(512, 2) mega(Args a) {
    extern __shared__ __attribute__((aligned(16))) unsigned char lds_[];
    LAS unsigned char* lds = (LAS unsigned char*)lds_;
    const Ptrs& P = a.P;
    const int wg = blockIdx.x, nwg = gridDim.x, lo = a.lo, hi = a.hi;
    for (int u = threadIdx.x; u < (LDS_BYTES - LDS_CTL) / 4; u += 512) ((LAS unsigned*)(lds + LDS_CTL))[u] = 0u;
    __syncthreads();
    if ((threadIdx.x & 63) == 0) ((volatile LAS int*)(lds + LDS_WIDTAB))[hw_wave_key()] = (int)(threadIdx.x >> 6);
    __syncthreads();
    XcdBarrier bar; bar.bar = (unsigned*)(P.ws + WS_CTL) + CW_BAR; bar.x = 0; bar.st = nullptr;
    const bool multi = (hi - lo) > 1;
    if (multi) bar = xcd_barrier_post((unsigned*)(P.ws + WS_CTL) + CW_BAR, (volatile LAS unsigned*)(lds + LDS_CTL) + 8, tid_opaque(P) == 0);
#define IN(k) (lo <= (k) && (k) < hi)
#define SEAM(k) do { if (IN(k) && IN((k) + 1)) xcd_barrier(bar, tid_opaque(P) == 0); } while (0)
#define RUN(k, ...) do { if (IN(k)) { __VA_ARGS__; } SEAM(k); } while (0)
    RUN(0, stage_prep(P, lds, wg, nwg));
    RUN(1, stage_gemm<G_IN0>(P, lds, wg, nwg));
    RUN(2, if (!(a.flags & 2)) stage_pool(P, wg, nwg); stage_attn(P, lds, wg, nwg, a.flags));
    RUN(3, stage_combine(P, wg, nwg));
    RUN(4, stage_gemm<G_OUT0>(P, lds, wg, nwg));
    RUN(5, stage_ln<0>(P, lds, wg, nwg));
    RUN(6, stage_gemm<G_GU0>(P, lds, wg, nwg));
    RUN(7, stage_gemm<G_DN0>(P, lds, wg, nwg));
    RUN(8, stage_ln<2>(P, lds, wg, nwg));
    RUN(9, stage_gemm<G_IN1>(P, lds, wg, nwg));
    RUN(10, gla::stage_pre(P, lds, wg, nwg));
    RUN(11, stage_gla_seg<false>(P, lds, wg, nwg));
    RUN(12, stage_gla_scan(P, wg, nwg));
    RUN(13, stage_gla_seg<true>(P, lds, wg, nwg));
    RUN(14, stage_gemm<G_OUT1>(P, lds, wg, nwg));
    RUN(15, stage_ln<1>(P, lds, wg, nwg));
    RUN(16, stage_gemm<G_GU1>(P, lds, wg, nwg));
    RUN(17, stage_gemm<G_DN1>(P, lds, wg, nwg));
    RUN(18, stage_ln<3>(P, lds, wg, nwg));
#undef RUN
#undef IN
#undef SEAM
}

#ifndef MK_MULTI
#define MK_MULTI 0
#endif
extern "C" void kernel_launch(void* const* d_in, const int* in_sizes, int n_in, void* d_out, int out_size, void* d_ws, size_t ws_size, hipStream_t stream) {
    static int grid = 0;
    if (grid == 0) {
        if (n_in != 25 || ws_size < WS_END || out_size != NB * SEQ * D) { fprintf(stderr, "kernel_launch: bad args n_in %d ws %zu (need %zu) out %d\n", n_in, ws_size, (size_t)WS_END, out_size); grid = -1; return; }
        int dev = 0, cus = 0, per_cu = 0;
        if (hipGetDevice(&dev) != hipSuccess || hipDeviceGetAttribute(&cus, hipDeviceAttributeMultiprocessorCount, dev) != hipSuccess) { grid = -1; return; }
        if (hipFuncSetAttribute((const void*)mega, hipFuncAttributeMaxDynamicSharedMemorySize, LDS_BYTES) != hipSuccess) { fprintf(stderr, "kernel_launch: hipFuncSetAttribute failed\n"); grid = -1; return; }
        if (hipOccupancyMaxActiveBlocksPerMultiprocessor(&per_cu, (const void*)mega, 512, LDS_BYTES) != hipSuccess || per_cu < 1) { fprintf(stderr, "kernel_launch: occupancy query says %d blocks/CU\n", per_cu); (void)hipGetLastError(); grid = -1; return; }
        grid = cus;
    }
    if (grid < 0) return;
    (void)hipMemsetAsync((char*)d_ws + WS_CTL, 0, CTL_ZERO, stream);
    Args a{};
    const float** pp = (const float**)&a.P;
    for (int i = 0; i < 25; ++i) pp[i] = (const float*)d_in[i];
    a.P.out = (float*)d_out; a.P.ws = (unsigned char*)d_ws;
#if MK_MULTI
    for (int k = 0; k < NPHASE; ++k) { a.lo = k; a.hi = k + 1; for (int r = 0; r < 1 + (int)((PROBE_DUP >> k) & 1u); ++r) { a.flags = r ? PROBE_FLAGS : 0; hipLaunchKernelGGL(mega, dim3(grid), dim3(512), LDS_BYTES, stream, a); } }
#else
    a.lo = 0; a.hi = NPHASE; hipLaunchKernelGGL(mega, dim3(grid), dim3(512), LDS_BYTES, stream, a);
#endif
}
```
